# Optimizing an MI355X kernel written in HIP

```python
import math
import jax, jax.numpy as jnp
from jax import lax
import numpy as np

D_MODEL = 1024
BATCH = 8
SEQ = 4096
DEPTH = 2

N_META = 16
GRID_W = 64
HEAD_DIM = 64
EPS = 1e-6

SSD_HEADS = 4
SSD_HEAD_DIM = 64
SSD_INNER = SSD_HEADS * SSD_HEAD_DIM
SSD_GROUPS = 2
SSD_STATE = 128
SSD_CONV = 5
SSD_CHUNK = 128
SSD_CONV_DIM = SSD_INNER + 2 * SSD_GROUPS * SSD_STATE

GLA_HEADS = 4
GLA_DK = 32
GLA_DV = 64
GLA_KEY = GLA_HEADS * GLA_DK
GLA_VAL = GLA_HEADS * GLA_DV
GLA_GATE_RANK = 16
GLA_GATE_NORM = 16.0
GLA_CHUNK = 64

SWA_Q_HEADS = 4
SWA_KV_HEADS = 2
WINDOW = 128
ATT_BLOCK = 128

G2_Q_HEADS = 4
G2_KV_HEADS = 2
ROPE_THETA = 10000.0

REL_BUCKETS = 32
REL_MAX_DIST = 128

MIX_WIDTH = SSD_INNER + GLA_VAL + SWA_Q_HEADS * HEAD_DIM + G2_Q_HEADS * HEAD_DIM

FFN_DENSE = 2816
N_EXPERTS = 8
TOP_K = 2
FFN_EXPERT = 3584

IN_SIZES = (
    SSD_INNER, SSD_CONV_DIM, 2 * SSD_HEADS,
    GLA_KEY, GLA_KEY, GLA_VAL, GLA_VAL, 2 * GLA_GATE_RANK,
    SWA_Q_HEADS * HEAD_DIM, SWA_KV_HEADS * HEAD_DIM, SWA_KV_HEADS * HEAD_DIM,
    G2_Q_HEADS * HEAD_DIM, G2_KV_HEADS * HEAD_DIM, G2_KV_HEADS * HEAD_DIM,
)
IN_WIDTH = sum(IN_SIZES)

kernel_name = 'hybrid_parallel_heads_encoder'


def _rmsnorm(x, w):
    xf = x.astype(jnp.float32)
    xf = xf * lax.rsqrt(jnp.mean(jnp.square(xf), axis=-1, keepdims=True) + EPS)
    return (xf * w.astype(jnp.float32)).astype(x.dtype)


def _pad_front(t, n):
    return jnp.pad(t, [(0, 0), (n, 0)] + [(0, 0)] * (t.ndim - 2))


def _flip(t):
    return jnp.flip(t, axis=1)


def _scan_states(decay, states):
    def step(s, inp):
        d, st = inp
        return d * s + st, s
    s0 = jnp.zeros_like(states[:, 0])
    _, s_in = lax.scan(step, s0, (jnp.moveaxis(decay, 1, 0), jnp.moveaxis(states, 1, 0)))
    return jnp.moveaxis(s_in, 0, 1)


def _depthwise_conv_centred(u, w, b):
    k = w.shape[0]
    out = lax.conv_general_dilated(u, w[:, None, :].astype(u.dtype), window_strides=(1,),
                                   padding=[((k - 1) // 2, k // 2)],
                                   dimension_numbers=('NWC', 'WIO', 'NWC'),
                                   feature_group_count=u.shape[-1])
    return out + b.astype(u.dtype)


def _ssd_chunked(x, dt, a, b, c):
    bsz, t, h, p = x.shape
    q = SSD_CHUNK
    nc = t // q
    xd = (x * dt[..., None]).reshape(bsz, nc, q, h, p)
    a_cs = jnp.cumsum((dt * a).reshape(bsz, nc, q, h), axis=2)
    b = b.reshape(bsz, nc, q, h, -1)
    c = c.reshape(bsz, nc, q, h, -1)
    causal = jnp.tril(jnp.ones((q, q), bool))[..., None]
    seg = a_cs[:, :, :, None, :] - a_cs[:, :, None, :, :]
    decay = jnp.exp(jnp.where(causal, seg, -jnp.inf))
    scores = jnp.einsum('bclhn,bcshn->bclsh', c, b) * decay
    y_diag = jnp.einsum('bclsh,bcshp->bclhp', scores, xd)
    decay_to_end = jnp.exp(a_cs[:, :, -1:, :] - a_cs)
    chunk_states = jnp.einsum('bclhn,bclhp->bchpn', b * decay_to_end[..., None], xd)
    s_in = _scan_states(jnp.exp(a_cs[:, :, -1, :])[..., None, None], chunk_states)
    y_off = jnp.einsum('bclhn,bchpn->bclhp', c, s_in) * jnp.exp(a_cs)[..., None]
    return (y_diag + y_off).reshape(bsz, t, h, p)


def _ssd_mixer(z, xbc, dt_raw, conv_w, conv_b, dt_bias, a_log, d_skip, norm_w):
    f32 = jnp.float32
    bsz, L, _ = xbc.shape
    xbc = jax.nn.silu(_depthwise_conv_centred(xbc, conv_w, conv_b)).astype(f32)
    xs, bs, cs = jnp.split(xbc, [SSD_INNER, SSD_INNER + SSD_GROUPS * SSD_STATE], axis=-1)
    xs = xs.reshape(bsz, L, SSD_HEADS, SSD_HEAD_DIM)
    rep = SSD_HEADS // SSD_GROUPS
    bs = jnp.repeat(bs.reshape(bsz, L, SSD_GROUPS, SSD_STATE), rep, axis=2)
    cs = jnp.repeat(cs.reshape(bsz, L, SSD_GROUPS, SSD_STATE), rep, axis=2)
    dt = jax.nn.softplus(dt_raw.astype(f32).reshape(bsz, L, 2, SSD_HEADS) + dt_bias.astype(f32))
    a = -jnp.exp(a_log.astype(f32))
    pad = (-L) % SSD_CHUNK
    xp, bp, cp, dtp = [_pad_front(t, pad) for t in (xs, bs, cs, dt)]
    y_f = _ssd_chunked(xp, dtp[:, :, 0], a[0], bp, cp)
    y_b = _flip(_ssd_chunked(_flip(xp), _flip(dtp[:, :, 1]), a[1], _flip(bp), _flip(cp)))
    y = (y_f + y_b)[:, pad:] + d_skip.astype(f32)[:, None] * xs
    y = y.reshape(bsz, L, SSD_INNER) * jax.nn.silu(z.astype(f32))
    return _rmsnorm(y, norm_w).astype(z.dtype)


def _gla_chunked(q, k, v, g):
    bsz, t, h, dk = q.shape
    dv = v.shape[-1]
    cl = GLA_CHUNK
    n = t // cl
    q, k, g = [u.reshape(bsz, n, cl, h, dk) for u in (q, k, g)]
    v = v.reshape(bsz, n, cl, h, dv)
    bcum = jnp.cumsum(g, axis=2)
    q_t = q * jnp.exp(bcum)
    k_t = k * jnp.exp(-bcum)
    att = jnp.einsum('bclhk,bcshk->bchls', q_t, k_t)
    att = jnp.where(jnp.tril(jnp.ones((cl, cl), bool)), att, 0.0)
    o_intra = jnp.einsum('bchls,bcshv->bclhv', att, v)
    b_last = bcum[:, :, -1]
    chunk_states = jnp.einsum('bclhk,bclhv->bchkv', k * jnp.exp(b_last[:, :, None] - bcum), v)
    s_in = _scan_states(jnp.exp(b_last)[..., None], chunk_states)
    o_inter = jnp.einsum('bclhk,bchkv->bclhv', q_t, s_in)
    return (o_intra + o_inter).reshape(bsz, t, h, dv)


def _gla_mixer(q, k, v, r, a, gate_w2, gate_b, norm_w):
    f32 = jnp.float32
    bsz, L, _ = q.shape
    q = q.astype(f32).reshape(bsz, L, GLA_HEADS, GLA_DK) * GLA_DK ** -0.5
    k = k.astype(f32).reshape(bsz, L, GLA_HEADS, GLA_DK)
    v = v.astype(f32).reshape(bsz, L, GLA_HEADS, GLA_DV)
    a = a.astype(f32).reshape(bsz, L, 2, GLA_GATE_RANK)
    g = jax.nn.log_sigmoid(jnp.einsum('bldr,drk->bldk', a, gate_w2.astype(f32)) + gate_b.astype(f32)) / GLA_GATE_NORM
    g = g.reshape(bsz, L, 2, GLA_HEADS, GLA_DK)
    pad = (-L) % GLA_CHUNK
    qp, kp, vp, gp = [_pad_front(t, pad) for t in (q, k, v, g)]
    o_f = _gla_chunked(qp, kp, vp, gp[:, :, 0])
    o_b = _flip(_gla_chunked(_flip(qp), _flip(kp), _flip(vp), _flip(gp[:, :, 1])))
    o = _rmsnorm((o_f + o_b)[:, pad:], norm_w)
    o = o.reshape(bsz, L, GLA_VAL) * jax.nn.silu(r.astype(f32))
    return o.astype(r.dtype)


def _t5_bucket(rel):
    nb = REL_BUCKETS // 2
    max_exact = nb // 2
    ret = (rel > 0).astype(jnp.int32) * nb
    n = jnp.abs(rel)
    nf = jnp.maximum(n, 1).astype(jnp.float32)
    large = max_exact + (jnp.log(nf / max_exact) / math.log(REL_MAX_DIST / max_exact)
                         * (nb - max_exact)).astype(jnp.int32)
    large = jnp.minimum(large, nb - 1)
    return ret + jnp.where(n < max_exact, n, large)


def _swa_mixer(q, k, v, sink, rel_bias):
    f32 = jnp.float32
    bsz, L, _ = q.shape
    S = L - N_META
    blk = ATT_BLOCK
    nb = S // blk
    R = SWA_Q_HEADS // SWA_KV_HEADS
    G = SWA_KV_HEADS
    q = q.reshape(bsz, L, G, R, HEAD_DIM) * HEAD_DIM ** -0.5
    k = k.reshape(bsz, L, G, HEAD_DIM)
    v = v.reshape(bsz, L, G, HEAD_DIM)
    qm, qr = q[:, :N_META], q[:, N_META:]
    km, kr = k[:, :N_META], k[:, N_META:]
    vm, vr = v[:, :N_META], v[:, N_META:]

    def band(t):
        tp = jnp.pad(t, [(0, 0), (blk, blk), (0, 0), (0, 0)]).reshape(bsz, nb + 2, blk, G, HEAD_DIM)
        return jnp.concatenate([tp[:, :-2], tp[:, 1:-1], tp[:, 2:]], axis=2)

    def head_bias(bucket):
        bb = jnp.moveaxis(rel_bias[bucket], -1, -3).astype(f32)
        return bb.reshape(bb.shape[:-3] + (G, R) + bb.shape[-2:])

    sink_l = sink.astype(f32).reshape(G, R, 1, 1)
    kb, vb = band(kr), band(vr)
    qb = qr.reshape(bsz, nb, blk, G, R, HEAD_DIM)
    qi = jnp.arange(blk)
    ki = jnp.arange(3 * blk)
    rel = ki[None, :] - blk - qi[:, None]
    kidx = jnp.arange(nb)[:, None] * blk + ki[None, :] - blk
    mask = (jnp.abs(rel) <= WINDOW)[None] & ((kidx >= 0) & (kidx < S))[:, None, :]
    qpos = N_META + jnp.arange(S).reshape(nb, blk)
    rel_m = jnp.arange(N_META)[None, None, :] - qpos[:, :, None]
    s_band = jnp.einsum('bnqgrd,bnkgd->bngrqk', qb, kb).astype(f32) + head_bias(_t5_bucket(rel))
    s_band = jnp.where(mask[None, :, None, None], s_band, -jnp.inf)
    s_meta = jnp.einsum('bnqgrd,bmgd->bngrqm', qb, km).astype(f32) + head_bias(_t5_bucket(rel_m))
    s_sink = jnp.broadcast_to(sink_l, s_band.shape[:-1] + (1,))
    p = jax.nn.softmax(jnp.concatenate([s_band, s_meta, s_sink], axis=-1), axis=-1).astype(v.dtype)
    o_r = (jnp.einsum('bngrqk,bnkgd->bnqgrd', p[..., :3 * blk], vb)
           + jnp.einsum('bngrqm,bmgd->bnqgrd', p[..., 3 * blk:3 * blk + N_META], vm))
    o_r = o_r.reshape(bsz, S, SWA_Q_HEADS * HEAD_DIM)

    kc = jnp.concatenate([km, kr[:, :blk]], axis=1)
    vc = jnp.concatenate([vm, vr[:, :blk]], axis=1)
    rel_q = jnp.arange(N_META + blk)[None, :] - jnp.arange(N_META)[:, None]
    s_q = jnp.einsum('bqgrd,bkgd->bgrqk', qm, kc).astype(f32) + head_bias(_t5_bucket(rel_q))
    s_q = jnp.where(jnp.abs(rel_q) <= WINDOW, s_q, -jnp.inf)
    s_q_sink = jnp.broadcast_to(sink_l, s_q.shape[:-1] + (1,))
    p_q = jax.nn.softmax(jnp.concatenate([s_q, s_q_sink], axis=-1), axis=-1).astype(v.dtype)
    o_m = jnp.einsum('bgrqk,bkgd->bqgrd', p_q[..., :-1], vc).reshape(bsz, N_META, SWA_Q_HEADS * HEAD_DIM)
    return jnp.concatenate([o_m, o_r], axis=1)


def _axial_rope(L):
    f32 = jnp.float32
    n_tok = L - N_META
    rows = n_tok // GRID_W
    t = jnp.arange(rows * GRID_W)
    meta_pos = jnp.arange(N_META) - N_META
    row = jnp.concatenate([meta_pos, t // GRID_W]).astype(f32)
    col = jnp.concatenate([meta_pos, t % GRID_W]).astype(f32)
    half = HEAD_DIM // 2
    inv = ROPE_THETA ** (-jnp.arange(0, half, 2, dtype=f32) / half)
    ang = jnp.concatenate([row[:, None] * inv, col[:, None] * inv], axis=-1)
    return jnp.cos(ang), jnp.sin(ang)


def _apply_rope(x, cos, sin):
    shp = x.shape
    xf = x.astype(jnp.float32).reshape(shp[:-1] + (HEAD_DIM // 2, 2))
    bshape = (1, shp[1]) + (1,) * (x.ndim - 3) + (HEAD_DIM // 2,)
    c = cos.reshape(bshape)
    s = sin.reshape(bshape)
    x0, x1 = xf[..., 0], xf[..., 1]
    return jnp.stack([x0 * c - x1 * s, x0 * s + x1 * c], axis=-1).reshape(shp).astype(x.dtype)


def _gqa2d_mixer(q, k, v, qn_w, kn_w):
    bsz, L, _ = q.shape
    G = G2_KV_HEADS
    R = G2_Q_HEADS // G2_KV_HEADS
    blk = ATT_BLOCK
    q = _rmsnorm(q.reshape(bsz, L, G, R, HEAD_DIM), qn_w)
    k = _rmsnorm(k.reshape(bsz, L, G, HEAD_DIM), kn_w)
    v = v.reshape(bsz, L, G, HEAD_DIM)
    cos, sin = _axial_rope(L)
    q = _apply_rope(q, cos, sin) * HEAD_DIM ** -0.5
    k = _apply_rope(k, cos, sin)
    pad = (-L) % blk
    nq = (L + pad) // blk
    qp = jnp.moveaxis(_pad_front(q, pad).reshape(bsz, nq, blk, G, R, HEAD_DIM), 1, 0)

    def block(qb):
        s = jnp.einsum('bqgrd,bkgd->bgrqk', qb, k).astype(jnp.float32)
        p = jax.nn.softmax(s, axis=-1).astype(v.dtype)
        return jnp.einsum('bgrqk,bkgd->bqgrd', p, v)

    o = lax.map(block, qp)
    o = jnp.moveaxis(o, 0, 1).reshape(bsz, nq * blk, G2_Q_HEADS * HEAD_DIM)
    return o[:, pad:]


def _swiglu(u, wg, wu, wd):
    return (jax.nn.silu(u @ wg) * (u @ wu)) @ wd


def _moe(u, router, wg, wu, wd):
    bsz, L, d = u.shape
    t = u.reshape(-1, d)
    logits = (t @ router).astype(jnp.float32)
    top_v, top_i = lax.top_k(logits, TOP_K)
    gates = jax.nn.softmax(top_v, axis=-1)
    combine = jnp.sum(jax.nn.one_hot(top_i, N_EXPERTS, dtype=jnp.float32) * gates[..., None], axis=1)
    out = jnp.zeros_like(t)
    for e in range(N_EXPERTS):
        out = out + combine[:, e:e + 1].astype(t.dtype) * _swiglu(t, wg[e], wu[e], wd[e])
    return out.reshape(bsz, L, d)


def setup_inputs(seed: int = 0) -> dict:
    key = jax.random.key(seed)
    ks = iter(jax.random.split(key, 32))
    f32 = jnp.float32
    n_dense = (DEPTH + 1) // 2
    n_moe = DEPTH // 2

    def nrm(shape, scale):
        return jax.random.normal(next(ks), shape, f32) * scale

    def gain(shape):
        return 1.0 + 0.05 * jax.random.normal(next(ks), shape, f32)

    x = nrm((BATCH, SEQ, D_MODEL), 1.0)
    meta_tokens = nrm((N_META, D_MODEL), 1.0)
    rel_bias = nrm((REL_BUCKETS, SWA_Q_HEADS), 0.5)
    norm_mix_w = gain((DEPTH, D_MODEL))
    norm_ffn_w = gain((DEPTH, D_MODEL))
    w_in = nrm((DEPTH, D_MODEL, IN_WIDTH), D_MODEL ** -0.5)
    ssd_conv_w = nrm((DEPTH, SSD_CONV, SSD_CONV_DIM), SSD_CONV ** -0.5)
    ssd_conv_b = nrm((DEPTH, SSD_CONV_DIM), 0.02)
    dt0 = jnp.exp(jax.random.uniform(next(ks), (DEPTH, 2, SSD_HEADS), f32, math.log(1e-3), math.log(1e-1)))
    ssd_dt_bias = dt0 + jnp.log(-jnp.expm1(-dt0))
    ssd_a_log = jnp.log(jax.random.uniform(next(ks), (DEPTH, 2, SSD_HEADS), f32, 1.0, 16.0))
    ssd_d = gain((DEPTH, SSD_HEADS))
    ssd_norm_w = gain((DEPTH, SSD_INNER))
    gla_gate_w2 = nrm((DEPTH, 2, GLA_GATE_RANK, GLA_KEY), GLA_GATE_RANK ** -0.5)
    gla_gate_b = nrm((DEPTH, 2, GLA_KEY), 0.1)
    gla_norm_w = gain((DEPTH, GLA_DV))
    swa_sink = nrm((DEPTH, SWA_Q_HEADS), 0.5)
    gqa_q_norm_w = gain((DEPTH, HEAD_DIM))
    gqa_k_norm_w = gain((DEPTH, HEAD_DIM))
    w_out = nrm((DEPTH, MIX_WIDTH, D_MODEL), MIX_WIDTH ** -0.5)
    ffn_w_gate = nrm((n_dense, D_MODEL, FFN_DENSE), D_MODEL ** -0.5)
    ffn_w_up = nrm((n_dense, D_MODEL, FFN_DENSE), D_MODEL ** -0.5)
    ffn_w_down = nrm((n_dense, FFN_DENSE, D_MODEL), FFN_DENSE ** -0.5)
    moe_router = nrm((n_moe, D_MODEL, N_EXPERTS), D_MODEL ** -0.5)
    moe_w_gate = nrm((n_moe, N_EXPERTS, D_MODEL, FFN_EXPERT), D_MODEL ** -0.5)
    moe_w_up = nrm((n_moe, N_EXPERTS, D_MODEL, FFN_EXPERT), D_MODEL ** -0.5)
    moe_w_down = nrm((n_moe, N_EXPERTS, FFN_EXPERT, D_MODEL), FFN_EXPERT ** -0.5)
    final_norm_w = gain((D_MODEL,))
    return {'x': x, 'meta_tokens': meta_tokens, 'rel_bias': rel_bias,
            'norm_mix_w': norm_mix_w, 'norm_ffn_w': norm_ffn_w, 'w_in': w_in,
            'ssd_conv_w': ssd_conv_w, 'ssd_conv_b': ssd_conv_b, 'ssd_dt_bias': ssd_dt_bias,
            'ssd_a_log': ssd_a_log, 'ssd_d': ssd_d, 'ssd_norm_w': ssd_norm_w,
            'gla_gate_w2': gla_gate_w2, 'gla_gate_b': gla_gate_b, 'gla_norm_w': gla_norm_w,
            'swa_sink': swa_sink, 'gqa_q_norm_w': gqa_q_norm_w, 'gqa_k_norm_w': gqa_k_norm_w,
            'w_out': w_out, 'ffn_w_gate': ffn_w_gate, 'ffn_w_up': ffn_w_up, 'ffn_w_down': ffn_w_down,
            'moe_router': moe_router, 'moe_w_gate': moe_w_gate, 'moe_w_up': moe_w_up,
            'moe_w_down': moe_w_down, 'final_norm_w': final_norm_w}


def reference(x, meta_tokens, rel_bias, norm_mix_w, norm_ffn_w, w_in, ssd_conv_w, ssd_conv_b,
              ssd_dt_bias, ssd_a_log, ssd_d, ssd_norm_w, gla_gate_w2, gla_gate_b, gla_norm_w,
              swa_sink, gqa_q_norm_w, gqa_k_norm_w, w_out, ffn_w_gate, ffn_w_up, ffn_w_down,
              moe_router, moe_w_gate, moe_w_up, moe_w_down, final_norm_w):
    bsz = x.shape[0]
    offs = [int(o) for o in np.cumsum(IN_SIZES)[:-1]]
    meta = jnp.broadcast_to(meta_tokens[None].astype(x.dtype), (bsz, N_META, D_MODEL))
    h = jnp.concatenate([meta, x], axis=1)
    for i in range(DEPTH):
        u = _rmsnorm(h, norm_mix_w[i])
        proj = u @ w_in[i]
        (z, xbc, dt_raw, gq, gk, gv, gr, ga, sq, sk, sv, aq, ak, av) = jnp.split(proj, offs, axis=-1)
        y_ssd = _ssd_mixer(z, xbc, dt_raw, ssd_conv_w[i], ssd_conv_b[i], ssd_dt_bias[i],
                           ssd_a_log[i], ssd_d[i], ssd_norm_w[i])
        y_gla = _gla_mixer(gq, gk, gv, gr, ga, gla_gate_w2[i], gla_gate_b[i], gla_norm_w[i])
        y_swa = _swa_mixer(sq, sk, sv, swa_sink[i], rel_bias)
        y_g2 = _gqa2d_mixer(aq, ak, av, gqa_q_norm_w[i], gqa_k_norm_w[i])
        mixed = jnp.concatenate([y_ssd, y_gla, y_swa, y_g2], axis=-1)
        h = h + mixed @ w_out[i]
        u = _rmsnorm(h, norm_ffn_w[i])
        if i % 2 == 0:
            j = i // 2
            h = h + _swiglu(u, ffn_w_gate[j], ffn_w_up[j], ffn_w_down[j])
        else:
            j = i // 2
            h = h + _moe(u, moe_router[j], moe_w_gate[j], moe_w_up[j], moe_w_down[j])
    return _rmsnorm(h, final_norm_w)[:, N_META:]
```

```cpp
#include <hip/hip_runtime.h>
#include <cstdio>
#include <cstdint>
#include <cmath>
#define HD_INLINE __device__ __forceinline__
#ifndef CFG_BATCH
#define CFG_BATCH 8
#endif
#ifndef CFG_SEQ
#define CFG_SEQ 4096
#endif
constexpr int B_ = CFG_BATCH, S_ = CFG_SEQ, NM = 16, L_ = S_ + NM;
constexpr int NREG = B_ * S_, NTOK = NREG + B_ * NM, MP = ((NTOK + 255) / 256) * 256;
constexpr int PW = 2816;
constexpr int PZ = 0, PX = 256, PB = 512, PC = 768, PGQ = 1024, PGK = 1152, PGV = 1280, PGR = 1536, PSQ = 1792, PSK = 2048, PSV = 2176, PAQ = 2304, PAK = 2560, PAV = 2688;
constexpr int DGW = 64;
constexpr int XW = 768;
typedef unsigned short bf16;

#ifdef __HIP_DEVICE_COMPILE__
#define FAST_COS(x) __cosf(x)
#define FAST_SIN(x) __sinf(x)
#else
#define FAST_COS(x) cosf(x)
#define FAST_SIN(x) sinf(x)
#endif
#define ROPE_INV(j) __builtin_exp2f(-(float)(j) * 0.8304820237218406f)
HD_INLINE int row_of(int b, int t) { return t < NM ? NREG + b * NM + t : b * S_ + (t - NM); }
HD_INLINE float bf2f(bf16 v) { unsigned u = ((unsigned)v) << 16; float f; __builtin_memcpy(&f, &u, 4); return f; }
HD_INLINE bf16 f2bf(float f) { unsigned u; __builtin_memcpy(&u, &f, 4); return (bf16)((u + 0x7fffu + ((u >> 16) & 1u)) >> 16); }
HD_INLINE float siluf(float x) { return x / (1.0f + expf(-x)); }
HD_INLINE float softplusf(float x) { return x > 20.f ? x : log1pf(expf(x)); }
HD_INLINE float logsigmoidf(float x) { return x >= 0.f ? -log1pf(expf(-x)) : x - log1pf(expf(x)); }
HD_INLINE int t5_bucket(int rel) {
    const int a = rel < 0 ? -rel : rel, base = rel > 0 ? 16 : 0;
    if (a < 8) return base + a;
    const int k = (a >= 12) + (a >= 16) + (a >= 23) + (a >= 32) + (a >= 46) + (a >= 64) + (a >= 91);
    return base + 8 + k;
}

struct MixParams {
    const float *conv_w, *conv_b, *dt_bias, *a_log, *ssd_d, *ssd_norm_w, *gate_w2, *gate_b, *gla_norm_w, *sink, *qn_w, *kn_w, *rel_bias;
};
struct MixBuf { bf16* proj; const float* dtga; bf16* xbca; bf16* mixed; };

HD_INLINE void nv_conv(const MixBuf& m, const MixParams& p, long gtid, long nthreads) {
    for (long idx = gtid; idx < (long)B_ * L_ * XW; idx += nthreads) {
        const int c = (int)(idx % XW); const long bt = idx / XW; const int t = (int)(bt % L_), b = (int)(bt / L_);
        float acc = p.conv_b[c];
        for (int j = 0; j < 5; ++j) { const int tt = t + j - 2; if (tt >= 0 && tt < L_) acc += p.conv_w[j * XW + c] * bf2f(m.proj[(size_t)row_of(b, tt) * PW + PX + c]); }
        m.xbca[(size_t)row_of(b, t) * XW + c] = f2bf(siluf(acc));
    }
}
HD_INLINE void nv_ssd_scan(const MixBuf& m, const MixParams& p, long gtid, long nthreads) {
    for (long idx = gtid; idx < (long)B_ * 4 * 64; idx += nthreads) {
        const int pp = (int)(idx % 64), h = (int)((idx / 64) % 4), b = (int)(idx / 256), g = h >> 1;
        float S[128];
        for (int dir = 0; dir < 2; ++dir) {
            const float a = -expf(p.a_log[dir * 4 + h]), dtb = p.dt_bias[dir * 4 + h];
#pragma unroll
            for (int n = 0; n < 128; ++n) S[n] = 0.f;
            for (int i = 0; i < L_; ++i) {
                const int t = dir == 0 ? i : L_ - 1 - i; const size_t row = (size_t)row_of(b, t);
                const float dt = softplusf(m.dtga[row * DGW + dir * 4 + h] + dtb);
                const float x = bf2f(m.xbca[row * XW + h * 64 + pp]);
                const float dA = expf(dt * a), xd = x * dt;
                const bf16* Bp = m.xbca + row * XW + 256 + g * 128; const bf16* Cp = m.xbca + row * XW + 512 + g * 128;
                float y = 0.f;
#pragma unroll
                for (int n = 0; n < 128; ++n) { S[n] = S[n] * dA + xd * bf2f(Bp[n]); y += bf2f(Cp[n]) * S[n]; }
                bf16* o = m.mixed + row * 1024 + h * 64 + pp;
                if (dir == 0) *o = f2bf(y);
                else { float yy = bf2f(*o) + y + p.ssd_d[h] * x; yy *= siluf(bf2f(m.proj[row * PW + PZ + h * 64 + pp])); *o = f2bf(yy); }
            }
        }
    }
}
HD_INLINE void nv_ssd_norm(const MixBuf& m, const MixParams& p, long gtid, long nthreads) {
    for (long row = gtid; row < NTOK; row += nthreads) {
        bf16* o = m.mixed + (size_t)row * 1024; float ss = 0.f;
        for (int c = 0; c < 256; ++c) { const float v = bf2f(o[c]); ss += v * v; }
        const float r = 1.0f / sqrtf(ss / 256.f + 1e-6f);
        for (int c = 0; c < 256; ++c) o[c] = f2bf(bf2f(o[c]) * r * p.ssd_norm_w[c]);
    }
}
HD_INLINE void nv_gla_scan(const MixBuf& m, const MixParams& p, long gtid, long nthreads) {
    for (long idx = gtid; idx < (long)B_ * 4 * 64; idx += nthreads) {
        const int v = (int)(idx % 64), h = (int)((idx / 64) % 4), b = (int)(idx / 256);
        float S[32];
        for (int dir = 0; dir < 2; ++dir) {
#pragma unroll
            for (int k = 0; k < 32; ++k) S[k] = 0.f;
            for (int i = 0; i < L_; ++i) {
                const int t = dir == 0 ? i : L_ - 1 - i; const size_t row = (size_t)row_of(b, t);
                const float* a = m.dtga + row * DGW + 8 + dir * 16;
                const float vv = bf2f(m.proj[row * PW + PGV + h * 64 + v]);
                float o = 0.f, z[32];
#pragma unroll
                for (int k = 0; k < 32; ++k) z[k] = p.gate_b[dir * 128 + h * 32 + k];
#pragma unroll 1
                for (int r = 0; r < 16; ++r) { const float ar = a[r]; const float* wp = p.gate_w2 + (dir * 16 + r) * 128 + h * 32;
#pragma unroll
                    for (int k = 0; k < 32; ++k) z[k] += ar * wp[k]; }
#pragma unroll
                for (int k = 0; k < 32; ++k) {
                    const float g = logsigmoidf(z[k]) * (1.0f / 16.0f);
                    const float q = bf2f(m.proj[row * PW + PGQ + h * 32 + k]) * 0.17677669529663687f, kk = bf2f(m.proj[row * PW + PGK + h * 32 + k]);
                    S[k] = expf(g) * S[k] + kk * vv; o += q * S[k];
                }
                bf16* op = m.mixed + row * 1024 + 256 + h * 64 + v;
                if (dir == 0) *op = f2bf(o); else *op = f2bf(bf2f(*op) + o);
            }
        }
    }
}
HD_INLINE void nv_gla_norm(const MixBuf& m, const MixParams& p, long gtid, long nthreads) {
    for (long idx = gtid; idx < (long)NTOK * 4; idx += nthreads) {
        const long row = idx >> 2; const int h = (int)(idx & 3);
        bf16* o = m.mixed + (size_t)row * 1024 + 256 + h * 64; float ss = 0.f;
        for (int c = 0; c < 64; ++c) { const float v = bf2f(o[c]); ss += v * v; }
        const float r = 1.0f / sqrtf(ss / 64.f + 1e-6f);
        for (int c = 0; c < 64; ++c) o[c] = f2bf(bf2f(o[c]) * r * p.gla_norm_w[c] * siluf(bf2f(m.proj[(size_t)row * PW + PGR + h * 64 + c])));
    }
}
HD_INLINE void nv_swa(const MixBuf& m, const MixParams& p, long gtid, long nthreads) {
    for (long idx = gtid; idx < (long)B_ * L_ * 4; idx += nthreads) {
        const int hd = (int)(idx & 3); const long bt = idx >> 2; const int t = (int)(bt % L_), b = (int)(bt / L_), g = hd >> 1;
        const size_t qrow = (size_t)row_of(b, t);
        float q[64], o[64];
#pragma unroll
        for (int d = 0; d < 64; ++d) { q[d] = bf2f(m.proj[qrow * PW + PSQ + hd * 64 + d]) * 0.125f; o[d] = 0.f; }
        float mx = p.sink[hd], l = 1.0f;
        const int lo = t - 128 < NM ? NM : t - 128, hi = t + 128 > L_ - 1 ? L_ - 1 : t + 128;
        for (int pass = 0; pass < 2; ++pass) {
            const int k0 = pass == 0 ? 0 : lo, k1 = pass == 0 ? NM - 1 : hi;
            for (int kp = k0; kp <= k1; ++kp) {
                const size_t krow = (size_t)row_of(b, kp);
                float s = p.rel_bias[t5_bucket(kp - t) * 4 + hd];
#pragma unroll
                for (int d = 0; d < 64; ++d) s += q[d] * bf2f(m.proj[krow * PW + PSK + g * 64 + d]);
                const float mn = s > mx ? s : mx, c = expf(mx - mn), e = expf(s - mn);
                l = l * c + e; mx = mn;
#pragma unroll
                for (int d = 0; d < 64; ++d) o[d] = o[d] * c + e * bf2f(m.proj[krow * PW + PSV + g * 64 + d]);
            }
        }
        const float inv = 1.0f / l;
#pragma unroll
        for (int d = 0; d < 64; ++d) m.mixed[qrow * 1024 + 512 + hd * 64 + d] = f2bf(o[d] * inv);
    }
}
HD_INLINE void nv_gqa_prep(const MixBuf& m, const MixParams& p, long gtid, long nthreads) {
    for (long idx = gtid; idx < (long)B_ * L_ * 6; idx += nthreads) {
        const int slot = (int)(idx % 6); const long bt = idx / 6; const int t = (int)(bt % L_), b = (int)(bt / L_);
        bf16* x = m.proj + (size_t)row_of(b, t) * PW + (slot < 4 ? PAQ + slot * 64 : PAK + (slot - 4) * 64);
        const float* w = slot < 4 ? p.qn_w : p.kn_w; const float sc = slot < 4 ? 0.125f : 1.0f;
        float v[64], ss = 0.f;
#pragma unroll
        for (int d = 0; d < 64; ++d) { v[d] = bf2f(x[d]); ss += v[d] * v[d]; }
        const float r = 1.0f / sqrtf(ss / 64.f + 1e-6f);
        const float prow = t < NM ? (float)(t - NM) : (float)((t - NM) / 64), pcol = t < NM ? (float)(t - NM) : (float)((t - NM) % 64);
#pragma unroll
        for (int i = 0; i < 32; ++i) {
            const float inv = ROPE_INV(i & 15), ang = (i < 16 ? prow : pcol) * inv, c = FAST_COS(ang), s = FAST_SIN(ang);
            const float x0 = v[2 * i] * r * w[2 * i], x1 = v[2 * i + 1] * r * w[2 * i + 1];
            x[2 * i] = f2bf((x0 * c - x1 * s) * sc); x[2 * i + 1] = f2bf((x0 * s + x1 * c) * sc);
        }
    }
}
HD_INLINE void nv_gqa_attn(const MixBuf& m, const MixParams& p, long gtid, long nthreads) {
    for (long idx = gtid; idx < (long)B_ * L_ * 4; idx += nthreads) {
        const int hd = (int)(idx & 3); const long bt = idx >> 2; const int t = (int)(bt % L_), b = (int)(bt / L_), g = hd >> 1;
        const size_t qrow = (size_t)row_of(b, t);
        float q[64], o[64];
#pragma unroll
        for (int d = 0; d < 64; ++d) { q[d] = bf2f(m.proj[qrow * PW + PAQ + hd * 64 + d]); o[d] = 0.f; }
        float mx = -1e30f, l = 0.f;
        for (int kp = 0; kp < L_; ++kp) {
            const size_t krow = (size_t)row_of(b, kp);
            float s = 0.f;
#pragma unroll
            for (int d = 0; d < 64; ++d) s += q[d] * bf2f(m.proj[krow * PW + PAK + g * 64 + d]);
            const float mn = s > mx ? s : mx, c = expf(mx - mn), e = expf(s - mn);
            l = l * c + e; mx = mn;
#pragma unroll
            for (int d = 0; d < 64; ++d) o[d] = o[d] * c + e * bf2f(m.proj[krow * PW + PAV + g * 64 + d]);
        }
        const float inv = 1.0f / l;
#pragma unroll
        for (int d = 0; d < 64; ++d) m.mixed[qrow * 1024 + 768 + hd * 64 + d] = f2bf(o[d] * inv);
    }
}

namespace pg8 {
#define PG8_LAS __attribute__((address_space(3)))
typedef unsigned short bf16_t;
typedef short bf16x8 __attribute__((ext_vector_type(8)));
typedef float f32x4 __attribute__((ext_vector_type(4)));
typedef unsigned u32x4 __attribute__((ext_vector_type(4)));
constexpr int BM = 256, BK = 64, HALF = 128, HTB = HALF * BK * 2  , STAGE_BYTES = 8 * HTB, NXCD = 8, WGM = 8;

__host__ __device__ __forceinline__ int lds_byte(int r, int c) { const int st = (r >> 4) * 2 + (c >> 5), rr = r & 15, cc = c & 31, ob = rr * 64 + cc * 2; return st * 1024 + (ob ^ (((ob >> 9) & 1) << 5)); }
__host__ __device__ __forceinline__ void stage_rc(int b, int& R, int& C) { const int st = b / 1024, sb = b % 1024, swz = sb ^ (((sb >> 9) & 1) << 5); R = (st >> 1) * 16 + swz / 64; C = (st & 1) * 32 + (swz % 64) / 2; }
__host__ __device__ __forceinline__ int perm32(int rho) { const int n = rho >> 4, i = rho & 15; return 8 * (i >> 2) + 4 * n + (i & 3); }

struct Unit { int pm, pn; };
struct Gemm { const bf16_t* A; const bf16_t* Bt; int M, N, K; };

struct StaticOrder {
    int nM, nN, nwg, G, c;
    __host__ __device__ void init(int M, int N, int G_, int c_) { nM = M / BM; nN = N / BM; nwg = nM * nN; G = G_; c = c_; }
    __host__ __device__ bool next(int i, Unit& u) const {
        const long L = (long)i * G + c; if (L >= nwg) return false;
        int wgid = (int)L; { const int q = nwg / NXCD, r = nwg % NXCD, xcd = wgid % NXCD, off = wgid / NXCD; wgid = (xcd < r ? xcd * (q + 1) : r * (q + 1) + (xcd - r) * q) + off; }
        const int nig = WGM * nN, gid = wgid / nig, fm = gid * WGM, gsz = (nM - fm) < WGM ? (nM - fm) : WGM;
        u.pm = fm + ((wgid % nig) % gsz); u.pn = (wgid % nig) / gsz; return true;
    }
    __device__ __forceinline__ void a_ready(const Unit&) const {}
    __device__ __forceinline__ void done(const Unit&) const {}
};

__device__ __forceinline__ unsigned cvt_pk_bf16(float lo, float hi) { unsigned r; asm volatile("v_cvt_pk_bf16_f32 %0, %1, %2" : "=v"(r) : "v"(lo), "v"(hi)); return r; }
typedef float f32x2 __attribute__((ext_vector_type(2)));
__device__ __forceinline__ f32x2 gelu_pk(f32x2 v) {
    const f32x2 av = __builtin_elementwise_abs(v), d = av * 0.2316418882f + 1.0f;
    f32x2 t; t.x = __builtin_amdgcn_rcpf(d.x); t.y = __builtin_amdgcn_rcpf(d.y);
    f32x2 q = t * 0.5307027145f + (-0.7265760135f); q = q * t + 0.7107068705f; q = q * t + (-0.142248368f); q = q * t + 0.127414796f; q = q * t;
    const f32x2 s = (v * v) * (-0.72134752044f);
    f32x2 e; e.x = __builtin_amdgcn_exp2f(s.x); e.y = __builtin_amdgcn_exp2f(s.y);
    const f32x2 m = v * (q * e), r = v - m;
    f32x2 o; o.x = v.x < 0.f ? m.x : r.x; o.y = v.y < 0.f ? m.y : r.y; return o;
}

template <int ACT  > struct EpiBf16 {
    static constexpr bool PERM = true, AFTER_DRAIN = false; static_assert(ACT == 0 || ACT == 1, "EpiBf16: ACT is 0 (none) or 1 (gelu_pk)");
    bf16_t* O; int ldc; const float* bias; int split_cols; size_t split_stride; float scale0;
    __device__ __forceinline__ void operator()(const f32x4 (&acc)[2][2][4][2], const Unit& u, int wr, int wc, int fr, int fq) const {
        const int row0 = u.pm * BM + wr * 64 + fr; int colt = u.pn * BM; bf16_t* base = O;
        float sc = 1.f; if (split_cols) { const int t = colt / split_cols; base += (size_t)t * split_stride; colt -= t * split_cols; if (t == 0) sc = scale0; }
        const int col0 = colt + wc * 32 + 8 * fq, bcol0 = u.pn * BM + wc * 32 + 8 * fq;
        f32x4 bv[2][2];
#pragma unroll
        for (int bj = 0; bj < 2; ++bj)
#pragma unroll
            for (int n = 0; n < 2; ++n) bv[bj][n] = bias ? *(const f32x4*)(bias + bcol0 + bj * HALF + 4 * n) : (f32x4){0.f, 0.f, 0.f, 0.f};
#pragma unroll
        for (int ai = 0; ai < 2; ++ai)
#pragma unroll
            for (int m = 0; m < 4; ++m) { bf16_t* rowp = base + (size_t)(row0 + ai * HALF + m * 16) * ldc + col0;
#pragma unroll
                for (int bj = 0; bj < 2; ++bj) { f32x4 v0 = acc[ai][bj][m][0] + bv[bj][0], v1 = acc[ai][bj][m][1] + bv[bj][1];
                    if (ACT == 1) { f32x2 a = gelu_pk((f32x2){v0[0], v0[1]}), b = gelu_pk((f32x2){v0[2], v0[3]}), c = gelu_pk((f32x2){v1[0], v1[1]}), d = gelu_pk((f32x2){v1[2], v1[3]});
                        v0 = (f32x4){a.x, a.y, b.x, b.y}; v1 = (f32x4){c.x, c.y, d.x, d.y}; }
                    v0 = v0 * sc; v1 = v1 * sc; u32x4 w; w.x = cvt_pk_bf16(v0[0], v0[1]); w.y = cvt_pk_bf16(v0[2], v0[3]); w.z = cvt_pk_bf16(v1[0], v1[1]); w.w = cvt_pk_bf16(v1[2], v1[3]);
                    *(u32x4*)(rowp + bj * HALF) = w; } }
    }
};

template <class Epi, class Sched, bool ALIGN_EPI = false, bool SP2 = false>
__device__ __forceinline__ void gemm_phase(PG8_LAS unsigned char* lds, const Gemm g, const Sched& S, const Epi& E) {
    const int tid = threadIdx.x, wid = __builtin_amdgcn_readfirstlane(tid >> 6), lane = tid & 63, wr = wid >> 2, wc = wid & 3, fr = lane & 15, fq = lane >> 4;
    const int K = g.K, nt = K / BK;
    unsigned voffA[2], voffB[2];
#pragma unroll
    for (int i = 0; i < 2; ++i) { int R, C; stage_rc(tid * 16 + i * 8192, R, C); const int Rb = Epi::PERM ? ((R & ~31) + perm32(R & 31)) : R;
        voffA[i] = (unsigned)(R * K + C) * 2u; voffB[i] = (unsigned)(Rb * K + C) * 2u; }
    const size_t kstep = (size_t)(BK * 2);
    const size_t hstep = (size_t)HALF * K * 2;
    const size_t tstep = 2 * hstep;
    const unsigned ldsw = (unsigned)wid * 1024u;
    const int aoff = lds_byte(wr * 64 + fr, fq * 8), boff = lds_byte(wc * 32 + fr, fq * 8);
#define PG8_SA(b, h) (((b) * 2 + (h)) * HTB)
#define PG8_SB(b, h) ((4 + (b) * 2 + (h)) * HTB)
#define PG8_STAGE(bufoff, gbase, voff) do { _Pragma("unroll") for (int _i = 0; _i < 2; ++_i) \
        __builtin_amdgcn_global_load_lds((const unsigned*)((const char*)(gbase) + (voff)[_i]), (PG8_LAS unsigned*)(lds + (bufoff) + ldsw + _i * 8192), 16, 0, 0); } while (0)
#define PG8_LDA(dst, b, h) do { _Pragma("unroll") for (int m = 0; m < 4; ++m) _Pragma("unroll") for (int k = 0; k < 2; ++k) dst[m][k] = *(const PG8_LAS bf16x8*)(lds + PG8_SA(b, h) + aoff + m * 2048 + k * 1024); } while (0)
#define PG8_LDB(dst, b, h) do { _Pragma("unroll") for (int n = 0; n < 2; ++n) _Pragma("unroll") for (int k = 0; k < 2; ++k) dst[n][k] = *(const PG8_LAS bf16x8*)(lds + PG8_SB(b, h) + boff + n * 2048 + k * 1024); } while (0)
#define PG8_MMA(ai, bj, At, Bt) do { __builtin_amdgcn_s_setprio(1); _Pragma("unroll") for (int m = 0; m < 4; ++m) _Pragma("unroll") for (int n = 0; n < 2; ++n) _Pragma("unroll") for (int k = 0; k < 2; ++k) \
        acc[ai][bj][m][n] = __builtin_amdgcn_mfma_f32_16x16x32_bf16(Bt[n][k], At[m][k], acc[ai][bj][m][n], 0, 0, 0); __builtin_amdgcn_s_setprio(0); } while (0)
#define PG8_WAIT_V(n) asm volatile("s_waitcnt vmcnt(" #n ")" ::: "memory")
#define PG8_WAIT_L(n) asm volatile("s_waitcnt lgkmcnt(" #n ")" ::: "memory")
#define PG8_BAR __builtin_amdgcn_s_barrier()
#define PG8_SCHED __builtin_amdgcn_sched_barrier(0)
    Unit cur, nxt; int ui = 0;
    if (!S.next(0, cur)) return;
    f32x4 acc[2][2][4][2];
#pragma unroll
    for (int a = 0; a < 2; ++a)
#pragma unroll
        for (int b = 0; b < 2; ++b)
#pragma unroll
            for (int m = 0; m < 4; ++m)
#pragma unroll
                for (int n = 0; n < 2; ++n) acc[a][b][m][n] = (f32x4){0.f, 0.f, 0.f, 0.f};
    bf16x8 At[4][2], B0[2][2], B1[2][2];
    const char* cA = (const char*)g.A + (size_t)cur.pm * tstep; const char* cB = (const char*)g.Bt + (size_t)cur.pn * tstep;
    S.a_ready(cur);
    if constexpr (SP2) {
        PG8_STAGE(PG8_SB(0, 0), cB, voffB); PG8_STAGE(PG8_SB(0, 1), cB + hstep, voffB); PG8_STAGE(PG8_SA(0, 0), cA, voffA); PG8_STAGE(PG8_SA(0, 1), cA + hstep, voffA);
        if (wr == 1) PG8_BAR;
        PG8_WAIT_V(2); PG8_BAR;
        PG8_STAGE(PG8_SB(1, 0), cB + kstep, voffB); PG8_STAGE(PG8_SA(1, 0), cA + kstep, voffA); PG8_STAGE(PG8_SB(1, 1), cB + hstep + kstep, voffB);
        PG8_WAIT_V(6); PG8_BAR;
    } else {
        PG8_STAGE(PG8_SB(0, 0), cB, voffB); PG8_STAGE(PG8_SA(0, 0), cA, voffA); PG8_STAGE(PG8_SB(0, 1), cB + hstep, voffB); PG8_STAGE(PG8_SA(0, 1), cA + hstep, voffA);
        if (wr == 1) PG8_BAR;
        PG8_WAIT_V(4); PG8_BAR;
        PG8_STAGE(PG8_SB(1, 0), cB + kstep, voffB); PG8_STAGE(PG8_SA(1, 0), cA + kstep, voffA); PG8_STAGE(PG8_SB(1, 1), cB + hstep + kstep, voffB);
        PG8_WAIT_V(6); PG8_BAR;
    }
    for (;;) {
        const bool has_next = S.next(ui + 1, nxt);
        const char* nA = has_next ? (const char*)g.A + (size_t)nxt.pm * tstep : cA; const char* nB = has_next ? (const char*)g.Bt + (size_t)nxt.pn * tstep : cB;
        for (int t = 0; t < nt; t += 2) {
            const bool last = (t == nt - 2);
            const char* a1 = cA + (size_t)(t + 1) * kstep;
            const char* a2 = last ? nA : cA + (size_t)(t + 2) * kstep; const char* b2 = last ? nB : cB + (size_t)(t + 2) * kstep;
            const char* a3 = a2 + kstep; const char* b3 = b2 + kstep;
            if (last && has_next) S.a_ready(nxt);
            if constexpr (SP2) {
            PG8_LDB(B0, 0, 0); PG8_LDB(B1, 0, 1); PG8_SCHED; PG8_LDA(At, 0, 0); PG8_STAGE(PG8_SA(1, 1), a1 + hstep, voffA);
            PG8_WAIT_V(8); PG8_WAIT_L(0); PG8_BAR; PG8_MMA(0, 0, At, B0); PG8_MMA(0, 1, At, B1); PG8_BAR; PG8_SCHED;
            PG8_LDA(At, 0, 1); PG8_STAGE(PG8_SB(0, 0), b2, voffB); PG8_STAGE(PG8_SB(0, 1), b2 + hstep, voffB); PG8_STAGE(PG8_SA(0, 0), a2, voffA);
            PG8_WAIT_V(8); PG8_WAIT_L(0); PG8_BAR; PG8_MMA(1, 0, At, B0); PG8_MMA(1, 1, At, B1); PG8_BAR; PG8_SCHED;
            PG8_LDB(B0, 1, 0); PG8_LDB(B1, 1, 1); PG8_SCHED; PG8_LDA(At, 1, 0); PG8_STAGE(PG8_SA(0, 1), a2 + hstep, voffA);
            PG8_WAIT_V(8); PG8_WAIT_L(0); PG8_BAR; PG8_MMA(0, 0, At, B0); PG8_MMA(0, 1, At, B1); PG8_BAR; PG8_SCHED;
            PG8_LDA(At, 1, 1); PG8_STAGE(PG8_SB(1, 0), b3, voffB); PG8_STAGE(PG8_SB(1, 1), b3 + hstep, voffB); PG8_STAGE(PG8_SA(1, 0), a3, voffA);
            PG8_WAIT_V(8); PG8_WAIT_L(0); PG8_BAR; PG8_MMA(1, 0, At, B0); PG8_MMA(1, 1, At, B1); PG8_BAR; PG8_SCHED;
            } else {
            PG8_LDB(B0, 0, 0); PG8_SCHED; PG8_LDA(At, 0, 0); PG8_STAGE(PG8_SA(1, 1), a1 + hstep, voffA);
            PG8_WAIT_L(8); PG8_BAR; PG8_WAIT_L(0); PG8_MMA(0, 0, At, B0); PG8_BAR; PG8_SCHED;
            PG8_LDB(B1, 0, 1); PG8_STAGE(PG8_SB(0, 0), b2, voffB);
            PG8_BAR; PG8_WAIT_L(0); PG8_MMA(0, 1, At, B1); PG8_BAR;
            PG8_LDA(At, 0, 1); PG8_STAGE(PG8_SA(0, 0), a2, voffA);
            PG8_BAR; PG8_WAIT_L(0); PG8_MMA(1, 0, At, B0); PG8_BAR; PG8_SCHED;
            PG8_STAGE(PG8_SB(0, 1), b2 + hstep, voffB);
            PG8_WAIT_V(6); PG8_BAR; PG8_MMA(1, 1, At, B1); PG8_BAR;
            PG8_LDB(B0, 1, 0); PG8_SCHED; PG8_LDA(At, 1, 0); PG8_STAGE(PG8_SA(0, 1), a2 + hstep, voffA);
            PG8_WAIT_L(8); PG8_BAR; PG8_WAIT_L(0); PG8_MMA(0, 0, At, B0); PG8_BAR; PG8_SCHED;
            PG8_LDB(B1, 1, 1); PG8_STAGE(PG8_SB(1, 0), b3, voffB);
            PG8_BAR; PG8_WAIT_L(0); PG8_MMA(0, 1, At, B1); PG8_BAR;
            PG8_LDA(At, 1, 1); PG8_STAGE(PG8_SA(1, 0), a3, voffA);
            PG8_BAR; PG8_WAIT_L(0); PG8_MMA(1, 0, At, B0); PG8_BAR; PG8_SCHED;
            PG8_STAGE(PG8_SB(1, 1), b3 + hstep, voffB);
            PG8_WAIT_V(6); PG8_BAR; PG8_MMA(1, 1, At, B1); PG8_BAR;
            }
        }
        if constexpr (ALIGN_EPI) { if (wr == 0) PG8_BAR; }
        if constexpr (!Epi::AFTER_DRAIN) { E(acc, cur, wr, wc, fr, fq); S.done(cur); }
        if (!has_next) break;
#pragma unroll
        for (int a = 0; a < 2; ++a)
#pragma unroll
            for (int b = 0; b < 2; ++b)
#pragma unroll
                for (int m = 0; m < 4; ++m)
#pragma unroll
                    for (int n = 0; n < 2; ++n) acc[a][b][m][n] = (f32x4){0.f, 0.f, 0.f, 0.f};
        cur = nxt; cA = nA; cB = nB; ++ui;
        if constexpr (ALIGN_EPI) { if (wr == 1) PG8_BAR; }
    }
    PG8_WAIT_V(0);
    if constexpr (!ALIGN_EPI) { if (wr == 0) PG8_BAR; }
    PG8_BAR;
    if constexpr (Epi::AFTER_DRAIN) { E.fused(acc, cur, wr, wc, fr, fq, lds, wid, lane); S.done(cur); }
#undef PG8_SA
#undef PG8_SB
#undef PG8_STAGE
#undef PG8_LDA
#undef PG8_LDB
#undef PG8_MMA
#undef PG8_WAIT_V
#undef PG8_WAIT_L
#undef PG8_BAR
#undef PG8_SCHED
}
}

namespace pg8 {
__device__ __forceinline__ float silu_fast(float x) { return x * __builtin_amdgcn_rcpf(1.0f + __expf(-x)); }
struct EpiInProj {
    static constexpr bool PERM = true, AFTER_DRAIN = false;
    bf16_t* proj; float* dtga;
    __device__ __forceinline__ void operator()(const f32x4 (&acc)[2][2][4][2], const Unit& u, int wr, int wc, int fr, int fq) const {
        const int row0 = u.pm * BM + wr * 64 + fr;
        if (u.pn < 11) {
            const int col0 = u.pn * BM + wc * 32 + 8 * fq;
#pragma unroll
            for (int ai = 0; ai < 2; ++ai)
#pragma unroll
                for (int m = 0; m < 4; ++m) { bf16_t* rowp = proj + (size_t)(row0 + ai * HALF + m * 16) * PW + col0;
#pragma unroll
                    for (int bj = 0; bj < 2; ++bj) { const f32x4 v0 = acc[ai][bj][m][0], v1 = acc[ai][bj][m][1];
                        u32x4 w; w.x = cvt_pk_bf16(v0[0], v0[1]); w.y = cvt_pk_bf16(v0[2], v0[3]); w.z = cvt_pk_bf16(v1[0], v1[1]); w.w = cvt_pk_bf16(v1[2], v1[3]);
                        *(u32x4*)(rowp + bj * HALF) = w; } }
        } else if (wc == 0 || (wc == 1 && fq == 0)) {
#pragma unroll
            for (int ai = 0; ai < 2; ++ai)
#pragma unroll
                for (int m = 0; m < 4; ++m) { float* rp = dtga + (size_t)(row0 + ai * HALF + m * 16) * DGW + wc * 32 + 8 * fq;
                    *(f32x4*)rp = acc[ai][0][m][0]; *(f32x4*)(rp + 4) = acc[ai][0][m][1]; }
        }
    }
};
struct EpiResid {
    static constexpr bool PERM = false, AFTER_DRAIN = false;
    const float* hin_reg; const float* hin_meta; int meta_mod; float* hout_reg; float* hout_meta;
    __device__ __forceinline__ void operator()(const f32x4 (&acc)[2][2][4][2], const Unit& u, int wr, int wc, int fr, int fq) const {
        const int row0 = u.pm * BM + wr * 64 + fr, col0 = u.pn * BM + wc * 32 + 4 * fq;
#pragma unroll
        for (int ai = 0; ai < 2; ++ai)
#pragma unroll
            for (int m = 0; m < 4; ++m) { const int r = row0 + ai * HALF + m * 16;
                if (r < NTOK) {
                    const float* ip = r < NREG ? hin_reg + (size_t)r * 1024 : hin_meta + (size_t)((r - NREG) % meta_mod) * 1024;
                    float* op = r < NREG ? hout_reg + (size_t)r * 1024 : hout_meta + (size_t)(r - NREG) * 1024;
#pragma unroll
                    for (int bj = 0; bj < 2; ++bj)
#pragma unroll
                        for (int n = 0; n < 2; ++n) { const int c = col0 + bj * HALF + n * 16; const f32x4 v = *(const f32x4*)(ip + c) + acc[ai][bj][m][n]; *(f32x4*)(op + c) = v; }
                }
                asm volatile("" ::: "memory"); }
    }
};
struct EpiSwiGLU {
    static constexpr bool PERM = true, AFTER_DRAIN = false;
    bf16_t* out; int ld; int ntile;
    __device__ __forceinline__ void operator()(const f32x4 (&acc)[2][2][4][2], const Unit& u, int wr, int wc, int fr, int fq) const {
        const int row0 = u.pm * BM + wr * 64 + fr, col0 = (u.pn % ntile) * HALF + wc * 32 + 8 * fq;
#pragma unroll
        for (int ai = 0; ai < 2; ++ai)
#pragma unroll
            for (int m = 0; m < 4; ++m) { bf16_t* rowp = out + (size_t)(row0 + ai * HALF + m * 16) * ld + col0;
                const f32x4 g0 = acc[ai][0][m][0], g1 = acc[ai][0][m][1], u0 = acc[ai][1][m][0], u1 = acc[ai][1][m][1];
                u32x4 w; w.x = cvt_pk_bf16(silu_fast(g0[0]) * u0[0], silu_fast(g0[1]) * u0[1]); w.y = cvt_pk_bf16(silu_fast(g0[2]) * u0[2], silu_fast(g0[3]) * u0[3]);
                w.z = cvt_pk_bf16(silu_fast(g1[0]) * u1[0], silu_fast(g1[1]) * u1[1]); w.w = cvt_pk_bf16(silu_fast(g1[2]) * u1[2], silu_fast(g1[3]) * u1[3]);
                *(u32x4*)rowp = w; }
    }
};
struct EpiMoeDown {
    static constexpr bool PERM = false, AFTER_DRAIN = false;
    float* h; const int* stok; const float* sgate; int row_base;
    __device__ __forceinline__ void operator()(const f32x4 (&acc)[2][2][4][2], const Unit& u, int wr, int wc, int fr, int fq) const {
        const int row0 = u.pm * BM + wr * 64 + fr, col0 = (u.pn & 3) * BM + wc * 32 + 4 * fq;
#pragma unroll
        for (int ai = 0; ai < 2; ++ai)
#pragma unroll
            for (int m = 0; m < 4; ++m) { const int sr = row_base + row0 + ai * HALF + m * 16; const int tok = stok[sr];
                if (tok >= 0) { const float gt = sgate[sr]; float* op = h + (size_t)tok * 1024;
#pragma unroll
                    for (int bj = 0; bj < 2; ++bj)
#pragma unroll
                        for (int n = 0; n < 2; ++n) { const int c = col0 + bj * HALF + n * 16; const f32x4 v = *(const f32x4*)(op + c) + acc[ai][bj][m][n] * gt; *(f32x4*)(op + c) = v; }
                }
                asm volatile("" ::: "memory"); }
    }
};
struct MoeOrder {
    int t0, nT, nN, G, c; const int* tile_expert;
    __device__ __forceinline__ bool next(int i, Unit& u) const {
        const long L = (long)i * G + c; if (L >= (long)nT * nN) return false;
        const int tl = (int)(L / nN), j = (int)(L % nN); u.pm = tl; u.pn = tile_expert[t0 + tl] * nN + j; return true;
    }
    __device__ __forceinline__ void a_ready(const Unit&) const {}
    __device__ __forceinline__ void done(const Unit&) const {}
};
}

namespace attn_body {
using bf16=unsigned short;
using bf16x8=__attribute__((ext_vector_type(8)))short;
using s16x4=__attribute__((ext_vector_type(4)))short;
using f32x16=__attribute__((ext_vector_type(16)))float;
using u32x4=__attribute__((ext_vector_type(4)))unsigned;
constexpr int D=64,DM=PW;
constexpr int NW=8,QBLK=32,KVBLK=64;
__device__ __forceinline__ int crow(int r,int hi){return (r&3)+8*(r>>2)+4*hi;}
#define SBAR() __builtin_amdgcn_sched_barrier(0)
__device__ __forceinline__ void meta_mask(f32x16&p0,f32x16&p1){
  const float NEG=-INFINITY;
  #pragma unroll
  for(int r=8;r<16;++r)p0[r]=NEG;
  #pragma unroll
  for(int r=0;r<16;++r)p1[r]=NEG;
}
__device__ __forceinline__ void swa_mask(f32x16&p0,f32x16&p1,int rel0,int lo,int hi_,bool metatile,bool dead,const __attribute__((address_space(3))) float*bt,float mh){
  const float NEG=-INFINITY;
  if(dead){
    #pragma unroll
    for(int r=0;r<16;++r){p0[r]=NEG;p1[r]=NEG;}
  } else {
    #pragma unroll
    for(int r4=0;r4<4;++r4){
      #pragma unroll
      for(int half=0;half<2;++half){
        #pragma unroll
        for(int j=0;j<4;++j){
          const int r=4*r4+j, rel=rel0+(j+8*r4+32*half);
          const int idx=rel>hi_?hi_:(rel<lo?lo:rel);
          const float bv=bt[idx+129]-mh;
          if(half==0)p0[r]+=bv; else p1[r]+=bv; } }
      __builtin_amdgcn_sched_barrier(0); }
    if(metatile){
      #pragma unroll
      for(int r=8;r<16;++r)p0[r]=NEG;
      #pragma unroll
      for(int r=0;r<16;++r)p1[r]=NEG; }
  }
}

constexpr int NSLOT=3, SLOTB=8192;
constexpr int LDS_K=0, LDS_V=NSLOT*SLOTB, LDS_WS=2*NSLOT*SLOTB, LDS_OST=LDS_WS+NW*64*4, LDS_BYTES=LDS_OST+NW*4096;
constexpr float C2=0.125f*1.4426950408889634f;
__device__ __forceinline__ void glds16(const void*gsrc,unsigned lds_dst){unsigned keep;
  asm volatile("s_mov_b32 %0, m0\n\ts_mov_b32 m0, %2\n\ts_nop 0\n\tglobal_load_lds_dwordx4 %1, off\n\ts_mov_b32 m0, %0":"=&s"(keep):"v"(gsrc),"s"(lds_dst):"memory");}
__device__ __forceinline__ float max3f(float a,float b,float c){float r;asm("v_max3_f32 %0, %1, %2, %3":"=v"(r):"v"(a),"v"(b),"v"(c));return r;}
__device__ __forceinline__ float max2f(float a,float b){float r;asm("v_max_f32_e32 %0, %1, %2":"=v"(r):"v"(a),"v"(b));return r;}
__device__ __forceinline__ float fadd_s(float a,float b){float r;asm("v_add_f32_e32 %0, %1, %2":"=v"(r):"v"(a),"v"(b));return r;}
__device__ __forceinline__ float fsub_s(float a,float b){float r;asm("v_sub_f32_e32 %0, %1, %2":"=v"(r):"v"(a),"v"(b));return r;}
typedef float f32x2_t __attribute__((ext_vector_type(2))); typedef __bf16 bf16x2_t __attribute__((ext_vector_type(2)));
__device__ __forceinline__ unsigned cvtpk_s(float lo,float hi){f32x2_t v={lo,hi};bf16x2_t b=__builtin_convertvector(v,bf16x2_t);return __builtin_bit_cast(unsigned,b);}
#define WAIT_BAR(N) asm volatile("s_waitcnt vmcnt(" #N ") lgkmcnt(0)\n\ts_barrier":::"memory")

__device__ __forceinline__ void qkt(f32x16&p0,f32x16&p1,const char*Kslot,const bf16x8*qr,const f32x16&negm,int r32,int hi){
  const char*kb=Kslot+hi*1024+r32*16;
  #pragma unroll
  for(int d0=0;d0<4;++d0){
    const bf16x8 b0=*reinterpret_cast<const bf16x8*>(kb+d0*2048);
    const bf16x8 b1=*reinterpret_cast<const bf16x8*>(kb+d0*2048+512);
    if(d0==0){p0=__builtin_amdgcn_mfma_f32_32x32x16_bf16(b0,qr[0],negm,0,0,0);p1=__builtin_amdgcn_mfma_f32_32x32x16_bf16(b1,qr[0],negm,0,0,0);}
    else{p0=__builtin_amdgcn_mfma_f32_32x32x16_bf16(b0,qr[d0],p0,0,0,0);p1=__builtin_amdgcn_mfma_f32_32x32x16_bf16(b1,qr[d0],p1,0,0,0);}}
}
typedef __attribute__((address_space(3))) const char* lds_cptr;
typedef short v4i16_t __attribute__((ext_vector_type(4)));
__device__ __forceinline__ void kload8(bf16x8*kf,lds_cptr kp){
  kf[0]=*(const __attribute__((address_space(3))) bf16x8*)(kp);      kf[1]=*(const __attribute__((address_space(3))) bf16x8*)(kp+512);
  kf[2]=*(const __attribute__((address_space(3))) bf16x8*)(kp+2048); kf[3]=*(const __attribute__((address_space(3))) bf16x8*)(kp+2560);
  kf[4]=*(const __attribute__((address_space(3))) bf16x8*)(kp+4096); kf[5]=*(const __attribute__((address_space(3))) bf16x8*)(kp+4608);
  kf[6]=*(const __attribute__((address_space(3))) bf16x8*)(kp+6144); kf[7]=*(const __attribute__((address_space(3))) bf16x8*)(kp+6656);
}
__device__ __forceinline__ void kload2(bf16x8*kf,lds_cptr kp,int j){ kf[2*j]=*(const __attribute__((address_space(3))) bf16x8*)(kp+j*2048); kf[2*j+1]=*(const __attribute__((address_space(3))) bf16x8*)(kp+j*2048+512); }
__device__ __forceinline__ s16x4 vtr(lds_cptr p){ return __builtin_bit_cast(s16x4,__builtin_amdgcn_ds_read_tr16_b64_v4i16((__attribute__((address_space(3))) v4i16_t*)p)); }
__device__ __forceinline__ float rowmax(const f32x16&p0,const f32x16&p1){
  float a=max3f(p0[0],p0[1],p1[0]),b=max3f(p0[2],p0[3],p1[1]);a=max3f(a,p1[2],p1[3]);
  #pragma unroll
  for(int r=4;r<16;r+=4){a=max3f(a,p0[r],p0[r+1]);b=max3f(b,p0[r+2],p0[r+3]);a=max3f(a,p1[r],p1[r+1]);b=max3f(b,p1[r+2],p1[r+3]);}
  const float m=max2f(a,b);
  auto rr=__builtin_amdgcn_permlane32_swap(__float_as_uint(m),__float_as_uint(m),false,false);
  return max2f(__uint_as_float(rr[0]),__uint_as_float(rr[1]));
}
__device__ __forceinline__ void pv(f32x16*o,int vb,bf16x8 pa0,bf16x8 pa1,bf16x8 pa2,bf16x8 pa3){
  #pragma unroll
  for(int d0=0;d0<2;++d0){s16x4 lo[4],hi[4];
    #pragma unroll
    for(int ks=0;ks<4;++ks){
      asm volatile("ds_read_b64_tr_b16 %0,%1 offset:%c2":"=&v"(lo[ks]):"v"(vb),"i"(d0*4096+ks*1024):"memory");
      asm volatile("ds_read_b64_tr_b16 %0,%1 offset:%c2":"=&v"(hi[ks]):"v"(vb),"i"(d0*4096+ks*1024+512):"memory");}
    asm volatile("s_waitcnt lgkmcnt(0)":::"memory");SBAR();
    #define PK(k) (bf16x8){lo[k][0],lo[k][1],lo[k][2],lo[k][3],hi[k][0],hi[k][1],hi[k][2],hi[k][3]}
    o[d0]=__builtin_amdgcn_mfma_f32_32x32x16_bf16(pa0,PK(0),o[d0],0,0,0);
    o[d0]=__builtin_amdgcn_mfma_f32_32x32x16_bf16(pa1,PK(1),o[d0],0,0,0);
    o[d0]=__builtin_amdgcn_mfma_f32_32x32x16_bf16(pa2,PK(2),o[d0],0,0,0);
    o[d0]=__builtin_amdgcn_mfma_f32_32x32x16_bf16(pa3,PK(3),o[d0],0,0,0);
    #undef PK
  }
}

__device__ __forceinline__ int swa_off(int j){ return j<2 ? 64*j : (j<4 ? 64*j-256 : 64*j-128); }
__device__ __forceinline__ int swa_clamp(int s){ return s<0?0:(s>S_-KVBLK?S_-KVBLK:s); }
#ifndef ATTN_STORE16
#define ATTN_STORE16(p,v) (*(u32x4*)(p)=(v))
#endif
template<int THRL,bool SWA> __device__ __forceinline__ void attn_unit(int b,int qb,const bf16*Qc,const bf16*__restrict__ Kc,const bf16*__restrict__ Vc,bf16*Oc,char*shm,const __attribute__((address_space(3))) float*btab,int g){
  constexpr int NT = SWA ? 7 : S_/KVBLK+1;
  static_assert((NT&1)==1 && NT>=7,"odd tile count");
  int tid=threadIdx.x; asm volatile("":"+v"(tid));
  const int lane=tid&63,r32=lane&31,hi=lane>>5; const int wid=__builtin_amdgcn_readfirstlane(tid>>6);
  const bool meta=qb<0; const int hh=wid&1, blk=wid>>1;
  const int qrow0= meta ? NREG+b*NM : b*S_+128*qb+32*blk;
  const int tq= meta ? r32 : NM+128*qb+32*blk+r32;
  const int T0s= meta ? 0 : 128*qb;
  const bf16*Qw=Qc+(long)qrow0*DM+hh*D;
  #define TROW(t) ( SWA ? ((t)==6 ? NREG+b*NM : b*S_+swa_clamp(T0s+swa_off(t))) : ((t)<NT-1 ? b*S_+KVBLK*(t) : NREG+b*NM) )
  const unsigned lds0=(unsigned)(uintptr_t)shm;
  float*wsf=(float*)(shm+LDS_WS)+wid*64;
  const bf16*ksrc=Kc+(long)lane*DM+wid*8;
  const bf16*vsrc=Vc+(long)(16*(wid&3)+(lane>>2))*DM+(wid>>2)*32+(lane&3)*8;
  const unsigned kdst=lds0+LDS_K+wid*1024, vdst=lds0+LDS_V+wid*1024;
  #define DMA_K(t,slot) glds16(ksrc+(long)TROW(t)*DM,(unsigned)__builtin_amdgcn_readfirstlane(kdst+(slot)))
  #define DMA_V(t,slot) glds16(vsrc+(long)TROW(t)*DM,(unsigned)__builtin_amdgcn_readfirstlane(vdst+(slot)))
  const int vb0=(int)(lds0+LDS_V)+((lane>>4)&1)*32+(lane&3)*8+(4*hi+((lane&15)>>2))*64;
  const char*Kbase=shm+LDS_K; bf16x8 kf[8];
  const lds_cptr shm3=(lds_cptr)shm; const lds_cptr kp0=shm3+LDS_K+hi*1024+r32*16; const lds_cptr vp0=shm3+LDS_V+((lane>>4)&1)*32+(lane&3)*8+(4*hi+((lane&15)>>2))*64;
  DMA_K(0,0);DMA_V(0,0);DMA_K(1,SLOTB);
  bf16x8 qr[4];
  #pragma unroll
  for(int d0=0;d0<4;++d0)qr[d0]=*reinterpret_cast<const bf16x8*>(&Qw[(long)r32*DM+d0*16+hi*8]);
  #define NEGC (SWA ? f32x16{} : negm)
  float mhat=0.f,l_reg=0.f;f32x16 o[2];o[0]=f32x16{};o[1]=f32x16{};f32x16 negm=f32x16{};if constexpr(!SWA){asm volatile("":"+v"(negm));}
  const __attribute__((address_space(3))) float*bt=btab+(2*g+hh)*264; const int relq=4*hi-tq;
  #define CMASK(P0,P1,t) do{ if constexpr(SWA){ swa_mask(P0,P1,((t)==6?0:NM+T0s+swa_off(t))+relq,(t)==6?-128:-129,(t)==6?128:129,(t)==6,(t)!=6&&((T0s+swa_off(t))<0||(T0s+swa_off(t))>=S_),bt,mhat); } else { if((t)==NT-1)meta_mask(P0,P1); } }while(0)
  bool resc=false;
  #define START(P0,P1) do{ const float rm=rowmax(P0,P1); resc=false; \
    { const float dl=rm; mhat=fadd_s(mhat,dl); \
      _Pragma("unroll") for(int r=0;r<16;++r){P0[r]=fsub_s(P0[r],dl);P1[r]=fsub_s(P1[r],dl);} \
      _Pragma("unroll") for(int r=0;r<16;++r)negm[r]=-mhat; if constexpr(!SWA){asm volatile("":"+v"(negm));} } \
    _Pragma("unroll") for(int r=0;r<16;++r)P0[r]=__builtin_amdgcn_exp2f(P0[r]); }while(0)
  #define RESC() do{ if(resc){ asm volatile("s_waitcnt lgkmcnt(0)":::"memory"); \
      _Pragma("unroll") for(int d_=0;d_<2;++d_) _Pragma("unroll") for(int r=0;r<16;++r)o[d_][r]*=wsf[crow(r,hi)]; } }while(0)
  f32x16 pA0,pA1,pB0,pB1;
  int sl_prev=0,sl_cur=0,sl_next=SLOTB;
  #define ROT() do{sl_prev=sl_cur;sl_cur=sl_next;sl_next=(sl_next==(NSLOT-1)*SLOTB)?0:sl_next+SLOTB;}while(0)
  DMA_K(2,2*SLOTB);
  WAIT_BAR(3);
  qkt(pA0,pA1,Kbase,qr,NEGC,r32,hi);asm volatile("s_nop 15\n\ts_nop 7":"+v"(pA0),"+v"(pA1));CMASK(pA0,pA1,0);
  START(pA0,pA1);
  _Pragma("unroll") for(int r=0;r<16;++r)pA1[r]=__builtin_amdgcn_exp2f(pA1[r]);
  WAIT_BAR(0);
  DMA_K(3,0);DMA_V(1,SLOTB);
  ROT();
  kload8(kf,kp0+sl_cur);
  WAIT_BAR(2);
  s16x4 vlo[8],vhi[8]; u32x4 pw0,pw1,pw2,pw3;
  #define PKW(P,B) cvtpk_s(P[B],P[B+1])
  #define PAF(k) __builtin_bit_cast(bf16x8,pw##k)
  #define VFR(i) (bf16x8){vlo[i][0],vlo[i][1],vlo[i][2],vlo[i][3],vhi[i][0],vhi[i][1],vhi[i][2],vhi[i][3]}
  #define PIN(x) asm volatile("":"+v"(x))
  #define MX3(a,b,c) __builtin_fmaxf(__builtin_fmaxf((a),(b)),(c))
  #define GAPA(MF,A0,A1,A2,A3,W0,W1,PW) do{ MF; sacc+=A0; sacc+=A1; sacc+=A2; sacc+=A3; PIN(sacc); W0; W1; PIN(PW); SBAR(); }while(0)
  #define EX(v) __builtin_amdgcn_exp2f(v)
  #define GAPB(MF,X,B) do{ MF; X[B]=EX(X[B]); X[B+1]=EX(X[B+1]); X[B+2]=EX(X[B+2]); X[B+3]=EX(X[B+3]); PIN(X); SBAR(); }while(0)
  #define VRD(i) do{ vlo[i]=vtr(vp_+(((i)>>2)*4096+((i)&3)*1024)); vhi[i]=vtr(vp_+(((i)>>2)*4096+((i)&3)*1024+512)); }while(0)
  #define KRD(G,j) do{ if(G){ kload2(kf,kp0+sl_next,j); SBAR(); } }while(0)
  #define STEP(C0,C1,P0,P1,t,GK,GV,GL) do{ SBAR(); \
    const lds_cptr vp_=vp0+sl_prev; \
    VRD(0); SBAR(); float sacc=(P0[0]+P0[1]); \
    GAPA(C0=__builtin_amdgcn_mfma_f32_32x32x16_bf16(kf[0],qr[0],NEGC,0,0,0), P0[2],P0[3],P0[4],P0[5],     pw0[0]=PKW(P0,0), pw0[1]=PKW(P0,2), pw0); \
    VRD(4); SBAR(); GAPA(C1=__builtin_amdgcn_mfma_f32_32x32x16_bf16(kf[1],qr[0],NEGC,0,0,0), P0[6],P0[7],P0[8],P0[9],     pw0[2]=PKW(P0,4), pw0[3]=PKW(P0,6), pw0); \
    VRD(1); SBAR(); GAPA(C0=__builtin_amdgcn_mfma_f32_32x32x16_bf16(kf[2],qr[1],C0,0,0,0),   P0[10],P0[11],P0[12],P0[13], pw1[0]=PKW(P0,8), pw1[1]=PKW(P0,10), pw1); \
    VRD(5); SBAR(); GAPA(C1=__builtin_amdgcn_mfma_f32_32x32x16_bf16(kf[3],qr[1],C1,0,0,0),   P0[14],P0[15],P1[0],P1[1],   pw1[2]=PKW(P0,12),pw1[3]=PKW(P0,14), pw1); \
    VRD(2); SBAR(); GAPA(C0=__builtin_amdgcn_mfma_f32_32x32x16_bf16(kf[4],qr[2],C0,0,0,0),   P1[2],P1[3],P1[4],P1[5],     pw2[0]=PKW(P1,0), pw2[1]=PKW(P1,2), pw2); \
    VRD(6); SBAR(); GAPA(C1=__builtin_amdgcn_mfma_f32_32x32x16_bf16(kf[5],qr[2],C1,0,0,0),   P1[6],P1[7],P1[8],P1[9],     pw2[2]=PKW(P1,4), pw2[3]=PKW(P1,6), pw2); \
    VRD(3); SBAR(); GAPA(C0=__builtin_amdgcn_mfma_f32_32x32x16_bf16(kf[6],qr[3],C0,0,0,0),   P1[10],P1[11],P1[12],P1[13], pw3[0]=PKW(P1,8), pw3[1]=PKW(P1,10), pw3); \
    VRD(7); SBAR(); GAPA(C1=__builtin_amdgcn_mfma_f32_32x32x16_bf16(kf[7],qr[3],C1,0,0,0),   P1[14],P1[15],0.f,0.f,       pw3[2]=PKW(P1,12),pw3[3]=PKW(P1,14), pw3); \
    l_reg+=sacc; \
    if(GK){DMA_K((t)+3,sl_cur);} if(GV){DMA_V((t)+1,sl_next);} \
    CMASK(C0,C1,t); \
    { float a=MX3(C0[0],C0[1],C1[0]),b=MX3(C0[2],C0[3],C1[1]); a=MX3(a,C1[2],C1[3]); \
      _Pragma("unroll") for(int r=4;r<16;r+=4){a=MX3(a,C0[r],C0[r+1]);b=MX3(b,C0[r+2],C0[r+3]);a=MX3(a,C1[r],C1[r+1]);b=MX3(b,C1[r+2],C1[r+3]);} \
      float rm=__builtin_fmaxf(a,b); { auto rr=__builtin_amdgcn_permlane32_swap(__float_as_uint(rm),__float_as_uint(rm),false,false); rm=__builtin_fmaxf(__uint_as_float(rr[0]),__uint_as_float(rr[1])); } \
      resc=false; \
      if(__builtin_expect(__any(rm>(float)THRL),0)){ const float dl=__builtin_fmaxf(rm,0.f); mhat+=dl; \
        _Pragma("unroll") for(int r=0;r<16;++r){C0[r]-=dl;C1[r]-=dl;} \
        _Pragma("unroll") for(int r=0;r<16;++r)negm[r]=-mhat; if constexpr(!SWA){asm volatile("":"+v"(negm));} \
        const float f=__builtin_amdgcn_exp2f(-dl); l_reg*=f; if(hi==0)wsf[r32]=f; resc=true; } } \
    SBAR(); \
    GAPB(o[0]=__builtin_amdgcn_mfma_f32_32x32x16_bf16(PAF(0),VFR(0),o[0],0,0,0), C0,0); \
    GAPB(o[1]=__builtin_amdgcn_mfma_f32_32x32x16_bf16(PAF(0),VFR(4),o[1],0,0,0), C0,4); \
    KRD(GL,0); GAPB(o[0]=__builtin_amdgcn_mfma_f32_32x32x16_bf16(PAF(1),VFR(1),o[0],0,0,0), C0,8); \
    KRD(GL,1); GAPB(o[1]=__builtin_amdgcn_mfma_f32_32x32x16_bf16(PAF(1),VFR(5),o[1],0,0,0), C0,12); \
    KRD(GL,2); GAPB(o[0]=__builtin_amdgcn_mfma_f32_32x32x16_bf16(PAF(2),VFR(2),o[0],0,0,0), C1,0); \
    KRD(GL,3); GAPB(o[1]=__builtin_amdgcn_mfma_f32_32x32x16_bf16(PAF(2),VFR(6),o[1],0,0,0), C1,4); \
    GAPB(o[0]=__builtin_amdgcn_mfma_f32_32x32x16_bf16(PAF(3),VFR(3),o[0],0,0,0), C1,8); \
    GAPB(o[1]=__builtin_amdgcn_mfma_f32_32x32x16_bf16(PAF(3),VFR(7),o[1],0,0,0), C1,12); \
    }while(0)
  int t=1;
  #undef CMASK
  #define CMASK(P0,P1,t) do{ if constexpr(SWA){ swa_mask(P0,P1,((t)==6?0:NM+T0s+swa_off(t))+relq,(t)==6?-128:-129,(t)==6?128:129,(t)==6,(t)!=6&&((T0s+swa_off(t))<0||(T0s+swa_off(t))>=S_),bt,mhat); } }while(0)
  for(;t+5<NT;t+=2){
    STEP(pB0,pB1,pA0,pA1,t,true,true,true);     WAIT_BAR(2); RESC(); ROT();
    STEP(pA0,pA1,pB0,pB1,t+1,true,true,true);   WAIT_BAR(2); RESC(); ROT();
  }
  #undef CMASK
  #define CMASK(P0,P1,t) do{ if constexpr(SWA){ swa_mask(P0,P1,((t)==6?0:NM+T0s+swa_off(t))+relq,(t)==6?-128:-129,(t)==6?128:129,(t)==6,(t)!=6&&((T0s+swa_off(t))<0||(T0s+swa_off(t))>=S_),bt,mhat); } else { if((t)==NT-1)meta_mask(P0,P1); } }while(0)
  #define ENDW(tt) do{ if((tt)+3<NT){WAIT_BAR(2);} else if((tt)+2<NT){WAIT_BAR(1);} else {WAIT_BAR(0);} }while(0)
  for(;t+2<NT;t+=2){
    STEP(pB0,pB1,pA0,pA1,t,(t+3<NT),(t+1<NT),(t+1<NT));       ENDW(t);   RESC(); ROT();
    STEP(pA0,pA1,pB0,pB1,t+1,(t+4<NT),(t+2<NT),(t+2<NT));     ENDW(t+1); RESC(); ROT();
  }
  STEP(pB0,pB1,pA0,pA1,NT-2,false,true,true); WAIT_BAR(0); RESC(); ROT();
  STEP(pA0,pA1,pB0,pB1,NT-1,false,false,false); RESC();
  { float sacc=pA0[0]+pA0[1]; _Pragma("unroll") for(int r=2;r<16;++r)sacc+=pA0[r]; _Pragma("unroll") for(int r=0;r<16;++r)sacc+=pA1[r]; l_reg+=sacc;
    pw0=(u32x4){PKW(pA0,0),PKW(pA0,2),PKW(pA0,4),PKW(pA0,6)};pw1=(u32x4){PKW(pA0,8),PKW(pA0,10),PKW(pA0,12),PKW(pA0,14)};pw2=(u32x4){PKW(pA1,0),PKW(pA1,2),PKW(pA1,4),PKW(pA1,6)};pw3=(u32x4){PKW(pA1,8),PKW(pA1,10),PKW(pA1,12),PKW(pA1,14)};
    SBAR(); pv(o,vb0+sl_cur,PAF(0),PAF(1),PAF(2),PAF(3)); }
  #undef PKW
  #undef PAF
  #undef VFR
  #undef PIN
  #undef MX3
  #undef GAPA
  #undef GAPB
  #undef EX
  #undef VRD
  #undef KRD
  #undef STEP
  #undef ENDW
  {auto rr=__builtin_amdgcn_permlane32_swap(__float_as_uint(l_reg),__float_as_uint(l_reg),false,false);l_reg=__uint_as_float(rr[0])+__uint_as_float(rr[1]);}
  if constexpr(SWA){ l_reg+=__builtin_amdgcn_exp2f(btab[4*264+2*g+hh]-mhat); }
  int lane_e=threadIdx.x&63; asm volatile("":"+v"(lane_e)); const int r32e=lane_e&31,hie=lane_e>>5;
  if(hie==0)wsf[32+r32e]=l_reg;asm volatile("s_waitcnt lgkmcnt(0)":::"memory");
  float rli[16];
  #pragma unroll
  for(int r=0;r<16;++r)rli[r]=__builtin_amdgcn_rcpf(wsf[32+crow(r,hie)]);
  bf16*Ow=Oc+(long)qrow0*1024+hh*D;
  { bf16*stg=(bf16*)(shm+LDS_OST)+wid*2048;
    #pragma unroll
    for(int r=0;r<16;++r){const int orow=crow(r,hie);
      #pragma unroll
      for(int d0=0;d0<2;++d0)stg[orow*64+d0*32+r32e]=(bf16)(cvtpk_s(o[d0][r]*rli[r],0.f)&0xffffu);}
    asm volatile("s_waitcnt lgkmcnt(0)":::"memory");
    #pragma unroll
    for(int i=0;i<4;++i){const int row=i*8+(lane_e>>3),ch=lane_e&7; const u32x4 v=*(const u32x4*)(stg+row*64+ch*8); if(!meta||(blk==0&&row<NM))ATTN_STORE16(Ow+(long)row*1024+ch*8,v);} }
  asm volatile("s_waitcnt lgkmcnt(0)\n\ts_barrier":::"memory");
  #undef DMA_K
  #undef DMA_V
  #undef TROW
  #undef NEGC
  #undef CMASK
  #undef START
  #undef RESC
  #undef ROT
}
constexpr int ATTN_LDS_BYTES=LDS_BYTES;
#undef SBAR
#undef WAIT_BAR
}

#define GAS __attribute__((address_space(1)))
#define LAS __attribute__((address_space(3)))
typedef unsigned short bf16;
typedef unsigned v4u __attribute__((ext_vector_type(4)));
typedef float f32x4 __attribute__((ext_vector_type(4)));
typedef short bf16x8 __attribute__((ext_vector_type(8)));
typedef GAS unsigned gu32;
typedef GAS unsigned long long gu64;
#define RLX_AGENT __ATOMIC_RELAXED, __HIP_MEMORY_SCOPE_AGENT
#define LDS_WAIT() asm volatile("s_waitcnt lgkmcnt(0)" ::: "memory")
#define VM_WAIT() asm volatile("s_waitcnt vmcnt(0)" ::: "memory")
__device__ __forceinline__ unsigned long long rt() { return __builtin_amdgcn_s_memrealtime(); }
__device__ __forceinline__ unsigned pk2(float lo, float hi) { return (unsigned)f2bf(lo) | ((unsigned)f2bf(hi) << 16); }

#define XB_TMO      128
#define XB_XCNT(j)  (256  + 64 * (j))
#define XB_XSUB(j)  (1280 + 64 * (j))
#define XB_XGEN(j)  (2304 + 64 * (j))
#define XB_TOP      3328
#define XB_TOPGEN   3392
#define XCD_BAR_WORDS 3456
#define XB_SPIN_CAP (1u << 22)

__device__ __forceinline__ unsigned xb_ld(unsigned* p)              { return __hip_atomic_load(p, __ATOMIC_RELAXED, __HIP_MEMORY_SCOPE_AGENT); }
__device__ __forceinline__ unsigned xb_add(unsigned* p, unsigned v) { return __hip_atomic_fetch_add(p, v, __ATOMIC_RELAXED, __HIP_MEMORY_SCOPE_AGENT); }
__device__ __forceinline__ unsigned xb_xcc_id() { return (unsigned)__builtin_amdgcn_s_getreg((3 << 11) | 20) & 0xFu; }
#define XB_SPIN(cond, bar) do { unsigned _sp = 0; while (cond) { __builtin_amdgcn_s_sleep(1); \
    if ((++_sp & 255u) == 0u) { if (xb_ld(&(bar)[XB_TMO])) break; if (_sp > XB_SPIN_CAP) { atomicAdd(&(bar)[XB_TMO], 1u); break; } } } } while (0)

struct XcdBarrier {
    unsigned* bar; unsigned x;
    volatile LAS unsigned* st;
};

__device__ __forceinline__ XcdBarrier xcd_barrier_post(unsigned* bar, volatile LAS unsigned* st) {
    XcdBarrier b; b.bar = bar; b.x = xb_xcc_id(); b.st = st;
    if (threadIdx.x == 0) (void)xb_add(&bar[XB_XCNT(b.x)], 1u);
    return b;
}
__device__ __forceinline__ void xcd_barrier_complete(unsigned* bar, unsigned x, unsigned& nloc, unsigned& nx) {
    const unsigned G = gridDim.x * gridDim.y * gridDim.z;
    unsigned sum, cnt, mine, sp = 0u;
    for (;;) {
        sum = 0u; cnt = 0u; mine = 0u;
#pragma unroll
        for (unsigned j = 0; j < 16; ++j) { const unsigned c = xb_ld(&bar[XB_XCNT(j)]); sum += c; cnt += (c > 0u) ? 1u : 0u; mine = (j == x) ? c : mine; }
        if (sum == G) break;
        __builtin_amdgcn_s_sleep(1);
        if ((++sp & 255u) == 0u) { if (xb_ld(&bar[XB_TMO])) break; if (sp > XB_SPIN_CAP) { atomicAdd(&bar[XB_TMO], 1u); break; } }
    }
    nloc = mine > 0u ? mine : 1u; nx = cnt > 0u ? cnt : 1u;
}

__device__ __forceinline__ void xcd_barrier(const XcdBarrier& b) {
    asm volatile("s_waitcnt vmcnt(0)" ::: "memory");
    __syncthreads();
    if (threadIdx.x == 0) {
        unsigned* bar = b.bar;
        __builtin_amdgcn_s_waitcnt(0);
        unsigned nloc = b.st[0], nx = b.st[1];
        if (nloc == 0u) { xcd_barrier_complete(bar, b.x, nloc, nx); b.st[0] = nloc; b.st[1] = nx; }
        const unsigned old = xb_add(&bar[XB_XSUB(b.x)], 1u);
        const unsigned gen = old / nloc;
        if (old + 1u == (gen + 1u) * nloc) {
            __builtin_amdgcn_fence(__ATOMIC_RELEASE, "agent");
            asm volatile("s_waitcnt vmcnt(0)" ::: "memory");
            const unsigned og = xb_add(&bar[XB_TOP], 1u);
            const unsigned tg = og / nx;
            if (og + 1u == (tg + 1u) * nx) xb_add(&bar[XB_TOPGEN], 1u);
            else XB_SPIN(xb_ld(&bar[XB_TOPGEN]) == tg, bar);
            __builtin_amdgcn_fence(__ATOMIC_ACQUIRE, "agent");
            xb_add(&bar[XB_XGEN(b.x)], 1u);
            asm volatile("s_waitcnt vmcnt(0)" ::: "memory");
        } else {
            XB_SPIN(xb_ld(&bar[XB_XGEN(b.x)]) == gen, bar);
            __builtin_amdgcn_fence(__ATOMIC_ACQUIRE, "agent");
            asm volatile("s_waitcnt vmcnt(0)" ::: "memory");
        }
    }
    __syncthreads();
}

namespace mix {
typedef short bf16x8 __attribute__((ext_vector_type(8)));
typedef short s16x4 __attribute__((ext_vector_type(4)));
typedef float f32x4 __attribute__((ext_vector_type(4)));
typedef unsigned u32x4 __attribute__((ext_vector_type(4)));
typedef unsigned u32x2 __attribute__((ext_vector_type(2)));
typedef __attribute__((address_space(3))) const char* lcp;
typedef __attribute__((address_space(3))) char* lp;
#define MFMA16(a, b, c) __builtin_amdgcn_mfma_f32_16x16x32_bf16((a), (b), (c), 0, 0, 0)
__device__ __forceinline__ bf16x8 frag_row(lcp tile, int P, int row0, int k0, int fr, int quad) { return *(const __attribute__((address_space(3))) bf16x8*)(tile + (row0 + fr) * P + (k0 + 8 * quad) * 2); }
__device__ __forceinline__ bf16x8 frag_tr(lcp tile, int P, int k0, int col0, int fr, int quad) {
    typedef short v4i16_t __attribute__((ext_vector_type(4)));
    lcp a = tile + (k0 + 8 * quad + (fr >> 2)) * P + (col0 + 4 * (fr & 3)) * 2;
    const s16x4 lo = __builtin_bit_cast(s16x4, __builtin_amdgcn_ds_read_tr16_b64_v4i16((__attribute__((address_space(3))) v4i16_t*)a));
    const s16x4 hi = __builtin_bit_cast(s16x4, __builtin_amdgcn_ds_read_tr16_b64_v4i16((__attribute__((address_space(3))) v4i16_t*)(a + 4 * P)));
    return (bf16x8){lo[0], lo[1], lo[2], lo[3], hi[0], hi[1], hi[2], hi[3]};
}
__device__ __forceinline__ unsigned pkbf(float lo, float hi) { typedef float f2 __attribute__((ext_vector_type(2))); typedef __bf16 b2 __attribute__((ext_vector_type(2))); f2 v = {lo, hi}; return __builtin_bit_cast(unsigned, __builtin_convertvector(v, b2)); }
__device__ __forceinline__ float bflo(unsigned u) { return __uint_as_float(u << 16); }
__device__ __forceinline__ float bfhi(unsigned u) { return __uint_as_float(u & 0xffff0000u); }

constexpr int SSD_CT = 0, SSD_BT = 34816, SSD_XD = 69632, SSD_XW = 88064, SSD_SB = 106496, SSD_ACS = 123904, SSD_DTL = 124416, SSD_LDS = 124928;
__device__ __forceinline__ int ssd_tok(int c, int l, int dir) { return dir == 0 ? 128 * c - 112 + l : 128 * (32 - c) + 15 - l; }
__device__ __forceinline__ void ssd_stream(int b, int h, int dir, const bf16* xbca, const float* dtga, float dt_bias, float a_neg, bf16* yout, int ypitch, lp lds) {
    int tid = threadIdx.x; asm volatile("" : "+v"(tid));
    const int lane = tid & 63, fr = lane & 15, quad = lane >> 4; const int w = __builtin_amdgcn_readfirstlane(tid >> 6);
    const int g = h >> 1;
    constexpr int P128 = 272, P64 = 144;
    f32x4 S[4];
#pragma unroll
    for (int pb = 0; pb < 4; ++pb) S[pb] = (f32x4){0.f, 0.f, 0.f, 0.f};
    __attribute__((address_space(3))) float* acs = (__attribute__((address_space(3))) float*)(lds + SSD_ACS);
    __attribute__((address_space(3))) float* dtl = (__attribute__((address_space(3))) float*)(lds + SSD_DTL);
    for (int c = 0; c < 33; ++c) {
        if (w == 0) {
            float d0, d1;
            { const int t0 = ssd_tok(c, 2 * lane, dir), t1 = ssd_tok(c, 2 * lane + 1, dir);
              d0 = t0 >= 0 ? softplusf(dtga[(size_t)row_of(b, t0 < 0 ? 0 : t0) * DGW + dir * 4 + h] + dt_bias) : 0.f;
              d1 = t1 >= 0 ? softplusf(dtga[(size_t)row_of(b, t1 < 0 ? 0 : t1) * DGW + dir * 4 + h] + dt_bias) : 0.f; }
            const float v0 = d0 * a_neg, v1 = v0 + d1 * a_neg;
            float inc = v1;
#pragma unroll
            for (int o = 1; o < 64; o <<= 1) { const float u = __shfl_up(inc, o); if (lane >= o) inc += u; }
            const float pre = inc - v1;
            acs[2 * lane] = pre + v0; acs[2 * lane + 1] = pre + v1; dtl[2 * lane] = d0; dtl[2 * lane + 1] = d1;
        }
#pragma unroll
        for (int i = 0; i < 4; ++i) { const int id = tid + 512 * i, row = id >> 4, ch = id & 15; const int t = ssd_tok(c, row, dir);
            u32x4 vc = {0u, 0u, 0u, 0u}, vb = {0u, 0u, 0u, 0u};
            if (t >= 0) { const bf16* src = xbca + (size_t)row_of(b, t) * XW + g * 128 + ch * 8; vb = *(const u32x4*)(src + 256); vc = *(const u32x4*)(src + 512); }
            *(__attribute__((address_space(3))) u32x4*)(lds + SSD_CT + row * P128 + ch * 16) = vc; *(__attribute__((address_space(3))) u32x4*)(lds + SSD_BT + row * P128 + ch * 16) = vb; }
#pragma unroll
        for (int pb = 0; pb < 4; ++pb) { u32x2 v; v.x = pkbf(S[pb][0], S[pb][1]); v.y = pkbf(S[pb][2], S[pb][3]);
            *(__attribute__((address_space(3))) u32x2*)(lds + SSD_SB + (16 * pb + fr) * P128 + (16 * w + 4 * quad) * 2) = v; }
        __syncthreads();
        const float alast = acs[127];
#pragma unroll
        for (int i = 0; i < 2; ++i) { const int id = tid + 512 * i, row = id >> 3, ch = id & 7; const int t = ssd_tok(c, row, dir);
            u32x4 vx = {0u, 0u, 0u, 0u};
            if (t >= 0) vx = *(const u32x4*)(xbca + (size_t)row_of(b, t) * XW + h * 64 + ch * 8);
            const float d = dtl[row], dw = d * __expf(alast - acs[row]);
            u32x4 o1, o2;
            o1.x = pkbf(bflo(vx.x) * d, bfhi(vx.x) * d); o1.y = pkbf(bflo(vx.y) * d, bfhi(vx.y) * d); o1.z = pkbf(bflo(vx.z) * d, bfhi(vx.z) * d); o1.w = pkbf(bflo(vx.w) * d, bfhi(vx.w) * d);
            o2.x = pkbf(bflo(vx.x) * dw, bfhi(vx.x) * dw); o2.y = pkbf(bflo(vx.y) * dw, bfhi(vx.y) * dw); o2.z = pkbf(bflo(vx.z) * dw, bfhi(vx.z) * dw); o2.w = pkbf(bflo(vx.w) * dw, bfhi(vx.w) * dw);
            *(__attribute__((address_space(3))) u32x4*)(lds + SSD_XD + row * P64 + ch * 16) = o1; *(__attribute__((address_space(3))) u32x4*)(lds + SSD_XW + row * P64 + ch * 16) = o2; }
        __syncthreads();
        f32x4 G[8];
#pragma unroll
        for (int sb = 0; sb < 8; ++sb) { G[sb] = (f32x4){0.f, 0.f, 0.f, 0.f};
            if (sb <= w) {
#pragma unroll
                for (int ks = 0; ks < 4; ++ks) G[sb] = MFMA16(frag_row(lds + SSD_BT, P128, 16 * sb, 32 * ks, fr, quad), frag_row(lds + SSD_CT, P128, 16 * w, 32 * ks, fr, quad), G[sb]); } }
        { const float dec = __expf(alast);
#pragma unroll
            for (int pb = 0; pb < 4; ++pb) S[pb] = S[pb] * dec;
#pragma unroll
            for (int ks = 0; ks < 4; ++ks) { const bf16x8 fb = frag_tr(lds + SSD_BT, P128, 32 * ks, 16 * w, fr, quad);
#pragma unroll
                for (int pb = 0; pb < 4; ++pb) S[pb] = MFMA16(fb, frag_tr(lds + SSD_XW, P64, 32 * ks, 16 * pb, fr, quad), S[pb]); } }
        __syncthreads();
        { const int l = 16 * w + fr; const float al = acs[l];
#pragma unroll
            for (int sb = 0; sb < 8; ++sb) { u32x2 v = {0u, 0u};
                if (sb <= w) { const int s0 = 16 * sb + 4 * quad; const f32x4 as = *(const __attribute__((address_space(3))) f32x4*)(acs + s0);
                    const float e0 = s0 + 0 <= l ? G[sb][0] * __expf(al - as[0]) : 0.f, e1 = s0 + 1 <= l ? G[sb][1] * __expf(al - as[1]) : 0.f;
                    const float e2 = s0 + 2 <= l ? G[sb][2] * __expf(al - as[2]) : 0.f, e3 = s0 + 3 <= l ? G[sb][3] * __expf(al - as[3]) : 0.f;
                    v.x = pkbf(e0, e1); v.y = pkbf(e2, e3); }
                *(__attribute__((address_space(3))) u32x2*)(lds + SSD_BT + l * P128 + (16 * sb + 4 * quad) * 2) = v; } }
        __syncthreads();
        f32x4 Y[4], YO[4];
#pragma unroll
        for (int pb = 0; pb < 4; ++pb) { Y[pb] = (f32x4){0.f, 0.f, 0.f, 0.f}; YO[pb] = (f32x4){0.f, 0.f, 0.f, 0.f}; }
#pragma unroll
        for (int ks = 0; ks < 4; ++ks) {
            if (32 * ks <= 16 * w + 15) { const bf16x8 fs = frag_row(lds + SSD_BT, P128, 16 * w, 32 * ks, fr, quad);
#pragma unroll
                for (int pb = 0; pb < 4; ++pb) Y[pb] = MFMA16(frag_tr(lds + SSD_XD, P64, 32 * ks, 16 * pb, fr, quad), fs, Y[pb]); }
            const bf16x8 fc = frag_row(lds + SSD_CT, P128, 16 * w, 32 * ks, fr, quad);
#pragma unroll
            for (int pb = 0; pb < 4; ++pb) YO[pb] = MFMA16(frag_row(lds + SSD_SB, P128, 16 * pb, 32 * ks, fr, quad), fc, YO[pb]);
        }
        { const int l = 16 * w + fr; const float el = __expf(acs[l]); const int t = ssd_tok(c, l, dir);
            if (t >= 0) { bf16* op = yout + (size_t)row_of(b, t) * ypitch + h * 64 + 4 * quad;
#pragma unroll
                for (int pb = 0; pb < 4; ++pb) { const f32x4 y = Y[pb] + YO[pb] * el; u32x2 v; v.x = pkbf(y[0], y[1]); v.y = pkbf(y[2], y[3]); *(u32x2*)(op + 16 * pb) = v; } } }
        __syncthreads();
    }
}

constexpr int GLA_QT = 0, GLA_KT = 5120, GLA_KD = 10240, GLA_V = 15360, GLA_ATT = 24576, GLA_SB = 33792, GLA_WTOT = 38912, GLA_W2 = 39936, GLA_GB = 41984, GLA_LDS = 42112;
__device__ __forceinline__ int gla_tok(int c, int l, int dir) { return dir == 0 ? 64 * c - 48 + l : 64 * (64 - c) + 15 - l; }
__device__ __forceinline__ void gla_stream(int b, int h, int dir, const bf16* proj, const float* dtga, const float* gate_w2, const float* gate_b, bf16* oout, int opitch, lp lds) {
    int tid = threadIdx.x; asm volatile("" : "+v"(tid));
    const int lane = tid & 63, fr = lane & 15, quad = lane >> 4; const int w = __builtin_amdgcn_readfirstlane(tid >> 6);
    constexpr int P32 = 80, P64 = 144;
    typedef __attribute__((address_space(3))) float lfloat; typedef __attribute__((address_space(3))) f32x4 lf4;
    lfloat* wtot = (lfloat*)(lds + GLA_WTOT); lfloat* w2s = (lfloat*)(lds + GLA_W2); lfloat* gbs = (lfloat*)(lds + GLA_GB);
    for (int i = tid; i < 16 * 32; i += 512) w2s[i] = gate_w2[(dir * 16 + (i >> 5)) * 128 + h * 32 + (i & 31)];
    if (tid < 32) gbs[tid] = gate_b[dir * 128 + h * 32 + tid];
    __syncthreads();
    const int kb = w & 1, vbs = w >> 1;
    f32x4 S = {0.f, 0.f, 0.f, 0.f};
    const int rl = tid >> 3, kq = tid & 7;
    for (int c = 0; c < 65; ++c) {
        const int t = gla_tok(c, rl, dir); const bool ok = t >= 0; const size_t row = (size_t)row_of(b, ok ? t : 0);
        float gv[4] = {0.f, 0.f, 0.f, 0.f}; float qv[4] = {0.f, 0.f, 0.f, 0.f}, kv[4] = {0.f, 0.f, 0.f, 0.f}; u32x4 vv = {0u, 0u, 0u, 0u};
        if (ok) {
            const float* ap = dtga + row * DGW + 8 + dir * 16;
            const f32x4 a0 = *(const f32x4*)ap, a1 = *(const f32x4*)(ap + 4), a2 = *(const f32x4*)(ap + 8), a3 = *(const f32x4*)(ap + 12);
            f32x4 z = *(const lf4*)(gbs + 4 * kq);
#pragma unroll
            for (int r = 0; r < 16; ++r) { const float ar = r < 4 ? a0[r & 3] : (r < 8 ? a1[r & 3] : (r < 12 ? a2[r & 3] : a3[r & 3])); const f32x4 ww = *(const lf4*)(w2s + r * 32 + 4 * kq); z = z + ww * ar; }
#pragma unroll
            for (int j = 0; j < 4; ++j) gv[j] = logsigmoidf(z[j]) * (1.0f / 16.0f);
            const unsigned long long qq = *(const unsigned long long*)(proj + row * PW + PGQ + h * 32 + 4 * kq), kk = *(const unsigned long long*)(proj + row * PW + PGK + h * 32 + 4 * kq);
#pragma unroll
            for (int j = 0; j < 4; ++j) { qv[j] = __uint_as_float((unsigned)((qq >> (16 * j)) & 0xffffu) << 16) * 0.17677669529663687f; kv[j] = __uint_as_float((unsigned)((kk >> (16 * j)) & 0xffffu) << 16); }
            vv = *(const u32x4*)(proj + row * PW + PGV + h * 64 + 8 * kq);
        }
        float bc[4];
#pragma unroll
        for (int j = 0; j < 4; ++j) { float x = gv[j];
#pragma unroll
            for (int o = 8; o < 64; o <<= 1) { const float u = __shfl_up(x, o); if (lane >= o) x += u; }
            bc[j] = x; }
        if (lane >= 56) { *(lf4*)(wtot + w * 32 + 4 * kq) = (f32x4){bc[0], bc[1], bc[2], bc[3]}; }
        *(__attribute__((address_space(3))) u32x4*)(lds + GLA_V + rl * P64 + kq * 16) = vv;
        { u32x2 sv; sv.x = pkbf(S[0], S[1]); sv.y = pkbf(S[2], S[3]); *(__attribute__((address_space(3))) u32x2*)(lds + GLA_SB + (16 * vbs + fr) * P32 + (16 * kb + 4 * quad) * 2) = sv; }
        __syncthreads();
        f32x4 pre = {0.f, 0.f, 0.f, 0.f}, blast = {0.f, 0.f, 0.f, 0.f};
#pragma unroll
        for (int ww = 0; ww < 8; ++ww) { const f32x4 tt = *(const lf4*)(wtot + ww * 32 + 4 * kq); blast = blast + tt; if (ww < w) pre = pre + tt; }
        { u32x2 oq, ok2, od; float e[4], en[4], ed[4];
#pragma unroll
            for (int j = 0; j < 4; ++j) { const float bb = bc[j] + pre[j]; e[j] = qv[j] * __expf(bb); en[j] = kv[j] * __expf(-bb); ed[j] = kv[j] * __expf(blast[j] - bb); }
            oq.x = pkbf(e[0], e[1]); oq.y = pkbf(e[2], e[3]); ok2.x = pkbf(en[0], en[1]); ok2.y = pkbf(en[2], en[3]); od.x = pkbf(ed[0], ed[1]); od.y = pkbf(ed[2], ed[3]);
            *(__attribute__((address_space(3))) u32x2*)(lds + GLA_QT + rl * P32 + kq * 8) = oq; *(__attribute__((address_space(3))) u32x2*)(lds + GLA_KT + rl * P32 + kq * 8) = ok2; *(__attribute__((address_space(3))) u32x2*)(lds + GLA_KD + rl * P32 + kq * 8) = od; }
        __syncthreads();
        { const int lb = w & 3;
#pragma unroll
            for (int i = 0; i < 2; ++i) { const int sb = 2 * (w >> 2) + i; f32x4 A = {0.f, 0.f, 0.f, 0.f};
                if (sb <= lb) A = MFMA16(frag_row(lds + GLA_KT, P32, 16 * sb, 0, fr, quad), frag_row(lds + GLA_QT, P32, 16 * lb, 0, fr, quad), A);
                const int l = 16 * lb + fr, s0 = 16 * sb + 4 * quad; u32x2 v;
                v.x = pkbf(s0 + 0 <= l ? A[0] : 0.f, s0 + 1 <= l ? A[1] : 0.f); v.y = pkbf(s0 + 2 <= l ? A[2] : 0.f, s0 + 3 <= l ? A[3] : 0.f);
                *(__attribute__((address_space(3))) u32x2*)(lds + GLA_ATT + l * P64 + s0 * 2) = v; } }
        { const f32x4 bl = *(const lf4*)(wtot + 0 * 32 + 16 * kb + 4 * quad) + *(const lf4*)(wtot + 1 * 32 + 16 * kb + 4 * quad)
                         + *(const lf4*)(wtot + 2 * 32 + 16 * kb + 4 * quad) + *(const lf4*)(wtot + 3 * 32 + 16 * kb + 4 * quad)
                         + *(const lf4*)(wtot + 4 * 32 + 16 * kb + 4 * quad) + *(const lf4*)(wtot + 5 * 32 + 16 * kb + 4 * quad)
                         + *(const lf4*)(wtot + 6 * 32 + 16 * kb + 4 * quad) + *(const lf4*)(wtot + 7 * 32 + 16 * kb + 4 * quad);
            S[0] *= __expf(bl[0]); S[1] *= __expf(bl[1]); S[2] *= __expf(bl[2]); S[3] *= __expf(bl[3]);
#pragma unroll
            for (int ks = 0; ks < 2; ++ks) S = MFMA16(frag_tr(lds + GLA_KD, P32, 32 * ks, 16 * kb, fr, quad), frag_tr(lds + GLA_V, P64, 32 * ks, 16 * vbs, fr, quad), S); }
        __syncthreads();
        { const int lb = w & 3; const int l = 16 * lb + fr; const int to = gla_tok(c, l, dir);
            const bf16x8 fq = frag_row(lds + GLA_QT, P32, 16 * lb, 0, fr, quad);
#pragma unroll
            for (int i = 0; i < 2; ++i) { const int vb = 2 * (w >> 2) + i; f32x4 O = {0.f, 0.f, 0.f, 0.f};
#pragma unroll
                for (int ks = 0; ks < 2; ++ks) if (32 * ks <= 16 * lb + 15) O = MFMA16(frag_tr(lds + GLA_V, P64, 32 * ks, 16 * vb, fr, quad), frag_row(lds + GLA_ATT, P64, 16 * lb, 32 * ks, fr, quad), O);
                O = MFMA16(frag_row(lds + GLA_SB, P32, 16 * vb, 0, fr, quad), fq, O);
                if (to >= 0) { u32x2 v; v.x = pkbf(O[0], O[1]); v.y = pkbf(O[2], O[3]); *(u32x2*)(oout + (size_t)row_of(b, to) * opitch + h * 64 + 16 * vb + 4 * quad) = v; } } }
        __syncthreads();
    }
}
}

constexpr int NWAVES = 8;
constexpr size_t MiB = 1u << 20;
constexpr size_t WS_CTL = 0, CTL_ZERO_BYTES = 1 * MiB;
constexpr size_t WS_DTGA = 1 * MiB;
constexpr size_t WS_ROUTE = 10 * MiB;
constexpr size_t WS_HMETA = 12 * MiB;
constexpr size_t WS_WIN = 13 * MiB;
constexpr size_t WS_WOUT = WS_WIN + 2ull * 3072 * 1024 * 2;
constexpr size_t WS_WGU = WS_WOUT + 2ull * 1024 * 1024 * 2;
constexpr size_t WS_WD = WS_WGU + 5632ull * 1024 * 2;
constexpr size_t WS_WMOE_GU = 46 * MiB;
constexpr size_t WS_WMOE_D = WS_WMOE_GU + 8ull * 7168 * 1024 * 2;
constexpr size_t WS_BIG = 214 * MiB;
constexpr size_t WS_ACT = 392 * MiB;
constexpr size_t WS_TMP = 457 * MiB;
constexpr size_t WS_END = 522 * MiB;
static_assert(WS_WD + 1024ull * 2816 * 2 <= WS_WMOE_GU && WS_WMOE_D + 8ull * 1024 * 3584 * 2 <= WS_BIG && WS_BIG + (size_t)MP * PW * 2 <= WS_ACT && WS_ACT + (size_t)MP * 1024 * 2 <= WS_TMP && WS_TMP + (size_t)MP * 1024 * 2 <= WS_END, "ws map");
static_assert(WS_DTGA + (size_t)MP * DGW * 4 <= WS_ROUTE, "ws map 2");
constexpr int CAP_TILES = 72;
constexpr size_t WS_MOE_ACT = WS_BIG;
constexpr size_t WS_MOE_XG = WS_BIG + (size_t)CAP_TILES * 256 * 3584 * 2;
static_assert(WS_MOE_XG + (size_t)CAP_TILES * 256 * 1024 * 2 <= WS_ACT, "moe pass buffers");
constexpr int MAX_SROWS = 2 * (NREG + 8 * 256);
constexpr size_t RT_E = 0;
constexpr size_t RT_G = RT_E + (size_t)NREG * 4;
constexpr size_t RT_STOK = RT_G + (size_t)NREG * 8;
constexpr size_t RT_SGATE = RT_STOK + (size_t)MAX_SROWS * 4;
constexpr size_t RT_TEXP = RT_SGATE + (size_t)MAX_SROWS * 4;
constexpr size_t RT_PASS = RT_TEXP + 4096;
static_assert(RT_PASS + 64 <= 2 * MiB, "route tables");
constexpr int CW_BAR = 4096;
constexpr int LDS_BYTES = 147456, MISC_OFF = 131072 + 320;

__device__ __forceinline__ float wave_sum(float v) {
#pragma unroll
    for (int o = 1; o < 64; o <<= 1) v += __shfl_xor(v, o);
    return v;
}
__device__ __forceinline__ int wmap(int kind, int n) {
    if (kind == 0) return n;
    if (kind == 1) { if (n < 1024) return n; if (n < 1032) return 2816 + (n - 1024); if (n < 1800) return n - 8; if (n < 1832) return 2824 + (n - 1800); return n - 40; }
    return (n >> 7) * 256 + (n & 127) + (kind == 3 ? 128 : 0);
}
__device__ __forceinline__ float wscale(int kind, int n) { return (kind == 1 && n >= 1832 && n < 2088) ? 0.125f * 1.4426950408889634f : 1.0f; }
__device__ __forceinline__ void transpose_mat(const float* W, int K, int N, bf16* WT, int kind, LAS float* scr, int gw, int NGW, int lane) {
    const int nblk = (N + 31) / 32, nitems = (K / 64) * nblk;
    for (int item = gw; item < nitems; item += NGW) {
        const int kb = item / nblk, nb = item % nblk, k0 = 64 * kb, n0 = 32 * nb;
        const int nn = n0 + (lane & 31); const float wsc = wscale(kind, nn);
#pragma unroll 8
        for (int i = 0; i < 32; ++i) { const int kk = 2 * i + (lane >> 5); scr[kk * 33 + (lane & 31)] = nn < N ? W[(size_t)(k0 + kk) * N + nn] * wsc : 0.f; }
        LDS_WAIT(); asm volatile("" ::: "memory");
        const int c = lane & 7;
#pragma unroll
        for (int j = 0; j < 4; ++j) { const int n = (lane >> 3) + 8 * j; const LAS float* s = scr + (8 * c) * 33 + n;
            v4u o; o.x = pk2(s[0 * 33], s[1 * 33]); o.y = pk2(s[2 * 33], s[3 * 33]); o.z = pk2(s[4 * 33], s[5 * 33]); o.w = pk2(s[6 * 33], s[7 * 33]);
            if (n0 + n < N) *(GAS v4u*)(WT + (size_t)wmap(kind, n0 + n) * K + k0 + 8 * c) = o; }
        LDS_WAIT(); asm volatile("" ::: "memory");
    }
}
__device__ __forceinline__ void rms_row_to_bf16(const float* xrow, const float* w, bf16* orow, int lane) {
    const GAS f32x4* xr = (const GAS f32x4*)xrow + lane; const GAS f32x4* wr = (const GAS f32x4*)w + lane;
    f32x4 v[4]; float s = 0.f;
#pragma unroll
    for (int j = 0; j < 4; ++j) { v[j] = xr[64 * j]; s += (v[j].x * v[j].x + v[j].y * v[j].y) + (v[j].z * v[j].z + v[j].w * v[j].w); }
    const float rstd = 1.f / sqrtf(wave_sum(s) * (1.f / 1024.f) + 1e-6f);
    GAS unsigned long long* o8 = (GAS unsigned long long*)orow + lane;
#pragma unroll
    for (int j = 0; j < 4; ++j) { const f32x4 ww = wr[64 * j]; o8[64 * j] = (unsigned long long)pk2(v[j].x * rstd * ww.x, v[j].y * rstd * ww.y) | ((unsigned long long)pk2(v[j].z * rstd * ww.z, v[j].w * rstd * ww.w) << 32); }
}

struct Args { const float* in[27]; float* out; unsigned char* ws; int li, pad; };
enum { IN_X = 0, IN_META, IN_RELB, IN_NMIX, IN_NFFN, IN_WIN, IN_CONVW, IN_CONVB, IN_DTB, IN_ALOG, IN_SSDD, IN_SSDN, IN_GW2, IN_GB, IN_GLAN, IN_SINK, IN_QN, IN_KN, IN_WOUT,
       IN_FG, IN_FU, IN_FD, IN_ROUTER, IN_MG, IN_MU, IN_MD, IN_FINAL };
enum { PH_PRO = 0, PH_L0 = 1, PH_L1 = 13, PH_SORT = PH_L1 + 10, PH_PASS0 = PH_SORT + 1, PH_FINAL = PH_PASS0 + 12, PH_END = PH_FINAL + 1 };

template <int LO, int HI> __global__ void __launch_bounds__(NWAVES * 64, 2) fwd_kernel(Args args) {
    extern __shared__ __attribute__((aligned(16))) unsigned char lds_raw[];
    LAS unsigned char* lds = (LAS unsigned char*)lds_raw;
    volatile LAS unsigned* MISC = (volatile LAS unsigned*)(lds + MISC_OFF);
    const int tid = threadIdx.x, lane = tid & 63, wave = __builtin_amdgcn_readfirstlane(tid >> 6);
    const int G = gridDim.x, bid = blockIdx.x;
    const int gw = bid * NWAVES + wave, NGW = G * NWAVES;
    const long gtid = (long)bid * (NWAVES * 64) + tid, nthreads = (long)G * NWAVES * 64;
    unsigned char* ws = args.ws;
    gu32* ctl = (gu32*)(ws + WS_CTL);
    for (int u = tid; u < (LDS_BYTES - 131072) / 4; u += NWAVES * 64) ((LAS unsigned*)(lds + 131072))[u] = 0u;
    __syncthreads();
    XcdBarrier bar = xcd_barrier_post((unsigned*)(ctl + CW_BAR) + args.li * XCD_BAR_WORDS, MISC + 8);
#define IN(k) (LO <= (k) && (k) < HI)
#define SEAM(k) do { if (IN(k) && IN((k) + 1)) xcd_barrier(bar); } while (0)

    float* dtga = (float*)(ws + WS_DTGA); float* hmeta = (float*)(ws + WS_HMETA);
    bf16* Win = (bf16*)(ws + WS_WIN); bf16* Wout = (bf16*)(ws + WS_WOUT); bf16* Wgu = (bf16*)(ws + WS_WGU); bf16* Wd = (bf16*)(ws + WS_WD);
    bf16* Wmgu = (bf16*)(ws + WS_WMOE_GU); bf16* Wmd = (bf16*)(ws + WS_WMOE_D);
    bf16* big = (bf16*)(ws + WS_BIG); bf16* act1k = (bf16*)(ws + WS_ACT); bf16* tmp = (bf16*)(ws + WS_TMP);
    unsigned char* rt_base = ws + WS_ROUTE;
    int* rt_e = (int*)(rt_base + RT_E); float* rt_g = (float*)(rt_base + RT_G); int* stok = (int*)(rt_base + RT_STOK); float* sgate = (float*)(rt_base + RT_SGATE);
    int* texp = (int*)(rt_base + RT_TEXP); int* passt = (int*)(rt_base + RT_PASS);
    float* hreg = args.out;

    if (IN(PH_PRO)) {
        LAS float* scr = (LAS float*)(lds + wave * 16384);
        for (int l = 0; l < 2; ++l) {
            transpose_mat(args.in[IN_WIN] + (size_t)l * 1024 * 2856, 1024, 2856, Win + (size_t)l * 3072 * 1024, 1, scr, gw, NGW, lane);
            transpose_mat(args.in[IN_WOUT] + (size_t)l * 1024 * 1024, 1024, 1024, Wout + (size_t)l * 1024 * 1024, 0, scr, gw, NGW, lane);
        }
        transpose_mat(args.in[IN_FG], 1024, 2816, Wgu, 2, scr, gw, NGW, lane);
        transpose_mat(args.in[IN_FU], 1024, 2816, Wgu, 3, scr, gw, NGW, lane);
        transpose_mat(args.in[IN_FD], 2816, 1024, Wd, 0, scr, gw, NGW, lane);
        for (int e = 0; e < 8; ++e) {
            transpose_mat(args.in[IN_MG] + (size_t)e * 1024 * 3584, 1024, 3584, Wmgu + (size_t)e * 7168 * 1024, 2, scr, gw, NGW, lane);
            transpose_mat(args.in[IN_MU] + (size_t)e * 1024 * 3584, 1024, 3584, Wmgu + (size_t)e * 7168 * 1024, 3, scr, gw, NGW, lane);
            transpose_mat(args.in[IN_MD] + (size_t)e * 3584 * 1024, 3584, 1024, Wmd + (size_t)e * 1024 * 3584, 0, scr, gw, NGW, lane);
        }
        for (int l = 0; l < 2; ++l) for (long i = gtid; i < (long)(3072 - 2856) * 1024 / 8; i += nthreads) ((GAS v4u*)(Win + ((size_t)l * 3072 + 2856) * 1024))[i] = (v4u){0u, 0u, 0u, 0u};
        __syncthreads();
    }
    SEAM(PH_PRO);

#pragma unroll
    for (int l = 0; l < 2; ++l) {
        const int pb = l == 0 ? PH_L0 : PH_L1;
        const float* hin_reg = l == 0 ? args.in[IN_X] : hreg; const float* hin_meta = l == 0 ? args.in[IN_META] : hmeta; const int meta_mod = l == 0 ? 16 : 128;
        MixParams mp; mp.conv_w = args.in[IN_CONVW] + l * 5 * 768; mp.conv_b = args.in[IN_CONVB] + l * 768; mp.dt_bias = args.in[IN_DTB] + l * 8; mp.a_log = args.in[IN_ALOG] + l * 8;
        mp.ssd_d = args.in[IN_SSDD] + l * 4; mp.ssd_norm_w = args.in[IN_SSDN] + l * 256; mp.gate_w2 = args.in[IN_GW2] + l * 2 * 16 * 128; mp.gate_b = args.in[IN_GB] + l * 256;
        mp.gla_norm_w = args.in[IN_GLAN] + l * 64; mp.sink = args.in[IN_SINK] + l * 4; mp.qn_w = args.in[IN_QN] + l * 64; mp.kn_w = args.in[IN_KN] + l * 64; mp.rel_bias = args.in[IN_RELB];
        MixBuf mb; mb.proj = big; mb.dtga = dtga; mb.xbca = tmp; mb.mixed = act1k;

        if (IN(pb + 0)) {
            const float* w = args.in[IN_NMIX] + l * 1024;
            for (int r = gw; r < NTOK; r += NGW) { const float* src = r < NREG ? hin_reg + (size_t)r * 1024 : hin_meta + (size_t)((r - NREG) % meta_mod) * 1024; rms_row_to_bf16(src, w, act1k + (size_t)r * 1024, lane); }
        }
        SEAM(pb + 0);
        if (IN(pb + 1)) {
            pg8::Gemm g{act1k, Win + (size_t)l * 3072 * 1024, MP, 3072, 1024}; pg8::StaticOrder S; S.init(MP, 3072, G, bid);
            pg8::EpiInProj E{big, dtga};
            pg8::gemm_phase<pg8::EpiInProj, pg8::StaticOrder, true, true>(lds, g, S, E);
        }
        SEAM(pb + 1);
#ifndef SKIP_NAIVE
        if (IN(pb + 2)) {
            nv_conv(mb, mp, gtid, nthreads);
            const int half = lane >> 5, pi = lane & 31;
            const float inv = __builtin_amdgcn_exp2f(-(float)(pi & 15) * 0.8304820237218406f);
            for (int r = gw; r < NTOK; r += NGW) {
                const int t = r < NREG ? NM + (r % S_) : (r - NREG) % NM;
                const float pos = t < NM ? (float)(t - NM) : (pi < 16 ? (float)((t - NM) / 64) : (float)((t - NM) % 64));
                const float ang = pos * inv, cs = __cosf(ang), sn = __sinf(ang);
#pragma unroll
                for (int k = 0; k < 3; ++k) { const int slot = half + 2 * k;
                    GAS unsigned* px = (GAS unsigned*)(big + (size_t)r * PW + PAQ + slot * 64) + pi; const unsigned xv = *px;
                    const float x0 = __uint_as_float(xv << 16), x1 = __uint_as_float(xv & 0xffff0000u);
                    float ss = x0 * x0 + x1 * x1;
#pragma unroll
                    for (int o = 1; o < 32; o <<= 1) ss += __shfl_xor(ss, o);
                    const float rstd = 1.0f / sqrtf(ss * (1.0f / 64.0f) + 1e-6f);
                    const float* w = slot < 4 ? mp.qn_w : mp.kn_w; const float sc = slot < 4 ? attn_body::C2 : 1.0f;
                    const float y0 = x0 * rstd * w[2 * pi], y1 = x1 * rstd * w[2 * pi + 1];
                    *px = pk2((y0 * cs - y1 * sn) * sc, (y0 * sn + y1 * cs) * sc); }
            }
        }
        SEAM(pb + 2);
        const long sg = lane + 64L * (bid + (long)G * wave);
        if (IN(pb + 3)) {
            for (int u = bid; u < 64; u += G) { const int b = u >> 3, h = (u >> 1) & 3, dir = u & 1;
                mix::ssd_stream(b, h, dir, tmp, dtga, mp.dt_bias[dir * 4 + h], -expf(mp.a_log[dir * 4 + h]), dir == 0 ? act1k : big + PX, dir == 0 ? 1024 : PW, (mix::lp)lds); }
        }
        SEAM(pb + 3);
        if (IN(pb + 4)) {
            for (int u = bid; u < 64; u += G) { const int b = u >> 3, h = (u >> 1) & 3, dir = u & 1;
                mix::gla_stream(b, h, dir, big, dtga, mp.gate_w2, mp.gate_b, dir == 0 ? act1k + 256 : big + PB, dir == 0 ? 1024 : PW, (mix::lp)lds); }
        }
        SEAM(pb + 4);
        if (IN(pb + 5)) {
            LAS float* btab = (LAS float*)(lds + 86016);
            for (int i = tid; i < 4 * 259; i += NWAVES * 64) { const int h = i / 259, k = i % 259, rc = k - 129; btab[h * 264 + k] = (k == 0 || k == 258) ? -INFINITY : mp.rel_bias[t5_bucket(rc) * 4 + h] * 1.4426950408889634f; }
            if (tid < 4) btab[4 * 264 + tid] = mp.sink[tid] * 1.4426950408889634f;
            __syncthreads();
            const int vcu = (G % 8 == 0) ? (bid % 8) * (G / 8) + bid / 8 : bid;
            const int nunits = 512 + (l == 0 ? 16 : 0);
            for (int unit = vcu; unit < nunits; unit += G) {
                const int bg = unit < 512 ? unit >> 5 : unit - 512, qb = unit < 512 ? (unit & 31) : -1, b = bg >> 1, g = bg & 1;
                attn_body::attn_unit<8, true>(b, qb, big + PSQ + g * 128, big + PSK + g * 64, big + PSV + g * 64, act1k + 512 + g * 128, (char*)lds_raw, btab, g);
            }
        }
        SEAM(pb + 5);
        if (IN(pb + 6)) {
            const int vcu = (G % 8 == 0) ? (bid % 8) * (G / 8) + bid / 8 : bid;
            const int nunits = 512 + (l == 0 ? 16 : 0);
            for (int unit = vcu; unit < nunits; unit += G) {
                const int bg = unit < 512 ? unit >> 5 : unit - 512, qb = unit < 512 ? (unit & 31) : -1, b = bg >> 1, g = bg & 1;
                attn_body::attn_unit<8, false>(b, qb, big + PAQ + g * 128, big + PAK + g * 64, big + PAV + g * 64, act1k + 768 + g * 128, (char*)lds_raw, nullptr, g);
            }
        }
        SEAM(pb + 6);
        if (IN(pb + 7)) {
            for (int r = gw; r < NTOK; r += NGW) {
                const int c0 = 4 * lane, hh = lane >> 4;
                const unsigned long long yf = *(const GAS unsigned long long*)(act1k + (size_t)r * 1024 + c0), yb = *(const GAS unsigned long long*)(big + (size_t)r * PW + PX + c0);
                const unsigned long long xx = *(const GAS unsigned long long*)(tmp + (size_t)r * XW + c0), zz = *(const GAS unsigned long long*)(big + (size_t)r * PW + PZ + c0);
                const float dsk = mp.ssd_d[hh]; float y[4]; float ss = 0.f;
#pragma unroll
                for (int j = 0; j < 4; ++j) { const float a = __uint_as_float((unsigned)((yf >> (16 * j)) & 0xffffu) << 16), bq = __uint_as_float((unsigned)((yb >> (16 * j)) & 0xffffu) << 16);
                    const float xv = __uint_as_float((unsigned)((xx >> (16 * j)) & 0xffffu) << 16), zv = __uint_as_float((unsigned)((zz >> (16 * j)) & 0xffffu) << 16);
                    y[j] = (a + bq + dsk * xv) * (zv / (1.0f + __expf(-zv))); ss += y[j] * y[j]; }
                const float rstd = 1.0f / sqrtf(wave_sum(ss) * (1.0f / 256.0f) + 1e-6f);
                const f32x4 nw = *(const GAS f32x4*)(mp.ssd_norm_w + c0);
                *(GAS unsigned long long*)(act1k + (size_t)r * 1024 + c0) = (unsigned long long)pk2(y[0] * rstd * nw.x, y[1] * rstd * nw.y) | ((unsigned long long)pk2(y[2] * rstd * nw.z, y[3] * rstd * nw.w) << 32);
            }
            for (int r = gw; r < NTOK; r += NGW) {
                const int c0 = 4 * lane;
                const unsigned long long of = *(const GAS unsigned long long*)(act1k + (size_t)r * 1024 + 256 + c0), ob = *(const GAS unsigned long long*)(big + (size_t)r * PW + PB + c0);
                const unsigned long long rr = *(const GAS unsigned long long*)(big + (size_t)r * PW + PGR + c0);
                float y[4]; float ss = 0.f;
#pragma unroll
                for (int j = 0; j < 4; ++j) { y[j] = __uint_as_float((unsigned)((of >> (16 * j)) & 0xffffu) << 16) + __uint_as_float((unsigned)((ob >> (16 * j)) & 0xffffu) << 16); ss += y[j] * y[j]; }
#pragma unroll
                for (int o = 1; o < 16; o <<= 1) ss += __shfl_xor(ss, o);
                const float rstd = 1.0f / sqrtf(ss * (1.0f / 64.0f) + 1e-6f);
                const f32x4 nw = *(const GAS f32x4*)(mp.gla_norm_w + (c0 & 63));
                float o4[4];
#pragma unroll
                for (int j = 0; j < 4; ++j) { const float rv = __uint_as_float((unsigned)((rr >> (16 * j)) & 0xffffu) << 16); o4[j] = y[j] * rstd * nw[j] * (rv / (1.0f + __expf(-rv))); }
                *(GAS unsigned long long*)(act1k + (size_t)r * 1024 + 256 + c0) = (unsigned long long)pk2(o4[0], o4[1]) | ((unsigned long long)pk2(o4[2], o4[3]) << 32);
            }
        }
#endif
        SEAM(pb + 7);
        if (IN(pb + 8)) {
            pg8::Gemm g{act1k, Wout + (size_t)l * 1024 * 1024, MP, 1024, 1024}; pg8::StaticOrder S; S.init(MP, 1024, G, bid);
            pg8::EpiResid E{hin_reg, hin_meta, meta_mod, hreg, hmeta};
            pg8::gemm_phase<pg8::EpiResid, pg8::StaticOrder, true, true>(lds, g, S, E);
        }
        SEAM(pb + 8);
        if (l == 0) {
            if (IN(pb + 9)) {
                const float* w = args.in[IN_NFFN];
                for (int r = gw; r < NTOK; r += NGW) { const float* src = r < NREG ? hreg + (size_t)r * 1024 : hmeta + (size_t)(r - NREG) * 1024; rms_row_to_bf16(src, w, act1k + (size_t)r * 1024, lane); }
            }
            SEAM(pb + 9);
            if (IN(pb + 10)) {
                pg8::Gemm g{act1k, Wgu, MP, 5632, 1024}; pg8::StaticOrder S; S.init(MP, 5632, G, bid);
                pg8::EpiSwiGLU E{big, PW, 22};
                pg8::gemm_phase<pg8::EpiSwiGLU, pg8::StaticOrder, true, true>(lds, g, S, E);
            }
            SEAM(pb + 10);
            if (IN(pb + 11)) {
                pg8::Gemm g{big, Wd, MP, 1024, 2816}; pg8::StaticOrder S; S.init(MP, 1024, G, bid);
                pg8::EpiResid E{hreg, hmeta, 128, hreg, hmeta};
                pg8::gemm_phase<pg8::EpiResid, pg8::StaticOrder, true, true>(lds, g, S, E);
            }
            SEAM(pb + 11);
        } else {
            if (IN(pb + 9)) {
                const float* w = args.in[IN_NFFN] + 1024; const float* rw = args.in[IN_ROUTER];
                for (int r = gw; r < NREG; r += NGW) {
                    const GAS f32x4* xr = (const GAS f32x4*)(hreg + (size_t)r * 1024) + lane; const GAS f32x4* wr = (const GAS f32x4*)w + lane;
                    f32x4 v[4]; float s = 0.f;
#pragma unroll
                    for (int j = 0; j < 4; ++j) { v[j] = xr[64 * j]; s += (v[j].x * v[j].x + v[j].y * v[j].y) + (v[j].z * v[j].z + v[j].w * v[j].w); }
                    const float rstd = 1.f / sqrtf(wave_sum(s) * (1.f / 1024.f) + 1e-6f);
                    float lg[8];
#pragma unroll
                    for (int e = 0; e < 8; ++e) lg[e] = 0.f;
                    GAS unsigned long long* o8 = (GAS unsigned long long*)(act1k + (size_t)r * 1024) + lane;
#pragma unroll
                    for (int j = 0; j < 4; ++j) { const f32x4 ww = wr[64 * j]; const f32x4 uu = v[j] * rstd * ww;
                        o8[64 * j] = (unsigned long long)pk2(uu.x, uu.y) | ((unsigned long long)pk2(uu.z, uu.w) << 32);
                        const GAS f32x4* rp = (const GAS f32x4*)(rw + (size_t)(4 * lane + 256 * j) * 8);
#pragma unroll
                        for (int c = 0; c < 4; ++c) { const f32x4 r0 = rp[2 * c], r1 = rp[2 * c + 1]; const float uc = uu[c];
                            lg[0] += uc * r0.x; lg[1] += uc * r0.y; lg[2] += uc * r0.z; lg[3] += uc * r0.w; lg[4] += uc * r1.x; lg[5] += uc * r1.y; lg[6] += uc * r1.z; lg[7] += uc * r1.w; } }
#pragma unroll
                    for (int e = 0; e < 8; ++e) lg[e] = wave_sum(lg[e]);
                    int i0 = 0; float v0 = lg[0];
#pragma unroll
                    for (int e = 1; e < 8; ++e) if (lg[e] > v0) { v0 = lg[e]; i0 = e; }
                    int i1 = -1; float v1 = -3.0e38f;
#pragma unroll
                    for (int e = 0; e < 8; ++e) if (e != i0 && lg[e] > v1) { v1 = lg[e]; i1 = e; }
                    if (lane == 0) { const float g1 = 1.0f / (1.0f + expf(v0 - v1)); rt_e[r] = i0 | (i1 << 8); rt_g[2 * r] = 1.0f - g1; rt_g[2 * r + 1] = g1; }
                }
            }
            SEAM(pb + 9);
            if (IN(PH_SORT)) {
                if (bid == 0) {
                    LAS int* cnt = (LAS int*)lds; LAS int* roff = cnt + 16; LAS int* cur = cnt + 32; LAS int* tot = cnt + 48;
                    if (tid < 64) cnt[tid] = 0;
                    __syncthreads();
                    for (int t = tid; t < NREG; t += NWAVES * 64) { const int e = rt_e[t]; atomicAdd((int*)&cnt[e & 255], 1); atomicAdd((int*)&cnt[8 + (e >> 8)], 1); }
                    __syncthreads();
                    if (tid == 0) {
                        int tile = 0, T0 = 0;
                        for (int s = 0; s < 16; ++s) { const int nt = (cnt[s] + 255) >> 8; roff[s] = tile * 256; for (int k = 0; k < nt; ++k) texp[tile + k] = s & 7; tile += nt; if (s == 7) T0 = tile; }
                        const int T1 = tile - T0; tot[0] = tile;
                        passt[0] = 0; passt[1] = (T0 + 1) / 2; passt[2] = T0; passt[3] = T0 + (T1 + 1) / 2; passt[4] = tile;
                    }
                    __syncthreads();
                    const int nrows = tot[0] * 256;
                    for (int i = tid; i < nrows; i += NWAVES * 64) { stok[i] = -1; sgate[i] = 0.f; }
                    __syncthreads();
                    for (int t = tid; t < NREG; t += NWAVES * 64) { const int e = rt_e[t]; const int e0 = e & 255, e1 = 8 + (e >> 8);
                        const int p0 = roff[e0] + atomicAdd((int*)&cur[e0], 1); stok[p0] = t; sgate[p0] = rt_g[2 * t];
                        const int p1 = roff[e1] + atomicAdd((int*)&cur[e1], 1); stok[p1] = t; sgate[p1] = rt_g[2 * t + 1]; }
                    __syncthreads();
                }
            }
            SEAM(PH_SORT);
#pragma unroll
            for (int p = 0; p < 4; ++p) {
                const int pp = PH_PASS0 + 3 * p;
                bf16* xg = (bf16*)(ws + WS_MOE_XG); bf16* mact = (bf16*)(ws + WS_MOE_ACT);
                if (IN(pp)) {
                    const int t0 = passt[p], t1 = passt[p + 1];
                    for (int r = t0 * 256 + gw; r < t1 * 256; r += NGW) { const int tok = stok[r];
                        GAS v4u* dst = (GAS v4u*)(xg + (size_t)(r - t0 * 256) * 1024) + lane; const GAS v4u* src = (const GAS v4u*)(act1k + (size_t)(tok < 0 ? 0 : tok) * 1024) + lane;
                        v4u a = src[0], b = src[64]; if (tok < 0) { a = (v4u){0u, 0u, 0u, 0u}; b = a; } dst[0] = a; dst[64] = b; }
                }
                SEAM(pp);
                if (IN(pp + 1)) {
                    const int t0 = passt[p], t1 = passt[p + 1];
                    pg8::Gemm g{xg, Wmgu, CAP_TILES * 256, 8 * 7168, 1024}; pg8::MoeOrder S{t0, t1 - t0, 28, G, bid, texp};
                    pg8::EpiSwiGLU E{mact, 3584, 28};
                    pg8::gemm_phase<pg8::EpiSwiGLU, pg8::MoeOrder, true, true>(lds, g, S, E);
                }
                SEAM(pp + 1);
                if (IN(pp + 2)) {
                    const int t0 = passt[p], t1 = passt[p + 1];
                    pg8::Gemm g{mact, Wmd, CAP_TILES * 256, 8 * 1024, 3584}; pg8::MoeOrder S{t0, t1 - t0, 4, G, bid, texp};
                    pg8::EpiMoeDown E{hreg, stok, sgate, t0 * 256};
                    pg8::gemm_phase<pg8::EpiMoeDown, pg8::MoeOrder, true, true>(lds, g, S, E);
                }
                SEAM(pp + 2);
            }
            if (IN(PH_FINAL)) {
                const float* w = args.in[IN_FINAL];
                for (int r = gw; r < NREG; r += NGW) {
                    GAS f32x4* xr = (GAS f32x4*)(hreg + (size_t)r * 1024) + lane; const GAS f32x4* wr = (const GAS f32x4*)w + lane;
                    f32x4 v[4]; float s = 0.f;
#pragma unroll
                    for (int j = 0; j < 4; ++j) { v[j] = xr[64 * j]; s += (v[j].x * v[j].x + v[j].y * v[j].y) + (v[j].z * v[j].z + v[j].w * v[j].w); }
                    const float rstd = 1.f / sqrtf(wave_sum(s) * (1.f / 1024.f) + 1e-6f);
#pragma unroll
                    for (int j = 0; j < 4; ++j) xr[64 * j] = v[j] * rstd * wr[64 * j];
                }
            }
        }
    }
#undef IN
#undef SEAM
}

template <int PH> static void launch_phase(int grid, const Args& a, hipStream_t stream) { hipLaunchKernelGGL((fwd_kernel<PH, PH + 1>), dim3(grid), dim3(NWAVES * 64), LDS_BYTES, stream, a); }
template <int PH> static void set_attr_phase() { (void)hipFuncSetAttribute((const void*)fwd_kernel<PH, PH + 1>, hipFuncAttributeMaxDynamicSharedMemorySize, LDS_BYTES); }
template <int PH> struct PhaseLoop { static void attr() { set_attr_phase<PH>(); PhaseLoop<PH + 1>::attr(); } static void run(int grid, const Args& a, hipStream_t st) { launch_phase<PH>(grid, a, st); PhaseLoop<PH + 1>::run(grid, a, st); } };
template <> struct PhaseLoop<PH_END> { static void attr() {} static void run(int, const Args&, hipStream_t) {} };
#ifndef N_LAUNCH_MODE
#define N_LAUNCH_MODE 0
#endif
extern "C" void kernel_launch(void* const* d_in, const int* in_sizes, int n_in, void* d_out, int out_size, void* d_ws, size_t ws_size, hipStream_t stream) {
    static int grid = 0;
    if (grid == 0) {
        if (n_in != 27 || ws_size < WS_END || out_size != NREG * 1024) { fprintf(stderr, "kernel_launch: unexpected problem (n_in %d, ws %zu, out %d)\n", n_in, ws_size, out_size); grid = -1; return; }
        int dev = 0, cus = 0;
        if (hipGetDevice(&dev) != hipSuccess || hipDeviceGetAttribute(&cus, hipDeviceAttributeMultiprocessorCount, dev) != hipSuccess) { grid = -1; return; }
#if N_LAUNCH_MODE == 1
        if (hipFuncSetAttribute((const void*)fwd_kernel<0, PH_END>, hipFuncAttributeMaxDynamicSharedMemorySize, LDS_BYTES) != hipSuccess) { fprintf(stderr, "kernel_launch: hipFuncSetAttribute failed\n"); grid = -1; return; }
#else
        PhaseLoop<0>::attr();
#endif
        (void)hipGetLastError();
        grid = cus;
    }
    if (grid < 0) return;
    (void)hipMemsetAsync((char*)d_ws + WS_CTL, 0, CTL_ZERO_BYTES, stream);
    Args a{};
    for (int i = 0; i < 27; ++i) a.in[i] = (const float*)d_in[i];
    a.out = (float*)d_out; a.ws = (unsigned char*)d_ws;
#if N_LAUNCH_MODE == 1
    hipLaunchKernelGGL((fwd_kernel<0, PH_END>), dim3(grid), dim3(NWAVES * 64), LDS_BYTES, stream, a);
#else
    PhaseLoop<0>::run(grid, a, stream);
#endif
}
```

```cpp
#include <hip/hip_runtime.h>
#include <cstdio>
#include <cstdint>
#include <cmath>
#define HD_INLINE __device__ __forceinline__
#ifndef CFG_BATCH
#define CFG_BATCH 8
#endif
#ifndef CFG_SEQ
#define CFG_SEQ 4096
#endif
constexpr int B_ = CFG_BATCH, S_ = CFG_SEQ, NM = 16, L_ = S_ + NM;
constexpr int NREG = B_ * S_, NTOK = NREG + B_ * NM, MP = ((NTOK + 255) / 256) * 256;
constexpr int PW = 2816;
constexpr int PZ = 0, PX = 256, PB = 512, PC = 768, PGQ = 1024, PGK = 1152, PGV = 1280, PGR = 1536, PSQ = 1792, PSK = 2048, PSV = 2176, PAQ = 2304, PAK = 2560, PAV = 2688;
constexpr int DGW = 64;
constexpr int XW = 768;
typedef unsigned short bf16;

#ifdef __HIP_DEVICE_COMPILE__
#define FAST_COS(x) __cosf(x)
#define FAST_SIN(x) __sinf(x)
#else
#define FAST_COS(x) cosf(x)
#define FAST_SIN(x) sinf(x)
#endif
#define ROPE_INV(j) __builtin_exp2f(-(float)(j) * 0.8304820237218406f)
HD_INLINE int row_of(int b, int t) { return t < NM ? NREG + b * NM + t : b * S_ + (t - NM); }
HD_INLINE float bf2f(bf16 v) { unsigned u = ((unsigned)v) << 16; float f; __builtin_memcpy(&f, &u, 4); return f; }
HD_INLINE bf16 f2bf(float f) { unsigned u; __builtin_memcpy(&u, &f, 4); return (bf16)((u + 0x7fffu + ((u >> 16) & 1u)) >> 16); }
HD_INLINE float siluf(float x) { return x / (1.0f + expf(-x)); }
HD_INLINE float softplusf(float x) { return x > 20.f ? x : log1pf(expf(x)); }
HD_INLINE float logsigmoidf(float x) { return x >= 0.f ? -log1pf(expf(-x)) : x - log1pf(expf(x)); }
HD_INLINE int t5_bucket(int rel) {
    const int a = rel < 0 ? -rel : rel, base = rel > 0 ? 16 : 0;
    if (a < 8) return base + a;
    const int k = (a >= 12) + (a >= 16) + (a >= 23) + (a >= 32) + (a >= 46) + (a >= 64) + (a >= 91);
    return base + 8 + k;
}

struct MixParams {
    const float *conv_w, *conv_b, *dt_bias, *a_log, *ssd_d, *ssd_norm_w, *gate_w2, *gate_b, *gla_norm_w, *sink, *qn_w, *kn_w, *rel_bias;
};
struct MixBuf { bf16* proj; const float* dtga; bf16* xbca; bf16* mixed; };

HD_INLINE void nv_conv(const MixBuf& m, const MixParams& p, long gtid, long nthreads) {
    for (long idx = gtid; idx < (long)B_ * L_ * XW; idx += nthreads) {
        const int c = (int)(idx % XW); const long bt = idx / XW; const int t = (int)(bt % L_), b = (int)(bt / L_);
        float acc = p.conv_b[c];
        for (int j = 0; j < 5; ++j) { const int tt = t + j - 2; if (tt >= 0 && tt < L_) acc += p.conv_w[j * XW + c] * bf2f(m.proj[(size_t)row_of(b, tt) * PW + PX + c]); }
        m.xbca[(size_t)row_of(b, t) * XW + c] = f2bf(siluf(acc));
    }
}

namespace pg8 {
#define PG8_LAS __attribute__((address_space(3)))
typedef unsigned short bf16_t;
typedef short bf16x8 __attribute__((ext_vector_type(8)));
typedef float f32x4 __attribute__((ext_vector_type(4)));
typedef unsigned u32x4 __attribute__((ext_vector_type(4)));
constexpr int BM = 256, BK = 64, HALF = 128, HTB = HALF * BK * 2  , STAGE_BYTES = 8 * HTB, NXCD = 8, WGM = 8;

__host__ __device__ __forceinline__ int lds_byte(int r, int c) { const int st = (r >> 4) * 2 + (c >> 5), rr = r & 15, cc = c & 31, ob = rr * 64 + cc * 2; return st * 1024 + (ob ^ (((ob >> 9) & 1) << 5)); }
__host__ __device__ __forceinline__ void stage_rc(int b, int& R, int& C) { const int st = b / 1024, sb = b % 1024, swz = sb ^ (((sb >> 9) & 1) << 5); R = (st >> 1) * 16 + swz / 64; C = (st & 1) * 32 + (swz % 64) / 2; }
__host__ __device__ __forceinline__ int perm32(int rho) { const int n = rho >> 4, i = rho & 15; return 8 * (i >> 2) + 4 * n + (i & 3); }

struct Unit { int pm, pn; };
struct Gemm { const bf16_t* A; const bf16_t* Bt; int M, N, K; };

struct StaticOrder {
    int nM, nN, nwg, G, c;
    __host__ __device__ void init(int M, int N, int G_, int c_) { nM = M / BM; nN = N / BM; nwg = nM * nN; G = G_; c = c_; }
    __host__ __device__ bool next(int i, Unit& u) const {
        const long L = (long)i * G + c; if (L >= nwg) return false;
        int wgid = (int)L; { const int q = nwg / NXCD, r = nwg % NXCD, xcd = wgid % NXCD, off = wgid / NXCD; wgid = (xcd < r ? xcd * (q + 1) : r * (q + 1) + (xcd - r) * q) + off; }
        const int nig = WGM * nN, gid = wgid / nig, fm = gid * WGM, gsz = (nM - fm) < WGM ? (nM - fm) : WGM;
        u.pm = fm + ((wgid % nig) % gsz); u.pn = (wgid % nig) / gsz; return true;
    }
    __device__ __forceinline__ void a_ready(const Unit&) const {}
    __device__ __forceinline__ void done(const Unit&) const {}
};

__device__ __forceinline__ unsigned cvt_pk_bf16(float lo, float hi) { unsigned r; asm volatile("v_cvt_pk_bf16_f32 %0, %1, %2" : "=v"(r) : "v"(lo), "v"(hi)); return r; }
typedef float f32x2 __attribute__((ext_vector_type(2)));
__device__ __forceinline__ f32x2 gelu_pk(f32x2 v) {
    const f32x2 av = __builtin_elementwise_abs(v), d = av * 0.2316418882f + 1.0f;
    f32x2 t; t.x = __builtin_amdgcn_rcpf(d.x); t.y = __builtin_amdgcn_rcpf(d.y);
    f32x2 q = t * 0.5307027145f + (-0.7265760135f); q = q * t + 0.7107068705f; q = q * t + (-0.142248368f); q = q * t + 0.127414796f; q = q * t;
    const f32x2 s = (v * v) * (-0.72134752044f);
    f32x2 e; e.x = __builtin_amdgcn_exp2f(s.x); e.y = __builtin_amdgcn_exp2f(s.y);
    const f32x2 m = v * (q * e), r = v - m;
    f32x2 o; o.x = v.x < 0.f ? m.x : r.x; o.y = v.y < 0.f ? m.y : r.y; return o;
}

template <int ACT  > struct EpiBf16 {
    static constexpr bool PERM = true, AFTER_DRAIN = false; static_assert(ACT == 0 || ACT == 1, "EpiBf16: ACT is 0 (none) or 1 (gelu_pk)");
    bf16_t* O; int ldc; const float* bias; int split_cols; size_t split_stride; float scale0;
    __device__ __forceinline__ void operator()(const f32x4 (&acc)[2][2][4][2], const Unit& u, int wr, int wc, int fr, int fq) const {
        const int row0 = u.pm * BM + wr * 64 + fr; int colt = u.pn * BM; bf16_t* base = O;
        float sc = 1.f; if (split_cols) { const int t = colt / split_cols; base += (size_t)t * split_stride; colt -= t * split_cols; if (t == 0) sc = scale0; }
        const int col0 = colt + wc * 32 + 8 * fq, bcol0 = u.pn * BM + wc * 32 + 8 * fq;
        f32x4 bv[2][2];
#pragma unroll
        for (int bj = 0; bj < 2; ++bj)
#pragma unroll
            for (int n = 0; n < 2; ++n) bv[bj][n] = bias ? *(const f32x4*)(bias + bcol0 + bj * HALF + 4 * n) : (f32x4){0.f, 0.f, 0.f, 0.f};
#pragma unroll
        for (int ai = 0; ai < 2; ++ai)
#pragma unroll
            for (int m = 0; m < 4; ++m) { bf16_t* rowp = base + (size_t)(row0 + ai * HALF + m * 16) * ldc + col0;
#pragma unroll
                for (int bj = 0; bj < 2; ++bj) { f32x4 v0 = acc[ai][bj][m][0] + bv[bj][0], v1 = acc[ai][bj][m][1] + bv[bj][1];
                    if (ACT == 1) { f32x2 a = gelu_pk((f32x2){v0[0], v0[1]}), b = gelu_pk((f32x2){v0[2], v0[3]}), c = gelu_pk((f32x2){v1[0], v1[1]}), d = gelu_pk((f32x2){v1[2], v1[3]});
                        v0 = (f32x4){a.x, a.y, b.x, b.y}; v1 = (f32x4){c.x, c.y, d.x, d.y}; }
                    v0 = v0 * sc; v1 = v1 * sc; u32x4 w; w.x = cvt_pk_bf16(v0[0], v0[1]); w.y = cvt_pk_bf16(v0[2], v0[3]); w.z = cvt_pk_bf16(v1[0], v1[1]); w.w = cvt_pk_bf16(v1[2], v1[3]);
                    *(u32x4*)(rowp + bj * HALF) = w; } }
    }
};

typedef int i32x4 __attribute__((ext_vector_type(4)));
template <bool I8> struct AccT { typedef f32x4 type; };
template <> struct AccT<true> { typedef i32x4 type; };
template <bool I8> __device__ __forceinline__ typename AccT<I8>::type mma1(bf16x8 b, bf16x8 a, typename AccT<I8>::type c) {
    if constexpr (I8) return __builtin_amdgcn_mfma_i32_16x16x64_i8(__builtin_bit_cast(i32x4, b), __builtin_bit_cast(i32x4, a), c, 0, 0, 0);
    else return __builtin_amdgcn_mfma_f32_16x16x32_bf16(b, a, c, 0, 0, 0);
}
typedef int i32x8 __attribute__((ext_vector_type(8)));
template <bool I8, bool F8> __device__ __forceinline__ typename AccT<I8>::type mma2(bf16x8 b0, bf16x8 b1, bf16x8 a0, bf16x8 a1, typename AccT<I8>::type c) {
    if constexpr (F8) { const i32x4 B0 = __builtin_bit_cast(i32x4, b0), B1 = __builtin_bit_cast(i32x4, b1), A0 = __builtin_bit_cast(i32x4, a0), A1 = __builtin_bit_cast(i32x4, a1);
        const i32x8 B = {B0.x, B0.y, B0.z, B0.w, B1.x, B1.y, B1.z, B1.w}, A = {A0.x, A0.y, A0.z, A0.w, A1.x, A1.y, A1.z, A1.w};
        return __builtin_amdgcn_mfma_scale_f32_16x16x128_f8f6f4(B, A, c, 0, 0, 0, 0, 0, 0); }
    else { c = mma1<I8>(b0, a0, c); return mma1<I8>(b1, a1, c); }
}
struct EpiPreNone {}; struct EpiPreI { int i[2][4]; };
struct EpiPreS { unsigned long long q[2]; float f[2]; };
template <class Epi, class Sched, bool ALIGN_EPI = false, bool SP2 = false, bool GATHER = false, bool TILED = false, bool I8 = false, bool F8 = false>
__device__ __forceinline__ void gemm_phase(PG8_LAS unsigned char* lds, const Gemm g, const Sched& S, const Epi& E) {
    int tid = threadIdx.x; asm volatile("" : "+v"(tid));
    const int wid = __builtin_amdgcn_readfirstlane(tid >> 6), lane = tid & 63, wr = wid >> 2, wc = wid & 3, fr = lane & 15, fq = lane >> 4;
    const int K = g.K, nt = K / BK;
    PG8_LAS float* const xl = (PG8_LAS float*)(lds + 144384 + wid * 1024);
    unsigned voffA, voffB;
    { int R, C; stage_rc(tid * 16, R, C); const int Rb = Epi::PERM ? ((R & ~31) + perm32(R & 31)) : R;
        voffA = (unsigned)(R * (TILED ? 64 : K) + C) * 2u; voffB = (unsigned)(Rb * (TILED ? 64 : K) + C) * 2u; }
    const size_t vstep = (size_t)64 * (TILED ? 64 : K) * 2;
    static_assert(!(GATHER && TILED), "gathered rows are row-major");
    static_assert(!GATHER || SP2, "the gathered A path is written for the SP2 loop");
    unsigned vgc[2][2] = {{0u, 0u}, {0u, 0u}}, vgn[2][2] = {{0u, 0u}, {0u, 0u}};
    const char* const A0 = (const char*)g.A;
#define PG8_GLOAD(dst, unit) do { _Pragma("unroll") for (int h_ = 0; h_ < 2; ++h_) _Pragma("unroll") for (int i_ = 0; i_ < 2; ++i_) { int R_, C_; stage_rc(tid * 16 + i_ * 8192, R_, C_); \
        int tk_ = S.ridx[S.row_base + (unit).pm * BM + h_ * HALF + R_]; tk_ = tk_ < 0 ? 0 : tk_; dst[h_][i_] = (unsigned)(tk_ * K + C_) * 2u; } } while (0)
#define PG8_STAGE_G(bufoff, gb, o0, o1) do { __builtin_amdgcn_global_load_lds((const unsigned*)((gb) + (o0)), (PG8_LAS unsigned*)(lds + (bufoff) + ldsw), 16, 0, 0); \
        __builtin_amdgcn_global_load_lds((const unsigned*)((gb) + (o1)), (PG8_LAS unsigned*)(lds + (bufoff) + ldsw + 8192), 16, 0, 0); } while (0)
    const size_t kstep = TILED ? (size_t)(BM * BK * 2) : (size_t)(BK * 2);
    const size_t hstep = TILED ? (size_t)(HALF * BK * 2) : (size_t)HALF * K * 2;
    const size_t tstep = (size_t)BM * K * 2;
    const unsigned ldsw = (unsigned)wid * 1024u;
    const int aoff = lds_byte(wr * 64 + fr, fq * 8), boff = lds_byte(wc * 32 + fr, fq * 8);
#define PG8_SA(b, h) (((b) * 2 + (h)) * HTB)
#define PG8_SB(b, h) ((4 + (b) * 2 + (h)) * HTB)
#define PG8_STAGE(bufoff, gbase, voff) do { _Pragma("unroll") for (int _i = 0; _i < 2; ++_i) \
        __builtin_amdgcn_global_load_lds((const unsigned*)((const char*)(gbase) + _i * vstep + (voff)), (PG8_LAS unsigned*)(lds + (bufoff) + ldsw + _i * 8192), 16, 0, 0); } while (0)
#define PG8_LDA(dst, b, h) do { _Pragma("unroll") for (int m = 0; m < 4; ++m) _Pragma("unroll") for (int k = 0; k < 2; ++k) dst[m][k] = *(const PG8_LAS bf16x8*)(lds + PG8_SA(b, h) + aoff + m * 2048 + k * 1024); } while (0)
#define PG8_LDB(dst, b, h) do { _Pragma("unroll") for (int n = 0; n < 2; ++n) _Pragma("unroll") for (int k = 0; k < 2; ++k) dst[n][k] = *(const PG8_LAS bf16x8*)(lds + PG8_SB(b, h) + boff + n * 2048 + k * 1024); } while (0)
#define PG8_MMA(ai, bj, At, Bt) do { __builtin_amdgcn_s_setprio(1); _Pragma("unroll") for (int m = 0; m < 4; ++m) _Pragma("unroll") for (int n = 0; n < 2; ++n) \
        acc[ai][bj][m][n] = mma2<I8, F8>(Bt[n][0], Bt[n][1], At[m][0], At[m][1], acc[ai][bj][m][n]); __builtin_amdgcn_s_setprio(0); } while (0)
#define PG8_WAIT_V(n) asm volatile("s_waitcnt vmcnt(" #n ")" ::: "memory")
#define PG8_WAIT_L(n) asm volatile("s_waitcnt lgkmcnt(" #n ")" ::: "memory")
#define PG8_BAR __builtin_amdgcn_s_barrier()
#define PG8_SCHED __builtin_amdgcn_sched_barrier(0)
    Unit cur, nxt; int ui = 0;
    if (!S.next(0, cur)) return;
    typedef typename AccT<I8>::type acc_t; acc_t acc[2][2][4][2];
#pragma unroll
    for (int a = 0; a < 2; ++a)
#pragma unroll
        for (int b = 0; b < 2; ++b)
#pragma unroll
            for (int m = 0; m < 4; ++m)
#pragma unroll
                for (int n = 0; n < 2; ++n) acc[a][b][m][n] = acc_t{};
    bf16x8 At[4][2], B0[2][2], B1[2][2];
    const char* cA = (const char*)g.A + (size_t)cur.pm * tstep; const char* cB = (const char*)g.Bt + (size_t)cur.pn * tstep;
    S.a_ready(cur);
    if constexpr (SP2) {
        if constexpr (GATHER) { PG8_GLOAD(vgc, cur); }
        PG8_STAGE(PG8_SB(0, 0), cB, voffB); PG8_STAGE(PG8_SB(0, 1), cB + hstep, voffB);
        if constexpr (GATHER) { PG8_STAGE_G(PG8_SA(0, 0), A0, vgc[0][0], vgc[0][1]); PG8_STAGE_G(PG8_SA(0, 1), A0, vgc[1][0], vgc[1][1]); } else { PG8_STAGE(PG8_SA(0, 0), cA, voffA); PG8_STAGE(PG8_SA(0, 1), cA + hstep, voffA); }
        if (wr == 1) PG8_BAR;
        PG8_WAIT_V(2); PG8_BAR;
        PG8_STAGE(PG8_SB(1, 0), cB + kstep, voffB);
        if constexpr (GATHER) { PG8_STAGE_G(PG8_SA(1, 0), A0 + kstep, vgc[0][0], vgc[0][1]); } else { PG8_STAGE(PG8_SA(1, 0), cA + kstep, voffA); }
        PG8_STAGE(PG8_SB(1, 1), cB + hstep + kstep, voffB);
        PG8_WAIT_V(6); PG8_BAR;
    } else {
        PG8_STAGE(PG8_SB(0, 0), cB, voffB); PG8_STAGE(PG8_SA(0, 0), cA, voffA); PG8_STAGE(PG8_SB(0, 1), cB + hstep, voffB); PG8_STAGE(PG8_SA(0, 1), cA + hstep, voffA);
        if (wr == 1) PG8_BAR;
        PG8_WAIT_V(4); PG8_BAR;
        PG8_STAGE(PG8_SB(1, 0), cB + kstep, voffB); PG8_STAGE(PG8_SA(1, 0), cA + kstep, voffA); PG8_STAGE(PG8_SB(1, 1), cB + hstep + kstep, voffB);
        PG8_WAIT_V(6); PG8_BAR;
    }
    for (;;) {
        const bool has_next = S.next(ui + 1, nxt);
        typename Epi::Pre epre; E.pre(cur, wr, fr, fq, epre, xl);
        if constexpr (GATHER) { if (has_next) { int R_, C_; stage_rc(tid * 16, R_, C_);
            __builtin_amdgcn_global_load_lds((const unsigned*)((const char*)S.ridxp + ((size_t)(S.row_base + nxt.pm * BM) * 4 + (size_t)R_ * 16)), (PG8_LAS unsigned*)(lds + 131072 + ldsw), 16, 0, 0); } }
        const char* nA = has_next ? (const char*)g.A + (size_t)nxt.pm * tstep : cA; const char* nB = has_next ? (const char*)g.Bt + (size_t)nxt.pn * tstep : cB;
        for (int t = 0; t < nt; t += 2) {
            const bool last = (t == nt - 2);
            const char* a1 = cA + (size_t)(t + 1) * kstep;
            const char* a2 = last ? nA : cA + (size_t)(t + 2) * kstep; const char* b2 = last ? nB : cB + (size_t)(t + 2) * kstep;
            const char* a3 = a2 + kstep; const char* b3 = b2 + kstep;
            const char* ga2 = A0 + (size_t)(last ? 0 : t + 2) * kstep; (void)ga2;
            if (last && has_next) S.a_ready(nxt);
            if constexpr (GATHER) { if (last) {
                if (has_next) { const i32x4 raw = *(const volatile PG8_LAS i32x4*)(lds + 131072 + ldsw + (tid & 63) * 16); int R_, C_; stage_rc(tid * 16, R_, C_);
#pragma unroll
                    for (int k_ = 0; k_ < 4; ++k_) { int tk_ = raw[k_]; tk_ = tk_ < 0 ? 0 : tk_; vgn[k_ >> 1][k_ & 1] = (unsigned)(tk_ * K + C_) * 2u; } }
                else { vgn[0][0] = vgc[0][0]; vgn[0][1] = vgc[0][1]; vgn[1][0] = vgc[1][0]; vgn[1][1] = vgc[1][1]; } } }
            if constexpr (SP2) {
            PG8_LDB(B0, 0, 0); PG8_LDB(B1, 0, 1); PG8_SCHED; PG8_LDA(At, 0, 0); if constexpr (GATHER) { PG8_STAGE_G(PG8_SA(1, 1), A0 + (size_t)(t + 1) * kstep, vgc[1][0], vgc[1][1]); } else { PG8_STAGE(PG8_SA(1, 1), a1 + hstep, voffA); }
            PG8_WAIT_V(8); PG8_WAIT_L(0); PG8_BAR; PG8_MMA(0, 0, At, B0); PG8_MMA(0, 1, At, B1); PG8_BAR; PG8_SCHED;
            PG8_LDA(At, 0, 1); PG8_STAGE(PG8_SB(0, 0), b2, voffB); PG8_STAGE(PG8_SB(0, 1), b2 + hstep, voffB); if constexpr (GATHER) { PG8_STAGE_G(PG8_SA(0, 0), ga2, last ? vgn[0][0] : vgc[0][0], last ? vgn[0][1] : vgc[0][1]); } else { PG8_STAGE(PG8_SA(0, 0), a2, voffA); }
            PG8_WAIT_V(8); PG8_WAIT_L(0); PG8_BAR; PG8_MMA(1, 0, At, B0); PG8_MMA(1, 1, At, B1); PG8_BAR; PG8_SCHED;
            PG8_LDB(B0, 1, 0); PG8_LDB(B1, 1, 1); PG8_SCHED; PG8_LDA(At, 1, 0); if constexpr (GATHER) { PG8_STAGE_G(PG8_SA(0, 1), ga2, last ? vgn[1][0] : vgc[1][0], last ? vgn[1][1] : vgc[1][1]); } else { PG8_STAGE(PG8_SA(0, 1), a2 + hstep, voffA); }
            PG8_WAIT_V(8); PG8_WAIT_L(0); PG8_BAR; PG8_MMA(0, 0, At, B0); PG8_MMA(0, 1, At, B1); PG8_BAR; PG8_SCHED;
            PG8_LDA(At, 1, 1); PG8_STAGE(PG8_SB(1, 0), b3, voffB); PG8_STAGE(PG8_SB(1, 1), b3 + hstep, voffB); if constexpr (GATHER) { PG8_STAGE_G(PG8_SA(1, 0), ga2 + kstep, last ? vgn[0][0] : vgc[0][0], last ? vgn[0][1] : vgc[0][1]); } else { PG8_STAGE(PG8_SA(1, 0), a3, voffA); }
            PG8_WAIT_V(8); PG8_WAIT_L(0); PG8_BAR; PG8_MMA(1, 0, At, B0); PG8_MMA(1, 1, At, B1); PG8_BAR; PG8_SCHED;
            } else {
            PG8_LDB(B0, 0, 0); PG8_SCHED; PG8_LDA(At, 0, 0); PG8_STAGE(PG8_SA(1, 1), a1 + hstep, voffA);
            PG8_WAIT_L(8); PG8_BAR; PG8_WAIT_L(0); PG8_MMA(0, 0, At, B0); PG8_BAR; PG8_SCHED;
            PG8_LDB(B1, 0, 1); PG8_STAGE(PG8_SB(0, 0), b2, voffB);
            PG8_BAR; PG8_WAIT_L(0); PG8_MMA(0, 1, At, B1); PG8_BAR;
            PG8_LDA(At, 0, 1); PG8_STAGE(PG8_SA(0, 0), a2, voffA);
            PG8_BAR; PG8_WAIT_L(0); PG8_MMA(1, 0, At, B0); PG8_BAR; PG8_SCHED;
            PG8_STAGE(PG8_SB(0, 1), b2 + hstep, voffB);
            PG8_WAIT_V(6); PG8_BAR; PG8_MMA(1, 1, At, B1); PG8_BAR;
            PG8_LDB(B0, 1, 0); PG8_SCHED; PG8_LDA(At, 1, 0); PG8_STAGE(PG8_SA(0, 1), a2 + hstep, voffA);
            PG8_WAIT_L(8); PG8_BAR; PG8_WAIT_L(0); PG8_MMA(0, 0, At, B0); PG8_BAR; PG8_SCHED;
            PG8_LDB(B1, 1, 1); PG8_STAGE(PG8_SB(1, 0), b3, voffB);
            PG8_BAR; PG8_WAIT_L(0); PG8_MMA(0, 1, At, B1); PG8_BAR;
            PG8_LDA(At, 1, 1); PG8_STAGE(PG8_SA(1, 0), a3, voffA);
            PG8_BAR; PG8_WAIT_L(0); PG8_MMA(1, 0, At, B0); PG8_BAR; PG8_SCHED;
            PG8_STAGE(PG8_SB(1, 1), b3 + hstep, voffB);
            PG8_WAIT_V(6); PG8_BAR; PG8_MMA(1, 1, At, B1); PG8_BAR;
            }
        }
        if constexpr (ALIGN_EPI) { if (wr == 0) PG8_BAR; }
        if constexpr (!Epi::AFTER_DRAIN) { E(acc, cur, wr, wc, fr, fq, epre, xl); S.done(cur); }
        if (!has_next) break;
#pragma unroll
        for (int a = 0; a < 2; ++a)
#pragma unroll
            for (int b = 0; b < 2; ++b)
#pragma unroll
                for (int m = 0; m < 4; ++m)
#pragma unroll
                    for (int n = 0; n < 2; ++n) acc[a][b][m][n] = acc_t{};
        cur = nxt; cA = nA; cB = nB; ++ui;
        if constexpr (GATHER) { vgc[0][0] = vgn[0][0]; vgc[0][1] = vgn[0][1]; vgc[1][0] = vgn[1][0]; vgc[1][1] = vgn[1][1]; }
        if constexpr (ALIGN_EPI) { if (wr == 1) PG8_BAR; }
    }
    PG8_WAIT_V(0);
    if constexpr (!ALIGN_EPI) { if (wr == 0) PG8_BAR; }
    PG8_BAR;
    if constexpr (Epi::AFTER_DRAIN) { E.fused(acc, cur, wr, wc, fr, fq, lds, wid, lane); S.done(cur); }
#undef PG8_SA
#undef PG8_GLOAD
#undef PG8_STAGE_G
#undef PG8_SB
#undef PG8_STAGE
#undef PG8_LDA
#undef PG8_LDB
#undef PG8_MMA
#undef PG8_WAIT_V
#undef PG8_WAIT_L
#undef PG8_BAR
#undef PG8_SCHED
}
}

namespace pg8 {
typedef unsigned long long ssq_t;
__device__ __forceinline__ float ssq_rstd(const ssq_t* ssq, int r) { return __builtin_amdgcn_rsqf((float)ssq[r] * (1.0f / (1048576.0f * 1024.0f)) + 1e-6f); }
__device__ __forceinline__ void ssq_add(ssq_t* ssq, int r, float ss) { atomicAdd(ssq + r, (ssq_t)(ss * 1048576.0f)); }
__device__ __forceinline__ void share_scales(PG8_LAS float* xl, int fr, int fq, float s0, float s1) { xl[fr * 8 + 2 * fq] = s0; xl[fr * 8 + 2 * fq + 1] = s1; asm volatile("s_waitcnt lgkmcnt(0)" ::: "memory"); }
__device__ __forceinline__ float silu_fast(float x) { return x * __builtin_amdgcn_rcpf(1.0f + __expf(-x)); }
struct EpiInProj {
    static constexpr bool PERM = true, AFTER_DRAIN = false;
    typedef EpiPreS Pre; bf16_t* proj; float* dtga; const ssq_t* ssq;
    __device__ __forceinline__ void pre(const Unit& u, int wr, int fr, int fq, Pre& p, PG8_LAS float*) const {
        if (ssq) {
#pragma unroll
            for (int k = 0; k < 2; ++k) { const int kk = 2 * fq + k; p.q[k] = ssq[u.pm * BM + wr * 64 + fr + (kk >> 2) * HALF + (kk & 3) * 16]; } }
    }
    __device__ __forceinline__ void operator()(const f32x4 (&acc)[2][2][4][2], const Unit& u, int wr, int wc, int fr, int fq, const Pre& p, PG8_LAS float* xl) const {
        const int row0 = u.pm * BM + wr * 64 + fr;
        if (ssq) share_scales(xl, fr, fq, ssq_rstd(p.q, 0), ssq_rstd(p.q, 1));
        if (u.pn < 11) {
            const int col0 = u.pn * BM + wc * 32 + 8 * fq;
#pragma unroll
            for (int ai = 0; ai < 2; ++ai)
#pragma unroll
                for (int m = 0; m < 4; ++m) { bf16_t* rowp = proj + (size_t)(row0 + ai * HALF + m * 16) * PW + col0;
                    const float rs = ssq ? xl[fr * 8 + ai * 4 + m] : 1.0f;
#pragma unroll
                    for (int bj = 0; bj < 2; ++bj) { const f32x4 v0 = acc[ai][bj][m][0] * rs, v1 = acc[ai][bj][m][1] * rs;
                        u32x4 w; w.x = cvt_pk_bf16(v0[0], v0[1]); w.y = cvt_pk_bf16(v0[2], v0[3]); w.z = cvt_pk_bf16(v1[0], v1[1]); w.w = cvt_pk_bf16(v1[2], v1[3]);
                        *(u32x4*)(rowp + bj * HALF) = w; } }
        } else if (wc == 0 || (wc == 1 && fq == 0)) {
#pragma unroll
            for (int ai = 0; ai < 2; ++ai)
#pragma unroll
                for (int m = 0; m < 4; ++m) { float* rp = dtga + (size_t)(row0 + ai * HALF + m * 16) * DGW + wc * 32 + 8 * fq;
                    *(f32x4*)rp = acc[ai][0][m][0]; *(f32x4*)(rp + 4) = acc[ai][0][m][1]; }
        }
    }
};
constexpr int HPITCH = 2048;
template <bool IN16> struct EpiResid {
    static constexpr bool PERM = true, AFTER_DRAIN = false;
    typedef EpiPreNone Pre; const void* hin; bf16_t* hout; float ascale = 1.0f;
    __device__ __forceinline__ void pre(const Unit&, int, int, int, Pre&, PG8_LAS float*) const {}
    __device__ __forceinline__ void operator()(const f32x4 (&acc)[2][2][4][2], const Unit& u, int wr, int wc, int fr, int fq, const Pre&, PG8_LAS float*) const {
        const int row0 = u.pm * BM + wr * 64 + fr, col0 = u.pn * BM + wc * 32 + 8 * fq;
#pragma unroll
        for (int ai = 0; ai < 2; ++ai)
#pragma unroll
            for (int m = 0; m < 4; ++m) { const int r = row0 + ai * HALF + m * 16; bf16_t* op = hout + (size_t)r * HPITCH + col0;
                f32x4 i0[2], i1[2];
                if constexpr (IN16) { const bf16_t* ip = (const bf16_t*)hin + (size_t)r * HPITCH + col0; u32x4 q[2];
#pragma unroll
                    for (int bj = 0; bj < 2; ++bj) q[bj] = *(const u32x4*)(ip + bj * HALF);
#pragma unroll
                    for (int bj = 0; bj < 2; ++bj) { i0[bj] = (f32x4){__uint_as_float(q[bj].x << 16), __uint_as_float(q[bj].x & 0xffff0000u), __uint_as_float(q[bj].y << 16), __uint_as_float(q[bj].y & 0xffff0000u)};
                        i1[bj] = (f32x4){__uint_as_float(q[bj].z << 16), __uint_as_float(q[bj].z & 0xffff0000u), __uint_as_float(q[bj].w << 16), __uint_as_float(q[bj].w & 0xffff0000u)}; } }
                else { const float* ip = (const float*)hin + (size_t)r * 1024 + col0;
#pragma unroll
                    for (int bj = 0; bj < 2; ++bj) { i0[bj] = *(const f32x4*)(ip + bj * HALF); i1[bj] = *(const f32x4*)(ip + bj * HALF + 4); } }
#pragma unroll
                for (int bj = 0; bj < 2; ++bj) { const f32x4 v0 = i0[bj] + acc[ai][bj][m][0] * ascale, v1 = i1[bj] + acc[ai][bj][m][1] * ascale;
                    u32x4 w; w.x = cvt_pk_bf16(v0[0], v0[1]); w.y = cvt_pk_bf16(v0[2], v0[3]); w.z = cvt_pk_bf16(v1[0], v1[1]); w.w = cvt_pk_bf16(v1[2], v1[3]); *(u32x4*)(op + bj * HALF) = w; }
                asm volatile("" ::: "memory"); }
    }
};
struct EpiSwiGLU {
    static constexpr bool PERM = true, AFTER_DRAIN = false;
    typedef EpiPreS Pre; bf16_t* out; int ld; int ntile; const ssq_t* ssq; const float* srs; int row_base; bool tiled;
    __device__ __forceinline__ void pre(const Unit& u, int wr, int fr, int fq, Pre& p, PG8_LAS float*) const {
#pragma unroll
        for (int k = 0; k < 2; ++k) { const int kk = 2 * fq + k, r = u.pm * BM + wr * 64 + fr + (kk >> 2) * HALF + (kk & 3) * 16;
            if (ssq) p.q[k] = ssq[r]; else if (srs) p.f[k] = srs[row_base + r]; }
    }
    __device__ __forceinline__ void operator()(const f32x4 (&acc)[2][2][4][2], const Unit& u, int wr, int wc, int fr, int fq, const Pre& p, PG8_LAS float* xl) const {
        const int row0 = u.pm * BM + wr * 64 + fr, col0 = (u.pn % ntile) * HALF + wc * 32 + 8 * fq;
        if (ssq) share_scales(xl, fr, fq, ssq_rstd(p.q, 0), ssq_rstd(p.q, 1)); else if (srs) share_scales(xl, fr, fq, p.f[0], p.f[1]);
#pragma unroll
        for (int ai = 0; ai < 2; ++ai)
#pragma unroll
            for (int m = 0; m < 4; ++m) { const int rr_ = row0 + ai * HALF + m * 16;
                bf16_t* rowp = tiled ? out + ((size_t)(rr_ >> 8) * (ld >> 6) + (col0 >> 6)) * 16384 + (size_t)(rr_ & 255) * 64 + (col0 & 63) : out + (size_t)rr_ * ld + col0;
                const float rs = (ssq || srs) ? xl[fr * 8 + ai * 4 + m] : 1.0f;
                const f32x4 g0 = acc[ai][0][m][0] * rs, g1 = acc[ai][0][m][1] * rs, u0 = acc[ai][1][m][0] * rs, u1 = acc[ai][1][m][1] * rs;
                u32x4 w; w.x = cvt_pk_bf16(silu_fast(g0[0]) * u0[0], silu_fast(g0[1]) * u0[1]); w.y = cvt_pk_bf16(silu_fast(g0[2]) * u0[2], silu_fast(g0[3]) * u0[3]);
                w.z = cvt_pk_bf16(silu_fast(g1[0]) * u1[0], silu_fast(g1[1]) * u1[1]); w.w = cvt_pk_bf16(silu_fast(g1[2]) * u1[2], silu_fast(g1[3]) * u1[3]);
                *(u32x4*)rowp = w; }
    }
};
struct EpiPre8 { float f[2]; float sbv; };
struct EpiSwiGLU8 {
    static constexpr bool PERM = true, AFTER_DRAIN = false;
    typedef EpiPre8 Pre; bf16_t* out; int ld; int ntile; const float* sa; const float* sb; int row_base; bool tiled;
    __device__ __forceinline__ void pre(const Unit& u, int wr, int fr, int fq, Pre& p, PG8_LAS float*) const {
#pragma unroll
        for (int k = 0; k < 2; ++k) { const int kk = 2 * fq + k; p.f[k] = sa[row_base + u.pm * BM + wr * 64 + fr + (kk >> 2) * HALF + (kk & 3) * 16]; }
        int t_ = threadIdx.x; asm volatile("" : "+v"(t_));
        const int lane = fr + 16 * fq, wc = (t_ >> 6) & 3; p.sbv = sb[(size_t)u.pn * BM + (lane >> 5) * HALF + wc * 32 + (lane & 31)];
    }
    __device__ __forceinline__ void operator()(const i32x4 (&acc)[2][2][4][2], const Unit& u, int wr, int wc, int fr, int fq, const Pre& p, PG8_LAS float* xl) const {
        const int row0 = u.pm * BM + wr * 64 + fr, col0 = (u.pn % ntile) * HALF + wc * 32 + 8 * fq;
        xl[fr * 8 + 2 * fq] = p.f[0]; xl[fr * 8 + 2 * fq + 1] = p.f[1]; xl[128 + fr + 16 * fq] = p.sbv; asm volatile("s_waitcnt lgkmcnt(0)" ::: "memory");
        const f32x4 sg0 = *(const PG8_LAS f32x4*)(xl + 128 + 8 * fq), sg1 = *(const PG8_LAS f32x4*)(xl + 128 + 8 * fq + 4), su0 = *(const PG8_LAS f32x4*)(xl + 160 + 8 * fq), su1 = *(const PG8_LAS f32x4*)(xl + 160 + 8 * fq + 4);
#pragma unroll
        for (int ai = 0; ai < 2; ++ai)
#pragma unroll
            for (int m = 0; m < 4; ++m) { const int rr_ = row0 + ai * HALF + m * 16;
                const float s = xl[fr * 8 + ai * 4 + m];
                bf16_t* rowp = out + (size_t)rr_ * ld + col0;
                float g[8], uu[8];
#pragma unroll
                for (int j = 0; j < 4; ++j) { g[j] = (float)acc[ai][0][m][0][j] * s * sg0[j]; g[4 + j] = (float)acc[ai][0][m][1][j] * s * sg1[j]; uu[j] = (float)acc[ai][1][m][0][j] * s * su0[j]; uu[4 + j] = (float)acc[ai][1][m][1][j] * s * su1[j]; }
                if (tiled) {
#pragma unroll
                    for (int j = 0; j < 8; ++j) g[j] = __builtin_amdgcn_fmed3f(silu_fast(g[j]) * uu[j], -448.0f, 448.0f);
                    unsigned lo = 0u, hi = 0u; lo = __builtin_amdgcn_cvt_pk_fp8_f32(g[0], g[1], lo, false); lo = __builtin_amdgcn_cvt_pk_fp8_f32(g[2], g[3], lo, true);
                    hi = __builtin_amdgcn_cvt_pk_fp8_f32(g[4], g[5], hi, false); hi = __builtin_amdgcn_cvt_pk_fp8_f32(g[6], g[7], hi, true);
                    *(unsigned long long*)((unsigned char*)out + ((size_t)(rr_ >> 8) * (ld >> 7) + (col0 >> 7)) * 32768 + (size_t)(rr_ & 255) * 128 + (col0 & 127)) = (unsigned long long)lo | ((unsigned long long)hi << 32);
                } else {
                u32x4 w; w.x = cvt_pk_bf16(silu_fast(g[0]) * uu[0], silu_fast(g[1]) * uu[1]); w.y = cvt_pk_bf16(silu_fast(g[2]) * uu[2], silu_fast(g[3]) * uu[3]);
                w.z = cvt_pk_bf16(silu_fast(g[4]) * uu[4], silu_fast(g[5]) * uu[5]); w.w = cvt_pk_bf16(silu_fast(g[6]) * uu[6], silu_fast(g[7]) * uu[7]);
                *(u32x4*)rowp = w; } }
    }
};
struct EpiInProj8 {
    static constexpr bool PERM = true, AFTER_DRAIN = false;
    typedef EpiPre8 Pre; bf16_t* proj; const float* sa; const float* sb;
    __device__ __forceinline__ void pre(const Unit& u, int wr, int fr, int fq, Pre& p, PG8_LAS float*) const {
#pragma unroll
        for (int k = 0; k < 2; ++k) { const int kk = 2 * fq + k; p.f[k] = sa[u.pm * BM + wr * 64 + fr + (kk >> 2) * HALF + (kk & 3) * 16]; }
        int t_ = threadIdx.x; asm volatile("" : "+v"(t_));
        const int lane = fr + 16 * fq, wc = (t_ >> 6) & 3; p.sbv = sb[(size_t)u.pn * BM + (lane >> 5) * HALF + wc * 32 + (lane & 31)];
    }
    __device__ __forceinline__ void operator()(const i32x4 (&acc)[2][2][4][2], const Unit& u, int wr, int wc, int fr, int fq, const Pre& p, PG8_LAS float* xl) const {
        const int row0 = u.pm * BM + wr * 64 + fr, col0 = u.pn * BM + wc * 32 + 8 * fq;
        xl[fr * 8 + 2 * fq] = p.f[0]; xl[fr * 8 + 2 * fq + 1] = p.f[1]; xl[128 + fr + 16 * fq] = p.sbv; asm volatile("s_waitcnt lgkmcnt(0)" ::: "memory");
        f32x4 sc[2][2];
#pragma unroll
        for (int bj = 0; bj < 2; ++bj) { sc[bj][0] = *(const PG8_LAS f32x4*)(xl + 128 + 32 * bj + 8 * fq); sc[bj][1] = *(const PG8_LAS f32x4*)(xl + 128 + 32 * bj + 8 * fq + 4); }
#pragma unroll
        for (int ai = 0; ai < 2; ++ai)
#pragma unroll
            for (int m = 0; m < 4; ++m) { const int r = row0 + ai * HALF + m * 16; const float s = xl[fr * 8 + ai * 4 + m]; bf16_t* rowp = proj + (size_t)r * PW + col0;
#pragma unroll
                for (int bj = 0; bj < 2; ++bj) { const i32x4 a0 = acc[ai][bj][m][0], a1 = acc[ai][bj][m][1]; const f32x4 s0 = sc[bj][0] * s, s1 = sc[bj][1] * s;
                    u32x4 w; w.x = cvt_pk_bf16((float)a0[0] * s0[0], (float)a0[1] * s0[1]); w.y = cvt_pk_bf16((float)a0[2] * s0[2], (float)a0[3] * s0[3]);
                    w.z = cvt_pk_bf16((float)a1[0] * s1[0], (float)a1[1] * s1[1]); w.w = cvt_pk_bf16((float)a1[2] * s1[2], (float)a1[3] * s1[3]);
                    *(u32x4*)(rowp + bj * HALF) = w; } }
    }
};
struct EpiMoeDown {
    static constexpr bool PERM = true, AFTER_DRAIN = false;
    typedef EpiPreNone Pre; bf16_t* ylo; long hi_off; const int* stok; const float* sgate; int row_base; float gscale;
    __device__ __forceinline__ void pre(const Unit& u, int wr, int, int, Pre&, PG8_LAS float* xl) const {
        int t_ = threadIdx.x; asm volatile("" : "+v"(t_));
        const unsigned voff = (unsigned)(t_ & 63) * 4u; const size_t sb_ = (size_t)(row_base + u.pm * BM + wr * 64) * 4;
#pragma unroll
        for (int ai = 0; ai < 2; ++ai) { __builtin_amdgcn_global_load_lds((const unsigned*)((const char*)stok + sb_ + ai * HALF * 4 + voff), (PG8_LAS unsigned*)(xl + ai * 64), 4, 0, 0);
            __builtin_amdgcn_global_load_lds((const unsigned*)((const char*)sgate + sb_ + ai * HALF * 4 + voff), (PG8_LAS unsigned*)(xl + 128 + ai * 64), 4, 0, 0); }
    }
    __device__ __forceinline__ void operator()(const f32x4 (&acc)[2][2][4][2], const Unit& u, int wr, int wc, int fr, int fq, const Pre&, PG8_LAS float* xl) const {
        { int t_ = threadIdx.x; asm volatile("" : "+v"(t_)); fr = t_ & 15; fq = (t_ >> 4) & 3; }
        bf16_t* ylo_ = ylo; asm volatile("" : "+s"(ylo_));
        const int ct = u.pn & 3, col0 = (ct & 1) * BM + wc * 32 + 8 * fq; bf16_t* const yb = ylo_ + (long)(ct >> 1) * hi_off;
#pragma unroll
        for (int ai = 0; ai < 2; ++ai)
#pragma unroll
            for (int m = 0; m < 4; ++m) { const int tok = ((const volatile PG8_LAS int*)xl)[ai * 64 + m * 16 + fr]; const float gt = ((const volatile PG8_LAS float*)xl)[128 + ai * 64 + m * 16 + fr] * gscale;
                if (tok >= 0) { bf16_t* op = yb + (size_t)tok * 512 + col0;
#pragma unroll
                    for (int bj = 0; bj < 2; ++bj) { const f32x4 v0 = acc[ai][bj][m][0] * gt, v1 = acc[ai][bj][m][1] * gt;
                        u32x4 w; w.x = cvt_pk_bf16(v0[0], v0[1]); w.y = cvt_pk_bf16(v0[2], v0[3]); w.z = cvt_pk_bf16(v1[0], v1[1]); w.w = cvt_pk_bf16(v1[2], v1[3]); *(u32x4*)(op + bj * HALF) = w; }
                } }
    }
};
struct MoeOrder {
    static constexpr int SKIP = 3; int t0, nT, nN, G, c, nx; const PG8_LAS int* tile_expert; const int* ridx; int row_base; const int* ridxp = nullptr;
    __device__ __forceinline__ bool next(int i, Unit& u) const {
        const int r = i + (c < nx ? SKIP : 0);
        const int L = r < SKIP ? r * (G - nx) + (c - nx) : SKIP * (G - nx) + (r - SKIP) * G + c;
        if (L >= nT * nN) return false;
        const int tl = L / nN, j = L % nN; u.pm = tl; u.pn = tile_expert[tl] * nN + j; return true;
    }
    __device__ __forceinline__ void a_ready(const Unit&) const {}
    __device__ __forceinline__ void done(const Unit&) const {}
};
}

namespace attn_body {
using bf16=unsigned short;
using bf16x8=__attribute__((ext_vector_type(8)))short;
using s16x4=__attribute__((ext_vector_type(4)))short;
using f32x16=__attribute__((ext_vector_type(16)))float;
using u32x4=__attribute__((ext_vector_type(4)))unsigned;
constexpr int D=64,DM=PW;
constexpr int NW=8,QBLK=32,KVBLK=64;
__device__ __forceinline__ int crow(int r,int hi){return (r&3)+8*(r>>2)+4*hi;}
#define SBAR() __builtin_amdgcn_sched_barrier(0)
__device__ __forceinline__ void meta_mask(f32x16&p0,f32x16&p1){
  const float NEG=-INFINITY;
  #pragma unroll
  for(int r=8;r<16;++r)p0[r]=NEG;
  #pragma unroll
  for(int r=0;r<16;++r)p1[r]=NEG;
}
__device__ __forceinline__ void swa_mask(f32x16&p0,f32x16&p1,int rel0,int lo,int hi_,bool metatile,bool dead,const __attribute__((address_space(3))) float*bt,float mh){
  const float NEG=-INFINITY;
  if(dead){
    #pragma unroll
    for(int r=0;r<16;++r){p0[r]=NEG;p1[r]=NEG;}
  } else {
    #pragma unroll
    for(int r4=0;r4<4;++r4){
      #pragma unroll
      for(int half=0;half<2;++half){
        #pragma unroll
        for(int j=0;j<4;++j){
          const int r=4*r4+j, rel=rel0+(j+8*r4+32*half);
          const int idx=rel>hi_?hi_:(rel<lo?lo:rel);
          const float bv=bt[idx+129]-mh;
          if(half==0)p0[r]+=bv; else p1[r]+=bv; } }
      __builtin_amdgcn_sched_barrier(0); }
    if(metatile){
      #pragma unroll
      for(int r=8;r<16;++r)p0[r]=NEG;
      #pragma unroll
      for(int r=0;r<16;++r)p1[r]=NEG; }
  }
}

constexpr int NSLOT=3, SLOTB=8192;
constexpr int LDS_K=0, LDS_V=NSLOT*SLOTB, LDS_WS=2*NSLOT*SLOTB, LDS_OST=LDS_WS+NW*64*4, LDS_BYTES=LDS_OST+NW*4096;
constexpr float C2=0.125f*1.4426950408889634f;
__device__ __forceinline__ void glds16(const void*gsrc,unsigned lds_dst){unsigned keep;
  asm volatile("s_mov_b32 %0, m0\n\ts_mov_b32 m0, %2\n\ts_nop 0\n\tglobal_load_lds_dwordx4 %1, off\n\ts_mov_b32 m0, %0":"=&s"(keep):"v"(gsrc),"s"(lds_dst):"memory");}
__device__ __forceinline__ float max3f(float a,float b,float c){float r;asm("v_max3_f32 %0, %1, %2, %3":"=v"(r):"v"(a),"v"(b),"v"(c));return r;}
__device__ __forceinline__ float max2f(float a,float b){float r;asm("v_max_f32_e32 %0, %1, %2":"=v"(r):"v"(a),"v"(b));return r;}
__device__ __forceinline__ float fadd_s(float a,float b){float r;asm("v_add_f32_e32 %0, %1, %2":"=v"(r):"v"(a),"v"(b));return r;}
__device__ __forceinline__ float fsub_s(float a,float b){float r;asm("v_sub_f32_e32 %0, %1, %2":"=v"(r):"v"(a),"v"(b));return r;}
typedef float f32x2_t __attribute__((ext_vector_type(2))); typedef __bf16 bf16x2_t __attribute__((ext_vector_type(2)));
__device__ __forceinline__ unsigned cvtpk_s(float lo,float hi){f32x2_t v={lo,hi};bf16x2_t b=__builtin_convertvector(v,bf16x2_t);return __builtin_bit_cast(unsigned,b);}
#define WAIT_BAR(N) asm volatile("s_waitcnt vmcnt(" #N ") lgkmcnt(0)\n\ts_barrier":::"memory")

__device__ __forceinline__ void qkt(f32x16&p0,f32x16&p1,const char*Kslot,const bf16x8*qr,const f32x16&negm,int r32,int hi){
  const char*kb=Kslot+hi*1024+r32*16;
  #pragma unroll
  for(int d0=0;d0<4;++d0){
    const bf16x8 b0=*reinterpret_cast<const bf16x8*>(kb+d0*2048);
    const bf16x8 b1=*reinterpret_cast<const bf16x8*>(kb+d0*2048+512);
    if(d0==0){p0=__builtin_amdgcn_mfma_f32_32x32x16_bf16(b0,qr[0],negm,0,0,0);p1=__builtin_amdgcn_mfma_f32_32x32x16_bf16(b1,qr[0],negm,0,0,0);}
    else{p0=__builtin_amdgcn_mfma_f32_32x32x16_bf16(b0,qr[d0],p0,0,0,0);p1=__builtin_amdgcn_mfma_f32_32x32x16_bf16(b1,qr[d0],p1,0,0,0);}}
}
typedef __attribute__((address_space(3))) const char* lds_cptr;
typedef short v4i16_t __attribute__((ext_vector_type(4)));
__device__ __forceinline__ void kload8(bf16x8*kf,lds_cptr kp){
  kf[0]=*(const __attribute__((address_space(3))) bf16x8*)(kp);      kf[1]=*(const __attribute__((address_space(3))) bf16x8*)(kp+512);
  kf[2]=*(const __attribute__((address_space(3))) bf16x8*)(kp+2048); kf[3]=*(const __attribute__((address_space(3))) bf16x8*)(kp+2560);
  kf[4]=*(const __attribute__((address_space(3))) bf16x8*)(kp+4096); kf[5]=*(const __attribute__((address_space(3))) bf16x8*)(kp+4608);
  kf[6]=*(const __attribute__((address_space(3))) bf16x8*)(kp+6144); kf[7]=*(const __attribute__((address_space(3))) bf16x8*)(kp+6656);
}
__device__ __forceinline__ void kload2(bf16x8*kf,lds_cptr kp,int j){ kf[2*j]=*(const __attribute__((address_space(3))) bf16x8*)(kp+j*2048); kf[2*j+1]=*(const __attribute__((address_space(3))) bf16x8*)(kp+j*2048+512); }
__device__ __forceinline__ s16x4 vtr(lds_cptr p){ return __builtin_bit_cast(s16x4,__builtin_amdgcn_ds_read_tr16_b64_v4i16((__attribute__((address_space(3))) v4i16_t*)p)); }
__device__ __forceinline__ float rowmax(const f32x16&p0,const f32x16&p1){
  float a=max3f(p0[0],p0[1],p1[0]),b=max3f(p0[2],p0[3],p1[1]);a=max3f(a,p1[2],p1[3]);
  #pragma unroll
  for(int r=4;r<16;r+=4){a=max3f(a,p0[r],p0[r+1]);b=max3f(b,p0[r+2],p0[r+3]);a=max3f(a,p1[r],p1[r+1]);b=max3f(b,p1[r+2],p1[r+3]);}
  const float m=max2f(a,b);
  auto rr=__builtin_amdgcn_permlane32_swap(__float_as_uint(m),__float_as_uint(m),false,false);
  return max2f(__uint_as_float(rr[0]),__uint_as_float(rr[1]));
}
__device__ __forceinline__ void pv(f32x16*o,int vb,bf16x8 pa0,bf16x8 pa1,bf16x8 pa2,bf16x8 pa3){
  #pragma unroll
  for(int d0=0;d0<2;++d0){s16x4 lo[4],hi[4];
    #pragma unroll
    for(int ks=0;ks<4;++ks){
      asm volatile("ds_read_b64_tr_b16 %0,%1 offset:%c2":"=&v"(lo[ks]):"v"(vb),"i"(d0*4096+ks*1024):"memory");
      asm volatile("ds_read_b64_tr_b16 %0,%1 offset:%c2":"=&v"(hi[ks]):"v"(vb),"i"(d0*4096+ks*1024+512):"memory");}
    asm volatile("s_waitcnt lgkmcnt(0)":::"memory");SBAR();
    #define PK(k) (bf16x8){lo[k][0],lo[k][1],lo[k][2],lo[k][3],hi[k][0],hi[k][1],hi[k][2],hi[k][3]}
    o[d0]=__builtin_amdgcn_mfma_f32_32x32x16_bf16(pa0,PK(0),o[d0],0,0,0);
    o[d0]=__builtin_amdgcn_mfma_f32_32x32x16_bf16(pa1,PK(1),o[d0],0,0,0);
    o[d0]=__builtin_amdgcn_mfma_f32_32x32x16_bf16(pa2,PK(2),o[d0],0,0,0);
    o[d0]=__builtin_amdgcn_mfma_f32_32x32x16_bf16(pa3,PK(3),o[d0],0,0,0);
    #undef PK
  }
}

__device__ __forceinline__ int swa_off(int j){ return j<2 ? 64*j : (j<4 ? 64*j-256 : 64*j-128); }
__device__ __forceinline__ int swa_clamp(int s){ return s<0?0:(s>S_-KVBLK?S_-KVBLK:s); }
#ifndef ATTN_STORE16
#define ATTN_STORE16(p,v) (*(u32x4*)(p)=(v))
#endif
template<int THRL,bool SWA> __device__ __forceinline__ void attn_unit(int b,int qb,const bf16*Qc,const bf16*__restrict__ Kc,const bf16*__restrict__ Vc,bf16*Oc,char*shm,const __attribute__((address_space(3))) float*btab,int g){
  int nt_ = SWA ? 7 : S_/KVBLK+1; asm volatile("":"+s"(nt_)); const int NT=nt_;
  int tid=threadIdx.x; asm volatile("":"+v"(tid));
  const int lane=tid&63,r32=lane&31,hi=lane>>5; const int wid=__builtin_amdgcn_readfirstlane(tid>>6);
  const bool meta=qb<0; const int hh=wid&1, blk=wid>>1;
  const int qrow0= meta ? NREG+b*NM : b*S_+128*qb+32*blk;
  const int tq= meta ? r32 : NM+128*qb+32*blk+r32;
  const int T0s= meta ? 0 : 128*qb;
  const bf16*Qw=Qc+(long)qrow0*DM+hh*D;
  #define TROW(t) ( SWA ? ((t)==NT-1 ? NREG+b*NM : b*S_+swa_clamp(T0s+swa_off(t))) : ((t)<NT-1 ? b*S_+KVBLK*(t) : NREG+b*NM) )
  const unsigned lds0=(unsigned)(uintptr_t)shm;
  float*wsf=(float*)(shm+LDS_WS)+wid*64;
  const bf16*ksrc=Kc+(long)lane*DM+wid*8;
  const bf16*vsrc=Vc+(long)(16*(wid&3)+(lane>>2))*DM+(wid>>2)*32+(lane&3)*8;
  const unsigned kdst=lds0+LDS_K+wid*1024, vdst=lds0+LDS_V+wid*1024;
  #define DMA_K(t,slot) glds16(ksrc+(long)TROW(t)*DM,(unsigned)__builtin_amdgcn_readfirstlane(kdst+(slot)))
  #define DMA_V(t,slot) glds16(vsrc+(long)TROW(t)*DM,(unsigned)__builtin_amdgcn_readfirstlane(vdst+(slot)))
  const int vb0=(int)(lds0+LDS_V)+((lane>>4)&1)*32+(lane&3)*8+(4*hi+((lane&15)>>2))*64;
  const char*Kbase=shm+LDS_K; bf16x8 kf[8];
  const lds_cptr shm3=(lds_cptr)shm; const lds_cptr kp0=shm3+LDS_K+hi*1024+r32*16; const lds_cptr vp0=shm3+LDS_V+((lane>>4)&1)*32+(lane&3)*8+(4*hi+((lane&15)>>2))*64;
  DMA_K(0,0);DMA_V(0,0);DMA_K(1,SLOTB);
  bf16x8 qr[4];
  #pragma unroll
  for(int d0=0;d0<4;++d0)qr[d0]=*reinterpret_cast<const bf16x8*>(&Qw[(long)r32*DM+d0*16+hi*8]);
  #define NEGC (SWA ? f32x16{} : negm)
  float mhat=0.f,l_reg=0.f;f32x16 o[2];o[0]=f32x16{};o[1]=f32x16{};f32x16 negm=f32x16{};if constexpr(!SWA){asm volatile("":"+v"(negm));}
  const __attribute__((address_space(3))) float*bt=btab+(2*g+hh)*264; const int relq=4*hi-tq;
  #define CMASK(P0,P1,t) do{ if constexpr(SWA){ swa_mask(P0,P1,((t)==NT-1?0:NM+T0s+swa_off(t))+relq,(t)==NT-1?-128:-129,(t)==NT-1?128:129,(t)==NT-1,(t)!=NT-1&&((T0s+swa_off(t))<0||(T0s+swa_off(t))>=S_),bt,mhat); } else { if((t)==NT-1)meta_mask(P0,P1); } }while(0)
  bool resc=false;
  #define START(P0,P1) do{ const float rm=rowmax(P0,P1); resc=false; \
    { const float dl=rm; mhat=fadd_s(mhat,dl); \
      _Pragma("unroll") for(int r=0;r<16;++r){P0[r]=fsub_s(P0[r],dl);P1[r]=fsub_s(P1[r],dl);} \
      _Pragma("unroll") for(int r=0;r<16;++r)negm[r]=-mhat; if constexpr(!SWA){asm volatile("":"+v"(negm));} } \
    _Pragma("unroll") for(int r=0;r<16;++r)P0[r]=__builtin_amdgcn_exp2f(P0[r]); }while(0)
  #define RESC() do{ if(resc){ asm volatile("s_waitcnt lgkmcnt(0)":::"memory"); \
      _Pragma("unroll") for(int d_=0;d_<2;++d_) _Pragma("unroll") for(int r=0;r<16;++r)o[d_][r]*=wsf[crow(r,hi)]; } }while(0)
  f32x16 pA0,pA1,pB0,pB1;
  int sl_prev=0,sl_cur=0,sl_next=SLOTB;
  #define ROT() do{sl_prev=sl_cur;sl_cur=sl_next;sl_next=(sl_next==(NSLOT-1)*SLOTB)?0:sl_next+SLOTB;}while(0)
  DMA_K(2,2*SLOTB);
  WAIT_BAR(3);
  qkt(pA0,pA1,Kbase,qr,NEGC,r32,hi);asm volatile("s_nop 15\n\ts_nop 7":"+v"(pA0),"+v"(pA1));CMASK(pA0,pA1,0);
  START(pA0,pA1);
  _Pragma("unroll") for(int r=0;r<16;++r)pA1[r]=__builtin_amdgcn_exp2f(pA1[r]);
  WAIT_BAR(0);
  DMA_K(3,0);DMA_V(1,SLOTB);
  ROT();
  kload8(kf,kp0+sl_cur);
  WAIT_BAR(2);
  s16x4 vlo[8],vhi[8]; u32x4 pw0,pw1,pw2,pw3;
  #define PKW(P,B) cvtpk_s(P[B],P[B+1])
  #define PAF(k) __builtin_bit_cast(bf16x8,pw##k)
  #define VFR(i) (bf16x8){vlo[i][0],vlo[i][1],vlo[i][2],vlo[i][3],vhi[i][0],vhi[i][1],vhi[i][2],vhi[i][3]}
  #define PIN(x) asm volatile("":"+v"(x))
  #define MX3(a,b,c) __builtin_fmaxf(__builtin_fmaxf((a),(b)),(c))
  #define GAPA(MF,A0,A1,A2,A3,W0,W1,PW) do{ MF; sacc+=A0; sacc+=A1; sacc+=A2; sacc+=A3; PIN(sacc); W0; W1; PIN(PW); SBAR(); }while(0)
  #define EX(v) __builtin_amdgcn_exp2f(v)
  #define GAPB(MF,X,B) do{ MF; X[B]=EX(X[B]); X[B+1]=EX(X[B+1]); X[B+2]=EX(X[B+2]); X[B+3]=EX(X[B+3]); PIN(X); SBAR(); }while(0)
  #define VRD(i) do{ vlo[i]=vtr(vp_+(((i)>>2)*4096+((i)&3)*1024)); vhi[i]=vtr(vp_+(((i)>>2)*4096+((i)&3)*1024+512)); }while(0)
  #define KRD(G,j) do{ if(G){ kload2(kf,kp0+sl_next,j); SBAR(); } }while(0)
  #define STEP(C0,C1,P0,P1,t,GK,GV,GL) do{ SBAR(); \
    const lds_cptr vp_=vp0+sl_prev; \
    VRD(0); SBAR(); float sacc=(P0[0]+P0[1]); \
    GAPA(C0=__builtin_amdgcn_mfma_f32_32x32x16_bf16(kf[0],qr[0],NEGC,0,0,0), P0[2],P0[3],P0[4],P0[5],     pw0[0]=PKW(P0,0), pw0[1]=PKW(P0,2), pw0); \
    VRD(4); SBAR(); GAPA(C1=__builtin_amdgcn_mfma_f32_32x32x16_bf16(kf[1],qr[0],NEGC,0,0,0), P0[6],P0[7],P0[8],P0[9],     pw0[2]=PKW(P0,4), pw0[3]=PKW(P0,6), pw0); \
    VRD(1); SBAR(); GAPA(C0=__builtin_amdgcn_mfma_f32_32x32x16_bf16(kf[2],qr[1],C0,0,0,0),   P0[10],P0[11],P0[12],P0[13], pw1[0]=PKW(P0,8), pw1[1]=PKW(P0,10), pw1); \
    VRD(5); SBAR(); GAPA(C1=__builtin_amdgcn_mfma_f32_32x32x16_bf16(kf[3],qr[1],C1,0,0,0),   P0[14],P0[15],P1[0],P1[1],   pw1[2]=PKW(P0,12),pw1[3]=PKW(P0,14), pw1); \
    VRD(2); SBAR(); GAPA(C0=__builtin_amdgcn_mfma_f32_32x32x16_bf16(kf[4],qr[2],C0,0,0,0),   P1[2],P1[3],P1[4],P1[5],     pw2[0]=PKW(P1,0), pw2[1]=PKW(P1,2), pw2); \
    VRD(6); SBAR(); GAPA(C1=__builtin_amdgcn_mfma_f32_32x32x16_bf16(kf[5],qr[2],C1,0,0,0),   P1[6],P1[7],P1[8],P1[9],     pw2[2]=PKW(P1,4), pw2[3]=PKW(P1,6), pw2); \
    VRD(3); SBAR(); GAPA(C0=__builtin_amdgcn_mfma_f32_32x32x16_bf16(kf[6],qr[3],C0,0,0,0),   P1[10],P1[11],P1[12],P1[13], pw3[0]=PKW(P1,8), pw3[1]=PKW(P1,10), pw3); \
    VRD(7); SBAR(); GAPA(C1=__builtin_amdgcn_mfma_f32_32x32x16_bf16(kf[7],qr[3],C1,0,0,0),   P1[14],P1[15],0.f,0.f,       pw3[2]=PKW(P1,12),pw3[3]=PKW(P1,14), pw3); \
    l_reg+=sacc; \
    if(GK){DMA_K((t)+3,sl_cur);} if(GV){DMA_V((t)+1,sl_next);} \
    CMASK(C0,C1,t); \
    { float a=MX3(C0[0],C0[1],C1[0]),b=MX3(C0[2],C0[3],C1[1]); a=MX3(a,C1[2],C1[3]); \
      _Pragma("unroll") for(int r=4;r<16;r+=4){a=MX3(a,C0[r],C0[r+1]);b=MX3(b,C0[r+2],C0[r+3]);a=MX3(a,C1[r],C1[r+1]);b=MX3(b,C1[r+2],C1[r+3]);} \
      float rm=__builtin_fmaxf(a,b); { auto rr=__builtin_amdgcn_permlane32_swap(__float_as_uint(rm),__float_as_uint(rm),false,false); rm=__builtin_fmaxf(__uint_as_float(rr[0]),__uint_as_float(rr[1])); } \
      resc=false; \
      if(__builtin_expect(__any(rm>(float)THRL),0)){ const float dl=__builtin_fmaxf(rm,0.f); mhat+=dl; \
        _Pragma("unroll") for(int r=0;r<16;++r){C0[r]-=dl;C1[r]-=dl;} \
        _Pragma("unroll") for(int r=0;r<16;++r)negm[r]=-mhat; if constexpr(!SWA){asm volatile("":"+v"(negm));} \
        const float f=__builtin_amdgcn_exp2f(-dl); l_reg*=f; if(hi==0)wsf[r32]=f; resc=true; } } \
    SBAR(); \
    GAPB(o[0]=__builtin_amdgcn_mfma_f32_32x32x16_bf16(PAF(0),VFR(0),o[0],0,0,0), C0,0); \
    GAPB(o[1]=__builtin_amdgcn_mfma_f32_32x32x16_bf16(PAF(0),VFR(4),o[1],0,0,0), C0,4); \
    KRD(GL,0); GAPB(o[0]=__builtin_amdgcn_mfma_f32_32x32x16_bf16(PAF(1),VFR(1),o[0],0,0,0), C0,8); \
    KRD(GL,1); GAPB(o[1]=__builtin_amdgcn_mfma_f32_32x32x16_bf16(PAF(1),VFR(5),o[1],0,0,0), C0,12); \
    KRD(GL,2); GAPB(o[0]=__builtin_amdgcn_mfma_f32_32x32x16_bf16(PAF(2),VFR(2),o[0],0,0,0), C1,0); \
    KRD(GL,3); GAPB(o[1]=__builtin_amdgcn_mfma_f32_32x32x16_bf16(PAF(2),VFR(6),o[1],0,0,0), C1,4); \
    GAPB(o[0]=__builtin_amdgcn_mfma_f32_32x32x16_bf16(PAF(3),VFR(3),o[0],0,0,0), C1,8); \
    GAPB(o[1]=__builtin_amdgcn_mfma_f32_32x32x16_bf16(PAF(3),VFR(7),o[1],0,0,0), C1,12); \
    }while(0)
  int t=1;
  #undef CMASK
  #define CMASK(P0,P1,t) do{ if constexpr(SWA){ swa_mask(P0,P1,((t)==NT-1?0:NM+T0s+swa_off(t))+relq,(t)==NT-1?-128:-129,(t)==NT-1?128:129,(t)==NT-1,(t)!=NT-1&&((T0s+swa_off(t))<0||(T0s+swa_off(t))>=S_),bt,mhat); } }while(0)
  for(;t+5<NT;t+=2){
    STEP(pB0,pB1,pA0,pA1,t,true,true,true);     WAIT_BAR(2); RESC(); ROT();
    STEP(pA0,pA1,pB0,pB1,t+1,true,true,true);   WAIT_BAR(2); RESC(); ROT();
  }
  #undef CMASK
  #define CMASK(P0,P1,t) do{ if constexpr(SWA){ swa_mask(P0,P1,((t)==NT-1?0:NM+T0s+swa_off(t))+relq,(t)==NT-1?-128:-129,(t)==NT-1?128:129,(t)==NT-1,(t)!=NT-1&&((T0s+swa_off(t))<0||(T0s+swa_off(t))>=S_),bt,mhat); } else { if((t)==NT-1)meta_mask(P0,P1); } }while(0)
  #define ENDW(tt) do{ if((tt)+3<NT){WAIT_BAR(2);} else if((tt)+2<NT){WAIT_BAR(1);} else {WAIT_BAR(0);} }while(0)
  for(;t+2<NT;t+=2){
    STEP(pB0,pB1,pA0,pA1,t,(t+3<NT),(t+1<NT),(t+1<NT));       ENDW(t);   RESC(); ROT();
    STEP(pA0,pA1,pB0,pB1,t+1,(t+4<NT),(t+2<NT),(t+2<NT));     ENDW(t+1); RESC(); ROT();
  }
  STEP(pB0,pB1,pA0,pA1,NT-2,false,true,true); WAIT_BAR(0); RESC(); ROT();
  STEP(pA0,pA1,pB0,pB1,NT-1,false,false,false); RESC();
  { float sacc=pA0[0]+pA0[1]; _Pragma("unroll") for(int r=2;r<16;++r)sacc+=pA0[r]; _Pragma("unroll") for(int r=0;r<16;++r)sacc+=pA1[r]; l_reg+=sacc;
    pw0=(u32x4){PKW(pA0,0),PKW(pA0,2),PKW(pA0,4),PKW(pA0,6)};pw1=(u32x4){PKW(pA0,8),PKW(pA0,10),PKW(pA0,12),PKW(pA0,14)};pw2=(u32x4){PKW(pA1,0),PKW(pA1,2),PKW(pA1,4),PKW(pA1,6)};pw3=(u32x4){PKW(pA1,8),PKW(pA1,10),PKW(pA1,12),PKW(pA1,14)};
    SBAR(); pv(o,vb0+sl_cur,PAF(0),PAF(1),PAF(2),PAF(3)); }
  #undef PKW
  #undef PAF
  #undef VFR
  #undef PIN
  #undef MX3
  #undef GAPA
  #undef GAPB
  #undef EX
  #undef VRD
  #undef KRD
  #undef STEP
  #undef ENDW
  {auto rr=__builtin_amdgcn_permlane32_swap(__float_as_uint(l_reg),__float_as_uint(l_reg),false,false);l_reg=__uint_as_float(rr[0])+__uint_as_float(rr[1]);}
  if constexpr(SWA){ l_reg+=__builtin_amdgcn_exp2f(btab[4*264+2*g+hh]-mhat); }
  int lane_e=threadIdx.x&63; asm volatile("":"+v"(lane_e)); const int r32e=lane_e&31,hie=lane_e>>5;
  if(hie==0)wsf[32+r32e]=l_reg;asm volatile("s_waitcnt lgkmcnt(0)":::"memory");
  float rli[16];
  #pragma unroll
  for(int r=0;r<16;++r)rli[r]=__builtin_amdgcn_rcpf(wsf[32+crow(r,hie)]);
  bf16*Ow=Oc+(long)qrow0*1024+hh*D;
  { bf16*stg=(bf16*)(shm+LDS_OST)+wid*2048;
    #pragma unroll
    for(int r=0;r<16;++r){const int orow=crow(r,hie);
      #pragma unroll
      for(int d0=0;d0<2;++d0)stg[orow*64+d0*32+r32e]=(bf16)(cvtpk_s(o[d0][r]*rli[r],0.f)&0xffffu);}
    asm volatile("s_waitcnt lgkmcnt(0)":::"memory");
    #pragma unroll
    for(int i=0;i<4;++i){const int row=i*8+(lane_e>>3),ch=lane_e&7; const u32x4 v=*(const u32x4*)(stg+row*64+ch*8); if(!meta||(blk==0&&row<NM))ATTN_STORE16(Ow+(long)row*1024+ch*8,v);} }
  asm volatile("s_waitcnt lgkmcnt(0)\n\ts_barrier":::"memory");
  #undef DMA_K
  #undef DMA_V
  #undef TROW
  #undef NEGC
  #undef CMASK
  #undef START
  #undef RESC
  #undef ROT
}
constexpr int ATTN_LDS_BYTES=LDS_BYTES;
#undef SBAR
#undef WAIT_BAR
}

#define GAS __attribute__((address_space(1)))
#define LAS __attribute__((address_space(3)))
typedef unsigned short bf16;
typedef unsigned v4u __attribute__((ext_vector_type(4)));
typedef float f32x4 __attribute__((ext_vector_type(4)));
typedef short bf16x8 __attribute__((ext_vector_type(8)));
typedef GAS unsigned gu32;
typedef GAS unsigned long long gu64;
#define RLX_AGENT __ATOMIC_RELAXED, __HIP_MEMORY_SCOPE_AGENT
#define LDS_WAIT() asm volatile("s_waitcnt lgkmcnt(0)" ::: "memory")
#define VM_WAIT() asm volatile("s_waitcnt vmcnt(0)" ::: "memory")
__device__ __forceinline__ unsigned long long rt() { return __builtin_amdgcn_s_memrealtime(); }
__device__ __forceinline__ unsigned pk2(float lo, float hi) { return (unsigned)f2bf(lo) | ((unsigned)f2bf(hi) << 16); }

#define XB_TMO      128
#define XB_XCNT(j)  (256  + 64 * (j))
#define XB_XSUB(j)  (1280 + 64 * (j))
#define XB_XGEN(j)  (2304 + 64 * (j))
#define XB_TOP      3328
#define XB_TOPGEN   3392
#define XCD_BAR_WORDS 3456
#define XB_SPIN_CAP (1u << 22)

__device__ __forceinline__ unsigned xb_ld(unsigned* p)              { return __hip_atomic_load(p, __ATOMIC_RELAXED, __HIP_MEMORY_SCOPE_AGENT); }
__device__ __forceinline__ unsigned xb_add(unsigned* p, unsigned v) { return __hip_atomic_fetch_add(p, v, __ATOMIC_RELAXED, __HIP_MEMORY_SCOPE_AGENT); }
__device__ __forceinline__ unsigned xb_xcc_id() { return (unsigned)__builtin_amdgcn_s_getreg((3 << 11) | 20) & 0xFu; }
#define XB_SPIN(cond, bar) do { unsigned _sp = 0; while (cond) { __builtin_amdgcn_s_sleep(1); \
    if ((++_sp & 255u) == 0u) { if (xb_ld(&(bar)[XB_TMO])) break; if (_sp > XB_SPIN_CAP) { atomicAdd(&(bar)[XB_TMO], 1u); break; } } } } while (0)

struct XcdBarrier {
    unsigned* bar; unsigned x;
    volatile LAS unsigned* st;
};

__device__ __forceinline__ XcdBarrier xcd_barrier_post(unsigned* bar, volatile LAS unsigned* st) {
    XcdBarrier b; b.bar = bar; b.x = xb_xcc_id(); b.st = st;
    if (threadIdx.x == 0) (void)xb_add(&bar[XB_XCNT(b.x)], 1u);
    return b;
}
__device__ __forceinline__ void xcd_barrier_complete(unsigned* bar, unsigned x, unsigned& nloc, unsigned& nx) {
    const unsigned G = gridDim.x * gridDim.y * gridDim.z;
    unsigned sum, cnt, mine, sp = 0u;
    for (;;) {
        sum = 0u; cnt = 0u; mine = 0u;
#pragma unroll
        for (unsigned j = 0; j < 16; ++j) { const unsigned c = xb_ld(&bar[XB_XCNT(j)]); sum += c; cnt += (c > 0u) ? 1u : 0u; mine = (j == x) ? c : mine; }
        if (sum == G) break;
        __builtin_amdgcn_s_sleep(1);
        if ((++sp & 255u) == 0u) { if (xb_ld(&bar[XB_TMO])) break; if (sp > XB_SPIN_CAP) { atomicAdd(&bar[XB_TMO], 1u); break; } }
    }
    nloc = mine > 0u ? mine : 1u; nx = cnt > 0u ? cnt : 1u;
}

__device__ __forceinline__ void xcd_barrier(const XcdBarrier& b) {
    asm volatile("s_waitcnt vmcnt(0)" ::: "memory");
    __syncthreads();
    if (threadIdx.x == 0) {
        unsigned* bar = b.bar;
        __builtin_amdgcn_s_waitcnt(0);
        unsigned nloc = b.st[0], nx = b.st[1];
        if (nloc == 0u) { xcd_barrier_complete(bar, b.x, nloc, nx); b.st[0] = nloc; b.st[1] = nx; }
        const unsigned old = xb_add(&bar[XB_XSUB(b.x)], 1u);
        const unsigned gen = old / nloc;
        if (old + 1u == (gen + 1u) * nloc) {
            __builtin_amdgcn_fence(__ATOMIC_RELEASE, "agent");
            asm volatile("s_waitcnt vmcnt(0)" ::: "memory");
            const unsigned og = xb_add(&bar[XB_TOP], 1u);
            const unsigned tg = og / nx;
            if (og + 1u == (tg + 1u) * nx) xb_add(&bar[XB_TOPGEN], 1u);
            else XB_SPIN(xb_ld(&bar[XB_TOPGEN]) == tg, bar);
            __builtin_amdgcn_fence(__ATOMIC_ACQUIRE, "agent");
            xb_add(&bar[XB_XGEN(b.x)], 1u);
            asm volatile("s_waitcnt vmcnt(0)" ::: "memory");
        } else {
            XB_SPIN(xb_ld(&bar[XB_XGEN(b.x)]) == gen, bar);
            __builtin_amdgcn_fence(__ATOMIC_ACQUIRE, "agent");
            asm volatile("s_waitcnt vmcnt(0)" ::: "memory");
        }
    }
    __syncthreads();
}

__device__ __forceinline__ void xcd_barrier_lean(const XcdBarrier& b) {
    asm volatile("s_waitcnt vmcnt(0)" ::: "memory");
    __syncthreads();
    if (threadIdx.x == 0) {
        unsigned* bar = b.bar; unsigned bx = b.x; asm volatile("" : "+s"(bar), "+s"(bx));
        __builtin_amdgcn_s_waitcnt(0);
        unsigned nloc = b.st[0], nx = b.st[1];
        const unsigned old = xb_add(&bar[XB_XSUB(bx)], 1u);
        const unsigned gen = old / nloc;
        if (old + 1u == (gen + 1u) * nloc) {
            __builtin_amdgcn_fence(__ATOMIC_RELEASE, "agent");
            asm volatile("s_waitcnt vmcnt(0)" ::: "memory");
            const unsigned og = xb_add(&bar[XB_TOP], 1u);
            const unsigned tg = og / nx;
            if (og + 1u == (tg + 1u) * nx) xb_add(&bar[XB_TOPGEN], 1u);
            else XB_SPIN(xb_ld(&bar[XB_TOPGEN]) == tg, bar);
            __builtin_amdgcn_fence(__ATOMIC_ACQUIRE, "agent");
            xb_add(&bar[XB_XGEN(bx)], 1u);
            asm volatile("s_waitcnt vmcnt(0)" ::: "memory");
        } else {
            XB_SPIN(xb_ld(&bar[XB_XGEN(bx)]) == gen, bar);
            __builtin_amdgcn_fence(__ATOMIC_ACQUIRE, "agent");
            asm volatile("s_waitcnt vmcnt(0)" ::: "memory");
        }
    }
    __syncthreads();
}

namespace mix {
typedef short bf16x8 __attribute__((ext_vector_type(8)));
typedef short s16x4 __attribute__((ext_vector_type(4)));
typedef float f32x4 __attribute__((ext_vector_type(4)));
typedef unsigned u32x4 __attribute__((ext_vector_type(4)));
typedef unsigned u32x2 __attribute__((ext_vector_type(2)));
typedef __attribute__((address_space(3))) const char* lcp;
typedef __attribute__((address_space(3))) char* lp;
#define MFMA16(a, b, c) __builtin_amdgcn_mfma_f32_16x16x32_bf16((a), (b), (c), 0, 0, 0)
__device__ __forceinline__ bf16x8 frag_row(lcp tile, int P, int row0, int k0, int fr, int quad) { return *(const __attribute__((address_space(3))) bf16x8*)(tile + (row0 + fr) * P + (k0 + 8 * quad) * 2); }
__device__ __forceinline__ bf16x8 frag_tr(lcp tile, int P, int k0, int col0, int fr, int quad) {
    typedef short v4i16_t __attribute__((ext_vector_type(4)));
    lcp a = tile + (k0 + 8 * quad + (fr >> 2)) * P + (col0 + 4 * (fr & 3)) * 2;
    const s16x4 lo = __builtin_bit_cast(s16x4, __builtin_amdgcn_ds_read_tr16_b64_v4i16((__attribute__((address_space(3))) v4i16_t*)a));
    const s16x4 hi = __builtin_bit_cast(s16x4, __builtin_amdgcn_ds_read_tr16_b64_v4i16((__attribute__((address_space(3))) v4i16_t*)(a + 4 * P)));
    return (bf16x8){lo[0], lo[1], lo[2], lo[3], hi[0], hi[1], hi[2], hi[3]};
}
__device__ __forceinline__ unsigned pkbf(float lo, float hi) { typedef float f2 __attribute__((ext_vector_type(2))); typedef __bf16 b2 __attribute__((ext_vector_type(2))); f2 v = {lo, hi}; return __builtin_bit_cast(unsigned, __builtin_convertvector(v, b2)); }
__device__ __forceinline__ float softplus_fast(float x) { return x > 20.f ? x : 0.6931471805599453f * __builtin_amdgcn_logf(1.0f + __builtin_amdgcn_exp2f(x * 1.4426950408889634f)); }
__device__ __forceinline__ float logsigmoid_fast(float x) { return x < -20.f ? x : -0.6931471805599453f * __builtin_amdgcn_logf(1.0f + __builtin_amdgcn_exp2f(-x * 1.4426950408889634f)); }
__device__ __forceinline__ float bflo(unsigned u) { return __uint_as_float(u << 16); }
__device__ __forceinline__ float bfhi(unsigned u) { return __uint_as_float(u & 0xffff0000u); }

constexpr int SSD_CT = 0, SSD_BT = 34816, SSD_XD = 69632, SSD_XW = 88064, SSD_SB = 106496, SSD_ACS = 123904, SSD_DTL = 124416, SSD_LDS = 124928;
__device__ __forceinline__ int ssd_tok(int c, int l, int dir) { return dir == 0 ? 128 * c - 112 + l : 128 * (32 - c) + 15 - l; }
__device__ __forceinline__ void ssd_stream(int b, int h, int dir, const bf16* xbca, const float* dtga, float dt_bias, float a_neg, bf16* yout, int ypitch, lp lds) {
    int tid = threadIdx.x; asm volatile("" : "+v"(tid));
    const int lane = tid & 63, fr = lane & 15, quad = lane >> 4; const int w = __builtin_amdgcn_readfirstlane(tid >> 6);
    const int g = h >> 1;
    constexpr int P128 = 272, P64 = 144;
    f32x4 S[4];
#pragma unroll
    for (int pb = 0; pb < 4; ++pb) S[pb] = (f32x4){0.f, 0.f, 0.f, 0.f};
    __attribute__((address_space(3))) float* acs = (__attribute__((address_space(3))) float*)(lds + SSD_ACS);
    __attribute__((address_space(3))) float* dtl = (__attribute__((address_space(3))) float*)(lds + SSD_DTL);
    u32x4 pc[4], pbv[4], px[2]; float pd0 = 0.f, pd1 = 0.f;
#define SSD_PREFETCH(cc) do { \
        _Pragma("unroll") for (int i = 0; i < 4; ++i) { const int id = tid + 512 * i, row = id >> 4, ch = id & 15; const int t = ssd_tok((cc), row, dir); pc[i] = (u32x4){0u, 0u, 0u, 0u}; pbv[i] = (u32x4){0u, 0u, 0u, 0u}; \
            if (t >= 0) { const bf16* src = xbca + (size_t)row_of(b, t) * XW + g * 128 + ch * 8; pbv[i] = *(const u32x4*)(src + 256); pc[i] = *(const u32x4*)(src + 512); } } \
        _Pragma("unroll") for (int i = 0; i < 2; ++i) { const int id = tid + 512 * i, row = id >> 3, ch = id & 7; const int t = ssd_tok((cc), row, dir); px[i] = (u32x4){0u, 0u, 0u, 0u}; \
            if (t >= 0) px[i] = *(const u32x4*)(xbca + (size_t)row_of(b, t) * XW + h * 64 + ch * 8); } \
        if (w == 0) { const int t0 = ssd_tok((cc), 2 * lane, dir), t1 = ssd_tok((cc), 2 * lane + 1, dir); \
            pd0 = t0 >= 0 ? dtga[(size_t)row_of(b, t0 < 0 ? 0 : t0) * DGW + dir * 4 + h] : 0.f; pd1 = t1 >= 0 ? dtga[(size_t)row_of(b, t1 < 0 ? 0 : t1) * DGW + dir * 4 + h] : 0.f; } } while (0)
    SSD_PREFETCH(0);
    for (int c = 0; c < 33; ++c) {
        if (w == 0) {
            const int t0 = ssd_tok(c, 2 * lane, dir), t1 = ssd_tok(c, 2 * lane + 1, dir);
            const float d0 = t0 >= 0 ? softplus_fast(pd0 + dt_bias) : 0.f, d1 = t1 >= 0 ? softplus_fast(pd1 + dt_bias) : 0.f;
            const float v0 = d0 * a_neg, v1 = v0 + d1 * a_neg;
            float inc = v1;
#pragma unroll
            for (int o = 1; o < 64; o <<= 1) { const float u = __shfl_up(inc, o); if (lane >= o) inc += u; }
            const float pre = inc - v1;
            acs[2 * lane] = pre + v0; acs[2 * lane + 1] = pre + v1; dtl[2 * lane] = d0; dtl[2 * lane + 1] = d1;
        }
#pragma unroll
        for (int i = 0; i < 4; ++i) { const int id = tid + 512 * i, row = id >> 4, ch = id & 15;
            *(__attribute__((address_space(3))) u32x4*)(lds + SSD_CT + row * P128 + ch * 16) = pc[i]; *(__attribute__((address_space(3))) u32x4*)(lds + SSD_BT + row * P128 + ch * 16) = pbv[i]; }
#pragma unroll
        for (int pb = 0; pb < 4; ++pb) { u32x2 v; v.x = pkbf(S[pb][0], S[pb][1]); v.y = pkbf(S[pb][2], S[pb][3]);
            *(__attribute__((address_space(3))) u32x2*)(lds + SSD_SB + (16 * pb + fr) * P128 + (16 * w + 4 * quad) * 2) = v; }
        __syncthreads();
        const float alast = acs[127];
#pragma unroll
        for (int i = 0; i < 2; ++i) { const int id = tid + 512 * i, row = id >> 3, ch = id & 7; const u32x4 vx = px[i];
            const float d = dtl[row], dw = d * __expf(alast - acs[row]);
            u32x4 o1, o2;
            o1.x = pkbf(bflo(vx.x) * d, bfhi(vx.x) * d); o1.y = pkbf(bflo(vx.y) * d, bfhi(vx.y) * d); o1.z = pkbf(bflo(vx.z) * d, bfhi(vx.z) * d); o1.w = pkbf(bflo(vx.w) * d, bfhi(vx.w) * d);
            o2.x = pkbf(bflo(vx.x) * dw, bfhi(vx.x) * dw); o2.y = pkbf(bflo(vx.y) * dw, bfhi(vx.y) * dw); o2.z = pkbf(bflo(vx.z) * dw, bfhi(vx.z) * dw); o2.w = pkbf(bflo(vx.w) * dw, bfhi(vx.w) * dw);
            *(__attribute__((address_space(3))) u32x4*)(lds + SSD_XD + row * P64 + ch * 16) = o1; *(__attribute__((address_space(3))) u32x4*)(lds + SSD_XW + row * P64 + ch * 16) = o2; }
        if (c + 1 < 33) SSD_PREFETCH(c + 1);
        __syncthreads();
        f32x4 G[8];
#pragma unroll
        for (int sb = 0; sb < 8; ++sb) { G[sb] = (f32x4){0.f, 0.f, 0.f, 0.f};
            if (sb <= w) {
#pragma unroll
                for (int ks = 0; ks < 4; ++ks) G[sb] = MFMA16(frag_row(lds + SSD_BT, P128, 16 * sb, 32 * ks, fr, quad), frag_row(lds + SSD_CT, P128, 16 * w, 32 * ks, fr, quad), G[sb]); } }
        { const float dec = __expf(alast);
#pragma unroll
            for (int pb = 0; pb < 4; ++pb) S[pb] = S[pb] * dec;
#pragma unroll
            for (int ks = 0; ks < 4; ++ks) { const bf16x8 fb = frag_tr(lds + SSD_BT, P128, 32 * ks, 16 * w, fr, quad);
#pragma unroll
                for (int pb = 0; pb < 4; ++pb) S[pb] = MFMA16(fb, frag_tr(lds + SSD_XW, P64, 32 * ks, 16 * pb, fr, quad), S[pb]); } }
        __syncthreads();
        { const int l = 16 * w + fr; const float al = acs[l]; int dq = fr - 4 * quad; asm volatile("" : "+v"(dq));
#pragma unroll
            for (int sb = 0; sb < 8; ++sb) { u32x2 v = {0u, 0u};
                if (sb <= w) { const int s0 = 16 * sb + 4 * quad; const f32x4 as = *(const __attribute__((address_space(3))) f32x4*)(acs + s0);
                    const bool dg = sb == w;
                    const float e0 = (!dg || 0 <= dq) ? G[sb][0] * __expf(al - as[0]) : 0.f, e1 = (!dg || 1 <= dq) ? G[sb][1] * __expf(al - as[1]) : 0.f;
                    const float e2 = (!dg || 2 <= dq) ? G[sb][2] * __expf(al - as[2]) : 0.f, e3 = (!dg || 3 <= dq) ? G[sb][3] * __expf(al - as[3]) : 0.f;
                    v.x = pkbf(e0, e1); v.y = pkbf(e2, e3); }
                *(__attribute__((address_space(3))) u32x2*)(lds + SSD_BT + l * P128 + (16 * sb + 4 * quad) * 2) = v; } }
        __syncthreads();
        f32x4 Y[4], YO[4];
#pragma unroll
        for (int pb = 0; pb < 4; ++pb) { Y[pb] = (f32x4){0.f, 0.f, 0.f, 0.f}; YO[pb] = (f32x4){0.f, 0.f, 0.f, 0.f}; }
#pragma unroll
        for (int ks = 0; ks < 4; ++ks) {
            if (32 * ks <= 16 * w + 15) { const bf16x8 fs = frag_row(lds + SSD_BT, P128, 16 * w, 32 * ks, fr, quad);
#pragma unroll
                for (int pb = 0; pb < 4; ++pb) Y[pb] = MFMA16(frag_tr(lds + SSD_XD, P64, 32 * ks, 16 * pb, fr, quad), fs, Y[pb]); }
            const bf16x8 fc = frag_row(lds + SSD_CT, P128, 16 * w, 32 * ks, fr, quad);
#pragma unroll
            for (int pb = 0; pb < 4; ++pb) YO[pb] = MFMA16(frag_row(lds + SSD_SB, P128, 16 * pb, 32 * ks, fr, quad), fc, YO[pb]);
        }
        { const int l = 16 * w + fr; const float el = __expf(acs[l]); const int t = ssd_tok(c, l, dir);
            if (t >= 0) { bf16* op = yout + (size_t)row_of(b, t) * ypitch + h * 64 + 4 * quad;
#pragma unroll
                for (int pb = 0; pb < 4; ++pb) { const f32x4 y = Y[pb] + YO[pb] * el; u32x2 v; v.x = pkbf(y[0], y[1]); v.y = pkbf(y[2], y[3]); *(u32x2*)(op + 16 * pb) = v; } } }
        __syncthreads();
    }
}

constexpr int GLA_QT = 0, GLA_KT = 5120, GLA_KD = 10240, GLA_V = 15360, GLA_ATT = 24576, GLA_SB = 33792, GLA_WTOT = 38912, GLA_W2 = 39936, GLA_GB = 41984, GLA_LDS = 42112;
__device__ __forceinline__ int gla_tok(int c, int l, int dir) { return dir == 0 ? 64 * c - 48 + l : 64 * (64 - c) + 15 - l; }
__device__ __forceinline__ void gla_stream(int b, int h, int dir, const bf16* proj, const float* dtga, const float* gate_w2, const float* gate_b, bf16* oout, int opitch, lp lds) {
    int tid = threadIdx.x; asm volatile("" : "+v"(tid));
    const int lane = tid & 63, fr = lane & 15, quad = lane >> 4; const int w = __builtin_amdgcn_readfirstlane(tid >> 6);
    constexpr int P32 = 80, P64 = 144;
    typedef __attribute__((address_space(3))) float lfloat; typedef __attribute__((address_space(3))) f32x4 lf4;
    lfloat* wtot = (lfloat*)(lds + GLA_WTOT); lfloat* w2s = (lfloat*)(lds + GLA_W2); lfloat* gbs = (lfloat*)(lds + GLA_GB);
    for (int i = tid; i < 16 * 32; i += 512) w2s[i] = gate_w2[(dir * 16 + (i >> 5)) * 128 + h * 32 + (i & 31)];
    if (tid < 32) gbs[tid] = gate_b[dir * 128 + h * 32 + tid];
    __syncthreads();
    const int kb = w & 1, vbs = w >> 1;
    f32x4 S = {0.f, 0.f, 0.f, 0.f};
    const int rl = tid >> 3, kq = tid & 7;
    f32x4 pa0, pa1, pa2, pa3; unsigned long long pqq, pkk; u32x4 pvv; bool pok;
#define GLA_PREFETCH(cc) do { const int t_ = gla_tok((cc), rl, dir); pok = t_ >= 0; const size_t row_ = (size_t)row_of(b, pok ? t_ : 0); \
        pa0 = (f32x4){0.f, 0.f, 0.f, 0.f}; pa1 = pa0; pa2 = pa0; pa3 = pa0; pqq = 0ull; pkk = 0ull; pvv = (u32x4){0u, 0u, 0u, 0u}; \
        if (pok) { const float* ap = dtga + row_ * DGW + 8 + dir * 16; pa0 = *(const f32x4*)ap; pa1 = *(const f32x4*)(ap + 4); pa2 = *(const f32x4*)(ap + 8); pa3 = *(const f32x4*)(ap + 12); \
            pqq = *(const unsigned long long*)(proj + row_ * PW + PGQ + h * 32 + 4 * kq); pkk = *(const unsigned long long*)(proj + row_ * PW + PGK + h * 32 + 4 * kq); \
            pvv = *(const u32x4*)(proj + row_ * PW + PGV + h * 64 + 8 * kq); } } while (0)
    GLA_PREFETCH(0);
    for (int c = 0; c < 65; ++c) {
        const bool ok = pok;
        float gv[4] = {0.f, 0.f, 0.f, 0.f}; float qv[4] = {0.f, 0.f, 0.f, 0.f}, kv[4] = {0.f, 0.f, 0.f, 0.f}; const u32x4 vv = pvv;
        if (ok) {
            const f32x4 a0 = pa0, a1 = pa1, a2 = pa2, a3 = pa3;
            f32x4 z = *(const lf4*)(gbs + 4 * kq);
#pragma unroll
            for (int r = 0; r < 16; ++r) { const float ar = r < 4 ? a0[r & 3] : (r < 8 ? a1[r & 3] : (r < 12 ? a2[r & 3] : a3[r & 3])); const f32x4 ww = *(const lf4*)(w2s + r * 32 + 4 * kq); z = z + ww * ar; }
#pragma unroll
            for (int j = 0; j < 4; ++j) gv[j] = logsigmoid_fast(z[j]) * (1.0f / 16.0f);
            const unsigned long long qq = pqq, kk = pkk;
#pragma unroll
            for (int j = 0; j < 4; ++j) { qv[j] = __uint_as_float((unsigned)((qq >> (16 * j)) & 0xffffu) << 16) * 0.17677669529663687f; kv[j] = __uint_as_float((unsigned)((kk >> (16 * j)) & 0xffffu) << 16); }
        }
        if (c + 1 < 65) GLA_PREFETCH(c + 1);
        float bc[4];
#pragma unroll
        for (int j = 0; j < 4; ++j) { float x = gv[j];
#pragma unroll
            for (int o = 8; o < 64; o <<= 1) { const float u = __shfl_up(x, o); if (lane >= o) x += u; }
            bc[j] = x; }
        if (lane >= 56) { *(lf4*)(wtot + w * 32 + 4 * kq) = (f32x4){bc[0], bc[1], bc[2], bc[3]}; }
        *(__attribute__((address_space(3))) u32x4*)(lds + GLA_V + rl * P64 + kq * 16) = vv;
        { u32x2 sv; sv.x = pkbf(S[0], S[1]); sv.y = pkbf(S[2], S[3]); *(__attribute__((address_space(3))) u32x2*)(lds + GLA_SB + (16 * vbs + fr) * P32 + (16 * kb + 4 * quad) * 2) = sv; }
        __syncthreads();
        f32x4 pre = {0.f, 0.f, 0.f, 0.f}, blast = {0.f, 0.f, 0.f, 0.f};
#pragma unroll
        for (int ww = 0; ww < 8; ++ww) { const f32x4 tt = *(const lf4*)(wtot + ww * 32 + 4 * kq); blast = blast + tt; if (ww < w) pre = pre + tt; }
        { u32x2 oq, ok2, od; float e[4], en[4], ed[4];
#pragma unroll
            for (int j = 0; j < 4; ++j) { const float bb = bc[j] + pre[j]; e[j] = qv[j] * __expf(bb); en[j] = kv[j] * __expf(-bb); ed[j] = kv[j] * __expf(blast[j] - bb); }
            oq.x = pkbf(e[0], e[1]); oq.y = pkbf(e[2], e[3]); ok2.x = pkbf(en[0], en[1]); ok2.y = pkbf(en[2], en[3]); od.x = pkbf(ed[0], ed[1]); od.y = pkbf(ed[2], ed[3]);
            *(__attribute__((address_space(3))) u32x2*)(lds + GLA_QT + rl * P32 + kq * 8) = oq; *(__attribute__((address_space(3))) u32x2*)(lds + GLA_KT + rl * P32 + kq * 8) = ok2; *(__attribute__((address_space(3))) u32x2*)(lds + GLA_KD + rl * P32 + kq * 8) = od; }
        __syncthreads();
        { const int lb = w & 3;
#pragma unroll
            for (int i = 0; i < 2; ++i) { const int sb = 2 * (w >> 2) + i; f32x4 A = {0.f, 0.f, 0.f, 0.f};
                if (sb <= lb) A = MFMA16(frag_row(lds + GLA_KT, P32, 16 * sb, 0, fr, quad), frag_row(lds + GLA_QT, P32, 16 * lb, 0, fr, quad), A);
                const int l = 16 * lb + fr, s0 = 16 * sb + 4 * quad; u32x2 v;
                v.x = pkbf(s0 + 0 <= l ? A[0] : 0.f, s0 + 1 <= l ? A[1] : 0.f); v.y = pkbf(s0 + 2 <= l ? A[2] : 0.f, s0 + 3 <= l ? A[3] : 0.f);
                *(__attribute__((address_space(3))) u32x2*)(lds + GLA_ATT + l * P64 + s0 * 2) = v; } }
        { const f32x4 bl = *(const lf4*)(wtot + 0 * 32 + 16 * kb + 4 * quad) + *(const lf4*)(wtot + 1 * 32 + 16 * kb + 4 * quad)
                         + *(const lf4*)(wtot + 2 * 32 + 16 * kb + 4 * quad) + *(const lf4*)(wtot + 3 * 32 + 16 * kb + 4 * quad)
                         + *(const lf4*)(wtot + 4 * 32 + 16 * kb + 4 * quad) + *(const lf4*)(wtot + 5 * 32 + 16 * kb + 4 * quad)
                         + *(const lf4*)(wtot + 6 * 32 + 16 * kb + 4 * quad) + *(const lf4*)(wtot + 7 * 32 + 16 * kb + 4 * quad);
            S[0] *= __expf(bl[0]); S[1] *= __expf(bl[1]); S[2] *= __expf(bl[2]); S[3] *= __expf(bl[3]);
#pragma unroll
            for (int ks = 0; ks < 2; ++ks) S = MFMA16(frag_tr(lds + GLA_KD, P32, 32 * ks, 16 * kb, fr, quad), frag_tr(lds + GLA_V, P64, 32 * ks, 16 * vbs, fr, quad), S); }
        __syncthreads();
        { const int lb = w & 3; const int l = 16 * lb + fr; const int to = gla_tok(c, l, dir);
            const bf16x8 fq = frag_row(lds + GLA_QT, P32, 16 * lb, 0, fr, quad);
#pragma unroll
            for (int i = 0; i < 2; ++i) { const int vb = 2 * (w >> 2) + i; f32x4 O = {0.f, 0.f, 0.f, 0.f};
#pragma unroll
                for (int ks = 0; ks < 2; ++ks) if (32 * ks <= 16 * lb + 15) O = MFMA16(frag_tr(lds + GLA_V, P64, 32 * ks, 16 * vb, fr, quad), frag_row(lds + GLA_ATT, P64, 16 * lb, 32 * ks, fr, quad), O);
                O = MFMA16(frag_row(lds + GLA_SB, P32, 16 * vb, 0, fr, quad), fq, O);
                if (to >= 0) { u32x2 v; v.x = pkbf(O[0], O[1]); v.y = pkbf(O[2], O[3]); *(u32x2*)(oout + (size_t)row_of(b, to) * opitch + h * 64 + 16 * vb + 4 * quad) = v; } } }
        __syncthreads();
    }
}
#undef SSD_PREFETCH
#undef GLA_PREFETCH
}

constexpr int NWAVES = 8;
constexpr size_t MiB = 1u << 20;
constexpr size_t WS_CTL = 0, CTL_ZERO_BYTES = 1 * MiB;
constexpr size_t WS_DTGA = 1 * MiB;
constexpr size_t WS_ROUTE = 10 * MiB;
constexpr size_t WS_HMETA = 12 * MiB;
constexpr size_t WS_WIN = 13 * MiB;
constexpr size_t WS_WOUT = WS_WIN + 2ull * 3072 * 1024 * 2;
constexpr size_t WS_WGU = WS_WOUT + 2ull * 1024 * 1024 * 2;
constexpr size_t WS_WD = WS_WGU + 5632ull * 1024 * 2;
constexpr size_t WS_WMOE_GU = 46 * MiB;
constexpr size_t WS_WMOE_D = WS_WMOE_GU + 8ull * 7168 * 1024 * 2;
constexpr size_t WS_BIG = 214 * MiB;
constexpr size_t WS_TMP = 392 * MiB;
constexpr size_t WS_ACT = 457 * MiB;
constexpr size_t WS_END = 522 * MiB;
static_assert(WS_WD + 1024ull * 2816 * 2 <= WS_WMOE_GU && WS_WMOE_D + 8ull * 1024 * 3584 * 2 <= WS_BIG && WS_BIG + (size_t)MP * PW * 2 <= WS_TMP && WS_TMP + (size_t)MP * 1024 * 2 <= WS_ACT && WS_ACT + (size_t)MP * 1024 * 2 <= WS_END, "ws map");
static_assert(WS_DTGA + (size_t)MP * DGW * 4 <= WS_ROUTE, "ws map 2");
constexpr int CAP_TILES = 69;
constexpr size_t MOE_ACT_BYTES = (size_t)CAP_TILES * 256 * 3584 * 2;
static_assert(WS_BIG + 2 * MOE_ACT_BYTES <= WS_ACT, "moe pass buffers");
constexpr int MAX_SROWS = 2 * (NREG + 8 * 256);
constexpr size_t RT_E = 0;
constexpr size_t RT_G = RT_E + (size_t)NREG * 4;
constexpr size_t RT_STOK = RT_G + (size_t)NREG * 8;
constexpr size_t RT_SGATE = RT_STOK + (size_t)MAX_SROWS * 4;
constexpr size_t RT_TEXP = RT_SGATE + (size_t)MAX_SROWS * 4;
constexpr size_t RT_PASS = RT_TEXP + 4096;
constexpr size_t RT_SSA = RT_PASS + 64;
constexpr size_t RT_RANK = RT_SSA + (size_t)MAX_SROWS * 4;
constexpr size_t RT_BLKCNT = RT_RANK + (size_t)NREG * 4;
constexpr size_t RT_STOKP = RT_BLKCNT + 1024 * 64;
static_assert(RT_STOKP + (size_t)MAX_SROWS * 4 <= 2 * MiB, "route tables");
__device__ __forceinline__ int permp(int p) { return (p & ~255) | ((p & 63) << 2) | ((p >> 6) & 3); }
constexpr int CW_BAR = 4096, CW_Q = 8192;
constexpr int LDS_BYTES = 155648, LDSCTL_OFF = 143360, MISC_OFF = LDSCTL_OFF + 320;

__device__ __forceinline__ float wave_sum(float v) {
#pragma unroll
    for (int o = 1; o < 64; o <<= 1) v += __shfl_xor(v, o);
    return v;
}
__device__ __forceinline__ float wave_sum_sw(float v) {
    v += __int_as_float(__builtin_amdgcn_ds_swizzle(__float_as_int(v), (1 << 10) | 0x1f)); v += __int_as_float(__builtin_amdgcn_ds_swizzle(__float_as_int(v), (2 << 10) | 0x1f));
    v += __int_as_float(__builtin_amdgcn_ds_swizzle(__float_as_int(v), (4 << 10) | 0x1f)); v += __int_as_float(__builtin_amdgcn_ds_swizzle(__float_as_int(v), (8 << 10) | 0x1f));
    v += __int_as_float(__builtin_amdgcn_ds_swizzle(__float_as_int(v), (16 << 10) | 0x1f));
    return __int_as_float(__builtin_amdgcn_readlane(__float_as_int(v), 0)) + __int_as_float(__builtin_amdgcn_readlane(__float_as_int(v), 32));
}
__device__ __forceinline__ int wmap(int kind, int n) {
    if (kind == 0) return n;
    if (kind == 1) { if (n < 1024) return n; if (n < 1032) return 2816 + (n - 1024); if (n < 1800) return n - 8; if (n < 1832) return 2824 + (n - 1800); return n - 40; }
    return (n >> 7) * 256 + (n & 127) + (kind == 3 ? 128 : 0);
}
__device__ __forceinline__ float wscale(int kind, int n) { return (kind == 1 && n >= 1832 && n < 2088) ? 0.125f * 1.4426950408889634f : 1.0f; }
__device__ __forceinline__ void transpose_mat(const float* W, int K, int N, bf16* WT, int kind, LAS float* scr, int gw, int NGW, int lane, bool tiled = false, bool dtonly = false) {
    const int nblk = (N + 31) / 32, nitems = (K / 64) * nblk;
    for (int item = gw; item < nitems; item += NGW) {
        const int kb = item / nblk, nb = item % nblk, k0 = 64 * kb, n0 = 32 * nb;
        if (dtonly && !(nb == 32 || nb == 56 || nb == 57)) continue;
        const int nn = n0 + (lane & 31); const float wsc = wscale(kind, nn);
        float wv[32];
#pragma unroll
        for (int i = 0; i < 32; ++i) { const int kk = 2 * i + (lane >> 5); wv[i] = nn < N ? __builtin_nontemporal_load(W + (size_t)(k0 + kk) * N + nn) : 0.f; }
#pragma unroll
        for (int i = 0; i < 32; ++i) { const int kk = 2 * i + (lane >> 5); scr[kk * 33 + (lane & 31)] = wv[i] * wsc; }
        LDS_WAIT(); asm volatile("" ::: "memory");
        const int c = lane & 7;
#pragma unroll
        for (int j = 0; j < 4; ++j) { const int n = (lane >> 3) + 8 * j; const LAS float* s = scr + (8 * c) * 33 + n;
            v4u o; o.x = pk2(s[0 * 33], s[1 * 33]); o.y = pk2(s[2 * 33], s[3 * 33]); o.z = pk2(s[4 * 33], s[5 * 33]); o.w = pk2(s[6 * 33], s[7 * 33]);
            if (n0 + n < N) { const int rn = wmap(kind, n0 + n);
                if (tiled) *(GAS v4u*)(WT + ((size_t)(rn >> 8) * (K >> 6) + (k0 >> 6)) * 16384 + (size_t)(rn & 255) * 64 + 8 * c) = o; else *(GAS v4u*)(WT + (size_t)rn * K + k0 + 8 * c) = o; } }
        LDS_WAIT(); asm volatile("" ::: "memory");
    }
}
__device__ __forceinline__ void colmax_mat(const float* W, int K, int N, unsigned* cmax, int kind, int gw, int NGW, int lane) {
    const int nblk = (N + 63) / 64, nitems = (K / 64) * nblk;
    for (int item = gw; item < nitems; item += NGW) { const int kb = item / nblk, nb = item % nblk, n = 64 * nb + lane;
        float m = 0.f;
        if (n < N) {
#pragma unroll 16
            for (int kk = 0; kk < 64; ++kk) m = fmaxf(m, fabsf(__builtin_nontemporal_load(W + (size_t)(64 * kb + kk) * N + n))); }
        if (n < N) atomicMax(cmax + wmap(kind, n), __float_as_uint(m * wscale(kind, n))); }
}
__device__ __forceinline__ void quant_mat(const float* W, int K, int N, signed char* W8, float* sB, const unsigned* cmax, int kind, LAS float* scr, int gw, int NGW, int lane, int maxrow = 1 << 30) {
    const int nblk = (N + 31) / 32, nitems = (K / 64) * nblk;
    for (int item = gw; item < nitems; item += NGW) {
        const int kb = item / nblk, nb = item % nblk, k0 = 64 * kb, n0 = 32 * nb; const int nn = n0 + (lane & 31);
        const float cm = nn < N ? __uint_as_float(cmax[wmap(kind, nn)]) : 1.f, qs = (cm > 0.f ? 127.0f / cm : 0.f) * wscale(kind, nn);
        if (kb == 0 && lane < 32 && nn < N && wmap(kind, nn) < maxrow) sB[wmap(kind, nn)] = cm * (1.0f / 127.0f);
        float wv[32];
#pragma unroll
        for (int i = 0; i < 32; ++i) { const int kk = 2 * i + (lane >> 5); wv[i] = nn < N ? __builtin_nontemporal_load(W + (size_t)(k0 + kk) * N + nn) : 0.f; }
#pragma unroll
        for (int i = 0; i < 32; ++i) { const int kk = 2 * i + (lane >> 5); scr[kk * 33 + (lane & 31)] = rintf(wv[i] * qs); }
        LDS_WAIT(); asm volatile("" ::: "memory");
        const int c = lane & 7;
#pragma unroll
        for (int j = 0; j < 4; ++j) { const int n = (lane >> 3) + 8 * j; const LAS float* s = scr + (8 * c) * 33 + n;
            unsigned lo = 0u, hi = 0u;
#pragma unroll
            for (int q = 0; q < 4; ++q) { lo |= ((unsigned)((int)s[q * 33]) & 0xffu) << (8 * q); hi |= ((unsigned)((int)s[(4 + q) * 33]) & 0xffu) << (8 * q); }
            if (n0 + n < N && wmap(kind, n0 + n) < maxrow) *(GAS unsigned long long*)(W8 + (size_t)wmap(kind, n0 + n) * K + k0 + 8 * c) = (unsigned long long)lo | ((unsigned long long)hi << 32); }
        LDS_WAIT(); asm volatile("" ::: "memory");
    }
}
__device__ __forceinline__ void absmax_all(const float* W, long n4, unsigned* amax, long gtid, long nthreads, int lane) {
    float m = 0.f;
    for (long i = gtid; i < n4; i += nthreads) { const f32x4 v = __builtin_nontemporal_load((const GAS f32x4*)W + i); m = fmaxf(fmaxf(m, fmaxf(fabsf(v.x), fabsf(v.y))), fmaxf(fabsf(v.z), fabsf(v.w))); }
    m = fmaxf(m, __int_as_float(__builtin_amdgcn_ds_swizzle(__float_as_int(m), (1 << 10) | 0x1f))); m = fmaxf(m, __int_as_float(__builtin_amdgcn_ds_swizzle(__float_as_int(m), (2 << 10) | 0x1f)));
    m = fmaxf(m, __int_as_float(__builtin_amdgcn_ds_swizzle(__float_as_int(m), (4 << 10) | 0x1f))); m = fmaxf(m, __int_as_float(__builtin_amdgcn_ds_swizzle(__float_as_int(m), (8 << 10) | 0x1f)));
    m = fmaxf(m, __int_as_float(__builtin_amdgcn_ds_swizzle(__float_as_int(m), (16 << 10) | 0x1f)));
    if ((lane & 31) == 0) atomicMax(amax, __float_as_uint(m));
}
__device__ __forceinline__ float f8_scale(unsigned amax_bits, bool inverse) { const int e = (int)(amax_bits >> 23) - 127; if (amax_bits == 0u) return 1.0f; return __uint_as_float((unsigned)(127 + (inverse ? e - 7 : 7 - e)) << 23); }
__device__ __forceinline__ void quant_f8_mat(const float* W, int K, int N, unsigned char* W8, float S, LAS float* scr, int gw, int NGW, int lane) {
    const int nblk = (N + 31) / 32, nitems = (K / 64) * nblk;
    for (int item = gw; item < nitems; item += NGW) {
        const int kb = item / nblk, nb = item % nblk, k0 = 64 * kb, n0 = 32 * nb; const int nn = n0 + (lane & 31);
        float wv[32];
#pragma unroll
        for (int i = 0; i < 32; ++i) { const int kk = 2 * i + (lane >> 5); wv[i] = nn < N ? __builtin_nontemporal_load(W + (size_t)(k0 + kk) * N + nn) : 0.f; }
#pragma unroll
        for (int i = 0; i < 32; ++i) { const int kk = 2 * i + (lane >> 5); scr[kk * 33 + (lane & 31)] = wv[i] * S; }
        LDS_WAIT(); asm volatile("" ::: "memory");
        const int c = lane & 7;
#pragma unroll
        for (int j = 0; j < 4; ++j) { const int n = (lane >> 3) + 8 * j; const LAS float* s = scr + (8 * c) * 33 + n;
            unsigned lo = 0u, hi = 0u; lo = __builtin_amdgcn_cvt_pk_fp8_f32(s[0 * 33], s[1 * 33], lo, false); lo = __builtin_amdgcn_cvt_pk_fp8_f32(s[2 * 33], s[3 * 33], lo, true);
            hi = __builtin_amdgcn_cvt_pk_fp8_f32(s[4 * 33], s[5 * 33], hi, false); hi = __builtin_amdgcn_cvt_pk_fp8_f32(s[6 * 33], s[7 * 33], hi, true);
            const int rn = n0 + n;
            if (rn < N) *(GAS unsigned long long*)(W8 + ((size_t)(rn >> 8) * (K >> 7) + (k0 >> 7)) * 32768 + (size_t)(rn & 255) * 128 + (k0 & 127) + 8 * c) = (unsigned long long)lo | ((unsigned long long)hi << 32); }
        LDS_WAIT(); asm volatile("" ::: "memory");
    }
}
__device__ __forceinline__ void rms_row_to_bf16(const float* xrow, const float* w, bf16* orow, int lane) {
    const GAS f32x4* xr = (const GAS f32x4*)xrow + lane; const GAS f32x4* wr = (const GAS f32x4*)w + lane;
    f32x4 v[4]; float s = 0.f;
#pragma unroll
    for (int j = 0; j < 4; ++j) { v[j] = xr[64 * j]; s += (v[j].x * v[j].x + v[j].y * v[j].y) + (v[j].z * v[j].z + v[j].w * v[j].w); }
    const float rstd = 1.f / sqrtf(wave_sum(s) * (1.f / 1024.f) + 1e-6f);
    GAS unsigned long long* o8 = (GAS unsigned long long*)orow + lane;
#pragma unroll
    for (int j = 0; j < 4; ++j) { const f32x4 ww = wr[64 * j]; o8[64 * j] = (unsigned long long)pk2(v[j].x * rstd * ww.x, v[j].y * rstd * ww.y) | ((unsigned long long)pk2(v[j].z * rstd * ww.z, v[j].w * rstd * ww.w) << 32); }
}

#ifndef N_LAUNCH_MODE
#define N_LAUNCH_MODE 1
#endif

template <int NB> __device__ __forceinline__ void skinny_task(const bf16* A, int K, int rb, const bf16* Bt, int b0, int bstep, f32x4 (&acc)[NB], int lane) {
    const int fr = lane & 15, quad = lane >> 4;
    const bf16* ap = A + (size_t)(16 * rb + fr) * K + 8 * quad; const bf16* bp = Bt + (size_t)(b0 + fr) * K + 8 * quad;
#pragma unroll
    for (int nb = 0; nb < NB; ++nb) acc[nb] = (f32x4){0.f, 0.f, 0.f, 0.f};
#pragma unroll 8
    for (int ks = 0; ks < K / 32; ++ks) { const bf16x8 av = *(const GAS bf16x8*)(ap + 32 * ks);
#pragma unroll
        for (int nb = 0; nb < NB; ++nb) acc[nb] = __builtin_amdgcn_mfma_f32_16x16x32_bf16(av, *(const GAS bf16x8*)(bp + (size_t)nb * bstep * K + 32 * ks), acc[nb], 0, 0, 0); }
}
__device__ __forceinline__ f32x4 bf4_f32(unsigned long long q) { f32x4 v; v.x = __uint_as_float((unsigned)q << 16); v.y = __uint_as_float((unsigned)q & 0xffff0000u); v.z = __uint_as_float((unsigned)(q >> 32) << 16); v.w = __uint_as_float((unsigned)(q >> 32) & 0xffff0000u); return v; }
constexpr int HP = 2048;
template <bool IN16 = false>
__device__ __forceinline__ void rms_row2_to_bf16(const void* xa, const void* xb, const f32x4 (&wreg)[4], bf16* oa, bf16* ob, int lane, signed char* qa8 = nullptr, signed char* qb8 = nullptr, float* sa8 = nullptr, float* sb8 = nullptr) {
    f32x4 va[4], vb[4]; float sa = 0.f, sb = 0.f;
    if constexpr (IN16) { const GAS unsigned long long* pa = (const GAS unsigned long long*)xa + lane; const GAS unsigned long long* pb = (const GAS unsigned long long*)xb + lane; unsigned long long ta[4], tb[4];
#pragma unroll
        for (int j = 0; j < 4; ++j) { ta[j] = pa[64 * j]; tb[j] = pb[64 * j]; }
#pragma unroll
        for (int j = 0; j < 4; ++j) { va[j] = bf4_f32(ta[j]); vb[j] = bf4_f32(tb[j]); } }
    else { const GAS f32x4* pa = (const GAS f32x4*)xa + lane; const GAS f32x4* pb = (const GAS f32x4*)xb + lane;
#pragma unroll
        for (int j = 0; j < 4; ++j) { va[j] = pa[64 * j]; vb[j] = pb[64 * j]; } }
#pragma unroll
    for (int j = 0; j < 4; ++j) { sa += (va[j].x * va[j].x + va[j].y * va[j].y) + (va[j].z * va[j].z + va[j].w * va[j].w); sb += (vb[j].x * vb[j].x + vb[j].y * vb[j].y) + (vb[j].z * vb[j].z + vb[j].w * vb[j].w); }
    const float ra = 1.f / sqrtf(wave_sum(sa) * (1.f / 1024.f) + 1e-6f), rb = 1.f / sqrtf(wave_sum(sb) * (1.f / 1024.f) + 1e-6f);
    GAS unsigned long long* qa = (GAS unsigned long long*)oa + lane; GAS unsigned long long* qb = (GAS unsigned long long*)ob + lane;
#pragma unroll
    for (int j = 0; j < 4; ++j) { const f32x4 ww = wreg[j];
        qa[64 * j] = (unsigned long long)pk2(va[j].x * ra * ww.x, va[j].y * ra * ww.y) | ((unsigned long long)pk2(va[j].z * ra * ww.z, va[j].w * ra * ww.w) << 32);
        qb[64 * j] = (unsigned long long)pk2(vb[j].x * rb * ww.x, vb[j].y * rb * ww.y) | ((unsigned long long)pk2(vb[j].z * rb * ww.z, vb[j].w * rb * ww.w) << 32); }
    if (qa8) {
        float ma = 0.f, mb = 0.f;
#pragma unroll
        for (int j = 0; j < 4; ++j) { const f32x4 ww = wreg[j]; va[j] = va[j] * ra * ww; vb[j] = vb[j] * rb * ww;
            ma = fmaxf(fmaxf(ma, fmaxf(fabsf(va[j].x), fabsf(va[j].y))), fmaxf(fabsf(va[j].z), fabsf(va[j].w))); mb = fmaxf(fmaxf(mb, fmaxf(fabsf(vb[j].x), fabsf(vb[j].y))), fmaxf(fabsf(vb[j].z), fabsf(vb[j].w))); }
#pragma unroll
        for (int o = 1; o < 64; o <<= 1) { ma = fmaxf(ma, __shfl_xor(ma, o)); mb = fmaxf(mb, __shfl_xor(mb, o)); }
        const float qsa = ma > 0.f ? 127.0f / ma : 0.f, qsb = mb > 0.f ? 127.0f / mb : 0.f; if (lane == 0) { *sa8 = ma * (1.0f / 127.0f); *sb8 = mb * (1.0f / 127.0f); }
#pragma unroll
        for (int j = 0; j < 4; ++j) {
            *((GAS unsigned*)qa8 + lane + 64 * j) = ((unsigned)((int)rintf(va[j].x * qsa)) & 0xffu) | (((unsigned)((int)rintf(va[j].y * qsa)) & 0xffu) << 8) | (((unsigned)((int)rintf(va[j].z * qsa)) & 0xffu) << 16) | (((unsigned)((int)rintf(va[j].w * qsa)) & 0xffu) << 24);
            *((GAS unsigned*)qb8 + lane + 64 * j) = ((unsigned)((int)rintf(vb[j].x * qsb)) & 0xffu) | (((unsigned)((int)rintf(vb[j].y * qsb)) & 0xffu) << 8) | (((unsigned)((int)rintf(vb[j].z * qsb)) & 0xffu) << 16) | (((unsigned)((int)rintf(vb[j].w * qsb)) & 0xffu) << 24); } }
}
struct Args { const float* in[27]; float* out; unsigned char* ws; int ph_lo, ph_hi; };
enum { IN_X = 0, IN_META, IN_RELB, IN_NMIX, IN_NFFN, IN_WIN, IN_CONVW, IN_CONVB, IN_DTB, IN_ALOG, IN_SSDD, IN_SSDN, IN_GW2, IN_GB, IN_GLAN, IN_SINK, IN_QN, IN_KN, IN_WOUT,
       IN_FG, IN_FU, IN_FD, IN_ROUTER, IN_MG, IN_MU, IN_MD, IN_FINAL };
enum { PH_PRO = 0, PH_L0 = 1, PH_L1 = 17, PH_SORT = PH_L1 + 10, PH_PASS0 = PH_SORT + 1, PH_FINAL = PH_PASS0 + 5, PH_END = PH_FINAL + 1 };

__global__ void __launch_bounds__(NWAVES * 64, 2) fwd_kernel(Args args) {
    extern __shared__ __attribute__((aligned(16))) unsigned char lds_raw[];
    LAS unsigned char* lds = (LAS unsigned char*)lds_raw;
    volatile LAS unsigned* MISC = (volatile LAS unsigned*)(lds + MISC_OFF);
    const int G = gridDim.x, bid = blockIdx.x, NGW = G * NWAVES; const long nthreads = (long)G * NWAVES * 64;
#define KAS __attribute__((address_space(4)))
#define INP(k) (*(const float* const KAS*)(ka_ + 8 * (k)))
#define IDS() const KAS char* ka_ = (const KAS char*)__builtin_amdgcn_kernarg_segment_ptr(); asm volatile("" : "+s"(ka_)); unsigned char* const ws = *(unsigned char* const KAS*)(ka_ + 224); float* const hreg = *(float* const KAS*)(ka_ + 216); (void)ws; (void)hreg; \
    int tid = threadIdx.x; asm volatile("" : "+v"(tid)); const int lane = tid & 63, wave = __builtin_amdgcn_readfirstlane(tid >> 6), gw = bid * NWAVES + wave; const long gtid = (long)bid * (NWAVES * 64) + tid; (void)lane; (void)gw; (void)gtid
    gu32* ctl = (gu32*)(args.ws + WS_CTL);
    { IDS(); for (int u = tid; u < (LDS_BYTES - LDSCTL_OFF) / 4; u += NWAVES * 64) ((LAS unsigned*)(lds + LDSCTL_OFF))[u] = 0u; }
    __syncthreads();
    XcdBarrier bar = xcd_barrier_post((unsigned*)(ctl + CW_BAR), MISC + 8);
#if N_LAUNCH_MODE == 1
#define IN(k) true
#define SEAM(k) xcd_barrier_lean(bar)
#define OPAQUE_RANGE() do { } while (0)
#else
    int lo = args.ph_lo, hi = args.ph_hi;
#define IN(k) (lo <= (k) && (k) < hi)
#define SEAM(k) do { if (IN(k) && IN((k) + 1)) xcd_barrier(bar); } while (0)
#define OPAQUE_RANGE() asm volatile("" : "+s"(lo), "+s"(hi))
#endif

#define dtga ((float*)(ws + WS_DTGA))
#define CMAX_GU ((unsigned*)(ws + 131072))
#define WGU8 ((signed char*)(ws + WS_DTGA))
#define SB_GU ((float*)(ws + WS_DTGA + 6 * MiB))
#define SA_U ((float*)(ws + WS_DTGA + 6 * MiB + 32768))
#define U8 ((signed char*)(ws + (l == 0 ? WS_TMP : WS_ACT)))
#define CMAX_IN ((unsigned*)(ws + 393216))
#define WIN8 ((signed char*)(ws + WS_WMOE_GU + 72 * MiB))
#define SB_IN ((float*)(ws + WS_WMOE_GU + 80 * MiB))
#define SA_IN ((float*)(ws + WS_HMETA + 524288))
#define U8IN ((signed char*)(ws + WS_TMP))
#define CMAX_MGU ((unsigned*)(ws + 163840))
#define WMGU8 ((signed char*)(ws + WS_WMOE_GU))
#define SB_MGU ((float*)(ws + WS_WMOE_GU + 64 * MiB))
#define YLO ((bf16*)(ws + WS_WIN))
#define YHI ((bf16*)(ws + WS_ACT + 33 * MiB))
#define Y1LO ((bf16*)(ws + WS_BIG + MOE_ACT_BYTES / 2))
#define Y1HI ((bf16*)(ws + WS_BIG + MOE_ACT_BYTES + MOE_ACT_BYTES / 2))
#define WMD8 ((unsigned char*)(ws + WS_WMOE_D))
#define AMAX_MD ((unsigned*)(ws + 131072 - 64))
#define hmeta ((float*)(ws + WS_HMETA))
#define Win ((bf16*)(ws + WS_WIN))
#define Wout ((bf16*)(ws + WS_WOUT))
#define Wgu ((bf16*)(ws + WS_WGU))
#define Wd ((bf16*)(ws + WS_WD))
#define Wmgu ((bf16*)(ws + WS_WMOE_GU))
#define Wmd ((bf16*)(ws + WS_WMOE_D))
#define big ((bf16*)(ws + WS_BIG))
#define act1k ((bf16*)(ws + WS_ACT))
#define tmp ((bf16*)(ws + WS_TMP))
#define rt_e ((int*)(ws + WS_ROUTE + RT_E))
#define rt_g ((float*)(ws + WS_ROUTE + RT_G))
#define stok ((int*)(ws + WS_ROUTE + RT_STOK))
#define stokp ((int*)(ws + WS_ROUTE + RT_STOKP))
#define sgate ((float*)(ws + WS_ROUTE + RT_SGATE))
#define texp ((int*)(ws + WS_ROUTE + RT_TEXP))
#define passt ((int*)(ws + WS_ROUTE + RT_PASS))
#define rt_rank ((int*)(ws + WS_ROUTE + RT_RANK))
#define ssa ((float*)(ws + WS_ROUTE + RT_SSA))
#define blkcnt ((int*)(ws + WS_ROUTE + RT_BLKCNT))

#ifndef PROBE_THIN_REP
#define PROBE_THIN_REP 1
#endif
#ifndef PROBE_PRO_REP
#define PROBE_PRO_REP 1
#endif
    for (int rep_ = 0; rep_ < PROBE_PRO_REP; ++rep_)
    if (IN(PH_PRO)) { IDS();
        LAS float* scr = (LAS float*)(lds + wave * 16384);
        for (int l = 0; l < 2; ++l) {
            transpose_mat(INP(IN_WIN) + (size_t)l * 1024 * 2856, 1024, 2856, Win + (size_t)l * 3072 * 1024, 1, scr, gw, NGW, lane, false, true);
            transpose_mat(INP(IN_WOUT) + (size_t)l * 1024 * 1024, 1024, 1024, Wout + (size_t)l * 1024 * 1024, 0, scr, gw, NGW, lane);
            colmax_mat(INP(IN_WIN) + (size_t)l * 1024 * 2856, 1024, 2856, CMAX_IN + l * 3072, 1, gw, NGW, lane);
        }
        transpose_mat(INP(IN_FG), 1024, 2816, Wgu, 2, scr, gw, NGW, lane);
        transpose_mat(INP(IN_FU), 1024, 2816, Wgu, 3, scr, gw, NGW, lane);
        transpose_mat(INP(IN_FD), 2816, 1024, Wd, 0, scr, gw, NGW, lane);
        colmax_mat(INP(IN_FG), 1024, 2816, CMAX_GU, 2, gw, NGW, lane); colmax_mat(INP(IN_FU), 1024, 2816, CMAX_GU, 3, gw, NGW, lane);
        for (int e = 0; e < 8; ++e) {
            colmax_mat(INP(IN_MG) + (size_t)e * 1024 * 3584, 1024, 3584, CMAX_MGU + e * 7168, 2, gw, NGW, lane); colmax_mat(INP(IN_MU) + (size_t)e * 1024 * 3584, 1024, 3584, CMAX_MGU + e * 7168, 3, gw, NGW, lane);
        }
        absmax_all(INP(IN_MD), 8l * 3584 * 1024 / 4, AMAX_MD, gtid, nthreads, lane);
        for (int l = 0; l < 2; ++l) for (long i = gtid; i < (long)(3072 - 2856) * 1024 / 8; i += nthreads) ((GAS v4u*)(Win + ((size_t)l * 3072 + 2856) * 1024))[i] = (v4u){0u, 0u, 0u, 0u};
        __syncthreads();
    }
    if (IN(PH_PRO) && IN(PH_PRO + 1)) xcd_barrier(bar);

    { constexpr int l = 0;
    {
        OPAQUE_RANGE();
        const int pb = PH_L0 + 16 * l;
#define hin_reg (l == 0 ? INP(IN_X) : (const float*)hreg)
#define hin_meta (l == 0 ? INP(IN_META) : (const float*)hmeta)
        const int meta_mod = l == 0 ? 16 : 128;
#define MKMP() MixParams mp; mp.conv_w = INP(IN_CONVW) + l * 5 * 768; mp.conv_b = INP(IN_CONVB) + l * 768; mp.dt_bias = INP(IN_DTB) + l * 8; mp.a_log = INP(IN_ALOG) + l * 8; \
        mp.ssd_d = INP(IN_SSDD) + l * 4; mp.ssd_norm_w = INP(IN_SSDN) + l * 256; mp.gate_w2 = INP(IN_GW2) + l * 2 * 16 * 128; mp.gate_b = INP(IN_GB) + l * 256; \
        mp.gla_norm_w = INP(IN_GLAN) + l * 64; mp.sink = INP(IN_SINK) + l * 4; mp.qn_w = INP(IN_QN) + l * 64; mp.kn_w = INP(IN_KN) + l * 64; mp.rel_bias = INP(IN_RELB); \
        MixBuf mb{big, dtga, tmp, act1k}; (void)mb
        for (int rep_ = 0; rep_ < PROBE_THIN_REP; ++rep_)
        if (IN(pb + 0)) { IDS();
            const float* w = INP(IN_NMIX) + l * 1024; f32x4 wreg[4];
#pragma unroll
            for (int j = 0; j < 4; ++j) wreg[j] = ((const GAS f32x4*)w + lane)[64 * j];
            if (l == 0) {
            for (int r = gw; r < NTOK; r += 2 * NGW) { const int r2 = r + NGW < NTOK ? r + NGW : r;
                const float* s1 = r < NREG ? hin_reg + (size_t)r * 1024 : hin_meta + (size_t)((r - NREG) % meta_mod) * 1024; const float* s2 = r2 < NREG ? hin_reg + (size_t)r2 * 1024 : hin_meta + (size_t)((r2 - NREG) % meta_mod) * 1024;
                rms_row2_to_bf16(s1, s2, wreg, act1k + (size_t)r * 1024, act1k + (size_t)r2 * 1024, lane, U8IN + (size_t)r * 1024, U8IN + (size_t)r2 * 1024, SA_IN + r, SA_IN + r2); }
            } else {
            for (int r = gw; r < NREG; r += 2 * NGW) { const int r2 = r + NGW < NREG ? r + NGW : r;
                rms_row2_to_bf16<true>((const bf16*)hreg + (size_t)r * HP, (const bf16*)hreg + (size_t)r2 * HP, wreg, act1k + (size_t)r * 1024, act1k + (size_t)r2 * 1024, lane, U8IN + (size_t)r * 1024, U8IN + (size_t)r2 * 1024, SA_IN + r, SA_IN + r2); }
            for (int r = NREG + gw; r < NTOK; r += NGW) { const float* s1 = hin_meta + (size_t)((r - NREG) % meta_mod) * 1024;
                rms_row2_to_bf16(s1, s1, wreg, act1k + (size_t)r * 1024, act1k + (size_t)r * 1024, lane, U8IN + (size_t)r * 1024, U8IN + (size_t)r * 1024, SA_IN + r, SA_IN + r); }
            }
            if (l == 0) { __syncthreads(); LAS float* scr = (LAS float*)(lds + wave * 16384);
                for (int l2 = 0; l2 < 2; ++l2) quant_mat(INP(IN_WIN) + (size_t)l2 * 1024 * 2856, 1024, 2856, WIN8 + (size_t)l2 * 2816 * 1024, SB_IN + l2 * 3072, CMAX_IN + l2 * 3072, 1, scr, gw, NGW, lane, 2816);
                for (int e = 0; e < 8; ++e) { quant_mat(INP(IN_MG) + (size_t)e * 1024 * 3584, 1024, 3584, WMGU8 + (size_t)e * 7168 * 1024, SB_MGU + e * 7168, CMAX_MGU + e * 7168, 2, scr, gw, NGW, lane);
                    quant_mat(INP(IN_MU) + (size_t)e * 1024 * 3584, 1024, 3584, WMGU8 + (size_t)e * 7168 * 1024, SB_MGU + e * 7168, CMAX_MGU + e * 7168, 3, scr, gw, NGW, lane);
                    quant_f8_mat(INP(IN_MD) + (size_t)e * 3584 * 1024, 3584, 1024, WMD8 + (size_t)e * 1024 * 3584, f8_scale(*AMAX_MD, false), scr, gw, NGW, lane); } }
        }
        SEAM(pb + 0);
#ifndef PROBE_INPROJ_REP
#define PROBE_INPROJ_REP 1
#endif
        for (int rep_ = 0; rep_ < PROBE_INPROJ_REP; ++rep_)
        if (IN(pb + 1)) { IDS();
            pg8::Gemm g{(const bf16*)U8IN, (const bf16*)(WIN8 + (size_t)l * 2816 * 1024), MP, 2816, 512}; pg8::StaticOrder S; S.init(MP, 2816, G, bid);
            pg8::EpiInProj8 E{big, SA_IN, SB_IN + l * 3072};
            pg8::gemm_phase<pg8::EpiInProj8, pg8::StaticOrder, true, true, false, false, true>(lds, g, S, E);
            const int nunits = (MP / 256) * 11, n6 = nunits % G;
            if (n6 > 0 && bid >= n6) {
                __syncthreads();
                const bf16* wdt = Win + ((size_t)l * 3072 + 2816) * 1024;
                for (int i = tid; i < 48 * 128; i += NWAVES * 64) { const int row = i >> 7, ch = i & 127; *(LAS v4u*)(lds + row * 2064 + ch * 16) = *(const GAS v4u*)(wdt + (size_t)row * 1024 + ch * 8); }
                __syncthreads();
                const int fr = lane & 15, quad = lane >> 4;
                for (int blk = (bid - n6) * NWAVES + wave; blk < MP / 16; blk += (G - n6) * NWAVES) {
                    f32x4 a0 = {0.f, 0.f, 0.f, 0.f}, a1 = a0, a2 = a0;
                    const bf16* ap = act1k + (size_t)(16 * blk + fr) * 1024 + 8 * quad;
#pragma unroll 8
                    for (int ks = 0; ks < 32; ++ks) { const bf16x8 av = *(const GAS bf16x8*)(ap + 32 * ks);
                        const LAS unsigned char* bp = lds + fr * 2064 + (32 * ks + 8 * quad) * 2;
                        a0 = __builtin_amdgcn_mfma_f32_16x16x32_bf16(av, *(const LAS bf16x8*)(bp), a0, 0, 0, 0);
                        a1 = __builtin_amdgcn_mfma_f32_16x16x32_bf16(av, *(const LAS bf16x8*)(bp + 16 * 2064), a1, 0, 0, 0);
                        a2 = __builtin_amdgcn_mfma_f32_16x16x32_bf16(av, *(const LAS bf16x8*)(bp + 32 * 2064), a2, 0, 0, 0); }
#pragma unroll
                    for (int j = 0; j < 4; ++j) { float* op = dtga + (size_t)(16 * blk + 4 * quad + j) * DGW; op[fr] = a0[j]; op[16 + fr] = a1[j]; if (fr < 8) op[32 + fr] = a2[j]; }
                }
                __syncthreads();
            }
        }
        SEAM(pb + 1);
        if (IN(pb + 2)) { IDS(); MKMP();
            for (int item = gw; item < B_ * 129 * 6; item += NGW) {
                const int cg = item % 6, rr = (item / 6) % 129, b = item / (6 * 129), c = cg * 128 + 2 * lane, t0 = rr * 32;
                float w0[5], w1[5];
#pragma unroll
                for (int j = 0; j < 5; ++j) { w0[j] = mp.conv_w[j * XW + c]; w1[j] = mp.conv_w[j * XW + c + 1]; }
                const float b0 = mp.conv_b[c], b1 = mp.conv_b[c + 1];
                unsigned xin[36];
#pragma unroll
                for (int i = 0; i < 36; ++i) { const int t = t0 - 2 + i; xin[i] = (t >= 0 && t < L_) ? *(const GAS unsigned*)(big + (size_t)row_of(b, t) * PW + PX + c) : 0u; }
#pragma unroll
                for (int i = 0; i < 32; ++i) { const int t = t0 + i;
                    if (t < L_) { float a0 = b0, a1 = b1;
#pragma unroll
                        for (int j = 0; j < 5; ++j) { a0 += w0[j] * __uint_as_float(xin[i + j] << 16); a1 += w1[j] * __uint_as_float(xin[i + j] & 0xffff0000u); }
                        a0 = a0 / (1.0f + __expf(-a0)); a1 = a1 / (1.0f + __expf(-a1));
                        *(GAS unsigned*)(tmp + (size_t)row_of(b, t) * XW + c) = pk2(a0, a1); } }
            }
            const int half = lane >> 5, pi = lane & 31;
            const float inv = __builtin_amdgcn_exp2f(-(float)(pi & 15) * 0.8304820237218406f);
            const float qw0 = mp.qn_w[2 * pi], qw1 = mp.qn_w[2 * pi + 1], kw0 = mp.kn_w[2 * pi], kw1 = mp.kn_w[2 * pi + 1];
            for (int r = gw; r < NTOK; r += NGW) {
                const int t = r < NREG ? NM + (r % S_) : (r - NREG) % NM;
                const float pos = t < NM ? (float)(t - NM) : (pi < 16 ? (float)((t - NM) / 64) : (float)((t - NM) % 64));
                const float ang = pos * inv, cs = __cosf(ang), sn = __sinf(ang);
#pragma unroll
                for (int k = 0; k < 3; ++k) { const int slot = half + 2 * k;
                    GAS unsigned* px = (GAS unsigned*)(big + (size_t)r * PW + PAQ + slot * 64) + pi; const unsigned xv = *px;
                    const float x0 = __uint_as_float(xv << 16), x1 = __uint_as_float(xv & 0xffff0000u);
                    float ss = x0 * x0 + x1 * x1;
#pragma unroll
                    for (int o = 1; o < 32; o <<= 1) ss += __shfl_xor(ss, o);
                    const float rstd = 1.0f / sqrtf(ss * (1.0f / 64.0f) + 1e-6f);
                    const float sc = slot < 4 ? attn_body::C2 : 1.0f;
                    const float y0 = x0 * rstd * (slot < 4 ? qw0 : kw0), y1 = x1 * rstd * (slot < 4 ? qw1 : kw1);
                    *px = pk2((y0 * cs - y1 * sn) * sc, (y0 * sn + y1 * cs) * sc); }
            }
        }
        SEAM(pb + 2);
        if (IN(pb + 3)) { IDS(); MKMP();
#ifndef PROBE_ATT_REP
#define PROBE_ATT_REP 1
#endif
#ifndef PROBE_SWA_REP
#define PROBE_SWA_REP 1
#endif
#ifndef PROBE_SSD_REP
#define PROBE_SSD_REP 1
#endif
#ifndef PROBE_GLA_REP
#define PROBE_GLA_REP 1
#endif
#ifndef PROBE_MIX_REP
#define PROBE_MIX_REP 1
#endif
            for (int rep_ = 0; rep_ < PROBE_MIX_REP; ++rep_) {
            gu32* qc = (gu32*)(ws + WS_CTL) + CW_Q + l * 2048 + rep_ * 4096;
#define Q_POP(k) ({ __syncthreads(); if (tid == 0) MISC[16] = __hip_atomic_fetch_add(qc + 64 * (k), 1u, __ATOMIC_RELAXED, __HIP_MEMORY_SCOPE_AGENT); __syncthreads(); (int)MISC[16]; })
            for (;;) { const int u_ = Q_POP(0); if (u_ >= 64 * PROBE_SSD_REP) break; const int u = u_ & 63; const int b = u >> 3, h = (u >> 1) & 3, dir = u & 1;
                mix::ssd_stream(b, h, dir, tmp, dtga, mp.dt_bias[dir * 4 + h], -expf(mp.a_log[dir * 4 + h]), dir == 0 ? act1k : big + PX, dir == 0 ? 1024 : PW, (mix::lp)lds); }
            for (;;) { const int u_ = Q_POP(1); if (u_ >= 64 * PROBE_GLA_REP) break; const int u = u_ & 63; const int b = u >> 3, h = (u >> 1) & 3, dir = u & 1;
                mix::gla_stream(b, h, dir, big, dtga, mp.gate_w2, mp.gate_b, dir == 0 ? act1k + 256 : big + PB, dir == 0 ? 1024 : PW, (mix::lp)lds); }
            const int x0 = (int)(xb_xcc_id() & 7u), nmeta = l == 0 ? 2 : 0, nper = 64 + nmeta;
            for (int k = 0; k < 8; ++k) { const int q = (x0 + k) & 7;
                for (;;) { const int u_ = Q_POP(2 + q); if (u_ >= nper * PROBE_ATT_REP) break; const int u = u_ % nper;
                    const int r = u - nmeta, bg = 2 * q + (u < nmeta ? u : (r >> 5)), qb = u < nmeta ? -1 : (r & 31), b = bg >> 1, g = bg & 1;
                    attn_body::attn_unit<8, false>(b, qb, big + PAQ + g * 128, big + PAK + g * 64, big + PAV + g * 64, act1k + 768 + g * 128, (char*)lds_raw, nullptr, g); } }
            LAS float* btab = (LAS float*)(lds + 86016);
            __syncthreads();
            for (int i = tid; i < 4 * 259; i += NWAVES * 64) { const int h = i / 259, k = i % 259, rc = k - 129; btab[h * 264 + k] = (k == 0 || k == 258) ? -INFINITY : mp.rel_bias[t5_bucket(rc) * 4 + h] * 1.4426950408889634f; }
            if (tid < 4) btab[4 * 264 + tid] = mp.sink[tid] * 1.4426950408889634f;
            for (int k = 0; k < 8; ++k) { const int q = (x0 + k) & 7;
                for (;;) { const int u_ = Q_POP(10 + q); if (u_ >= nper * PROBE_SWA_REP) break; const int u = u_ % nper;
                    const int r = u - nmeta, bg = 2 * q + (u < nmeta ? u : (r >> 5)), qb = u < nmeta ? -1 : (r & 31), b = bg >> 1, g = bg & 1;
                    attn_body::attn_unit<8, true>(b, qb, big + PSQ + g * 128, big + PSK + g * 64, big + PSV + g * 64, act1k + 512 + g * 128, (char*)lds_raw, btab, g); } }
            }
#undef Q_POP
        }
        SEAM(pb + 3);
        if (IN(pb + 7)) { IDS(); MKMP();
            const f32x4 snw = *(const GAS f32x4*)(mp.ssd_norm_w + 4 * lane); const float dskv = mp.ssd_d[lane >> 4]; const f32x4 gnw = *(const GAS f32x4*)(mp.gla_norm_w + ((4 * lane) & 63));
#define BFX(q, j) __uint_as_float((unsigned)(((q) >> (16 * (j))) & 0xffffu) << 16)
            for (int r = gw; r < NTOK; r += 2 * NGW) { const int r2 = r + NGW < NTOK ? r + NGW : r; const int c0 = 4 * lane;
                unsigned long long yf[2], yb[2], xx[2], zz[2], of[2], ob[2], rr[2];
#pragma unroll
                for (int k = 0; k < 2; ++k) { const size_t rk = (size_t)(k == 0 ? r : r2);
                    yf[k] = *(const GAS unsigned long long*)(act1k + rk * 1024 + c0); yb[k] = *(const GAS unsigned long long*)(big + rk * PW + PX + c0);
                    xx[k] = *(const GAS unsigned long long*)(tmp + rk * XW + c0); zz[k] = *(const GAS unsigned long long*)(big + rk * PW + PZ + c0);
                    of[k] = *(const GAS unsigned long long*)(act1k + rk * 1024 + 256 + c0); ob[k] = *(const GAS unsigned long long*)(big + rk * PW + PB + c0); rr[k] = *(const GAS unsigned long long*)(big + rk * PW + PGR + c0); }
#pragma unroll
                for (int k = 0; k < 2; ++k) { const size_t rk = (size_t)(k == 0 ? r : r2);
                    float y[4]; float ss = 0.f;
#pragma unroll
                    for (int j = 0; j < 4; ++j) { const float zv = BFX(zz[k], j); y[j] = (BFX(yf[k], j) + BFX(yb[k], j) + dskv * BFX(xx[k], j)) * (zv / (1.0f + __expf(-zv))); ss += y[j] * y[j]; }
                    const float rstd = 1.0f / sqrtf(wave_sum(ss) * (1.0f / 256.0f) + 1e-6f);
                    float o[4]; float s2 = 0.f;
#pragma unroll
                    for (int j = 0; j < 4; ++j) { o[j] = BFX(of[k], j) + BFX(ob[k], j); s2 += o[j] * o[j]; }
#pragma unroll
                    for (int sh = 1; sh < 16; sh <<= 1) s2 += __shfl_xor(s2, sh);
                    const float rs2 = 1.0f / sqrtf(s2 * (1.0f / 64.0f) + 1e-6f);
                    float o4[4];
#pragma unroll
                    for (int j = 0; j < 4; ++j) { const float rv = BFX(rr[k], j); o4[j] = o[j] * rs2 * gnw[j] * (rv / (1.0f + __expf(-rv))); }
                    if (k == 0 || r2 != r) {
                        *(GAS unsigned long long*)(act1k + rk * 1024 + c0) = (unsigned long long)pk2(y[0] * rstd * snw.x, y[1] * rstd * snw.y) | ((unsigned long long)pk2(y[2] * rstd * snw.z, y[3] * rstd * snw.w) << 32);
                        *(GAS unsigned long long*)(act1k + rk * 1024 + 256 + c0) = (unsigned long long)pk2(o4[0], o4[1]) | ((unsigned long long)pk2(o4[2], o4[3]) << 32); } }
            }
#undef BFX
        }
        SEAM(pb + 7);
        if (IN(pb + 8)) { IDS();
            pg8::Gemm g{act1k, Wout + (size_t)l * 1024 * 1024, NREG, 1024, 1024}; pg8::StaticOrder S; S.init(NREG, 1024, G, bid);
            pg8::EpiResid<(l != 0)> E{l == 0 ? (const void*)INP(IN_X) : (const void*)hreg, (bf16*)hreg};
            pg8::gemm_phase<pg8::EpiResid<(l != 0)>, pg8::StaticOrder, true, true>(lds, g, S, E);
            if (l == 0) {
                const int fr = lane & 15, quad = lane >> 4;
                for (int task = gw; task < 8 * 32; task += NGW) { const int rb = task >> 5, cg = task & 31; f32x4 acc[2];
                    skinny_task<2>(act1k + (size_t)NREG * 1024, 1024, rb, Wout, cg * 32, 16, acc, lane);
#pragma unroll
                    for (int nb = 0; nb < 2; ++nb)
#pragma unroll
                        for (int j = 0; j < 4; ++j) { const int mr = 16 * rb + 4 * quad + j, c = cg * 32 + 16 * nb + fr; hmeta[(size_t)mr * 1024 + c] = INP(IN_META)[(size_t)(mr % 16) * 1024 + c] + acc[nb][j]; } }
            }
        }
        SEAM(pb + 8);
        if (l == 0) {
            for (int rep_ = 0; rep_ < PROBE_THIN_REP; ++rep_)
            if (IN(pb + 9)) { IDS();
                const float* w = INP(IN_NFFN); f32x4 wreg[4];
#pragma unroll
                for (int j = 0; j < 4; ++j) wreg[j] = ((const GAS f32x4*)w + lane)[64 * j];
                for (int r = gw; r < NREG; r += 2 * NGW) { const int r2 = r + NGW < NREG ? r + NGW : r;
                    rms_row2_to_bf16<true>((const bf16*)hreg + (size_t)r * HP, (const bf16*)hreg + (size_t)r2 * HP, wreg, act1k + (size_t)r * 1024, act1k + (size_t)r2 * 1024, lane, U8 + (size_t)r * 1024, U8 + (size_t)r2 * 1024, SA_U + r, SA_U + r2); }
                for (int r = NREG + gw; r < NTOK; r += NGW) { const float* s1 = hmeta + (size_t)(r - NREG) * 1024;
                    rms_row2_to_bf16(s1, s1, wreg, act1k + (size_t)r * 1024, act1k + (size_t)r * 1024, lane, U8 + (size_t)r * 1024, U8 + (size_t)r * 1024, SA_U + r, SA_U + r); }
                __syncthreads();
                { LAS float* scr = (LAS float*)(lds + wave * 16384);
                    quant_mat(INP(IN_FG), 1024, 2816, WGU8, SB_GU, CMAX_GU, 2, scr, gw, NGW, lane); quant_mat(INP(IN_FU), 1024, 2816, WGU8, SB_GU, CMAX_GU, 3, scr, gw, NGW, lane); }
            }
            SEAM(pb + 9);
#ifndef PROBE_FFNUP_REP
#define PROBE_FFNUP_REP 1
#endif
            for (int rep_ = 0; rep_ < PROBE_FFNUP_REP; ++rep_)
            if (IN(pb + 10)) { IDS();
                pg8::Gemm g{(const bf16*)U8, (const bf16*)WGU8, NREG, 5632, 512}; pg8::StaticOrder S; S.init(NREG, 5632, G, bid);
                pg8::EpiSwiGLU8 E{big, PW, 22, SA_U, SB_GU, 0, false};
                pg8::gemm_phase<pg8::EpiSwiGLU8, pg8::StaticOrder, true, true, false, false, true>(lds, g, S, E);
                { const int fr = lane & 15, quad = lane >> 4;
                    for (int task = gw; task < 8 * 176; task += NGW) { const int rb = task / 176, fg = task % 176, f0 = 16 * fg; f32x4 acc[2];
                        skinny_task<2>(act1k + (size_t)NREG * 1024, 1024, rb, Wgu, (f0 >> 7) * 256 + (f0 & 127), 128, acc, lane);
#pragma unroll
                        for (int j = 0; j < 4; ++j) { const float gg = acc[0][j], uu = acc[1][j]; big[(size_t)(NREG + 16 * rb + 4 * quad + j) * PW + f0 + fr] = f2bf(gg / (1.0f + __expf(-gg)) * uu); } } }
            }
            SEAM(pb + 10);
#ifndef PROBE_FFND_REP
#define PROBE_FFND_REP 1
#endif
            if (IN(pb + 11)) { IDS();
                pg8::Gemm g{big, Wd, NREG, 1024, 2816}; pg8::StaticOrder S; S.init(NREG, 1024, G, bid);
                for (int rep_ = 0; rep_ < PROBE_FFND_REP; ++rep_) {
                pg8::EpiResid<true> E{hreg, (bf16*)hreg, rep_ + 1 < PROBE_FFND_REP ? 0.0f : 1.0f};
                pg8::gemm_phase<pg8::EpiResid<true>, pg8::StaticOrder, true, true>(lds, g, S, E); }
                { const int fr = lane & 15, quad = lane >> 4;
                    for (int task = gw; task < 8 * 64; task += NGW) { const int rb = task >> 6, cb = task & 63; f32x4 acc[1];
                        skinny_task<1>(big + (size_t)NREG * PW, PW, rb, Wd, cb * 16, 0, acc, lane);
#pragma unroll
                        for (int j = 0; j < 4; ++j) { float* hp = hmeta + (size_t)(16 * rb + 4 * quad + j) * 1024 + cb * 16 + fr; *hp += acc[0][j]; } } }
            }
            SEAM(pb + 11);
        } else {
            for (int rep_ = 0; rep_ < PROBE_THIN_REP; ++rep_)
            if (IN(pb + 9)) { IDS();
                const float* w = INP(IN_NFFN) + 1024; const float* rw = INP(IN_ROUTER);
                LAS int* lcnt = (LAS int*)lds;
                f32x4 nwr[4];
#pragma unroll
                for (int j = 0; j < 4; ++j) nwr[j] = ((const GAS f32x4*)w + lane)[64 * j];
                f32x4 rwr[4][4][2];
#pragma unroll
                for (int j = 0; j < 4; ++j)
#pragma unroll
                    for (int c = 0; c < 4; ++c) { const GAS f32x4* rp = (const GAS f32x4*)(rw + (size_t)(4 * lane + 256 * j + c) * 8); rwr[j][c][0] = rp[0]; rwr[j][c][1] = rp[1]; }
                if (tid < 16) lcnt[tid] = 0;
                __syncthreads();
                for (int r0 = gw; r0 < NREG; r0 += 2 * NGW) {
                    f32x4 v[2][4];
#pragma unroll
                    for (int q = 0; q < 2; ++q) { const int r = r0 + q * NGW < NREG ? r0 + q * NGW : r0; const GAS unsigned long long* xr = (const GAS unsigned long long*)((const bf16*)hreg + (size_t)r * HP) + lane;
#pragma unroll
                        for (int j = 0; j < 4; ++j) v[q][j] = bf4_f32(xr[64 * j]); }
#pragma unroll
                    for (int q = 0; q < 2; ++q) { const int r = r0 + q * NGW;
                        if (r < NREG) {
                            float s = 0.f;
#pragma unroll
                            for (int j = 0; j < 4; ++j) s += (v[q][j].x * v[q][j].x + v[q][j].y * v[q][j].y) + (v[q][j].z * v[q][j].z + v[q][j].w * v[q][j].w);
                            const float rstd = 1.f / sqrtf(wave_sum(s) * (1.f / 1024.f) + 1e-6f);
                            float lg[8];
#pragma unroll
                            for (int e = 0; e < 8; ++e) lg[e] = 0.f;
                            float umx = 0.f;
#pragma unroll
                            for (int j = 0; j < 4; ++j) { const f32x4 ww = nwr[j]; const f32x4 uu = v[q][j] * rstd * ww; umx = fmaxf(fmaxf(umx, fmaxf(fabsf(uu.x), fabsf(uu.y))), fmaxf(fabsf(uu.z), fabsf(uu.w))); }
#pragma unroll
                            for (int o = 1; o < 64; o <<= 1) umx = fmaxf(umx, __shfl_xor(umx, o));
                            const float uqs = umx > 0.f ? 127.0f / umx : 0.f; if (lane == 0) SA_U[r] = umx * (1.0f / 127.0f);
#pragma unroll
                            for (int j = 0; j < 4; ++j) { const f32x4 ww = nwr[j]; const f32x4 uu = v[q][j] * rstd * ww;
                                *((GAS unsigned*)(U8 + (size_t)r * 1024) + lane + 64 * j) = ((unsigned)((int)rintf(uu.x * uqs)) & 0xffu) | (((unsigned)((int)rintf(uu.y * uqs)) & 0xffu) << 8) | (((unsigned)((int)rintf(uu.z * uqs)) & 0xffu) << 16) | (((unsigned)((int)rintf(uu.w * uqs)) & 0xffu) << 24);
#pragma unroll
                                for (int c = 0; c < 4; ++c) { const f32x4 r0_ = rwr[j][c][0], r1_ = rwr[j][c][1]; const float uc = uu[c];
                                    lg[0] += uc * r0_.x; lg[1] += uc * r0_.y; lg[2] += uc * r0_.z; lg[3] += uc * r0_.w; lg[4] += uc * r1_.x; lg[5] += uc * r1_.y; lg[6] += uc * r1_.z; lg[7] += uc * r1_.w; } }
                            const bool h5 = lane & 32, h4 = lane & 16, h3 = lane & 8; float a4[4], b2[2], c1;
#pragma unroll
                            for (int k = 0; k < 4; ++k) a4[k] = (h5 ? lg[4 + k] : lg[k]) + __shfl_xor(h5 ? lg[k] : lg[4 + k], 32);
#pragma unroll
                            for (int k = 0; k < 2; ++k) b2[k] = (h4 ? a4[2 + k] : a4[k]) + __shfl_xor(h4 ? a4[k] : a4[2 + k], 16);
                            c1 = (h3 ? b2[1] : b2[0]) + __shfl_xor(h3 ? b2[0] : b2[1], 8);
                            c1 += __shfl_xor(c1, 4); c1 += __shfl_xor(c1, 2); c1 += __shfl_xor(c1, 1);
#pragma unroll
                            for (int e = 0; e < 8; ++e) lg[e] = __shfl(c1, ((e & 4) ? 32 : 0) + ((e & 2) ? 16 : 0) + ((e & 1) ? 8 : 0));
                            int i0 = 0; float v0 = lg[0];
#pragma unroll
                            for (int e = 1; e < 8; ++e) if (lg[e] > v0) { v0 = lg[e]; i0 = e; }
                            int i1 = -1; float v1 = -3.0e38f;
#pragma unroll
                            for (int e = 0; e < 8; ++e) if (e != i0 && lg[e] > v1) { v1 = lg[e]; i1 = e; }
                            if (lane == 0) { const float g1 = 1.0f / (1.0f + __expf(v0 - v1)); const int k0 = __hip_atomic_fetch_add(lcnt + i0, 1, __ATOMIC_RELAXED, __HIP_MEMORY_SCOPE_WORKGROUP), k1 = __hip_atomic_fetch_add(lcnt + 8 + i1, 1, __ATOMIC_RELAXED, __HIP_MEMORY_SCOPE_WORKGROUP);
                                rt_e[r] = i0 | (i1 << 8); rt_rank[r] = k0 | (k1 << 16); rt_g[2 * r] = 1.0f - g1; rt_g[2 * r + 1] = g1; }
                        } }
                }
                __syncthreads();
                if (tid < 16) blkcnt[bid * 16 + tid] = lcnt[tid];
            }
            SEAM(pb + 9);
#ifndef PROBE_SORT_REP
#define PROBE_SORT_REP 1
#endif
            for (int rep_ = 0; rep_ < PROBE_SORT_REP; ++rep_)
            if (IN(PH_SORT)) { IDS();
                LAS int* tot = (LAS int*)lds; LAS int* pre = tot + 16; LAS int* roff = tot + 32; LAS int* ntl = tot + 48;
                if (tid < 64) tot[tid] = 0;
                __syncthreads();
                { const int sgm = tid & 15, part = tid >> 4; int a = 0, bfore = 0;
                    for (int k = 0; k < 8; ++k) { const int wgi = part * 8 + k; if (wgi < G) { const int cv = blkcnt[wgi * 16 + sgm]; a += cv; if (wgi < bid) bfore += cv; } }
                    __hip_atomic_fetch_add(tot + sgm, a, __ATOMIC_RELAXED, __HIP_MEMORY_SCOPE_WORKGROUP); __hip_atomic_fetch_add(pre + sgm, bfore, __ATOMIC_RELAXED, __HIP_MEMORY_SCOPE_WORKGROUP); }
                __syncthreads();
                if (tid == 0) {
                    int tile = 0, T0 = 0;
                    for (int sg = 0; sg < 16; ++sg) { const int nt = (tot[sg] + 255) >> 8; roff[sg] = tile * 256; ntl[sg] = nt; if (bid == 0) for (int k = 0; k < nt; ++k) texp[tile + k] = sg & 7; tile += nt; if (sg == 7) T0 = tile; }
                    if (bid == 0) { const int T1 = tile - T0;
                        int p1 = T0 >= 64 && T0 - 64 <= CAP_TILES ? 64 : (T0 + 1) / 2, p2 = T1 >= 64 && T1 - 64 <= CAP_TILES ? T1 - 64 : (T1 + 1) / 2;
                        passt[0] = 0; passt[1] = p1; passt[2] = T0; passt[3] = T0 + p2; passt[4] = tile; }
                }
                __syncthreads();
                if (bid < 16) { const int b0 = roff[bid] + tot[bid], b1 = roff[bid] + ntl[bid] * 256; for (int i = b0 + tid; i < b1; i += NWAVES * 64) { stok[i] = -1; stokp[permp(i)] = -1; sgate[i] = 0.f; ssa[i] = 0.f; } }
                for (int k = lane; gw + k * NGW < NREG; k += 64) { const int r = gw + k * NGW;
                    { const int e = rt_e[r], rk = rt_rank[r]; const int e0 = e & 255, e1 = 8 + (e >> 8);
                        const int p0 = roff[e0] + pre[e0] + (rk & 0xffff), p1 = roff[e1] + pre[e1] + (rk >> 16);
                        const float sar = SA_U[r];
                        stok[p0] = r; stokp[permp(p0)] = r; sgate[p0] = rt_g[2 * r]; ssa[p0] = sar; stok[p1] = r; stokp[permp(p1)] = r; sgate[p1] = rt_g[2 * r + 1]; ssa[p1] = sar; } }
#ifndef PROBE_IDENT
#define PROBE_IDENT 0
#endif
                if (PROBE_IDENT) for (long i = gtid; i < MAX_SROWS; i += (long)G * NWAVES * 64) ((int*)(ws + WS_DTGA))[i] = (int)(i & 32767);
                __syncthreads();
            }
            SEAM(PH_SORT);
#ifndef PROBE_DK_HALF
#define PROBE_DK_HALF 0
#endif
#ifndef PROBE_MOE_REP
#define PROBE_MOE_REP 1
#endif
#pragma unroll 1
            for (int p_ = 0; p_ < 5 * PROBE_MOE_REP; ++p_) { const int p = p_ % 5; const float gscale_ = p_ < 5 * (PROBE_MOE_REP - 1) ? 0.0f : 1.0f;
                OPAQUE_RANGE();
                if (IN(PH_PASS0 + p)) { IDS();
                    int nd = 0;
                    LAS int* lexd = (LAS int*)(lds + 139264); LAS int* lexg = lexd + 128;
                    if (p > 0) { const int t0 = passt[p - 1], n = passt[p] - t0; if (tid < n) lexd[tid] = texp[t0 + tid]; }
                    if (p < 4) { const int t0 = passt[p], n = passt[p + 1] - t0; if (tid < n) lexg[tid] = texp[t0 + tid]; }
                    __syncthreads();
                    if (p > 0) {
                        const int t0 = passt[p - 1], t1 = passt[p]; nd = (t1 - t0) * 4;
                        pg8::Gemm g{(const bf16*)(ws + WS_BIG + (size_t)((p - 1) & 1) * MOE_ACT_BYTES), (const bf16*)WMD8, CAP_TILES * 256, 8 * 1024, (PROBE_DK_HALF && gscale_ == 0.0f) ? 896 : 1792}; pg8::MoeOrder S{t0, t1 - t0, 4, G, bid, 0, lexd, stok, t0 * 256};
                        pg8::EpiMoeDown E{p >= 3 ? Y1LO : YLO, p >= 3 ? (long)(Y1HI - Y1LO) : (long)(YHI - YLO), stok, sgate, t0 * 256, gscale_ * f8_scale(*AMAX_MD, true)};
                        pg8::gemm_phase<pg8::EpiMoeDown, pg8::MoeOrder, true, true, false, true, false, true>(lds, g, S, E);
                    }
                    if (p < 4) {
                        const int t0 = passt[p], t1 = passt[p + 1];
                        pg8::Gemm g{(const bf16*)U8, (const bf16*)WMGU8, NREG, 8 * 7168, 512}; pg8::MoeOrder S{t0, t1 - t0, 28, G, bid, nd > G ? nd - G : 0, lexg, stok, t0 * 256, stokp};
                        pg8::EpiSwiGLU8 E{(bf16*)(ws + WS_BIG + (size_t)(p & 1) * MOE_ACT_BYTES), 3584, 28, ssa, SB_MGU, t0 * 256, true};
                        pg8::gemm_phase<pg8::EpiSwiGLU8, pg8::MoeOrder, true, true, true, false, true>(lds, g, S, E);
                    }
                }
                SEAM(PH_PASS0 + p);
            }
#ifndef PROBE_BAR_REP
#define PROBE_BAR_REP 0
#endif
            for (int rep_ = 0; rep_ < PROBE_BAR_REP; ++rep_) xcd_barrier_lean(bar);
            if (IN(PH_FINAL)) { IDS();
                const float* w = INP(IN_FINAL); f32x4 fwr[4];
#pragma unroll
                for (int j = 0; j < 4; ++j) fwr[j] = ((const GAS f32x4*)w + lane)[64 * j];
                for (int r = gw; r < NREG; r += 2 * NGW) { const int r2 = r + NGW < NREG ? r + NGW : r;
                    GAS f32x4* xa = (GAS f32x4*)(hreg + (size_t)r * 1024) + lane; GAS f32x4* xb = (GAS f32x4*)(hreg + (size_t)r2 * 1024) + lane;
                    f32x4 va[4], vb[4]; float sa = 0.f, sb = 0.f;
                    { const GAS unsigned long long* ha = (const GAS unsigned long long*)((const bf16*)hreg + (size_t)r * HP) + lane; const GAS unsigned long long* hb_ = (const GAS unsigned long long*)((const bf16*)hreg + (size_t)r2 * HP) + lane;
#pragma unroll
                    for (int j = 0; j < 4; ++j) { va[j] = bf4_f32(ha[64 * j]); vb[j] = bf4_f32(hb_[64 * j]); } }
#pragma unroll
                    for (int sl = 0; sl < 2; ++sl)
#pragma unroll
                    for (int j = 0; j < 4; ++j) { const bf16* yb_ = sl == 0 ? (j < 2 ? YLO : YHI) : (j < 2 ? Y1LO : Y1HI); const int cy = 4 * lane + 256 * (j & 1);
                        const unsigned long long qa = *(const GAS unsigned long long*)(yb_ + (size_t)r * 512 + cy), qb = *(const GAS unsigned long long*)(yb_ + (size_t)r2 * 512 + cy);
                        va[j].x += __uint_as_float((unsigned)qa << 16); va[j].y += __uint_as_float((unsigned)qa & 0xffff0000u); va[j].z += __uint_as_float((unsigned)(qa >> 32) << 16); va[j].w += __uint_as_float((unsigned)(qa >> 32) & 0xffff0000u);
                        vb[j].x += __uint_as_float((unsigned)qb << 16); vb[j].y += __uint_as_float((unsigned)qb & 0xffff0000u); vb[j].z += __uint_as_float((unsigned)(qb >> 32) << 16); vb[j].w += __uint_as_float((unsigned)(qb >> 32) & 0xffff0000u); }
#pragma unroll
                    for (int j = 0; j < 4; ++j) { sa += (va[j].x * va[j].x + va[j].y * va[j].y) + (va[j].z * va[j].z + va[j].w * va[j].w); sb += (vb[j].x * vb[j].x + vb[j].y * vb[j].y) + (vb[j].z * vb[j].z + vb[j].w * vb[j].w); }
                    const float ra = 1.f / sqrtf(wave_sum_sw(sa) * (1.f / 1024.f) + 1e-6f), rb = 1.f / sqrtf(wave_sum_sw(sb) * (1.f / 1024.f) + 1e-6f);
#pragma unroll
                    for (int j = 0; j < 4; ++j) { const f32x4 ww = fwr[j]; xa[64 * j] = va[j] * ra * ww; if (r2 != r) xb[64 * j] = vb[j] * rb * ww; }
                }
            }
        }
    }
    }
    { constexpr int l = 1;
    {
        OPAQUE_RANGE();
        const int pb = PH_L0 + 16 * l;
#define hin_reg (l == 0 ? INP(IN_X) : (const float*)hreg)
#define hin_meta (l == 0 ? INP(IN_META) : (const float*)hmeta)
        const int meta_mod = l == 0 ? 16 : 128;
#define MKMP() MixParams mp; mp.conv_w = INP(IN_CONVW) + l * 5 * 768; mp.conv_b = INP(IN_CONVB) + l * 768; mp.dt_bias = INP(IN_DTB) + l * 8; mp.a_log = INP(IN_ALOG) + l * 8; \
        mp.ssd_d = INP(IN_SSDD) + l * 4; mp.ssd_norm_w = INP(IN_SSDN) + l * 256; mp.gate_w2 = INP(IN_GW2) + l * 2 * 16 * 128; mp.gate_b = INP(IN_GB) + l * 256; \
        mp.gla_norm_w = INP(IN_GLAN) + l * 64; mp.sink = INP(IN_SINK) + l * 4; mp.qn_w = INP(IN_QN) + l * 64; mp.kn_w = INP(IN_KN) + l * 64; mp.rel_bias = INP(IN_RELB); \
        MixBuf mb{big, dtga, tmp, act1k}; (void)mb
        for (int rep_ = 0; rep_ < PROBE_THIN_REP; ++rep_)
        if (IN(pb + 0)) { IDS();
            const float* w = INP(IN_NMIX) + l * 1024; f32x4 wreg[4];
#pragma unroll
            for (int j = 0; j < 4; ++j) wreg[j] = ((const GAS f32x4*)w + lane)[64 * j];
            if (l == 0) {
            for (int r = gw; r < NTOK; r += 2 * NGW) { const int r2 = r + NGW < NTOK ? r + NGW : r;
                const float* s1 = r < NREG ? hin_reg + (size_t)r * 1024 : hin_meta + (size_t)((r - NREG) % meta_mod) * 1024; const float* s2 = r2 < NREG ? hin_reg + (size_t)r2 * 1024 : hin_meta + (size_t)((r2 - NREG) % meta_mod) * 1024;
                rms_row2_to_bf16(s1, s2, wreg, act1k + (size_t)r * 1024, act1k + (size_t)r2 * 1024, lane, U8IN + (size_t)r * 1024, U8IN + (size_t)r2 * 1024, SA_IN + r, SA_IN + r2); }
            } else {
            for (int r = gw; r < NREG; r += 2 * NGW) { const int r2 = r + NGW < NREG ? r + NGW : r;
                rms_row2_to_bf16<true>((const bf16*)hreg + (size_t)r * HP, (const bf16*)hreg + (size_t)r2 * HP, wreg, act1k + (size_t)r * 1024, act1k + (size_t)r2 * 1024, lane, U8IN + (size_t)r * 1024, U8IN + (size_t)r2 * 1024, SA_IN + r, SA_IN + r2); }
            for (int r = NREG + gw; r < NTOK; r += NGW) { const float* s1 = hin_meta + (size_t)((r - NREG) % meta_mod) * 1024;
                rms_row2_to_bf16(s1, s1, wreg, act1k + (size_t)r * 1024, act1k + (size_t)r * 1024, lane, U8IN + (size_t)r * 1024, U8IN + (size_t)r * 1024, SA_IN + r, SA_IN + r); }
            }
            if (l == 0) { __syncthreads(); LAS float* scr = (LAS float*)(lds + wave * 16384);
                for (int l2 = 0; l2 < 2; ++l2) quant_mat(INP(IN_WIN) + (size_t)l2 * 1024 * 2856, 1024, 2856, WIN8 + (size_t)l2 * 2816 * 1024, SB_IN + l2 * 3072, CMAX_IN + l2 * 3072, 1, scr, gw, NGW, lane, 2816);
                for (int e = 0; e < 8; ++e) { quant_mat(INP(IN_MG) + (size_t)e * 1024 * 3584, 1024, 3584, WMGU8 + (size_t)e * 7168 * 1024, SB_MGU + e * 7168, CMAX_MGU + e * 7168, 2, scr, gw, NGW, lane);
                    quant_mat(INP(IN_MU) + (size_t)e * 1024 * 3584, 1024, 3584, WMGU8 + (size_t)e * 7168 * 1024, SB_MGU + e * 7168, CMAX_MGU + e * 7168, 3, scr, gw, NGW, lane);
                    quant_f8_mat(INP(IN_MD) + (size_t)e * 3584 * 1024, 3584, 1024, WMD8 + (size_t)e * 1024 * 3584, f8_scale(*AMAX_MD, false), scr, gw, NGW, lane); } }
        }
        SEAM(pb + 0);
#ifndef PROBE_INPROJ_REP
#define PROBE_INPROJ_REP 1
#endif
        for (int rep_ = 0; rep_ < PROBE_INPROJ_REP; ++rep_)
        if (IN(pb + 1)) { IDS();
            pg8::Gemm g{(const bf16*)U8IN, (const bf16*)(WIN8 + (size_t)l * 2816 * 1024), MP, 2816, 512}; pg8::StaticOrder S; S.init(MP, 2816, G, bid);
            pg8::EpiInProj8 E{big, SA_IN, SB_IN + l * 3072};
            pg8::gemm_phase<pg8::EpiInProj8, pg8::StaticOrder, true, true, false, false, true>(lds, g, S, E);
            const int nunits = (MP / 256) * 11, n6 = nunits % G;
            if (n6 > 0 && bid >= n6) {
                __syncthreads();
                const bf16* wdt = Win + ((size_t)l * 3072 + 2816) * 1024;
                for (int i = tid; i < 48 * 128; i += NWAVES * 64) { const int row = i >> 7, ch = i & 127; *(LAS v4u*)(lds + row * 2064 + ch * 16) = *(const GAS v4u*)(wdt + (size_t)row * 1024 + ch * 8); }
                __syncthreads();
                const int fr = lane & 15, quad = lane >> 4;
                for (int blk = (bid - n6) * NWAVES + wave; blk < MP / 16; blk += (G - n6) * NWAVES) {
                    f32x4 a0 = {0.f, 0.f, 0.f, 0.f}, a1 = a0, a2 = a0;
                    const bf16* ap = act1k + (size_t)(16 * blk + fr) * 1024 + 8 * quad;
#pragma unroll 8
                    for (int ks = 0; ks < 32; ++ks) { const bf16x8 av = *(const GAS bf16x8*)(ap + 32 * ks);
                        const LAS unsigned char* bp = lds + fr * 2064 + (32 * ks + 8 * quad) * 2;
                        a0 = __builtin_amdgcn_mfma_f32_16x16x32_bf16(av, *(const LAS bf16x8*)(bp), a0, 0, 0, 0);
                        a1 = __builtin_amdgcn_mfma_f32_16x16x32_bf16(av, *(const LAS bf16x8*)(bp + 16 * 2064), a1, 0, 0, 0);
                        a2 = __builtin_amdgcn_mfma_f32_16x16x32_bf16(av, *(const LAS bf16x8*)(bp + 32 * 2064), a2, 0, 0, 0); }
#pragma unroll
                    for (int j = 0; j < 4; ++j) { float* op = dtga + (size_t)(16 * blk + 4 * quad + j) * DGW; op[fr] = a0[j]; op[16 + fr] = a1[j]; if (fr < 8) op[32 + fr] = a2[j]; }
                }
                __syncthreads();
            }
        }
        SEAM(pb + 1);
        if (IN(pb + 2)) { IDS(); MKMP();
            for (int item = gw; item < B_ * 129 * 6; item += NGW) {
                const int cg = item % 6, rr = (item / 6) % 129, b = item / (6 * 129), c = cg * 128 + 2 * lane, t0 = rr * 32;
                float w0[5], w1[5];
#pragma unroll
                for (int j = 0; j < 5; ++j) { w0[j] = mp.conv_w[j * XW + c]; w1[j] = mp.conv_w[j * XW + c + 1]; }
                const float b0 = mp.conv_b[c], b1 = mp.conv_b[c + 1];
                unsigned xin[36];
#pragma unroll
                for (int i = 0; i < 36; ++i) { const int t = t0 - 2 + i; xin[i] = (t >= 0 && t < L_) ? *(const GAS unsigned*)(big + (size_t)row_of(b, t) * PW + PX + c) : 0u; }
#pragma unroll
                for (int i = 0; i < 32; ++i) { const int t = t0 + i;
                    if (t < L_) { float a0 = b0, a1 = b1;
#pragma unroll
                        for (int j = 0; j < 5; ++j) { a0 += w0[j] * __uint_as_float(xin[i + j] << 16); a1 += w1[j] * __uint_as_float(xin[i + j] & 0xffff0000u); }
                        a0 = a0 / (1.0f + __expf(-a0)); a1 = a1 / (1.0f + __expf(-a1));
                        *(GAS unsigned*)(tmp + (size_t)row_of(b, t) * XW + c) = pk2(a0, a1); } }
            }
            const int half = lane >> 5, pi = lane & 31;
            const float inv = __builtin_amdgcn_exp2f(-(float)(pi & 15) * 0.8304820237218406f);
            const float qw0 = mp.qn_w[2 * pi], qw1 = mp.qn_w[2 * pi + 1], kw0 = mp.kn_w[2 * pi], kw1 = mp.kn_w[2 * pi + 1];
            for (int r = gw; r < NTOK; r += NGW) {
                const int t = r < NREG ? NM + (r % S_) : (r - NREG) % NM;
                const float pos = t < NM ? (float)(t - NM) : (pi < 16 ? (float)((t - NM) / 64) : (float)((t - NM) % 64));
                const float ang = pos * inv, cs = __cosf(ang), sn = __sinf(ang);
#pragma unroll
                for (int k = 0; k < 3; ++k) { const int slot = half + 2 * k;
                    GAS unsigned* px = (GAS unsigned*)(big + (size_t)r * PW + PAQ + slot * 64) + pi; const unsigned xv = *px;
                    const float x0 = __uint_as_float(xv << 16), x1 = __uint_as_float(xv & 0xffff0000u);
                    float ss = x0 * x0 + x1 * x1;
#pragma unroll
                    for (int o = 1; o < 32; o <<= 1) ss += __shfl_xor(ss, o);
                    const float rstd = 1.0f / sqrtf(ss * (1.0f / 64.0f) + 1e-6f);
                    const float sc = slot < 4 ? attn_body::C2 : 1.0f;
                    const float y0 = x0 * rstd * (slot < 4 ? qw0 : kw0), y1 = x1 * rstd * (slot < 4 ? qw1 : kw1);
                    *px = pk2((y0 * cs - y1 * sn) * sc, (y0 * sn + y1 * cs) * sc); }
            }
        }
        SEAM(pb + 2);
        if (IN(pb + 3)) { IDS(); MKMP();
#ifndef PROBE_ATT_REP
#define PROBE_ATT_REP 1
#endif
#ifndef PROBE_SWA_REP
#define PROBE_SWA_REP 1
#endif
#ifndef PROBE_SSD_REP
#define PROBE_SSD_REP 1
#endif
#ifndef PROBE_GLA_REP
#define PROBE_GLA_REP 1
#endif
#ifndef PROBE_MIX_REP
#define PROBE_MIX_REP 1
#endif
            for (int rep_ = 0; rep_ < PROBE_MIX_REP; ++rep_) {
            gu32* qc = (gu32*)(ws + WS_CTL) + CW_Q + l * 2048 + rep_ * 4096;
#define Q_POP(k) ({ __syncthreads(); if (tid == 0) MISC[16] = __hip_atomic_fetch_add(qc + 64 * (k), 1u, __ATOMIC_RELAXED, __HIP_MEMORY_SCOPE_AGENT); __syncthreads(); (int)MISC[16]; })
            for (;;) { const int u_ = Q_POP(0); if (u_ >= 64 * PROBE_SSD_REP) break; const int u = u_ & 63; const int b = u >> 3, h = (u >> 1) & 3, dir = u & 1;
                mix::ssd_stream(b, h, dir, tmp, dtga, mp.dt_bias[dir * 4 + h], -expf(mp.a_log[dir * 4 + h]), dir == 0 ? act1k : big + PX, dir == 0 ? 1024 : PW, (mix::lp)lds); }
            for (;;) { const int u_ = Q_POP(1); if (u_ >= 64 * PROBE_GLA_REP) break; const int u = u_ & 63; const int b = u >> 3, h = (u >> 1) & 3, dir = u & 1;
                mix::gla_stream(b, h, dir, big, dtga, mp.gate_w2, mp.gate_b, dir == 0 ? act1k + 256 : big + PB, dir == 0 ? 1024 : PW, (mix::lp)lds); }
            const int x0 = (int)(xb_xcc_id() & 7u), nmeta = l == 0 ? 2 : 0, nper = 64 + nmeta;
            for (int k = 0; k < 8; ++k) { const int q = (x0 + k) & 7;
                for (;;) { const int u_ = Q_POP(2 + q); if (u_ >= nper * PROBE_ATT_REP) break; const int u = u_ % nper;
                    const int r = u - nmeta, bg = 2 * q + (u < nmeta ? u : (r >> 5)), qb = u < nmeta ? -1 : (r & 31), b = bg >> 1, g = bg & 1;
                    attn_body::attn_unit<8, false>(b, qb, big + PAQ + g * 128, big + PAK + g * 64, big + PAV + g * 64, act1k + 768 + g * 128, (char*)lds_raw, nullptr, g); } }
            LAS float* btab = (LAS float*)(lds + 86016);
            __syncthreads();
            for (int i = tid; i < 4 * 259; i += NWAVES * 64) { const int h = i / 259, k = i % 259, rc = k - 129; btab[h * 264 + k] = (k == 0 || k == 258) ? -INFINITY : mp.rel_bias[t5_bucket(rc) * 4 + h] * 1.4426950408889634f; }
            if (tid < 4) btab[4 * 264 + tid] = mp.sink[tid] * 1.4426950408889634f;
            for (int k = 0; k < 8; ++k) { const int q = (x0 + k) & 7;
                for (;;) { const int u_ = Q_POP(10 + q); if (u_ >= nper * PROBE_SWA_REP) break; const int u = u_ % nper;
                    const int r = u - nmeta, bg = 2 * q + (u < nmeta ? u : (r >> 5)), qb = u < nmeta ? -1 : (r & 31), b = bg >> 1, g = bg & 1;
                    attn_body::attn_unit<8, true>(b, qb, big + PSQ + g * 128, big + PSK + g * 64, big + PSV + g * 64, act1k + 512 + g * 128, (char*)lds_raw, btab, g); } }
            }
#undef Q_POP
        }
        SEAM(pb + 3);
        if (IN(pb + 7)) { IDS(); MKMP();
            const f32x4 snw = *(const GAS f32x4*)(mp.ssd_norm_w + 4 * lane); const float dskv = mp.ssd_d[lane >> 4]; const f32x4 gnw = *(const GAS f32x4*)(mp.gla_norm_w + ((4 * lane) & 63));
#define BFX(q, j) __uint_as_float((unsigned)(((q) >> (16 * (j))) & 0xffffu) << 16)
            for (int r = gw; r < NTOK; r += 2 * NGW) { const int r2 = r + NGW < NTOK ? r + NGW : r; const int c0 = 4 * lane;
                unsigned long long yf[2], yb[2], xx[2], zz[2], of[2], ob[2], rr[2];
#pragma unroll
                for (int k = 0; k < 2; ++k) { const size_t rk = (size_t)(k == 0 ? r : r2);
                    yf[k] = *(const GAS unsigned long long*)(act1k + rk * 1024 + c0); yb[k] = *(const GAS unsigned long long*)(big + rk * PW + PX + c0);
                    xx[k] = *(const GAS unsigned long long*)(tmp + rk * XW + c0); zz[k] = *(const GAS unsigned long long*)(big + rk * PW + PZ + c0);
                    of[k] = *(const GAS unsigned long long*)(act1k + rk * 1024 + 256 + c0); ob[k] = *(const GAS unsigned long long*)(big + rk * PW + PB + c0); rr[k] = *(const GAS unsigned long long*)(big + rk * PW + PGR + c0); }
#pragma unroll
                for (int k = 0; k < 2; ++k) { const size_t rk = (size_t)(k == 0 ? r : r2);
                    float y[4]; float ss = 0.f;
#pragma unroll
                    for (int j = 0; j < 4; ++j) { const float zv = BFX(zz[k], j); y[j] = (BFX(yf[k], j) + BFX(yb[k], j) + dskv * BFX(xx[k], j)) * (zv / (1.0f + __expf(-zv))); ss += y[j] * y[j]; }
                    const float rstd = 1.0f / sqrtf(wave_sum(ss) * (1.0f / 256.0f) + 1e-6f);
                    float o[4]; float s2 = 0.f;
#pragma unroll
                    for (int j = 0; j < 4; ++j) { o[j] = BFX(of[k], j) + BFX(ob[k], j); s2 += o[j] * o[j]; }
#pragma unroll
                    for (int sh = 1; sh < 16; sh <<= 1) s2 += __shfl_xor(s2, sh);
                    const float rs2 = 1.0f / sqrtf(s2 * (1.0f / 64.0f) + 1e-6f);
                    float o4[4];
#pragma unroll
                    for (int j = 0; j < 4; ++j) { const float rv = BFX(rr[k], j); o4[j] = o[j] * rs2 * gnw[j] * (rv / (1.0f + __expf(-rv))); }
                    if (k == 0 || r2 != r) {
                        *(GAS unsigned long long*)(act1k + rk * 1024 + c0) = (unsigned long long)pk2(y[0] * rstd * snw.x, y[1] * rstd * snw.y) | ((unsigned long long)pk2(y[2] * rstd * snw.z, y[3] * rstd * snw.w) << 32);
                        *(GAS unsigned long long*)(act1k + rk * 1024 + 256 + c0) = (unsigned long long)pk2(o4[0], o4[1]) | ((unsigned long long)pk2(o4[2], o4[3]) << 32); } }
            }
#undef BFX
        }
        SEAM(pb + 7);
        if (IN(pb + 8)) { IDS();
            pg8::Gemm g{act1k, Wout + (size_t)l * 1024 * 1024, NREG, 1024, 1024}; pg8::StaticOrder S; S.init(NREG, 1024, G, bid);
            pg8::EpiResid<(l != 0)> E{l == 0 ? (const void*)INP(IN_X) : (const void*)hreg, (bf16*)hreg};
            pg8::gemm_phase<pg8::EpiResid<(l != 0)>, pg8::StaticOrder, true, true>(lds, g, S, E);
            if (l == 0) {
                const int fr = lane & 15, quad = lane >> 4;
                for (int task = gw; task < 8 * 32; task += NGW) { const int rb = task >> 5, cg = task & 31; f32x4 acc[2];
                    skinny_task<2>(act1k + (size_t)NREG * 1024, 1024, rb, Wout, cg * 32, 16, acc, lane);
#pragma unroll
                    for (int nb = 0; nb < 2; ++nb)
#pragma unroll
                        for (int j = 0; j < 4; ++j) { const int mr = 16 * rb + 4 * quad + j, c = cg * 32 + 16 * nb + fr; hmeta[(size_t)mr * 1024 + c] = INP(IN_META)[(size_t)(mr % 16) * 1024 + c] + acc[nb][j]; } }
            }
        }
        SEAM(pb + 8);
        if (l == 0) {
            for (int rep_ = 0; rep_ < PROBE_THIN_REP; ++rep_)
            if (IN(pb + 9)) { IDS();
                const float* w = INP(IN_NFFN); f32x4 wreg[4];
#pragma unroll
                for (int j = 0; j < 4; ++j) wreg[j] = ((const GAS f32x4*)w + lane)[64 * j];
                for (int r = gw; r < NREG; r += 2 * NGW) { const int r2 = r + NGW < NREG ? r + NGW : r;
                    rms_row2_to_bf16<true>((const bf16*)hreg + (size_t)r * HP, (const bf16*)hreg + (size_t)r2 * HP, wreg, act1k + (size_t)r * 1024, act1k + (size_t)r2 * 1024, lane, U8 + (size_t)r * 1024, U8 + (size_t)r2 * 1024, SA_U + r, SA_U + r2); }
                for (int r = NREG + gw; r < NTOK; r += NGW) { const float* s1 = hmeta + (size_t)(r - NREG) * 1024;
                    rms_row2_to_bf16(s1, s1, wreg, act1k + (size_t)r * 1024, act1k + (size_t)r * 1024, lane, U8 + (size_t)r * 1024, U8 + (size_t)r * 1024, SA_U + r, SA_U + r); }
                __syncthreads();
                { LAS float* scr = (LAS float*)(lds + wave * 16384);
                    quant_mat(INP(IN_FG), 1024, 2816, WGU8, SB_GU, CMAX_GU, 2, scr, gw, NGW, lane); quant_mat(INP(IN_FU), 1024, 2816, WGU8, SB_GU, CMAX_GU, 3, scr, gw, NGW, lane); }
            }
            SEAM(pb + 9);
#ifndef PROBE_FFNUP_REP
#define PROBE_FFNUP_REP 1
#endif
            for (int rep_ = 0; rep_ < PROBE_FFNUP_REP; ++rep_)
            if (IN(pb + 10)) { IDS();
                pg8::Gemm g{(const bf16*)U8, (const bf16*)WGU8, NREG, 5632, 512}; pg8::StaticOrder S; S.init(NREG, 5632, G, bid);
                pg8::EpiSwiGLU8 E{big, PW, 22, SA_U, SB_GU, 0, false};
                pg8::gemm_phase<pg8::EpiSwiGLU8, pg8::StaticOrder, true, true, false, false, true>(lds, g, S, E);
                { const int fr = lane & 15, quad = lane >> 4;
                    for (int task = gw; task < 8 * 176; task += NGW) { const int rb = task / 176, fg = task % 176, f0 = 16 * fg; f32x4 acc[2];
                        skinny_task<2>(act1k + (size_t)NREG * 1024, 1024, rb, Wgu, (f0 >> 7) * 256 + (f0 & 127), 128, acc, lane);
#pragma unroll
                        for (int j = 0; j < 4; ++j) { const float gg = acc[0][j], uu = acc[1][j]; big[(size_t)(NREG + 16 * rb + 4 * quad + j) * PW + f0 + fr] = f2bf(gg / (1.0f + __expf(-gg)) * uu); } } }
            }
            SEAM(pb + 10);
#ifndef PROBE_FFND_REP
#define PROBE_FFND_REP 1
#endif
            if (IN(pb + 11)) { IDS();
                pg8::Gemm g{big, Wd, NREG, 1024, 2816}; pg8::StaticOrder S; S.init(NREG, 1024, G, bid);
                for (int rep_ = 0; rep_ < PROBE_FFND_REP; ++rep_) {
                pg8::EpiResid<true> E{hreg, (bf16*)hreg, rep_ + 1 < PROBE_FFND_REP ? 0.0f : 1.0f};
                pg8::gemm_phase<pg8::EpiResid<true>, pg8::StaticOrder, true, true>(lds, g, S, E); }
                { const int fr = lane & 15, quad = lane >> 4;
                    for (int task = gw; task < 8 * 64; task += NGW) { const int rb = task >> 6, cb = task & 63; f32x4 acc[1];
                        skinny_task<1>(big + (size_t)NREG * PW, PW, rb, Wd, cb * 16, 0, acc, lane);
#pragma unroll
                        for (int j = 0; j < 4; ++j) { float* hp = hmeta + (size_t)(16 * rb + 4 * quad + j) * 1024 + cb * 16 + fr; *hp += acc[0][j]; } } }
            }
            SEAM(pb + 11);
        } else {
            for (int rep_ = 0; rep_ < PROBE_THIN_REP; ++rep_)
            if (IN(pb + 9)) { IDS();
                const float* w = INP(IN_NFFN) + 1024; const float* rw = INP(IN_ROUTER);
                LAS int* lcnt = (LAS int*)lds;
                f32x4 nwr[4];
#pragma unroll
                for (int j = 0; j < 4; ++j) nwr[j] = ((const GAS f32x4*)w + lane)[64 * j];
                f32x4 rwr[4][4][2];
#pragma unroll
                for (int j = 0; j < 4; ++j)
#pragma unroll
                    for (int c = 0; c < 4; ++c) { const GAS f32x4* rp = (const GAS f32x4*)(rw + (size_t)(4 * lane + 256 * j + c) * 8); rwr[j][c][0] = rp[0]; rwr[j][c][1] = rp[1]; }
                if (tid < 16) lcnt[tid] = 0;
                __syncthreads();
                for (int r0 = gw; r0 < NREG; r0 += 2 * NGW) {
                    f32x4 v[2][4];
#pragma unroll
                    for (int q = 0; q < 2; ++q) { const int r = r0 + q * NGW < NREG ? r0 + q * NGW : r0; const GAS unsigned long long* xr = (const GAS unsigned long long*)((const bf16*)hreg + (size_t)r * HP) + lane;
#pragma unroll
                        for (int j = 0; j < 4; ++j) v[q][j] = bf4_f32(xr[64 * j]); }
#pragma unroll
                    for (int q = 0; q < 2; ++q) { const int r = r0 + q * NGW;
                        if (r < NREG) {
                            float s = 0.f;
#pragma unroll
                            for (int j = 0; j < 4; ++j) s += (v[q][j].x * v[q][j].x + v[q][j].y * v[q][j].y) + (v[q][j].z * v[q][j].z + v[q][j].w * v[q][j].w);
                            const float rstd = 1.f / sqrtf(wave_sum(s) * (1.f / 1024.f) + 1e-6f);
                            float lg[8];
#pragma unroll
                            for (int e = 0; e < 8; ++e) lg[e] = 0.f;
                            float umx = 0.f;
#pragma unroll
                            for (int j = 0; j < 4; ++j) { const f32x4 ww = nwr[j]; const f32x4 uu = v[q][j] * rstd * ww; umx = fmaxf(fmaxf(umx, fmaxf(fabsf(uu.x), fabsf(uu.y))), fmaxf(fabsf(uu.z), fabsf(uu.w))); }
#pragma unroll
                            for (int o = 1; o < 64; o <<= 1) umx = fmaxf(umx, __shfl_xor(umx, o));
                            const float uqs = umx > 0.f ? 127.0f / umx : 0.f; if (lane == 0) SA_U[r] = umx * (1.0f / 127.0f);
#pragma unroll
                            for (int j = 0; j < 4; ++j) { const f32x4 ww = nwr[j]; const f32x4 uu = v[q][j] * rstd * ww;
                                *((GAS unsigned*)(U8 + (size_t)r * 1024) + lane + 64 * j) = ((unsigned)((int)rintf(uu.x * uqs)) & 0xffu) | (((unsigned)((int)rintf(uu.y * uqs)) & 0xffu) << 8) | (((unsigned)((int)rintf(uu.z * uqs)) & 0xffu) << 16) | (((unsigned)((int)rintf(uu.w * uqs)) & 0xffu) << 24);
#pragma unroll
                                for (int c = 0; c < 4; ++c) { const f32x4 r0_ = rwr[j][c][0], r1_ = rwr[j][c][1]; const float uc = uu[c];
                                    lg[0] += uc * r0_.x; lg[1] += uc * r0_.y; lg[2] += uc * r0_.z; lg[3] += uc * r0_.w; lg[4] += uc * r1_.x; lg[5] += uc * r1_.y; lg[6] += uc * r1_.z; lg[7] += uc * r1_.w; } }
                            const bool h5 = lane & 32, h4 = lane & 16, h3 = lane & 8; float a4[4], b2[2], c1;
#pragma unroll
                            for (int k = 0; k < 4; ++k) a4[k] = (h5 ? lg[4 + k] : lg[k]) + __shfl_xor(h5 ? lg[k] : lg[4 + k], 32);
#pragma unroll
                            for (int k = 0; k < 2; ++k) b2[k] = (h4 ? a4[2 + k] : a4[k]) + __shfl_xor(h4 ? a4[k] : a4[2 + k], 16);
                            c1 = (h3 ? b2[1] : b2[0]) + __shfl_xor(h3 ? b2[0] : b2[1], 8);
                            c1 += __shfl_xor(c1, 4); c1 += __shfl_xor(c1, 2); c1 += __shfl_xor(c1, 1);
#pragma unroll
                            for (int e = 0; e < 8; ++e) lg[e] = __shfl(c1, ((e & 4) ? 32 : 0) + ((e & 2) ? 16 : 0) + ((e & 1) ? 8 : 0));
                            int i0 = 0; float v0 = lg[0];
#pragma unroll
                            for (int e = 1; e < 8; ++e) if (lg[e] > v0) { v0 = lg[e]; i0 = e; }
                            int i1 = -1; float v1 = -3.0e38f;
#pragma unroll
                            for (int e = 0; e < 8; ++e) if (e != i0 && lg[e] > v1) { v1 = lg[e]; i1 = e; }
                            if (lane == 0) { const float g1 = 1.0f / (1.0f + __expf(v0 - v1)); const int k0 = __hip_atomic_fetch_add(lcnt + i0, 1, __ATOMIC_RELAXED, __HIP_MEMORY_SCOPE_WORKGROUP), k1 = __hip_atomic_fetch_add(lcnt + 8 + i1, 1, __ATOMIC_RELAXED, __HIP_MEMORY_SCOPE_WORKGROUP);
                                rt_e[r] = i0 | (i1 << 8); rt_rank[r] = k0 | (k1 << 16); rt_g[2 * r] = 1.0f - g1; rt_g[2 * r + 1] = g1; }
                        } }
                }
                __syncthreads();
                if (tid < 16) blkcnt[bid * 16 + tid] = lcnt[tid];
            }
            SEAM(pb + 9);
#ifndef PROBE_SORT_REP
#define PROBE_SORT_REP 1
#endif
            for (int rep_ = 0; rep_ < PROBE_SORT_REP; ++rep_)
            if (IN(PH_SORT)) { IDS();
                LAS int* tot = (LAS int*)lds; LAS int* pre = tot + 16; LAS int* roff = tot + 32; LAS int* ntl = tot + 48;
                if (tid < 64) tot[tid] = 0;
                __syncthreads();
                { const int sgm = tid & 15, part = tid >> 4; int a = 0, bfore = 0;
                    for (int k = 0; k < 8; ++k) { const int wgi = part * 8 + k; if (wgi < G) { const int cv = blkcnt[wgi * 16 + sgm]; a += cv; if (wgi < bid) bfore += cv; } }
                    __hip_atomic_fetch_add(tot + sgm, a, __ATOMIC_RELAXED, __HIP_MEMORY_SCOPE_WORKGROUP); __hip_atomic_fetch_add(pre + sgm, bfore, __ATOMIC_RELAXED, __HIP_MEMORY_SCOPE_WORKGROUP); }
                __syncthreads();
                if (tid == 0) {
                    int tile = 0, T0 = 0;
                    for (int sg = 0; sg < 16; ++sg) { const int nt = (tot[sg] + 255) >> 8; roff[sg] = tile * 256; ntl[sg] = nt; if (bid == 0) for (int k = 0; k < nt; ++k) texp[tile + k] = sg & 7; tile += nt; if (sg == 7) T0 = tile; }
                    if (bid == 0) { const int T1 = tile - T0;
                        int p1 = T0 >= 64 && T0 - 64 <= CAP_TILES ? 64 : (T0 + 1) / 2, p2 = T1 >= 64 && T1 - 64 <= CAP_TILES ? T1 - 64 : (T1 + 1) / 2;
                        passt[0] = 0; passt[1] = p1; passt[2] = T0; passt[3] = T0 + p2; passt[4] = tile; }
                }
                __syncthreads();
                if (bid < 16) { const int b0 = roff[bid] + tot[bid], b1 = roff[bid] + ntl[bid] * 256; for (int i = b0 + tid; i < b1; i += NWAVES * 64) { stok[i] = -1; stokp[permp(i)] = -1; sgate[i] = 0.f; ssa[i] = 0.f; } }
                for (int k = lane; gw + k * NGW < NREG; k += 64) { const int r = gw + k * NGW;
                    { const int e = rt_e[r], rk = rt_rank[r]; const int e0 = e & 255, e1 = 8 + (e >> 8);
                        const int p0 = roff[e0] + pre[e0] + (rk & 0xffff), p1 = roff[e1] + pre[e1] + (rk >> 16);
                        const float sar = SA_U[r];
                        stok[p0] = r; stokp[permp(p0)] = r; sgate[p0] = rt_g[2 * r]; ssa[p0] = sar; stok[p1] = r; stokp[permp(p1)] = r; sgate[p1] = rt_g[2 * r + 1]; ssa[p1] = sar; } }
#ifndef PROBE_IDENT
#define PROBE_IDENT 0
#endif
                if (PROBE_IDENT) for (long i = gtid; i < MAX_SROWS; i += (long)G * NWAVES * 64) ((int*)(ws + WS_DTGA))[i] = (int)(i & 32767);
                __syncthreads();
            }
            SEAM(PH_SORT);
#ifndef PROBE_DK_HALF
#define PROBE_DK_HALF 0
#endif
#ifndef PROBE_MOE_REP
#define PROBE_MOE_REP 1
#endif
#pragma unroll 1
            for (int p_ = 0; p_ < 5 * PROBE_MOE_REP; ++p_) { const int p = p_ % 5; const float gscale_ = p_ < 5 * (PROBE_MOE_REP - 1) ? 0.0f : 1.0f;
                OPAQUE_RANGE();
                if (IN(PH_PASS0 + p)) { IDS();
                    int nd = 0;
                    LAS int* lexd = (LAS int*)(lds + 139264); LAS int* lexg = lexd + 128;
                    if (p > 0) { const int t0 = passt[p - 1], n = passt[p] - t0; if (tid < n) lexd[tid] = texp[t0 + tid]; }
                    if (p < 4) { const int t0 = passt[p], n = passt[p + 1] - t0; if (tid < n) lexg[tid] = texp[t0 + tid]; }
                    __syncthreads();
                    if (p > 0) {
                        const int t0 = passt[p - 1], t1 = passt[p]; nd = (t1 - t0) * 4;
                        pg8::Gemm g{(const bf16*)(ws + WS_BIG + (size_t)((p - 1) & 1) * MOE_ACT_BYTES), (const bf16*)WMD8, CAP_TILES * 256, 8 * 1024, (PROBE_DK_HALF && gscale_ == 0.0f) ? 896 : 1792}; pg8::MoeOrder S{t0, t1 - t0, 4, G, bid, 0, lexd, stok, t0 * 256};
                        pg8::EpiMoeDown E{p >= 3 ? Y1LO : YLO, p >= 3 ? (long)(Y1HI - Y1LO) : (long)(YHI - YLO), stok, sgate, t0 * 256, gscale_ * f8_scale(*AMAX_MD, true)};
                        pg8::gemm_phase<pg8::EpiMoeDown, pg8::MoeOrder, true, true, false, true, false, true>(lds, g, S, E);
                    }
                    if (p < 4) {
                        const int t0 = passt[p], t1 = passt[p + 1];
                        pg8::Gemm g{(const bf16*)U8, (const bf16*)WMGU8, NREG, 8 * 7168, 512}; pg8::MoeOrder S{t0, t1 - t0, 28, G, bid, nd > G ? nd - G : 0, lexg, stok, t0 * 256, stokp};
                        pg8::EpiSwiGLU8 E{(bf16*)(ws + WS_BIG + (size_t)(p & 1) * MOE_ACT_BYTES), 3584, 28, ssa, SB_MGU, t0 * 256, true};
                        pg8::gemm_phase<pg8::EpiSwiGLU8, pg8::MoeOrder, true, true, true, false, true>(lds, g, S, E);
                    }
                }
                SEAM(PH_PASS0 + p);
            }
#ifndef PROBE_BAR_REP
#define PROBE_BAR_REP 0
#endif
            for (int rep_ = 0; rep_ < PROBE_BAR_REP; ++rep_) xcd_barrier_lean(bar);
            if (IN(PH_FINAL)) { IDS();
                const float* w = INP(IN_FINAL); f32x4 fwr[4];
#pragma unroll
                for (int j = 0; j < 4; ++j) fwr[j] = ((const GAS f32x4*)w + lane)[64 * j];
                for (int r = gw; r < NREG; r += 2 * NGW) { const int r2 = r + NGW < NREG ? r + NGW : r;
                    GAS f32x4* xa = (GAS f32x4*)(hreg + (size_t)r * 1024) + lane; GAS f32x4* xb = (GAS f32x4*)(hreg + (size_t)r2 * 1024) + lane;
                    f32x4 va[4], vb[4]; float sa = 0.f, sb = 0.f;
                    { const GAS unsigned long long* ha = (const GAS unsigned long long*)((const bf16*)hreg + (size_t)r * HP) + lane; const GAS unsigned long long* hb_ = (const GAS unsigned long long*)((const bf16*)hreg + (size_t)r2 * HP) + lane;
#pragma unroll
                    for (int j = 0; j < 4; ++j) { va[j] = bf4_f32(ha[64 * j]); vb[j] = bf4_f32(hb_[64 * j]); } }
#pragma unroll
                    for (int sl = 0; sl < 2; ++sl)
#pragma unroll
                    for (int j = 0; j < 4; ++j) { const bf16* yb_ = sl == 0 ? (j < 2 ? YLO : YHI) : (j < 2 ? Y1LO : Y1HI); const int cy = 4 * lane + 256 * (j & 1);
                        const unsigned long long qa = *(const GAS unsigned long long*)(yb_ + (size_t)r * 512 + cy), qb = *(const GAS unsigned long long*)(yb_ + (size_t)r2 * 512 + cy);
                        va[j].x += __uint_as_float((unsigned)qa << 16); va[j].y += __uint_as_float((unsigned)qa & 0xffff0000u); va[j].z += __uint_as_float((unsigned)(qa >> 32) << 16); va[j].w += __uint_as_float((unsigned)(qa >> 32) & 0xffff0000u);
                        vb[j].x += __uint_as_float((unsigned)qb << 16); vb[j].y += __uint_as_float((unsigned)qb & 0xffff0000u); vb[j].z += __uint_as_float((unsigned)(qb >> 32) << 16); vb[j].w += __uint_as_float((unsigned)(qb >> 32) & 0xffff0000u); }
#pragma unroll
                    for (int j = 0; j < 4; ++j) { sa += (va[j].x * va[j].x + va[j].y * va[j].y) + (va[j].z * va[j].z + va[j].w * va[j].w); sb += (vb[j].x * vb[j].x + vb[j].y * vb[j].y) + (vb[j].z * vb[j].z + vb[j].w * vb[j].w); }
                    const float ra = 1.f / sqrtf(wave_sum_sw(sa) * (1.f / 1024.f) + 1e-6f), rb = 1.f / sqrtf(wave_sum_sw(sb) * (1.f / 1024.f) + 1e-6f);
#pragma unroll
                    for (int j = 0; j < 4; ++j) { const f32x4 ww = fwr[j]; xa[64 * j] = va[j] * ra * ww; if (r2 != r) xb[64 * j] = vb[j] * rb * ww; }
                }
            }
        }
    }
    }

#undef IN
#undef SEAM
}

extern "C" void kernel_launch(void* const* d_in, const int* in_sizes, int n_in, void* d_out, int out_size, void* d_ws, size_t ws_size, hipStream_t stream) {
    static int grid = 0;
    if (grid == 0) {
        if (n_in != 27 || ws_size < WS_END || out_size != NREG * 1024) { fprintf(stderr, "kernel_launch: unexpected problem (n_in %d, ws %zu, out %d)\n", n_in, ws_size, out_size); grid = -1; return; }
        int dev = 0, cus = 0;
        if (hipGetDevice(&dev) != hipSuccess || hipDeviceGetAttribute(&cus, hipDeviceAttributeMultiprocessorCount, dev) != hipSuccess) { grid = -1; return; }
        if (hipFuncSetAttribute((const void*)fwd_kernel, hipFuncAttributeMaxDynamicSharedMemorySize, LDS_BYTES) != hipSuccess) { fprintf(stderr, "kernel_launch: hipFuncSetAttribute failed\n"); grid = -1; return; }
        int per_cu = 0;
        if (hipOccupancyMaxActiveBlocksPerMultiprocessor(&per_cu, (const void*)fwd_kernel, NWAVES * 64, LDS_BYTES) != hipSuccess || per_cu < 1) fprintf(stderr, "kernel_launch: occupancy query reports %d workgroups per CU\n", per_cu);
        (void)hipGetLastError();
        grid = cus;
    }
    if (grid < 0) return;
    (void)hipMemsetAsync((char*)d_ws + WS_CTL, 0, CTL_ZERO_BYTES, stream);
    Args a{};
    for (int i = 0; i < 27; ++i) a.in[i] = (const float*)d_in[i];
    a.out = (float*)d_out; a.ws = (unsigned char*)d_ws;
#if N_LAUNCH_MODE == 1
    a.ph_lo = 0; a.ph_hi = PH_END;
    hipLaunchKernelGGL(fwd_kernel, dim3(grid), dim3(NWAVES * 64), LDS_BYTES, stream, a);
#else
    for (int ph = 0; ph < PH_END; ++ph) {
        const bool used = ph == 0 || (ph >= PH_L0 && ph < PH_L0 + 12) || (ph >= PH_L1 && ph < PH_L1 + 10) || ph >= PH_SORT;
        if (!used) continue;
        a.ph_lo = ph; a.ph_hi = ph + 1;
        hipLaunchKernelGGL(fwd_kernel, dim3(grid), dim3(NWAVES * 64), LDS_BYTES, stream, a);
    }
#endif
}
```

```cpp
#include <hip/hip_runtime.h>
#include <cstdio>
#include <cstdint>
#include <cmath>
#define HD_INLINE __device__ __forceinline__
#ifndef CFG_BATCH
#define CFG_BATCH 8
#endif
#ifndef CFG_SEQ
#define CFG_SEQ 4096
#endif
constexpr int B_ = CFG_BATCH, S_ = CFG_SEQ, NM = 16, L_ = S_ + NM;
constexpr int NREG = B_ * S_, NTOK = NREG + B_ * NM, MP = ((NTOK + 255) / 256) * 256;
constexpr int PW = 2816;
constexpr int PZ = 0, PX = 256, PB = 512, PC = 768, PGQ = 1024, PGK = 1152, PGV = 1280, PGR = 1536, PSQ = 1792, PSK = 2048, PSV = 2176, PAQ = 2304, PAK = 2560, PAV = 2688;
constexpr int DGW = 64;
constexpr int XW = 768;
typedef unsigned short bf16;

#ifdef __HIP_DEVICE_COMPILE__
#define FAST_COS(x) __cosf(x)
#define FAST_SIN(x) __sinf(x)
#else
#define FAST_COS(x) cosf(x)
#define FAST_SIN(x) sinf(x)
#endif
#define ROPE_INV(j) __builtin_exp2f(-(float)(j) * 0.8304820237218406f)
HD_INLINE int row_of(int b, int t) { return t < NM ? NREG + b * NM + t : b * S_ + (t - NM); }
HD_INLINE float bf2f(bf16 v) { unsigned u = ((unsigned)v) << 16; float f; __builtin_memcpy(&f, &u, 4); return f; }
HD_INLINE bf16 f2bf(float f) { unsigned u; __builtin_memcpy(&u, &f, 4); return (bf16)((u + 0x7fffu + ((u >> 16) & 1u)) >> 16); }
HD_INLINE float siluf(float x) { return x / (1.0f + expf(-x)); }
HD_INLINE float softplusf(float x) { return x > 20.f ? x : log1pf(expf(x)); }
HD_INLINE float logsigmoidf(float x) { return x >= 0.f ? -log1pf(expf(-x)) : x - log1pf(expf(x)); }
HD_INLINE int t5_bucket(int rel) {
    const int a = rel < 0 ? -rel : rel, base = rel > 0 ? 16 : 0;
    if (a < 8) return base + a;
    const int k = (a >= 12) + (a >= 16) + (a >= 23) + (a >= 32) + (a >= 46) + (a >= 64) + (a >= 91);
    return base + 8 + k;
}

struct MixParams {
    const float *conv_w, *conv_b, *dt_bias, *a_log, *ssd_d, *ssd_norm_w, *gate_w2, *gate_b, *gla_norm_w, *sink, *qn_w, *kn_w, *rel_bias;
};
struct MixBuf { bf16* proj; const float* dtga; bf16* xbca; bf16* mixed; };

HD_INLINE void nv_conv(const MixBuf& m, const MixParams& p, long gtid, long nthreads) {
    for (long idx = gtid; idx < (long)B_ * L_ * XW; idx += nthreads) {
        const int c = (int)(idx % XW); const long bt = idx / XW; const int t = (int)(bt % L_), b = (int)(bt / L_);
        float acc = p.conv_b[c];
        for (int j = 0; j < 5; ++j) { const int tt = t + j - 2; if (tt >= 0 && tt < L_) acc += p.conv_w[j * XW + c] * bf2f(m.proj[(size_t)row_of(b, tt) * PW + PX + c]); }
        m.xbca[(size_t)row_of(b, t) * XW + c] = f2bf(siluf(acc));
    }
}

namespace pg8 {
#define PG8_LAS __attribute__((address_space(3)))
typedef unsigned short bf16_t;
typedef short bf16x8 __attribute__((ext_vector_type(8)));
typedef float f32x4 __attribute__((ext_vector_type(4)));
typedef unsigned u32x4 __attribute__((ext_vector_type(4)));
constexpr int BM = 256, BK = 64, HALF = 128, HTB = HALF * BK * 2  , STAGE_BYTES = 8 * HTB, NXCD = 8, WGM = 8;

__host__ __device__ __forceinline__ int lds_byte(int r, int c) { const int st = (r >> 4) * 2 + (c >> 5), rr = r & 15, cc = c & 31, ob = rr * 64 + cc * 2; return st * 1024 + (ob ^ (((ob >> 9) & 1) << 5)); }
__host__ __device__ __forceinline__ void stage_rc(int b, int& R, int& C) { const int st = b / 1024, sb = b % 1024, swz = sb ^ (((sb >> 9) & 1) << 5); R = (st >> 1) * 16 + swz / 64; C = (st & 1) * 32 + (swz % 64) / 2; }
__host__ __device__ __forceinline__ int perm32(int rho) { const int n = rho >> 4, i = rho & 15; return 8 * (i >> 2) + 4 * n + (i & 3); }

struct Unit { int pm, pn; };
struct Gemm { const bf16_t* A; const bf16_t* Bt; int M, N, K; };

struct StaticOrder {
    int nM, nN, nwg, G, c;
    __host__ __device__ void init(int M, int N, int G_, int c_) { nM = M / BM; nN = N / BM; nwg = nM * nN; G = G_; c = c_; }
    __host__ __device__ bool next(int i, Unit& u) const {
        const long L = (long)i * G + c; if (L >= nwg) return false;
        int wgid = (int)L; { const int q = nwg / NXCD, r = nwg % NXCD, xcd = wgid % NXCD, off = wgid / NXCD; wgid = (xcd < r ? xcd * (q + 1) : r * (q + 1) + (xcd - r) * q) + off; }
        const int nig = WGM * nN, gid = wgid / nig, fm = gid * WGM, gsz = (nM - fm) < WGM ? (nM - fm) : WGM;
        u.pm = fm + ((wgid % nig) % gsz); u.pn = (wgid % nig) / gsz; return true;
    }
    __device__ __forceinline__ void a_ready(const Unit&) const {}
    __device__ __forceinline__ void done(const Unit&) const {}
};

__device__ __forceinline__ unsigned cvt_pk_bf16(float lo, float hi) { unsigned r; asm volatile("v_cvt_pk_bf16_f32 %0, %1, %2" : "=v"(r) : "v"(lo), "v"(hi)); return r; }
typedef float f32x2 __attribute__((ext_vector_type(2)));
__device__ __forceinline__ f32x2 gelu_pk(f32x2 v) {
    const f32x2 av = __builtin_elementwise_abs(v), d = av * 0.2316418882f + 1.0f;
    f32x2 t; t.x = __builtin_amdgcn_rcpf(d.x); t.y = __builtin_amdgcn_rcpf(d.y);
    f32x2 q = t * 0.5307027145f + (-0.7265760135f); q = q * t + 0.7107068705f; q = q * t + (-0.142248368f); q = q * t + 0.127414796f; q = q * t;
    const f32x2 s = (v * v) * (-0.72134752044f);
    f32x2 e; e.x = __builtin_amdgcn_exp2f(s.x); e.y = __builtin_amdgcn_exp2f(s.y);
    const f32x2 m = v * (q * e), r = v - m;
    f32x2 o; o.x = v.x < 0.f ? m.x : r.x; o.y = v.y < 0.f ? m.y : r.y; return o;
}

template <int ACT  > struct EpiBf16 {
    static constexpr bool PERM = true, AFTER_DRAIN = false; static_assert(ACT == 0 || ACT == 1, "EpiBf16: ACT is 0 (none) or 1 (gelu_pk)");
    bf16_t* O; int ldc; const float* bias; int split_cols; size_t split_stride; float scale0;
    __device__ __forceinline__ void operator()(const f32x4 (&acc)[2][2][4][2], const Unit& u, int wr, int wc, int fr, int fq) const {
        const int row0 = u.pm * BM + wr * 64 + fr; int colt = u.pn * BM; bf16_t* base = O;
        float sc = 1.f; if (split_cols) { const int t = colt / split_cols; base += (size_t)t * split_stride; colt -= t * split_cols; if (t == 0) sc = scale0; }
        const int col0 = colt + wc * 32 + 8 * fq, bcol0 = u.pn * BM + wc * 32 + 8 * fq;
        f32x4 bv[2][2];
#pragma unroll
        for (int bj = 0; bj < 2; ++bj)
#pragma unroll
            for (int n = 0; n < 2; ++n) bv[bj][n] = bias ? *(const f32x4*)(bias + bcol0 + bj * HALF + 4 * n) : (f32x4){0.f, 0.f, 0.f, 0.f};
#pragma unroll
        for (int ai = 0; ai < 2; ++ai)
#pragma unroll
            for (int m = 0; m < 4; ++m) { bf16_t* rowp = base + (size_t)(row0 + ai * HALF + m * 16) * ldc + col0;
#pragma unroll
                for (int bj = 0; bj < 2; ++bj) { f32x4 v0 = acc[ai][bj][m][0] + bv[bj][0], v1 = acc[ai][bj][m][1] + bv[bj][1];
                    if (ACT == 1) { f32x2 a = gelu_pk((f32x2){v0[0], v0[1]}), b = gelu_pk((f32x2){v0[2], v0[3]}), c = gelu_pk((f32x2){v1[0], v1[1]}), d = gelu_pk((f32x2){v1[2], v1[3]});
                        v0 = (f32x4){a.x, a.y, b.x, b.y}; v1 = (f32x4){c.x, c.y, d.x, d.y}; }
                    v0 = v0 * sc; v1 = v1 * sc; u32x4 w; w.x = cvt_pk_bf16(v0[0], v0[1]); w.y = cvt_pk_bf16(v0[2], v0[3]); w.z = cvt_pk_bf16(v1[0], v1[1]); w.w = cvt_pk_bf16(v1[2], v1[3]);
                    *(u32x4*)(rowp + bj * HALF) = w; } }
    }
};

typedef int i32x4 __attribute__((ext_vector_type(4)));
template <bool I8> struct AccT { typedef f32x4 type; };
template <> struct AccT<true> { typedef i32x4 type; };
template <bool I8> __device__ __forceinline__ typename AccT<I8>::type mma1(bf16x8 b, bf16x8 a, typename AccT<I8>::type c) {
    if constexpr (I8) return __builtin_amdgcn_mfma_i32_16x16x64_i8(__builtin_bit_cast(i32x4, b), __builtin_bit_cast(i32x4, a), c, 0, 0, 0);
    else return __builtin_amdgcn_mfma_f32_16x16x32_bf16(b, a, c, 0, 0, 0);
}
typedef int i32x8 __attribute__((ext_vector_type(8)));
template <bool I8, bool F8> __device__ __forceinline__ typename AccT<I8>::type mma2(bf16x8 b0, bf16x8 b1, bf16x8 a0, bf16x8 a1, typename AccT<I8>::type c) {
    if constexpr (F8) { const i32x4 B0 = __builtin_bit_cast(i32x4, b0), B1 = __builtin_bit_cast(i32x4, b1), A0 = __builtin_bit_cast(i32x4, a0), A1 = __builtin_bit_cast(i32x4, a1);
        const i32x8 B = {B0.x, B0.y, B0.z, B0.w, B1.x, B1.y, B1.z, B1.w}, A = {A0.x, A0.y, A0.z, A0.w, A1.x, A1.y, A1.z, A1.w};
        return __builtin_amdgcn_mfma_scale_f32_16x16x128_f8f6f4(B, A, c, 0, 0, 0, 0, 0, 0); }
    else { c = mma1<I8>(b0, a0, c); return mma1<I8>(b1, a1, c); }
}
struct EpiPreNone {}; struct EpiPreI { int i[2][4]; };
struct EpiPreS { unsigned long long q[2]; float f[2]; };
template <class Epi, class Sched, bool ALIGN_EPI = false, bool SP2 = false, bool GATHER = false, bool TILED = false, bool I8 = false, bool F8 = false>
__device__ __forceinline__ void gemm_phase(PG8_LAS unsigned char* lds, const Gemm g, const Sched& S, const Epi& E) {
    int tid = threadIdx.x; asm volatile("" : "+v"(tid));
    const int wid = __builtin_amdgcn_readfirstlane(tid >> 6), lane = tid & 63, wr = wid >> 2, wc = wid & 3, fr = lane & 15, fq = lane >> 4;
    const int K = g.K, nt = K / BK;
    PG8_LAS float* const xl = (PG8_LAS float*)(lds + 144384 + wid * 1024);
    unsigned voffA, voffB;
    { int R, C; stage_rc(tid * 16, R, C); const int Rb = Epi::PERM ? ((R & ~31) + perm32(R & 31)) : R;
        voffA = (unsigned)(R * (TILED ? 64 : K) + C) * 2u; voffB = (unsigned)(Rb * (TILED ? 64 : K) + C) * 2u; }
    const size_t vstep = (size_t)64 * (TILED ? 64 : K) * 2;
    static_assert(!(GATHER && TILED), "gathered rows are row-major");
    static_assert(!GATHER || SP2, "the gathered A path is written for the SP2 loop");
    unsigned vgc[2][2] = {{0u, 0u}, {0u, 0u}}, vgn[2][2] = {{0u, 0u}, {0u, 0u}};
    const char* const A0 = (const char*)g.A;
#define PG8_GLOAD(dst, unit) do { _Pragma("unroll") for (int h_ = 0; h_ < 2; ++h_) _Pragma("unroll") for (int i_ = 0; i_ < 2; ++i_) { int R_, C_; stage_rc(tid * 16 + i_ * 8192, R_, C_); \
        int tk_ = S.ridx[S.row_base + (unit).pm * BM + h_ * HALF + R_]; tk_ = tk_ < 0 ? 0 : tk_; dst[h_][i_] = (unsigned)(tk_ * K + C_) * 2u; } } while (0)
#define PG8_STAGE_G(bufoff, gb, o0, o1) do { __builtin_amdgcn_global_load_lds((const unsigned*)((gb) + (o0)), (PG8_LAS unsigned*)(lds + (bufoff) + ldsw), 16, 0, 0); \
        __builtin_amdgcn_global_load_lds((const unsigned*)((gb) + (o1)), (PG8_LAS unsigned*)(lds + (bufoff) + ldsw + 8192), 16, 0, 0); } while (0)
    const size_t kstep = TILED ? (size_t)(BM * BK * 2) : (size_t)(BK * 2);
    const size_t hstep = TILED ? (size_t)(HALF * BK * 2) : (size_t)HALF * K * 2;
    const size_t tstep = (size_t)BM * K * 2;
    const unsigned ldsw = (unsigned)wid * 1024u;
    const int aoff = lds_byte(wr * 64 + fr, fq * 8), boff = lds_byte(wc * 32 + fr, fq * 8);
#define PG8_SA(b, h) (((b) * 2 + (h)) * HTB)
#define PG8_SB(b, h) ((4 + (b) * 2 + (h)) * HTB)
#define PG8_STAGE(bufoff, gbase, voff) do { _Pragma("unroll") for (int _i = 0; _i < 2; ++_i) \
        __builtin_amdgcn_global_load_lds((const unsigned*)((const char*)(gbase) + _i * vstep + (voff)), (PG8_LAS unsigned*)(lds + (bufoff) + ldsw + _i * 8192), 16, 0, 0); } while (0)
#define PG8_LDA(dst, b, h) do { _Pragma("unroll") for (int m = 0; m < 4; ++m) _Pragma("unroll") for (int k = 0; k < 2; ++k) dst[m][k] = *(const PG8_LAS bf16x8*)(lds + PG8_SA(b, h) + aoff + m * 2048 + k * 1024); } while (0)
#define PG8_LDB(dst, b, h) do { _Pragma("unroll") for (int n = 0; n < 2; ++n) _Pragma("unroll") for (int k = 0; k < 2; ++k) dst[n][k] = *(const PG8_LAS bf16x8*)(lds + PG8_SB(b, h) + boff + n * 2048 + k * 1024); } while (0)
#define PG8_MMA(ai, bj, At, Bt) do { __builtin_amdgcn_s_setprio(1); _Pragma("unroll") for (int m = 0; m < 4; ++m) _Pragma("unroll") for (int n = 0; n < 2; ++n) \
        acc[ai][bj][m][n] = mma2<I8, F8>(Bt[n][0], Bt[n][1], At[m][0], At[m][1], acc[ai][bj][m][n]); __builtin_amdgcn_s_setprio(0); } while (0)
#define PG8_WAIT_V(n) asm volatile("s_waitcnt vmcnt(" #n ")" ::: "memory")
#define PG8_WAIT_L(n) asm volatile("s_waitcnt lgkmcnt(" #n ")" ::: "memory")
#define PG8_BAR __builtin_amdgcn_s_barrier()
#define PG8_SCHED __builtin_amdgcn_sched_barrier(0)
    Unit cur, nxt; int ui = 0;
    if (!S.next(0, cur)) return;
    typedef typename AccT<I8>::type acc_t; acc_t acc[2][2][4][2];
#pragma unroll
    for (int a = 0; a < 2; ++a)
#pragma unroll
        for (int b = 0; b < 2; ++b)
#pragma unroll
            for (int m = 0; m < 4; ++m)
#pragma unroll
                for (int n = 0; n < 2; ++n) acc[a][b][m][n] = acc_t{};
    bf16x8 At[4][2], B0[2][2], B1[2][2];
    const char* cA = (const char*)g.A + (size_t)cur.pm * tstep; const char* cB = (const char*)g.Bt + (size_t)cur.pn * tstep;
    S.a_ready(cur);
    if constexpr (SP2) {
        if constexpr (GATHER) { PG8_GLOAD(vgc, cur); }
        PG8_STAGE(PG8_SB(0, 0), cB, voffB); PG8_STAGE(PG8_SB(0, 1), cB + hstep, voffB);
        if constexpr (GATHER) { PG8_STAGE_G(PG8_SA(0, 0), A0, vgc[0][0], vgc[0][1]); PG8_STAGE_G(PG8_SA(0, 1), A0, vgc[1][0], vgc[1][1]); } else { PG8_STAGE(PG8_SA(0, 0), cA, voffA); PG8_STAGE(PG8_SA(0, 1), cA + hstep, voffA); }
        if (wr == 1) PG8_BAR;
        PG8_WAIT_V(2); PG8_BAR;
        PG8_STAGE(PG8_SB(1, 0), cB + kstep, voffB);
        if constexpr (GATHER) { PG8_STAGE_G(PG8_SA(1, 0), A0 + kstep, vgc[0][0], vgc[0][1]); } else { PG8_STAGE(PG8_SA(1, 0), cA + kstep, voffA); }
        PG8_STAGE(PG8_SB(1, 1), cB + hstep + kstep, voffB);
        PG8_WAIT_V(6); PG8_BAR;
    } else {
        PG8_STAGE(PG8_SB(0, 0), cB, voffB); PG8_STAGE(PG8_SA(0, 0), cA, voffA); PG8_STAGE(PG8_SB(0, 1), cB + hstep, voffB); PG8_STAGE(PG8_SA(0, 1), cA + hstep, voffA);
        if (wr == 1) PG8_BAR;
        PG8_WAIT_V(4); PG8_BAR;
        PG8_STAGE(PG8_SB(1, 0), cB + kstep, voffB); PG8_STAGE(PG8_SA(1, 0), cA + kstep, voffA); PG8_STAGE(PG8_SB(1, 1), cB + hstep + kstep, voffB);
        PG8_WAIT_V(6); PG8_BAR;
    }
    for (;;) {
        const bool has_next = S.next(ui + 1, nxt);
        typename Epi::Pre epre; E.pre(cur, wr, fr, fq, epre, xl);
        if constexpr (GATHER) { if (has_next) { int R_, C_; stage_rc(tid * 16, R_, C_);
            __builtin_amdgcn_global_load_lds((const unsigned*)((const char*)S.ridxp + ((size_t)(S.row_base + nxt.pm * BM) * 4 + (size_t)R_ * 16)), (PG8_LAS unsigned*)(lds + 131072 + ldsw), 16, 0, 0); } }
        const char* nA = has_next ? (const char*)g.A + (size_t)nxt.pm * tstep : cA; const char* nB = has_next ? (const char*)g.Bt + (size_t)nxt.pn * tstep : cB;
        for (int t = 0; t < nt; t += 2) {
            const bool last = (t == nt - 2);
            const char* a1 = cA + (size_t)(t + 1) * kstep;
            const char* a2 = last ? nA : cA + (size_t)(t + 2) * kstep; const char* b2 = last ? nB : cB + (size_t)(t + 2) * kstep;
            const char* a3 = a2 + kstep; const char* b3 = b2 + kstep;
            const char* ga2 = A0 + (size_t)(last ? 0 : t + 2) * kstep; (void)ga2;
            if (last && has_next) S.a_ready(nxt);
            if constexpr (GATHER) { if (last) {
                if (has_next) { const i32x4 raw = *(const volatile PG8_LAS i32x4*)(lds + 131072 + ldsw + (tid & 63) * 16); int R_, C_; stage_rc(tid * 16, R_, C_);
#pragma unroll
                    for (int k_ = 0; k_ < 4; ++k_) { int tk_ = raw[k_]; tk_ = tk_ < 0 ? 0 : tk_; vgn[k_ >> 1][k_ & 1] = (unsigned)(tk_ * K + C_) * 2u; } }
                else { vgn[0][0] = vgc[0][0]; vgn[0][1] = vgc[0][1]; vgn[1][0] = vgc[1][0]; vgn[1][1] = vgc[1][1]; } } }
            if constexpr (SP2) {
            PG8_LDB(B0, 0, 0); PG8_LDB(B1, 0, 1); PG8_SCHED; PG8_LDA(At, 0, 0); if constexpr (GATHER) { PG8_STAGE_G(PG8_SA(1, 1), A0 + (size_t)(t + 1) * kstep, vgc[1][0], vgc[1][1]); } else { PG8_STAGE(PG8_SA(1, 1), a1 + hstep, voffA); }
            PG8_WAIT_V(8); PG8_WAIT_L(0); PG8_BAR; PG8_MMA(0, 0, At, B0); PG8_MMA(0, 1, At, B1); PG8_BAR; PG8_SCHED;
            PG8_LDA(At, 0, 1); PG8_STAGE(PG8_SB(0, 0), b2, voffB); PG8_STAGE(PG8_SB(0, 1), b2 + hstep, voffB); if constexpr (GATHER) { PG8_STAGE_G(PG8_SA(0, 0), ga2, last ? vgn[0][0] : vgc[0][0], last ? vgn[0][1] : vgc[0][1]); } else { PG8_STAGE(PG8_SA(0, 0), a2, voffA); }
            PG8_WAIT_V(8); PG8_WAIT_L(0); PG8_BAR; PG8_MMA(1, 0, At, B0); PG8_MMA(1, 1, At, B1); PG8_BAR; PG8_SCHED;
            PG8_LDB(B0, 1, 0); PG8_LDB(B1, 1, 1); PG8_SCHED; PG8_LDA(At, 1, 0); if constexpr (GATHER) { PG8_STAGE_G(PG8_SA(0, 1), ga2, last ? vgn[1][0] : vgc[1][0], last ? vgn[1][1] : vgc[1][1]); } else { PG8_STAGE(PG8_SA(0, 1), a2 + hstep, voffA); }
            PG8_WAIT_V(8); PG8_WAIT_L(0); PG8_BAR; PG8_MMA(0, 0, At, B0); PG8_MMA(0, 1, At, B1); PG8_BAR; PG8_SCHED;
            PG8_LDA(At, 1, 1); PG8_STAGE(PG8_SB(1, 0), b3, voffB); PG8_STAGE(PG8_SB(1, 1), b3 + hstep, voffB); if constexpr (GATHER) { PG8_STAGE_G(PG8_SA(1, 0), ga2 + kstep, last ? vgn[0][0] : vgc[0][0], last ? vgn[0][1] : vgc[0][1]); } else { PG8_STAGE(PG8_SA(1, 0), a3, voffA); }
            PG8_WAIT_V(8); PG8_WAIT_L(0); PG8_BAR; PG8_MMA(1, 0, At, B0); PG8_MMA(1, 1, At, B1); PG8_BAR; PG8_SCHED;
            } else {
            PG8_LDB(B0, 0, 0); PG8_SCHED; PG8_LDA(At, 0, 0); PG8_STAGE(PG8_SA(1, 1), a1 + hstep, voffA);
            PG8_WAIT_L(8); PG8_BAR; PG8_WAIT_L(0); PG8_MMA(0, 0, At, B0); PG8_BAR; PG8_SCHED;
            PG8_LDB(B1, 0, 1); PG8_STAGE(PG8_SB(0, 0), b2, voffB);
            PG8_BAR; PG8_WAIT_L(0); PG8_MMA(0, 1, At, B1); PG8_BAR;
            PG8_LDA(At, 0, 1); PG8_STAGE(PG8_SA(0, 0), a2, voffA);
            PG8_BAR; PG8_WAIT_L(0); PG8_MMA(1, 0, At, B0); PG8_BAR; PG8_SCHED;
            PG8_STAGE(PG8_SB(0, 1), b2 + hstep, voffB);
            PG8_WAIT_V(6); PG8_BAR; PG8_MMA(1, 1, At, B1); PG8_BAR;
            PG8_LDB(B0, 1, 0); PG8_SCHED; PG8_LDA(At, 1, 0); PG8_STAGE(PG8_SA(0, 1), a2 + hstep, voffA);
            PG8_WAIT_L(8); PG8_BAR; PG8_WAIT_L(0); PG8_MMA(0, 0, At, B0); PG8_BAR; PG8_SCHED;
            PG8_LDB(B1, 1, 1); PG8_STAGE(PG8_SB(1, 0), b3, voffB);
            PG8_BAR; PG8_WAIT_L(0); PG8_MMA(0, 1, At, B1); PG8_BAR;
            PG8_LDA(At, 1, 1); PG8_STAGE(PG8_SA(1, 0), a3, voffA);
            PG8_BAR; PG8_WAIT_L(0); PG8_MMA(1, 0, At, B0); PG8_BAR; PG8_SCHED;
            PG8_STAGE(PG8_SB(1, 1), b3 + hstep, voffB);
            PG8_WAIT_V(6); PG8_BAR; PG8_MMA(1, 1, At, B1); PG8_BAR;
            }
        }
        if constexpr (ALIGN_EPI) { if (wr == 0) PG8_BAR; }
        if constexpr (!Epi::AFTER_DRAIN) { E(acc, cur, wr, wc, fr, fq, epre, xl); S.done(cur); }
        if (!has_next) break;
#pragma unroll
        for (int a = 0; a < 2; ++a)
#pragma unroll
            for (int b = 0; b < 2; ++b)
#pragma unroll
                for (int m = 0; m < 4; ++m)
#pragma unroll
                    for (int n = 0; n < 2; ++n) acc[a][b][m][n] = acc_t{};
        cur = nxt; cA = nA; cB = nB; ++ui;
        if constexpr (GATHER) { vgc[0][0] = vgn[0][0]; vgc[0][1] = vgn[0][1]; vgc[1][0] = vgn[1][0]; vgc[1][1] = vgn[1][1]; }
        if constexpr (ALIGN_EPI) { if (wr == 1) PG8_BAR; }
    }
    PG8_WAIT_V(0);
    if constexpr (!ALIGN_EPI) { if (wr == 0) PG8_BAR; }
    PG8_BAR;
    if constexpr (Epi::AFTER_DRAIN) { E.fused(acc, cur, wr, wc, fr, fq, lds, wid, lane); S.done(cur); }
#undef PG8_SA
#undef PG8_GLOAD
#undef PG8_STAGE_G
#undef PG8_SB
#undef PG8_STAGE
#undef PG8_LDA
#undef PG8_LDB
#undef PG8_MMA
#undef PG8_WAIT_V
#undef PG8_WAIT_L
#undef PG8_BAR
#undef PG8_SCHED
}
}

namespace pg8 {
typedef unsigned long long ssq_t;
__device__ __forceinline__ float ssq_rstd(const ssq_t* ssq, int r) { return __builtin_amdgcn_rsqf((float)ssq[r] * (1.0f / (1048576.0f * 1024.0f)) + 1e-6f); }
__device__ __forceinline__ void ssq_add(ssq_t* ssq, int r, float ss) { atomicAdd(ssq + r, (ssq_t)(ss * 1048576.0f)); }
__device__ __forceinline__ void share_scales(PG8_LAS float* xl, int fr, int fq, float s0, float s1) { xl[fr * 8 + 2 * fq] = s0; xl[fr * 8 + 2 * fq + 1] = s1; asm volatile("s_waitcnt lgkmcnt(0)" ::: "memory"); }
__device__ __forceinline__ float silu_fast(float x) { return x * __builtin_amdgcn_rcpf(1.0f + __expf(-x)); }
struct EpiInProj {
    static constexpr bool PERM = true, AFTER_DRAIN = false;
    typedef EpiPreS Pre; bf16_t* proj; float* dtga; const ssq_t* ssq;
    __device__ __forceinline__ void pre(const Unit& u, int wr, int fr, int fq, Pre& p, PG8_LAS float*) const {
        if (ssq) {
#pragma unroll
            for (int k = 0; k < 2; ++k) { const int kk = 2 * fq + k; p.q[k] = ssq[u.pm * BM + wr * 64 + fr + (kk >> 2) * HALF + (kk & 3) * 16]; } }
    }
    __device__ __forceinline__ void operator()(const f32x4 (&acc)[2][2][4][2], const Unit& u, int wr, int wc, int fr, int fq, const Pre& p, PG8_LAS float* xl) const {
        const int row0 = u.pm * BM + wr * 64 + fr;
        if (ssq) share_scales(xl, fr, fq, ssq_rstd(p.q, 0), ssq_rstd(p.q, 1));
        if (u.pn < 11) {
            const int col0 = u.pn * BM + wc * 32 + 8 * fq;
#pragma unroll
            for (int ai = 0; ai < 2; ++ai)
#pragma unroll
                for (int m = 0; m < 4; ++m) { bf16_t* rowp = proj + (size_t)(row0 + ai * HALF + m * 16) * PW + col0;
                    const float rs = ssq ? xl[fr * 8 + ai * 4 + m] : 1.0f;
#pragma unroll
                    for (int bj = 0; bj < 2; ++bj) { const f32x4 v0 = acc[ai][bj][m][0] * rs, v1 = acc[ai][bj][m][1] * rs;
                        u32x4 w; w.x = cvt_pk_bf16(v0[0], v0[1]); w.y = cvt_pk_bf16(v0[2], v0[3]); w.z = cvt_pk_bf16(v1[0], v1[1]); w.w = cvt_pk_bf16(v1[2], v1[3]);
                        *(u32x4*)(rowp + bj * HALF) = w; } }
        } else if (wc == 0 || (wc == 1 && fq == 0)) {
#pragma unroll
            for (int ai = 0; ai < 2; ++ai)
#pragma unroll
                for (int m = 0; m < 4; ++m) { float* rp = dtga + (size_t)(row0 + ai * HALF + m * 16) * DGW + wc * 32 + 8 * fq;
                    *(f32x4*)rp = acc[ai][0][m][0]; *(f32x4*)(rp + 4) = acc[ai][0][m][1]; }
        }
    }
};
constexpr int HPITCH = 2048;
template <bool IN16> struct EpiResid {
    static constexpr bool PERM = true, AFTER_DRAIN = false;
    typedef EpiPreNone Pre; const void* hin; bf16_t* hout; float ascale = 1.0f;
    __device__ __forceinline__ void pre(const Unit&, int, int, int, Pre&, PG8_LAS float*) const {}
    __device__ __forceinline__ void operator()(const f32x4 (&acc)[2][2][4][2], const Unit& u, int wr, int wc, int fr, int fq, const Pre&, PG8_LAS float*) const {
        const int row0 = u.pm * BM + wr * 64 + fr, col0 = u.pn * BM + wc * 32 + 8 * fq;
#pragma unroll
        for (int ai = 0; ai < 2; ++ai)
#pragma unroll
            for (int m = 0; m < 4; ++m) { const int r = row0 + ai * HALF + m * 16; bf16_t* op = hout + (size_t)r * HPITCH + col0;
                f32x4 i0[2], i1[2];
                if constexpr (IN16) { const bf16_t* ip = (const bf16_t*)hin + (size_t)r * HPITCH + col0; u32x4 q[2];
#pragma unroll
                    for (int bj = 0; bj < 2; ++bj) q[bj] = *(const u32x4*)(ip + bj * HALF);
#pragma unroll
                    for (int bj = 0; bj < 2; ++bj) { i0[bj] = (f32x4){__uint_as_float(q[bj].x << 16), __uint_as_float(q[bj].x & 0xffff0000u), __uint_as_float(q[bj].y << 16), __uint_as_float(q[bj].y & 0xffff0000u)};
                        i1[bj] = (f32x4){__uint_as_float(q[bj].z << 16), __uint_as_float(q[bj].z & 0xffff0000u), __uint_as_float(q[bj].w << 16), __uint_as_float(q[bj].w & 0xffff0000u)}; } }
                else { const float* ip = (const float*)hin + (size_t)r * 1024 + col0;
#pragma unroll
                    for (int bj = 0; bj < 2; ++bj) { i0[bj] = *(const f32x4*)(ip + bj * HALF); i1[bj] = *(const f32x4*)(ip + bj * HALF + 4); } }
#pragma unroll
                for (int bj = 0; bj < 2; ++bj) { const f32x4 v0 = i0[bj] + acc[ai][bj][m][0] * ascale, v1 = i1[bj] + acc[ai][bj][m][1] * ascale;
                    u32x4 w; w.x = cvt_pk_bf16(v0[0], v0[1]); w.y = cvt_pk_bf16(v0[2], v0[3]); w.z = cvt_pk_bf16(v1[0], v1[1]); w.w = cvt_pk_bf16(v1[2], v1[3]); *(u32x4*)(op + bj * HALF) = w; }
                asm volatile("" ::: "memory"); }
    }
};
struct EpiSwiGLU {
    static constexpr bool PERM = true, AFTER_DRAIN = false;
    typedef EpiPreS Pre; bf16_t* out; int ld; int ntile; const ssq_t* ssq; const float* srs; int row_base; bool tiled;
    __device__ __forceinline__ void pre(const Unit& u, int wr, int fr, int fq, Pre& p, PG8_LAS float*) const {
#pragma unroll
        for (int k = 0; k < 2; ++k) { const int kk = 2 * fq + k, r = u.pm * BM + wr * 64 + fr + (kk >> 2) * HALF + (kk & 3) * 16;
            if (ssq) p.q[k] = ssq[r]; else if (srs) p.f[k] = srs[row_base + r]; }
    }
    __device__ __forceinline__ void operator()(const f32x4 (&acc)[2][2][4][2], const Unit& u, int wr, int wc, int fr, int fq, const Pre& p, PG8_LAS float* xl) const {
        const int row0 = u.pm * BM + wr * 64 + fr, col0 = (u.pn % ntile) * HALF + wc * 32 + 8 * fq;
        if (ssq) share_scales(xl, fr, fq, ssq_rstd(p.q, 0), ssq_rstd(p.q, 1)); else if (srs) share_scales(xl, fr, fq, p.f[0], p.f[1]);
#pragma unroll
        for (int ai = 0; ai < 2; ++ai)
#pragma unroll
            for (int m = 0; m < 4; ++m) { const int rr_ = row0 + ai * HALF + m * 16;
                bf16_t* rowp = tiled ? out + ((size_t)(rr_ >> 8) * (ld >> 6) + (col0 >> 6)) * 16384 + (size_t)(rr_ & 255) * 64 + (col0 & 63) : out + (size_t)rr_ * ld + col0;
                const float rs = (ssq || srs) ? xl[fr * 8 + ai * 4 + m] : 1.0f;
                const f32x4 g0 = acc[ai][0][m][0] * rs, g1 = acc[ai][0][m][1] * rs, u0 = acc[ai][1][m][0] * rs, u1 = acc[ai][1][m][1] * rs;
                u32x4 w; w.x = cvt_pk_bf16(silu_fast(g0[0]) * u0[0], silu_fast(g0[1]) * u0[1]); w.y = cvt_pk_bf16(silu_fast(g0[2]) * u0[2], silu_fast(g0[3]) * u0[3]);
                w.z = cvt_pk_bf16(silu_fast(g1[0]) * u1[0], silu_fast(g1[1]) * u1[1]); w.w = cvt_pk_bf16(silu_fast(g1[2]) * u1[2], silu_fast(g1[3]) * u1[3]);
                *(u32x4*)rowp = w; }
    }
};
struct EpiPre8 { float f[2]; float sbv; };
struct EpiSwiGLU8 {
    static constexpr bool PERM = true, AFTER_DRAIN = false;
    typedef EpiPre8 Pre; bf16_t* out; int ld; int ntile; const float* sa; const float* sb; int row_base; bool tiled;
    __device__ __forceinline__ void pre(const Unit& u, int wr, int fr, int fq, Pre& p, PG8_LAS float*) const {
#pragma unroll
        for (int k = 0; k < 2; ++k) { const int kk = 2 * fq + k; p.f[k] = sa[row_base + u.pm * BM + wr * 64 + fr + (kk >> 2) * HALF + (kk & 3) * 16]; }
        int t_ = threadIdx.x; asm volatile("" : "+v"(t_));
        const int lane = fr + 16 * fq, wc = (t_ >> 6) & 3; p.sbv = sb[(size_t)u.pn * BM + (lane >> 5) * HALF + wc * 32 + (lane & 31)];
    }
    __device__ __forceinline__ void operator()(const i32x4 (&acc)[2][2][4][2], const Unit& u, int wr, int wc, int fr, int fq, const Pre& p, PG8_LAS float* xl) const {
        const int row0 = u.pm * BM + wr * 64 + fr, col0 = (u.pn % ntile) * HALF + wc * 32 + 8 * fq;
        xl[fr * 8 + 2 * fq] = p.f[0]; xl[fr * 8 + 2 * fq + 1] = p.f[1]; xl[128 + fr + 16 * fq] = p.sbv; asm volatile("s_waitcnt lgkmcnt(0)" ::: "memory");
        const f32x4 sg0 = *(const PG8_LAS f32x4*)(xl + 128 + 8 * fq), sg1 = *(const PG8_LAS f32x4*)(xl + 128 + 8 * fq + 4), su0 = *(const PG8_LAS f32x4*)(xl + 160 + 8 * fq), su1 = *(const PG8_LAS f32x4*)(xl + 160 + 8 * fq + 4);
#pragma unroll
        for (int ai = 0; ai < 2; ++ai)
#pragma unroll
            for (int m = 0; m < 4; ++m) { const int rr_ = row0 + ai * HALF + m * 16;
                const float s = xl[fr * 8 + ai * 4 + m];
                bf16_t* rowp = out + (size_t)rr_ * ld + col0;
                float g[8], uu[8];
#pragma unroll
                for (int j = 0; j < 4; ++j) { g[j] = (float)acc[ai][0][m][0][j] * s * sg0[j]; g[4 + j] = (float)acc[ai][0][m][1][j] * s * sg1[j]; uu[j] = (float)acc[ai][1][m][0][j] * s * su0[j]; uu[4 + j] = (float)acc[ai][1][m][1][j] * s * su1[j]; }
                if (tiled) {
#pragma unroll
                    for (int j = 0; j < 8; ++j) g[j] = __builtin_amdgcn_fmed3f(silu_fast(g[j]) * uu[j], -448.0f, 448.0f);
                    unsigned lo = 0u, hi = 0u; lo = __builtin_amdgcn_cvt_pk_fp8_f32(g[0], g[1], lo, false); lo = __builtin_amdgcn_cvt_pk_fp8_f32(g[2], g[3], lo, true);
                    hi = __builtin_amdgcn_cvt_pk_fp8_f32(g[4], g[5], hi, false); hi = __builtin_amdgcn_cvt_pk_fp8_f32(g[6], g[7], hi, true);
                    *(unsigned long long*)((unsigned char*)out + ((size_t)(rr_ >> 8) * (ld >> 7) + (col0 >> 7)) * 32768 + (size_t)(rr_ & 255) * 128 + (col0 & 127)) = (unsigned long long)lo | ((unsigned long long)hi << 32);
                } else {
                u32x4 w; w.x = cvt_pk_bf16(silu_fast(g[0]) * uu[0], silu_fast(g[1]) * uu[1]); w.y = cvt_pk_bf16(silu_fast(g[2]) * uu[2], silu_fast(g[3]) * uu[3]);
                w.z = cvt_pk_bf16(silu_fast(g[4]) * uu[4], silu_fast(g[5]) * uu[5]); w.w = cvt_pk_bf16(silu_fast(g[6]) * uu[6], silu_fast(g[7]) * uu[7]);
                *(u32x4*)rowp = w; } }
    }
};
struct EpiInProj8 {
    static constexpr bool PERM = true, AFTER_DRAIN = false;
    typedef EpiPre8 Pre; bf16_t* proj; const float* sa; const float* sb;
    __device__ __forceinline__ void pre(const Unit& u, int wr, int fr, int fq, Pre& p, PG8_LAS float*) const {
#pragma unroll
        for (int k = 0; k < 2; ++k) { const int kk = 2 * fq + k; p.f[k] = sa[u.pm * BM + wr * 64 + fr + (kk >> 2) * HALF + (kk & 3) * 16]; }
        int t_ = threadIdx.x; asm volatile("" : "+v"(t_));
        const int lane = fr + 16 * fq, wc = (t_ >> 6) & 3; p.sbv = sb[(size_t)u.pn * BM + (lane >> 5) * HALF + wc * 32 + (lane & 31)];
    }
    __device__ __forceinline__ void operator()(const i32x4 (&acc)[2][2][4][2], const Unit& u, int wr, int wc, int fr, int fq, const Pre& p, PG8_LAS float* xl) const {
        const int row0 = u.pm * BM + wr * 64 + fr, col0 = u.pn * BM + wc * 32 + 8 * fq;
        xl[fr * 8 + 2 * fq] = p.f[0]; xl[fr * 8 + 2 * fq + 1] = p.f[1]; xl[128 + fr + 16 * fq] = p.sbv; asm volatile("s_waitcnt lgkmcnt(0)" ::: "memory");
        f32x4 sc[2][2];
#pragma unroll
        for (int bj = 0; bj < 2; ++bj) { sc[bj][0] = *(const PG8_LAS f32x4*)(xl + 128 + 32 * bj + 8 * fq); sc[bj][1] = *(const PG8_LAS f32x4*)(xl + 128 + 32 * bj + 8 * fq + 4); }
#pragma unroll
        for (int ai = 0; ai < 2; ++ai)
#pragma unroll
            for (int m = 0; m < 4; ++m) { const int r = row0 + ai * HALF + m * 16; const float s = xl[fr * 8 + ai * 4 + m]; bf16_t* rowp = proj + (size_t)r * PW + col0;
#pragma unroll
                for (int bj = 0; bj < 2; ++bj) { const i32x4 a0 = acc[ai][bj][m][0], a1 = acc[ai][bj][m][1]; const f32x4 s0 = sc[bj][0] * s, s1 = sc[bj][1] * s;
                    u32x4 w; w.x = cvt_pk_bf16((float)a0[0] * s0[0], (float)a0[1] * s0[1]); w.y = cvt_pk_bf16((float)a0[2] * s0[2], (float)a0[3] * s0[3]);
                    w.z = cvt_pk_bf16((float)a1[0] * s1[0], (float)a1[1] * s1[1]); w.w = cvt_pk_bf16((float)a1[2] * s1[2], (float)a1[3] * s1[3]);
                    *(u32x4*)(rowp + bj * HALF) = w; } }
    }
};
struct EpiMoeDown {
    static constexpr bool PERM = true, AFTER_DRAIN = false;
    typedef EpiPreNone Pre; bf16_t* ylo; long hi_off; const int* stok; const float* sgate; int row_base; float gscale;
    __device__ __forceinline__ void pre(const Unit& u, int wr, int, int, Pre&, PG8_LAS float* xl) const {
        int t_ = threadIdx.x; asm volatile("" : "+v"(t_));
        const unsigned voff = (unsigned)(t_ & 63) * 4u; const size_t sb_ = (size_t)(row_base + u.pm * BM + wr * 64) * 4;
#pragma unroll
        for (int ai = 0; ai < 2; ++ai) { __builtin_amdgcn_global_load_lds((const unsigned*)((const char*)stok + sb_ + ai * HALF * 4 + voff), (PG8_LAS unsigned*)(xl + ai * 64), 4, 0, 0);
            __builtin_amdgcn_global_load_lds((const unsigned*)((const char*)sgate + sb_ + ai * HALF * 4 + voff), (PG8_LAS unsigned*)(xl + 128 + ai * 64), 4, 0, 0); }
    }
    __device__ __forceinline__ void operator()(const f32x4 (&acc)[2][2][4][2], const Unit& u, int wr, int wc, int fr, int fq, const Pre&, PG8_LAS float* xl) const {
        { int t_ = threadIdx.x; asm volatile("" : "+v"(t_)); fr = t_ & 15; fq = (t_ >> 4) & 3; }
        bf16_t* ylo_ = ylo; asm volatile("" : "+s"(ylo_));
        const int ct = u.pn & 3, col0 = (ct & 1) * BM + wc * 32 + 8 * fq; bf16_t* const yb = ylo_ + (long)(ct >> 1) * hi_off;
#pragma unroll
        for (int ai = 0; ai < 2; ++ai)
#pragma unroll
            for (int m = 0; m < 4; ++m) { const int tok = ((const volatile PG8_LAS int*)xl)[ai * 64 + m * 16 + fr]; const float gt = ((const volatile PG8_LAS float*)xl)[128 + ai * 64 + m * 16 + fr] * gscale;
                if (tok >= 0) { bf16_t* op = yb + (size_t)tok * 512 + col0;
#pragma unroll
                    for (int bj = 0; bj < 2; ++bj) { const f32x4 v0 = acc[ai][bj][m][0] * gt, v1 = acc[ai][bj][m][1] * gt;
                        u32x4 w; w.x = cvt_pk_bf16(v0[0], v0[1]); w.y = cvt_pk_bf16(v0[2], v0[3]); w.z = cvt_pk_bf16(v1[0], v1[1]); w.w = cvt_pk_bf16(v1[2], v1[3]); *(u32x4*)(op + bj * HALF) = w; }
                } }
    }
};
struct MoeOrder {
    static constexpr int SKIP = 3; int t0, nT, nN, G, c, nx; const PG8_LAS int* tile_expert; const int* ridx; int row_base; const int* ridxp = nullptr;
    __device__ __forceinline__ bool next(int i, Unit& u) const {
        const int r = i + (c < nx ? SKIP : 0);
        const int L = r < SKIP ? r * (G - nx) + (c - nx) : SKIP * (G - nx) + (r - SKIP) * G + c;
        if (L >= nT * nN) return false;
        const int tl = L / nN, j = L % nN; u.pm = tl; u.pn = tile_expert[tl] * nN + j; return true;
    }
    __device__ __forceinline__ void a_ready(const Unit&) const {}
    __device__ __forceinline__ void done(const Unit&) const {}
};
}

namespace attn_body {
using bf16=unsigned short;
using bf16x8=__attribute__((ext_vector_type(8)))short;
using s16x4=__attribute__((ext_vector_type(4)))short;
using f32x16=__attribute__((ext_vector_type(16)))float;
using u32x4=__attribute__((ext_vector_type(4)))unsigned;
constexpr int D=64,DM=PW;
constexpr int NW=8,QBLK=32,KVBLK=64;
__device__ __forceinline__ int crow(int r,int hi){return (r&3)+8*(r>>2)+4*hi;}
#define SBAR() __builtin_amdgcn_sched_barrier(0)
__device__ __forceinline__ void meta_mask(f32x16&p0,f32x16&p1){
  const float NEG=-INFINITY;
  #pragma unroll
  for(int r=8;r<16;++r)p0[r]=NEG;
  #pragma unroll
  for(int r=0;r<16;++r)p1[r]=NEG;
}
__device__ __forceinline__ void swa_mask(f32x16&p0,f32x16&p1,int rel0,int lo,int hi_,bool metatile,bool dead,const __attribute__((address_space(3))) float*bt,float mh){
  const float NEG=-INFINITY;
  if(dead){
    #pragma unroll
    for(int r=0;r<16;++r){p0[r]=NEG;p1[r]=NEG;}
  } else {
    #pragma unroll
    for(int r4=0;r4<4;++r4){
      #pragma unroll
      for(int half=0;half<2;++half){
        #pragma unroll
        for(int j=0;j<4;++j){
          const int r=4*r4+j, rel=rel0+(j+8*r4+32*half);
          const int idx=rel>hi_?hi_:(rel<lo?lo:rel);
          const float bv=bt[idx+129]-mh;
          if(half==0)p0[r]+=bv; else p1[r]+=bv; } }
      __builtin_amdgcn_sched_barrier(0); }
    if(metatile){
      #pragma unroll
      for(int r=8;r<16;++r)p0[r]=NEG;
      #pragma unroll
      for(int r=0;r<16;++r)p1[r]=NEG; }
  }
}

constexpr int NSLOT=3, SLOTB=8192;
constexpr int LDS_K=0, LDS_V=NSLOT*SLOTB, LDS_WS=2*NSLOT*SLOTB, LDS_OST=LDS_WS+NW*64*4, LDS_BYTES=LDS_OST+NW*4096;
constexpr float C2=0.125f*1.4426950408889634f;
__device__ __forceinline__ void glds16(const void*gsrc,unsigned lds_dst){unsigned keep;
  asm volatile("s_mov_b32 %0, m0\n\ts_mov_b32 m0, %2\n\ts_nop 0\n\tglobal_load_lds_dwordx4 %1, off\n\ts_mov_b32 m0, %0":"=&s"(keep):"v"(gsrc),"s"(lds_dst):"memory");}
__device__ __forceinline__ float max3f(float a,float b,float c){float r;asm("v_max3_f32 %0, %1, %2, %3":"=v"(r):"v"(a),"v"(b),"v"(c));return r;}
__device__ __forceinline__ float max2f(float a,float b){float r;asm("v_max_f32_e32 %0, %1, %2":"=v"(r):"v"(a),"v"(b));return r;}
__device__ __forceinline__ float fadd_s(float a,float b){float r;asm("v_add_f32_e32 %0, %1, %2":"=v"(r):"v"(a),"v"(b));return r;}
__device__ __forceinline__ float fsub_s(float a,float b){float r;asm("v_sub_f32_e32 %0, %1, %2":"=v"(r):"v"(a),"v"(b));return r;}
typedef float f32x2_t __attribute__((ext_vector_type(2))); typedef __bf16 bf16x2_t __attribute__((ext_vector_type(2)));
__device__ __forceinline__ unsigned cvtpk_s(float lo,float hi){f32x2_t v={lo,hi};bf16x2_t b=__builtin_convertvector(v,bf16x2_t);return __builtin_bit_cast(unsigned,b);}
#define WAIT_BAR(N) asm volatile("s_waitcnt vmcnt(" #N ") lgkmcnt(0)\n\ts_barrier":::"memory")

__device__ __forceinline__ void qkt(f32x16&p0,f32x16&p1,const char*Kslot,const bf16x8*qr,const f32x16&negm,int r32,int hi){
  const char*kb=Kslot+hi*1024+r32*16;
  #pragma unroll
  for(int d0=0;d0<4;++d0){
    const bf16x8 b0=*reinterpret_cast<const bf16x8*>(kb+d0*2048);
    const bf16x8 b1=*reinterpret_cast<const bf16x8*>(kb+d0*2048+512);
    if(d0==0){p0=__builtin_amdgcn_mfma_f32_32x32x16_bf16(b0,qr[0],negm,0,0,0);p1=__builtin_amdgcn_mfma_f32_32x32x16_bf16(b1,qr[0],negm,0,0,0);}
    else{p0=__builtin_amdgcn_mfma_f32_32x32x16_bf16(b0,qr[d0],p0,0,0,0);p1=__builtin_amdgcn_mfma_f32_32x32x16_bf16(b1,qr[d0],p1,0,0,0);}}
}
typedef __attribute__((address_space(3))) const char* lds_cptr;
typedef short v4i16_t __attribute__((ext_vector_type(4)));
__device__ __forceinline__ void kload8(bf16x8*kf,lds_cptr kp){
  kf[0]=*(const __attribute__((address_space(3))) bf16x8*)(kp);      kf[1]=*(const __attribute__((address_space(3))) bf16x8*)(kp+512);
  kf[2]=*(const __attribute__((address_space(3))) bf16x8*)(kp+2048); kf[3]=*(const __attribute__((address_space(3))) bf16x8*)(kp+2560);
  kf[4]=*(const __attribute__((address_space(3))) bf16x8*)(kp+4096); kf[5]=*(const __attribute__((address_space(3))) bf16x8*)(kp+4608);
  kf[6]=*(const __attribute__((address_space(3))) bf16x8*)(kp+6144); kf[7]=*(const __attribute__((address_space(3))) bf16x8*)(kp+6656);
}
__device__ __forceinline__ void kload2(bf16x8*kf,lds_cptr kp,int j){ kf[2*j]=*(const __attribute__((address_space(3))) bf16x8*)(kp+j*2048); kf[2*j+1]=*(const __attribute__((address_space(3))) bf16x8*)(kp+j*2048+512); }
__device__ __forceinline__ s16x4 vtr(lds_cptr p){ return __builtin_bit_cast(s16x4,__builtin_amdgcn_ds_read_tr16_b64_v4i16((__attribute__((address_space(3))) v4i16_t*)p)); }
__device__ __forceinline__ float rowmax(const f32x16&p0,const f32x16&p1){
  float a=max3f(p0[0],p0[1],p1[0]),b=max3f(p0[2],p0[3],p1[1]);a=max3f(a,p1[2],p1[3]);
  #pragma unroll
  for(int r=4;r<16;r+=4){a=max3f(a,p0[r],p0[r+1]);b=max3f(b,p0[r+2],p0[r+3]);a=max3f(a,p1[r],p1[r+1]);b=max3f(b,p1[r+2],p1[r+3]);}
  const float m=max2f(a,b);
  auto rr=__builtin_amdgcn_permlane32_swap(__float_as_uint(m),__float_as_uint(m),false,false);
  return max2f(__uint_as_float(rr[0]),__uint_as_float(rr[1]));
}
__device__ __forceinline__ void pv(f32x16*o,int vb,bf16x8 pa0,bf16x8 pa1,bf16x8 pa2,bf16x8 pa3){
  #pragma unroll
  for(int d0=0;d0<2;++d0){s16x4 lo[4],hi[4];
    #pragma unroll
    for(int ks=0;ks<4;++ks){
      asm volatile("ds_read_b64_tr_b16 %0,%1 offset:%c2":"=&v"(lo[ks]):"v"(vb),"i"(d0*4096+ks*1024):"memory");
      asm volatile("ds_read_b64_tr_b16 %0,%1 offset:%c2":"=&v"(hi[ks]):"v"(vb),"i"(d0*4096+ks*1024+512):"memory");}
    asm volatile("s_waitcnt lgkmcnt(0)":::"memory");SBAR();
    #define PK(k) (bf16x8){lo[k][0],lo[k][1],lo[k][2],lo[k][3],hi[k][0],hi[k][1],hi[k][2],hi[k][3]}
    o[d0]=__builtin_amdgcn_mfma_f32_32x32x16_bf16(pa0,PK(0),o[d0],0,0,0);
    o[d0]=__builtin_amdgcn_mfma_f32_32x32x16_bf16(pa1,PK(1),o[d0],0,0,0);
    o[d0]=__builtin_amdgcn_mfma_f32_32x32x16_bf16(pa2,PK(2),o[d0],0,0,0);
    o[d0]=__builtin_amdgcn_mfma_f32_32x32x16_bf16(pa3,PK(3),o[d0],0,0,0);
    #undef PK
  }
}

__device__ __forceinline__ int swa_off(int j){ return j<2 ? 64*j : (j<4 ? 64*j-256 : 64*j-128); }
__device__ __forceinline__ int swa_clamp(int s){ return s<0?0:(s>S_-KVBLK?S_-KVBLK:s); }
#ifndef ATTN_STORE16
#define ATTN_STORE16(p,v) (*(u32x4*)(p)=(v))
#endif
template<int THRL,bool SWA> __device__ __forceinline__ void attn_unit(int b,int qb,const bf16*Qc,const bf16*__restrict__ Kc,const bf16*__restrict__ Vc,bf16*Oc,char*shm,const __attribute__((address_space(3))) float*btab,int g){
  int nt_ = SWA ? 7 : S_/KVBLK+1; asm volatile("":"+s"(nt_)); const int NT=nt_;
  int tid=threadIdx.x; asm volatile("":"+v"(tid));
  const int lane=tid&63,r32=lane&31,hi=lane>>5; const int wid=__builtin_amdgcn_readfirstlane(tid>>6);
  const bool meta=qb<0; const int hh=wid&1, blk=wid>>1;
  const int qrow0= meta ? NREG+b*NM : b*S_+128*qb+32*blk;
  const int tq= meta ? r32 : NM+128*qb+32*blk+r32;
  const int T0s= meta ? 0 : 128*qb;
  const bf16*Qw=Qc+(long)qrow0*DM+hh*D;
  #define TROW(t) ( SWA ? ((t)==NT-1 ? NREG+b*NM : b*S_+swa_clamp(T0s+swa_off(t))) : ((t)<NT-1 ? b*S_+KVBLK*(t) : NREG+b*NM) )
  const unsigned lds0=(unsigned)(uintptr_t)shm;
  float*wsf=(float*)(shm+LDS_WS)+wid*64;
  const bf16*ksrc=Kc+(long)lane*DM+wid*8;
  const bf16*vsrc=Vc+(long)(16*(wid&3)+(lane>>2))*DM+(wid>>2)*32+(lane&3)*8;
  const unsigned kdst=lds0+LDS_K+wid*1024, vdst=lds0+LDS_V+wid*1024;
  #define DMA_K(t,slot) glds16(ksrc+(long)TROW(t)*DM,(unsigned)__builtin_amdgcn_readfirstlane(kdst+(slot)))
  #define DMA_V(t,slot) glds16(vsrc+(long)TROW(t)*DM,(unsigned)__builtin_amdgcn_readfirstlane(vdst+(slot)))
  const int vb0=(int)(lds0+LDS_V)+((lane>>4)&1)*32+(lane&3)*8+(4*hi+((lane&15)>>2))*64;
  const char*Kbase=shm+LDS_K; bf16x8 kf[8];
  const lds_cptr shm3=(lds_cptr)shm; const lds_cptr kp0=shm3+LDS_K+hi*1024+r32*16; const lds_cptr vp0=shm3+LDS_V+((lane>>4)&1)*32+(lane&3)*8+(4*hi+((lane&15)>>2))*64;
  DMA_K(0,0);DMA_V(0,0);DMA_K(1,SLOTB);
  bf16x8 qr[4];
  #pragma unroll
  for(int d0=0;d0<4;++d0)qr[d0]=*reinterpret_cast<const bf16x8*>(&Qw[(long)r32*DM+d0*16+hi*8]);
  #define NEGC (SWA ? f32x16{} : negm)
  float mhat=0.f,l_reg=0.f;f32x16 o[2];o[0]=f32x16{};o[1]=f32x16{};f32x16 negm=f32x16{};if constexpr(!SWA){asm volatile("":"+v"(negm));}
  const __attribute__((address_space(3))) float*bt=btab+(2*g+hh)*264; const int relq=4*hi-tq;
  #define CMASK(P0,P1,t) do{ if constexpr(SWA){ swa_mask(P0,P1,((t)==NT-1?0:NM+T0s+swa_off(t))+relq,(t)==NT-1?-128:-129,(t)==NT-1?128:129,(t)==NT-1,(t)!=NT-1&&((T0s+swa_off(t))<0||(T0s+swa_off(t))>=S_),bt,mhat); } else { if((t)==NT-1)meta_mask(P0,P1); } }while(0)
  bool resc=false;
  #define START(P0,P1) do{ const float rm=rowmax(P0,P1); resc=false; \
    { const float dl=rm; mhat=fadd_s(mhat,dl); \
      _Pragma("unroll") for(int r=0;r<16;++r){P0[r]=fsub_s(P0[r],dl);P1[r]=fsub_s(P1[r],dl);} \
      _Pragma("unroll") for(int r=0;r<16;++r)negm[r]=-mhat; if constexpr(!SWA){asm volatile("":"+v"(negm));} } \
    _Pragma("unroll") for(int r=0;r<16;++r)P0[r]=__builtin_amdgcn_exp2f(P0[r]); }while(0)
  #define RESC() do{ if(resc){ asm volatile("s_waitcnt lgkmcnt(0)":::"memory"); \
      _Pragma("unroll") for(int d_=0;d_<2;++d_) _Pragma("unroll") for(int r=0;r<16;++r)o[d_][r]*=wsf[crow(r,hi)]; } }while(0)
  f32x16 pA0,pA1,pB0,pB1;
  int sl_prev=0,sl_cur=0,sl_next=SLOTB;
  #define ROT() do{sl_prev=sl_cur;sl_cur=sl_next;sl_next=(sl_next==(NSLOT-1)*SLOTB)?0:sl_next+SLOTB;}while(0)
  DMA_K(2,2*SLOTB);
  WAIT_BAR(3);
  qkt(pA0,pA1,Kbase,qr,NEGC,r32,hi);asm volatile("s_nop 15\n\ts_nop 7":"+v"(pA0),"+v"(pA1));CMASK(pA0,pA1,0);
  START(pA0,pA1);
  _Pragma("unroll") for(int r=0;r<16;++r)pA1[r]=__builtin_amdgcn_exp2f(pA1[r]);
  WAIT_BAR(0);
  DMA_K(3,0);DMA_V(1,SLOTB);
  ROT();
  kload8(kf,kp0+sl_cur);
  WAIT_BAR(2);
  s16x4 vlo[8],vhi[8]; u32x4 pw0,pw1,pw2,pw3;
  #define PKW(P,B) cvtpk_s(P[B],P[B+1])
  #define PAF(k) __builtin_bit_cast(bf16x8,pw##k)
  #define VFR(i) (bf16x8){vlo[i][0],vlo[i][1],vlo[i][2],vlo[i][3],vhi[i][0],vhi[i][1],vhi[i][2],vhi[i][3]}
  #define PIN(x) asm volatile("":"+v"(x))
  #define MX3(a,b,c) __builtin_fmaxf(__builtin_fmaxf((a),(b)),(c))
  #define GAPA(MF,A0,A1,A2,A3,W0,W1,PW) do{ MF; sacc+=A0; sacc+=A1; sacc+=A2; sacc+=A3; PIN(sacc); W0; W1; PIN(PW); SBAR(); }while(0)
  #define EX(v) __builtin_amdgcn_exp2f(v)
  #define GAPB(MF,X,B) do{ MF; X[B]=EX(X[B]); X[B+1]=EX(X[B+1]); X[B+2]=EX(X[B+2]); X[B+3]=EX(X[B+3]); PIN(X); SBAR(); }while(0)
  #define VRD(i) do{ vlo[i]=vtr(vp_+(((i)>>2)*4096+((i)&3)*1024)); vhi[i]=vtr(vp_+(((i)>>2)*4096+((i)&3)*1024+512)); }while(0)
  #define KRD(G,j) do{ if(G){ kload2(kf,kp0+sl_next,j); SBAR(); } }while(0)
  #define STEP(C0,C1,P0,P1,t,GK,GV,GL) do{ SBAR(); \
    const lds_cptr vp_=vp0+sl_prev; \
    VRD(0); SBAR(); float sacc=(P0[0]+P0[1]); \
    GAPA(C0=__builtin_amdgcn_mfma_f32_32x32x16_bf16(kf[0],qr[0],NEGC,0,0,0), P0[2],P0[3],P0[4],P0[5],     pw0[0]=PKW(P0,0), pw0[1]=PKW(P0,2), pw0); \
    VRD(4); SBAR(); GAPA(C1=__builtin_amdgcn_mfma_f32_32x32x16_bf16(kf[1],qr[0],NEGC,0,0,0), P0[6],P0[7],P0[8],P0[9],     pw0[2]=PKW(P0,4), pw0[3]=PKW(P0,6), pw0); \
    VRD(1); SBAR(); GAPA(C0=__builtin_amdgcn_mfma_f32_32x32x16_bf16(kf[2],qr[1],C0,0,0,0),   P0[10],P0[11],P0[12],P0[13], pw1[0]=PKW(P0,8), pw1[1]=PKW(P0,10), pw1); \
    VRD(5); SBAR(); GAPA(C1=__builtin_amdgcn_mfma_f32_32x32x16_bf16(kf[3],qr[1],C1,0,0,0),   P0[14],P0[15],P1[0],P1[1],   pw1[2]=PKW(P0,12),pw1[3]=PKW(P0,14), pw1); \
    VRD(2); SBAR(); GAPA(C0=__builtin_amdgcn_mfma_f32_32x32x16_bf16(kf[4],qr[2],C0,0,0,0),   P1[2],P1[3],P1[4],P1[5],     pw2[0]=PKW(P1,0), pw2[1]=PKW(P1,2), pw2); \
    VRD(6); SBAR(); GAPA(C1=__builtin_amdgcn_mfma_f32_32x32x16_bf16(kf[5],qr[2],C1,0,0,0),   P1[6],P1[7],P1[8],P1[9],     pw2[2]=PKW(P1,4), pw2[3]=PKW(P1,6), pw2); \
    VRD(3); SBAR(); GAPA(C0=__builtin_amdgcn_mfma_f32_32x32x16_bf16(kf[6],qr[3],C0,0,0,0),   P1[10],P1[11],P1[12],P1[13], pw3[0]=PKW(P1,8), pw3[1]=PKW(P1,10), pw3); \
    VRD(7); SBAR(); GAPA(C1=__builtin_amdgcn_mfma_f32_32x32x16_bf16(kf[7],qr[3],C1,0,0,0),   P1[14],P1[15],0.f,0.f,       pw3[2]=PKW(P1,12),pw3[3]=PKW(P1,14), pw3); \
    l_reg+=sacc; \
    if(GK){DMA_K((t)+3,sl_cur);} if(GV){DMA_V((t)+1,sl_next);} \
    CMASK(C0,C1,t); \
    { float a=MX3(C0[0],C0[1],C1[0]),b=MX3(C0[2],C0[3],C1[1]); a=MX3(a,C1[2],C1[3]); \
      _Pragma("unroll") for(int r=4;r<16;r+=4){a=MX3(a,C0[r],C0[r+1]);b=MX3(b,C0[r+2],C0[r+3]);a=MX3(a,C1[r],C1[r+1]);b=MX3(b,C1[r+2],C1[r+3]);} \
      float rm=__builtin_fmaxf(a,b); { auto rr=__builtin_amdgcn_permlane32_swap(__float_as_uint(rm),__float_as_uint(rm),false,false); rm=__builtin_fmaxf(__uint_as_float(rr[0]),__uint_as_float(rr[1])); } \
      resc=false; \
      if(__builtin_expect(__any(rm>(float)THRL),0)){ const float dl=__builtin_fmaxf(rm,0.f); mhat+=dl; \
        _Pragma("unroll") for(int r=0;r<16;++r){C0[r]-=dl;C1[r]-=dl;} \
        _Pragma("unroll") for(int r=0;r<16;++r)negm[r]=-mhat; if constexpr(!SWA){asm volatile("":"+v"(negm));} \
        const float f=__builtin_amdgcn_exp2f(-dl); l_reg*=f; if(hi==0)wsf[r32]=f; resc=true; } } \
    SBAR(); \
    GAPB(o[0]=__builtin_amdgcn_mfma_f32_32x32x16_bf16(PAF(0),VFR(0),o[0],0,0,0), C0,0); \
    GAPB(o[1]=__builtin_amdgcn_mfma_f32_32x32x16_bf16(PAF(0),VFR(4),o[1],0,0,0), C0,4); \
    KRD(GL,0); GAPB(o[0]=__builtin_amdgcn_mfma_f32_32x32x16_bf16(PAF(1),VFR(1),o[0],0,0,0), C0,8); \
    KRD(GL,1); GAPB(o[1]=__builtin_amdgcn_mfma_f32_32x32x16_bf16(PAF(1),VFR(5),o[1],0,0,0), C0,12); \
    KRD(GL,2); GAPB(o[0]=__builtin_amdgcn_mfma_f32_32x32x16_bf16(PAF(2),VFR(2),o[0],0,0,0), C1,0); \
    KRD(GL,3); GAPB(o[1]=__builtin_amdgcn_mfma_f32_32x32x16_bf16(PAF(2),VFR(6),o[1],0,0,0), C1,4); \
    GAPB(o[0]=__builtin_amdgcn_mfma_f32_32x32x16_bf16(PAF(3),VFR(3),o[0],0,0,0), C1,8); \
    GAPB(o[1]=__builtin_amdgcn_mfma_f32_32x32x16_bf16(PAF(3),VFR(7),o[1],0,0,0), C1,12); \
    }while(0)
  int t=1;
  #undef CMASK
  #define CMASK(P0,P1,t) do{ if constexpr(SWA){ swa_mask(P0,P1,((t)==NT-1?0:NM+T0s+swa_off(t))+relq,(t)==NT-1?-128:-129,(t)==NT-1?128:129,(t)==NT-1,(t)!=NT-1&&((T0s+swa_off(t))<0||(T0s+swa_off(t))>=S_),bt,mhat); } }while(0)
  for(;t+5<NT;t+=2){
    STEP(pB0,pB1,pA0,pA1,t,true,true,true);     WAIT_BAR(2); RESC(); ROT();
    STEP(pA0,pA1,pB0,pB1,t+1,true,true,true);   WAIT_BAR(2); RESC(); ROT();
  }
  #undef CMASK
  #define CMASK(P0,P1,t) do{ if constexpr(SWA){ swa_mask(P0,P1,((t)==NT-1?0:NM+T0s+swa_off(t))+relq,(t)==NT-1?-128:-129,(t)==NT-1?128:129,(t)==NT-1,(t)!=NT-1&&((T0s+swa_off(t))<0||(T0s+swa_off(t))>=S_),bt,mhat); } else { if((t)==NT-1)meta_mask(P0,P1); } }while(0)
  #define ENDW(tt) do{ if((tt)+3<NT){WAIT_BAR(2);} else if((tt)+2<NT){WAIT_BAR(1);} else {WAIT_BAR(0);} }while(0)
  for(;t+2<NT;t+=2){
    STEP(pB0,pB1,pA0,pA1,t,(t+3<NT),(t+1<NT),(t+1<NT));       ENDW(t);   RESC(); ROT();
    STEP(pA0,pA1,pB0,pB1,t+1,(t+4<NT),(t+2<NT),(t+2<NT));     ENDW(t+1); RESC(); ROT();
  }
  STEP(pB0,pB1,pA0,pA1,NT-2,false,true,true); WAIT_BAR(0); RESC(); ROT();
  STEP(pA0,pA1,pB0,pB1,NT-1,false,false,false); RESC();
  { float sacc=pA0[0]+pA0[1]; _Pragma("unroll") for(int r=2;r<16;++r)sacc+=pA0[r]; _Pragma("unroll") for(int r=0;r<16;++r)sacc+=pA1[r]; l_reg+=sacc;
    pw0=(u32x4){PKW(pA0,0),PKW(pA0,2),PKW(pA0,4),PKW(pA0,6)};pw1=(u32x4){PKW(pA0,8),PKW(pA0,10),PKW(pA0,12),PKW(pA0,14)};pw2=(u32x4){PKW(pA1,0),PKW(pA1,2),PKW(pA1,4),PKW(pA1,6)};pw3=(u32x4){PKW(pA1,8),PKW(pA1,10),PKW(pA1,12),PKW(pA1,14)};
    SBAR(); pv(o,vb0+sl_cur,PAF(0),PAF(1),PAF(2),PAF(3)); }
  #undef PKW
  #undef PAF
  #undef VFR
  #undef PIN
  #undef MX3
  #undef GAPA
  #undef GAPB
  #undef EX
  #undef VRD
  #undef KRD
  #undef STEP
  #undef ENDW
  {auto rr=__builtin_amdgcn_permlane32_swap(__float_as_uint(l_reg),__float_as_uint(l_reg),false,false);l_reg=__uint_as_float(rr[0])+__uint_as_float(rr[1]);}
  if constexpr(SWA){ l_reg+=__builtin_amdgcn_exp2f(btab[4*264+2*g+hh]-mhat); }
  int lane_e=threadIdx.x&63; asm volatile("":"+v"(lane_e)); const int r32e=lane_e&31,hie=lane_e>>5;
  if(hie==0)wsf[32+r32e]=l_reg;asm volatile("s_waitcnt lgkmcnt(0)":::"memory");
  float rli[16];
  #pragma unroll
  for(int r=0;r<16;++r)rli[r]=__builtin_amdgcn_rcpf(wsf[32+crow(r,hie)]);
  bf16*Ow=Oc+(long)qrow0*1024+hh*D;
  { bf16*stg=(bf16*)(shm+LDS_OST)+wid*2048;
    #pragma unroll
    for(int r=0;r<16;++r){const int orow=crow(r,hie);
      #pragma unroll
      for(int d0=0;d0<2;++d0)stg[orow*64+d0*32+r32e]=(bf16)(cvtpk_s(o[d0][r]*rli[r],0.f)&0xffffu);}
    asm volatile("s_waitcnt lgkmcnt(0)":::"memory");
    #pragma unroll
    for(int i=0;i<4;++i){const int row=i*8+(lane_e>>3),ch=lane_e&7; const u32x4 v=*(const u32x4*)(stg+row*64+ch*8); if(!meta||(blk==0&&row<NM))ATTN_STORE16(Ow+(long)row*1024+ch*8,v);} }
  asm volatile("s_waitcnt lgkmcnt(0)\n\ts_barrier":::"memory");
  #undef DMA_K
  #undef DMA_V
  #undef TROW
  #undef NEGC
  #undef CMASK
  #undef START
  #undef RESC
  #undef ROT
}
constexpr int ATTN_LDS_BYTES=LDS_BYTES;
#undef SBAR
#undef WAIT_BAR
}

#define GAS __attribute__((address_space(1)))
#define LAS __attribute__((address_space(3)))
typedef unsigned short bf16;
typedef unsigned v4u __attribute__((ext_vector_type(4)));
typedef float f32x4 __attribute__((ext_vector_type(4)));
typedef short bf16x8 __attribute__((ext_vector_type(8)));
typedef GAS unsigned gu32;
typedef GAS unsigned long long gu64;
#define RLX_AGENT __ATOMIC_RELAXED, __HIP_MEMORY_SCOPE_AGENT
#define LDS_WAIT() asm volatile("s_waitcnt lgkmcnt(0)" ::: "memory")
#define VM_WAIT() asm volatile("s_waitcnt vmcnt(0)" ::: "memory")
__device__ __forceinline__ unsigned long long rt() { return __builtin_amdgcn_s_memrealtime(); }
__device__ __forceinline__ unsigned pk2(float lo, float hi) { return (unsigned)f2bf(lo) | ((unsigned)f2bf(hi) << 16); }

#define XB_TMO      128
#define XB_XCNT(j)  (256  + 64 * (j))
#define XB_XSUB(j)  (1280 + 64 * (j))
#define XB_XGEN(j)  (2304 + 64 * (j))
#define XB_TOP      3328
#define XB_TOPGEN   3392
#define XCD_BAR_WORDS 3456
#define XB_SPIN_CAP (1u << 22)

__device__ __forceinline__ unsigned xb_ld(unsigned* p)              { return __hip_atomic_load(p, __ATOMIC_RELAXED, __HIP_MEMORY_SCOPE_AGENT); }
__device__ __forceinline__ unsigned xb_add(unsigned* p, unsigned v) { return __hip_atomic_fetch_add(p, v, __ATOMIC_RELAXED, __HIP_MEMORY_SCOPE_AGENT); }
__device__ __forceinline__ unsigned xb_xcc_id() { return (unsigned)__builtin_amdgcn_s_getreg((3 << 11) | 20) & 0xFu; }
#define XB_SPIN(cond, bar) do { unsigned _sp = 0; while (cond) { __builtin_amdgcn_s_sleep(1); \
    if ((++_sp & 255u) == 0u) { if (xb_ld(&(bar)[XB_TMO])) break; if (_sp > XB_SPIN_CAP) { atomicAdd(&(bar)[XB_TMO], 1u); break; } } } } while (0)

struct XcdBarrier {
    unsigned* bar; unsigned x;
    volatile LAS unsigned* st;
};

__device__ __forceinline__ XcdBarrier xcd_barrier_post(unsigned* bar, volatile LAS unsigned* st) {
    XcdBarrier b; b.bar = bar; b.x = xb_xcc_id(); b.st = st;
    if (threadIdx.x == 0) (void)xb_add(&bar[XB_XCNT(b.x)], 1u);
    return b;
}
__device__ __forceinline__ void xcd_barrier_complete(unsigned* bar, unsigned x, unsigned& nloc, unsigned& nx) {
    const unsigned G = gridDim.x * gridDim.y * gridDim.z;
    unsigned sum, cnt, mine, sp = 0u;
    for (;;) {
        sum = 0u; cnt = 0u; mine = 0u;
#pragma unroll
        for (unsigned j = 0; j < 16; ++j) { const unsigned c = xb_ld(&bar[XB_XCNT(j)]); sum += c; cnt += (c > 0u) ? 1u : 0u; mine = (j == x) ? c : mine; }
        if (sum == G) break;
        __builtin_amdgcn_s_sleep(1);
        if ((++sp & 255u) == 0u) { if (xb_ld(&bar[XB_TMO])) break; if (sp > XB_SPIN_CAP) { atomicAdd(&bar[XB_TMO], 1u); break; } }
    }
    nloc = mine > 0u ? mine : 1u; nx = cnt > 0u ? cnt : 1u;
}

__device__ __forceinline__ void xcd_barrier(const XcdBarrier& b) {
    asm volatile("s_waitcnt vmcnt(0)" ::: "memory");
    __syncthreads();
    if (threadIdx.x == 0) {
        unsigned* bar = b.bar;
        __builtin_amdgcn_s_waitcnt(0);
        unsigned nloc = b.st[0], nx = b.st[1];
        if (nloc == 0u) { xcd_barrier_complete(bar, b.x, nloc, nx); b.st[0] = nloc; b.st[1] = nx; }
        const unsigned old = xb_add(&bar[XB_XSUB(b.x)], 1u);
        const unsigned gen = old / nloc;
        if (old + 1u == (gen + 1u) * nloc) {
            __builtin_amdgcn_fence(__ATOMIC_RELEASE, "agent");
            asm volatile("s_waitcnt vmcnt(0)" ::: "memory");
            const unsigned og = xb_add(&bar[XB_TOP], 1u);
            const unsigned tg = og / nx;
            if (og + 1u == (tg + 1u) * nx) xb_add(&bar[XB_TOPGEN], 1u);
            else XB_SPIN(xb_ld(&bar[XB_TOPGEN]) == tg, bar);
            __builtin_amdgcn_fence(__ATOMIC_ACQUIRE, "agent");
            xb_add(&bar[XB_XGEN(b.x)], 1u);
            asm volatile("s_waitcnt vmcnt(0)" ::: "memory");
        } else {
            XB_SPIN(xb_ld(&bar[XB_XGEN(b.x)]) == gen, bar);
            __builtin_amdgcn_fence(__ATOMIC_ACQUIRE, "agent");
            asm volatile("s_waitcnt vmcnt(0)" ::: "memory");
        }
    }
    __syncthreads();
}

__device__ __forceinline__ void xcd_barrier_lean(const XcdBarrier& b) {
    asm volatile("s_waitcnt vmcnt(0)" ::: "memory");
    __syncthreads();
    if (threadIdx.x == 0) {
        unsigned* bar = b.bar; unsigned bx = b.x; asm volatile("" : "+s"(bar), "+s"(bx));
        __builtin_amdgcn_s_waitcnt(0);
        unsigned nloc = b.st[0], nx = b.st[1];
        const unsigned old = xb_add(&bar[XB_XSUB(bx)], 1u);
        const unsigned gen = old / nloc;
        if (old + 1u == (gen + 1u) * nloc) {
            __builtin_amdgcn_fence(__ATOMIC_RELEASE, "agent");
            asm volatile("s_waitcnt vmcnt(0)" ::: "memory");
            const unsigned og = xb_add(&bar[XB_TOP], 1u);
            const unsigned tg = og / nx;
            if (og + 1u == (tg + 1u) * nx) xb_add(&bar[XB_TOPGEN], 1u);
            else XB_SPIN(xb_ld(&bar[XB_TOPGEN]) == tg, bar);
            __builtin_amdgcn_fence(__ATOMIC_ACQUIRE, "agent");
            xb_add(&bar[XB_XGEN(bx)], 1u);
            asm volatile("s_waitcnt vmcnt(0)" ::: "memory");
        } else {
            XB_SPIN(xb_ld(&bar[XB_XGEN(bx)]) == gen, bar);
            __builtin_amdgcn_fence(__ATOMIC_ACQUIRE, "agent");
            asm volatile("s_waitcnt vmcnt(0)" ::: "memory");
        }
    }
    __syncthreads();
}

namespace mix {
typedef short bf16x8 __attribute__((ext_vector_type(8)));
typedef short s16x4 __attribute__((ext_vector_type(4)));
typedef float f32x4 __attribute__((ext_vector_type(4)));
typedef unsigned u32x4 __attribute__((ext_vector_type(4)));
typedef unsigned u32x2 __attribute__((ext_vector_type(2)));
typedef __attribute__((address_space(3))) const char* lcp;
typedef __attribute__((address_space(3))) char* lp;
#define MFMA16(a, b, c) __builtin_amdgcn_mfma_f32_16x16x32_bf16((a), (b), (c), 0, 0, 0)
__device__ __forceinline__ bf16x8 frag_row(lcp tile, int P, int row0, int k0, int fr, int quad) { return *(const __attribute__((address_space(3))) bf16x8*)(tile + (row0 + fr) * P + (k0 + 8 * quad) * 2); }
__device__ __forceinline__ bf16x8 frag_tr(lcp tile, int P, int k0, int col0, int fr, int quad) {
    typedef short v4i16_t __attribute__((ext_vector_type(4)));
    lcp a = tile + (k0 + 8 * quad + (fr >> 2)) * P + (col0 + 4 * (fr & 3)) * 2;
    const s16x4 lo = __builtin_bit_cast(s16x4, __builtin_amdgcn_ds_read_tr16_b64_v4i16((__attribute__((address_space(3))) v4i16_t*)a));
    const s16x4 hi = __builtin_bit_cast(s16x4, __builtin_amdgcn_ds_read_tr16_b64_v4i16((__attribute__((address_space(3))) v4i16_t*)(a + 4 * P)));
    return (bf16x8){lo[0], lo[1], lo[2], lo[3], hi[0], hi[1], hi[2], hi[3]};
}
__device__ __forceinline__ unsigned pkbf(float lo, float hi) { typedef float f2 __attribute__((ext_vector_type(2))); typedef __bf16 b2 __attribute__((ext_vector_type(2))); f2 v = {lo, hi}; return __builtin_bit_cast(unsigned, __builtin_convertvector(v, b2)); }
__device__ __forceinline__ float softplus_fast(float x) { return x > 20.f ? x : 0.6931471805599453f * __builtin_amdgcn_logf(1.0f + __builtin_amdgcn_exp2f(x * 1.4426950408889634f)); }
__device__ __forceinline__ float logsigmoid_fast(float x) { return x < -20.f ? x : -0.6931471805599453f * __builtin_amdgcn_logf(1.0f + __builtin_amdgcn_exp2f(-x * 1.4426950408889634f)); }
__device__ __forceinline__ float bflo(unsigned u) { return __uint_as_float(u << 16); }
__device__ __forceinline__ float bfhi(unsigned u) { return __uint_as_float(u & 0xffff0000u); }

constexpr int SSD_CT = 0, SSD_BT = 34816, SSD_XD = 69632, SSD_XW = 88064, SSD_SB = 106496, SSD_ACS = 123904, SSD_DTL = 124416, SSD_LDS = 124928;
__device__ __forceinline__ int ssd_tok(int c, int l, int dir) { return dir == 0 ? 128 * c - 112 + l : 128 * (32 - c) + 15 - l; }
__device__ __forceinline__ void ssd_stream(int b, int h, int dir, const bf16* xbca, const float* dtga, float dt_bias, float a_neg, bf16* yout, int ypitch, lp lds) {
    int tid = threadIdx.x; asm volatile("" : "+v"(tid));
    const int lane = tid & 63, fr = lane & 15, quad = lane >> 4; const int w = __builtin_amdgcn_readfirstlane(tid >> 6);
    const int g = h >> 1;
    constexpr int P128 = 272, P64 = 144;
    f32x4 S[4];
#pragma unroll
    for (int pb = 0; pb < 4; ++pb) S[pb] = (f32x4){0.f, 0.f, 0.f, 0.f};
    __attribute__((address_space(3))) float* acs = (__attribute__((address_space(3))) float*)(lds + SSD_ACS);
    __attribute__((address_space(3))) float* dtl = (__attribute__((address_space(3))) float*)(lds + SSD_DTL);
    u32x4 pc[4], pbv[4], px[2]; float pd0 = 0.f, pd1 = 0.f;
#define SSD_PREFETCH(cc) do { \
        _Pragma("unroll") for (int i = 0; i < 4; ++i) { const int id = tid + 512 * i, row = id >> 4, ch = id & 15; const int t = ssd_tok((cc), row, dir); pc[i] = (u32x4){0u, 0u, 0u, 0u}; pbv[i] = (u32x4){0u, 0u, 0u, 0u}; \
            if (t >= 0) { const bf16* src = xbca + (size_t)row_of(b, t) * XW + g * 128 + ch * 8; pbv[i] = *(const u32x4*)(src + 256); pc[i] = *(const u32x4*)(src + 512); } } \
        _Pragma("unroll") for (int i = 0; i < 2; ++i) { const int id = tid + 512 * i, row = id >> 3, ch = id & 7; const int t = ssd_tok((cc), row, dir); px[i] = (u32x4){0u, 0u, 0u, 0u}; \
            if (t >= 0) px[i] = *(const u32x4*)(xbca + (size_t)row_of(b, t) * XW + h * 64 + ch * 8); } \
        if (w == 0) { const int t0 = ssd_tok((cc), 2 * lane, dir), t1 = ssd_tok((cc), 2 * lane + 1, dir); \
            pd0 = t0 >= 0 ? dtga[(size_t)row_of(b, t0 < 0 ? 0 : t0) * DGW + dir * 4 + h] : 0.f; pd1 = t1 >= 0 ? dtga[(size_t)row_of(b, t1 < 0 ? 0 : t1) * DGW + dir * 4 + h] : 0.f; } } while (0)
    SSD_PREFETCH(0);
    for (int c = 0; c < 33; ++c) {
        if (w == 0) {
            const int t0 = ssd_tok(c, 2 * lane, dir), t1 = ssd_tok(c, 2 * lane + 1, dir);
            const float d0 = t0 >= 0 ? softplus_fast(pd0 + dt_bias) : 0.f, d1 = t1 >= 0 ? softplus_fast(pd1 + dt_bias) : 0.f;
            const float v0 = d0 * a_neg, v1 = v0 + d1 * a_neg;
            float inc = v1;
#pragma unroll
            for (int o = 1; o < 64; o <<= 1) { const float u = __shfl_up(inc, o); if (lane >= o) inc += u; }
            const float pre = inc - v1;
            acs[2 * lane] = pre + v0; acs[2 * lane + 1] = pre + v1; dtl[2 * lane] = d0; dtl[2 * lane + 1] = d1;
        }
#pragma unroll
        for (int i = 0; i < 4; ++i) { const int id = tid + 512 * i, row = id >> 4, ch = id & 15;
            *(__attribute__((address_space(3))) u32x4*)(lds + SSD_CT + row * P128 + ch * 16) = pc[i]; *(__attribute__((address_space(3))) u32x4*)(lds + SSD_BT + row * P128 + ch * 16) = pbv[i]; }
#pragma unroll
        for (int pb = 0; pb < 4; ++pb) { u32x2 v; v.x = pkbf(S[pb][0], S[pb][1]); v.y = pkbf(S[pb][2], S[pb][3]);
            *(__attribute__((address_space(3))) u32x2*)(lds + SSD_SB + (16 * pb + fr) * P128 + (16 * w + 4 * quad) * 2) = v; }
        __syncthreads();
        const float alast = acs[127];
#pragma unroll
        for (int i = 0; i < 2; ++i) { const int id = tid + 512 * i, row = id >> 3, ch = id & 7; const u32x4 vx = px[i];
            const float d = dtl[row], dw = d * __expf(alast - acs[row]);
            u32x4 o1, o2;
            o1.x = pkbf(bflo(vx.x) * d, bfhi(vx.x) * d); o1.y = pkbf(bflo(vx.y) * d, bfhi(vx.y) * d); o1.z = pkbf(bflo(vx.z) * d, bfhi(vx.z) * d); o1.w = pkbf(bflo(vx.w) * d, bfhi(vx.w) * d);
            o2.x = pkbf(bflo(vx.x) * dw, bfhi(vx.x) * dw); o2.y = pkbf(bflo(vx.y) * dw, bfhi(vx.y) * dw); o2.z = pkbf(bflo(vx.z) * dw, bfhi(vx.z) * dw); o2.w = pkbf(bflo(vx.w) * dw, bfhi(vx.w) * dw);
            *(__attribute__((address_space(3))) u32x4*)(lds + SSD_XD + row * P64 + ch * 16) = o1; *(__attribute__((address_space(3))) u32x4*)(lds + SSD_XW + row * P64 + ch * 16) = o2; }
        if (c + 1 < 33) SSD_PREFETCH(c + 1);
        __syncthreads();
        f32x4 G[8];
#pragma unroll
        for (int sb = 0; sb < 8; ++sb) { G[sb] = (f32x4){0.f, 0.f, 0.f, 0.f};
            if (sb <= w) {
#pragma unroll
                for (int ks = 0; ks < 4; ++ks) G[sb] = MFMA16(frag_row(lds + SSD_BT, P128, 16 * sb, 32 * ks, fr, quad), frag_row(lds + SSD_CT, P128, 16 * w, 32 * ks, fr, quad), G[sb]); } }
        { const float dec = __expf(alast);
#pragma unroll
            for (int pb = 0; pb < 4; ++pb) S[pb] = S[pb] * dec;
#pragma unroll
            for (int ks = 0; ks < 4; ++ks) { const bf16x8 fb = frag_tr(lds + SSD_BT, P128, 32 * ks, 16 * w, fr, quad);
#pragma unroll
                for (int pb = 0; pb < 4; ++pb) S[pb] = MFMA16(fb, frag_tr(lds + SSD_XW, P64, 32 * ks, 16 * pb, fr, quad), S[pb]); } }
        __syncthreads();
        { const int l = 16 * w + fr; const float al = acs[l]; int dq = fr - 4 * quad; asm volatile("" : "+v"(dq));
#pragma unroll
            for (int sb = 0; sb < 8; ++sb) { u32x2 v = {0u, 0u};
                if (sb <= w) { const int s0 = 16 * sb + 4 * quad; const f32x4 as = *(const __attribute__((address_space(3))) f32x4*)(acs + s0);
                    const bool dg = sb == w;
                    const float e0 = (!dg || 0 <= dq) ? G[sb][0] * __expf(al - as[0]) : 0.f, e1 = (!dg || 1 <= dq) ? G[sb][1] * __expf(al - as[1]) : 0.f;
                    const float e2 = (!dg || 2 <= dq) ? G[sb][2] * __expf(al - as[2]) : 0.f, e3 = (!dg || 3 <= dq) ? G[sb][3] * __expf(al - as[3]) : 0.f;
                    v.x = pkbf(e0, e1); v.y = pkbf(e2, e3); }
                *(__attribute__((address_space(3))) u32x2*)(lds + SSD_BT + l * P128 + (16 * sb + 4 * quad) * 2) = v; } }
        __syncthreads();
        f32x4 Y[4], YO[4];
#pragma unroll
        for (int pb = 0; pb < 4; ++pb) { Y[pb] = (f32x4){0.f, 0.f, 0.f, 0.f}; YO[pb] = (f32x4){0.f, 0.f, 0.f, 0.f}; }
#pragma unroll
        for (int ks = 0; ks < 4; ++ks) {
            if (32 * ks <= 16 * w + 15) { const bf16x8 fs = frag_row(lds + SSD_BT, P128, 16 * w, 32 * ks, fr, quad);
#pragma unroll
                for (int pb = 0; pb < 4; ++pb) Y[pb] = MFMA16(frag_tr(lds + SSD_XD, P64, 32 * ks, 16 * pb, fr, quad), fs, Y[pb]); }
            const bf16x8 fc = frag_row(lds + SSD_CT, P128, 16 * w, 32 * ks, fr, quad);
#pragma unroll
            for (int pb = 0; pb < 4; ++pb) YO[pb] = MFMA16(frag_row(lds + SSD_SB, P128, 16 * pb, 32 * ks, fr, quad), fc, YO[pb]);
        }
        { const int l = 16 * w + fr; const float el = __expf(acs[l]); const int t = ssd_tok(c, l, dir);
            if (t >= 0) { bf16* op = yout + (size_t)row_of(b, t) * ypitch + h * 64 + 4 * quad;
#pragma unroll
                for (int pb = 0; pb < 4; ++pb) { const f32x4 y = Y[pb] + YO[pb] * el; u32x2 v; v.x = pkbf(y[0], y[1]); v.y = pkbf(y[2], y[3]); *(u32x2*)(op + 16 * pb) = v; } } }
        __syncthreads();
    }
}

constexpr int GLA_QT = 0, GLA_KT = 5120, GLA_KD = 10240, GLA_V = 15360, GLA_ATT = 24576, GLA_SB = 33792, GLA_WTOT = 38912, GLA_W2 = 39936, GLA_GB = 41984, GLA_LDS = 42112;
__device__ __forceinline__ int gla_tok(int c, int l, int dir) { return dir == 0 ? 64 * c - 48 + l : 64 * (64 - c) + 15 - l; }
__device__ __forceinline__ void gla_stream(int b, int h, int dir, const bf16* proj, const float* dtga, const float* gate_w2, const float* gate_b, bf16* oout, int opitch, lp lds) {
    int tid = threadIdx.x; asm volatile("" : "+v"(tid));
    const int lane = tid & 63, fr = lane & 15, quad = lane >> 4; const int w = __builtin_amdgcn_readfirstlane(tid >> 6);
    constexpr int P32 = 80, P64 = 144;
    typedef __attribute__((address_space(3))) float lfloat; typedef __attribute__((address_space(3))) f32x4 lf4;
    lfloat* wtot = (lfloat*)(lds + GLA_WTOT); lfloat* w2s = (lfloat*)(lds + GLA_W2); lfloat* gbs = (lfloat*)(lds + GLA_GB);
    for (int i = tid; i < 16 * 32; i += 512) w2s[i] = gate_w2[(dir * 16 + (i >> 5)) * 128 + h * 32 + (i & 31)];
    if (tid < 32) gbs[tid] = gate_b[dir * 128 + h * 32 + tid];
    __syncthreads();
    const int kb = w & 1, vbs = w >> 1;
    f32x4 S = {0.f, 0.f, 0.f, 0.f};
    const int rl = tid >> 3, kq = tid & 7;
    f32x4 pa0, pa1, pa2, pa3; unsigned long long pqq, pkk; u32x4 pvv; bool pok;
#define GLA_PREFETCH(cc) do { const int t_ = gla_tok((cc), rl, dir); pok = t_ >= 0; const size_t row_ = (size_t)row_of(b, pok ? t_ : 0); \
        pa0 = (f32x4){0.f, 0.f, 0.f, 0.f}; pa1 = pa0; pa2 = pa0; pa3 = pa0; pqq = 0ull; pkk = 0ull; pvv = (u32x4){0u, 0u, 0u, 0u}; \
        if (pok) { const float* ap = dtga + row_ * DGW + 8 + dir * 16; pa0 = *(const f32x4*)ap; pa1 = *(const f32x4*)(ap + 4); pa2 = *(const f32x4*)(ap + 8); pa3 = *(const f32x4*)(ap + 12); \
            pqq = *(const unsigned long long*)(proj + row_ * PW + PGQ + h * 32 + 4 * kq); pkk = *(const unsigned long long*)(proj + row_ * PW + PGK + h * 32 + 4 * kq); \
            pvv = *(const u32x4*)(proj + row_ * PW + PGV + h * 64 + 8 * kq); } } while (0)
    GLA_PREFETCH(0);
    for (int c = 0; c < 65; ++c) {
        const bool ok = pok;
        float gv[4] = {0.f, 0.f, 0.f, 0.f}; float qv[4] = {0.f, 0.f, 0.f, 0.f}, kv[4] = {0.f, 0.f, 0.f, 0.f}; const u32x4 vv = pvv;
        if (ok) {
            const f32x4 a0 = pa0, a1 = pa1, a2 = pa2, a3 = pa3;
            f32x4 z = *(const lf4*)(gbs + 4 * kq);
#pragma unroll
            for (int r = 0; r < 16; ++r) { const float ar = r < 4 ? a0[r & 3] : (r < 8 ? a1[r & 3] : (r < 12 ? a2[r & 3] : a3[r & 3])); const f32x4 ww = *(const lf4*)(w2s + r * 32 + 4 * kq); z = z + ww * ar; }
#pragma unroll
            for (int j = 0; j < 4; ++j) gv[j] = logsigmoid_fast(z[j]) * (1.0f / 16.0f);
            const unsigned long long qq = pqq, kk = pkk;
#pragma unroll
            for (int j = 0; j < 4; ++j) { qv[j] = __uint_as_float((unsigned)((qq >> (16 * j)) & 0xffffu) << 16) * 0.17677669529663687f; kv[j] = __uint_as_float((unsigned)((kk >> (16 * j)) & 0xffffu) << 16); }
        }
        if (c + 1 < 65) GLA_PREFETCH(c + 1);
        float bc[4];
#pragma unroll
        for (int j = 0; j < 4; ++j) { float x = gv[j];
#pragma unroll
            for (int o = 8; o < 64; o <<= 1) { const float u = __shfl_up(x, o); if (lane >= o) x += u; }
            bc[j] = x; }
        if (lane >= 56) { *(lf4*)(wtot + w * 32 + 4 * kq) = (f32x4){bc[0], bc[1], bc[2], bc[3]}; }
        *(__attribute__((address_space(3))) u32x4*)(lds + GLA_V + rl * P64 + kq * 16) = vv;
        { u32x2 sv; sv.x = pkbf(S[0], S[1]); sv.y = pkbf(S[2], S[3]); *(__attribute__((address_space(3))) u32x2*)(lds + GLA_SB + (16 * vbs + fr) * P32 + (16 * kb + 4 * quad) * 2) = sv; }
        __syncthreads();
        f32x4 pre = {0.f, 0.f, 0.f, 0.f}, blast = {0.f, 0.f, 0.f, 0.f};
#pragma unroll
        for (int ww = 0; ww < 8; ++ww) { const f32x4 tt = *(const lf4*)(wtot + ww * 32 + 4 * kq); blast = blast + tt; if (ww < w) pre = pre + tt; }
        { u32x2 oq, ok2, od; float e[4], en[4], ed[4];
#pragma unroll
            for (int j = 0; j < 4; ++j) { const float bb = bc[j] + pre[j]; e[j] = qv[j] * __expf(bb); en[j] = kv[j] * __expf(-bb); ed[j] = kv[j] * __expf(blast[j] - bb); }
            oq.x = pkbf(e[0], e[1]); oq.y = pkbf(e[2], e[3]); ok2.x = pkbf(en[0], en[1]); ok2.y = pkbf(en[2], en[3]); od.x = pkbf(ed[0], ed[1]); od.y = pkbf(ed[2], ed[3]);
            *(__attribute__((address_space(3))) u32x2*)(lds + GLA_QT + rl * P32 + kq * 8) = oq; *(__attribute__((address_space(3))) u32x2*)(lds + GLA_KT + rl * P32 + kq * 8) = ok2; *(__attribute__((address_space(3))) u32x2*)(lds + GLA_KD + rl * P32 + kq * 8) = od; }
        __syncthreads();
        { const int lb = w & 3;
#pragma unroll
            for (int i = 0; i < 2; ++i) { const int sb = 2 * (w >> 2) + i; f32x4 A = {0.f, 0.f, 0.f, 0.f};
                if (sb <= lb) A = MFMA16(frag_row(lds + GLA_KT, P32, 16 * sb, 0, fr, quad), frag_row(lds + GLA_QT, P32, 16 * lb, 0, fr, quad), A);
                const int l = 16 * lb + fr, s0 = 16 * sb + 4 * quad; u32x2 v;
                v.x = pkbf(s0 + 0 <= l ? A[0] : 0.f, s0 + 1 <= l ? A[1] : 0.f); v.y = pkbf(s0 + 2 <= l ? A[2] : 0.f, s0 + 3 <= l ? A[3] : 0.f);
                *(__attribute__((address_space(3))) u32x2*)(lds + GLA_ATT + l * P64 + s0 * 2) = v; } }
        { const f32x4 bl = *(const lf4*)(wtot + 0 * 32 + 16 * kb + 4 * quad) + *(const lf4*)(wtot + 1 * 32 + 16 * kb + 4 * quad)
                         + *(const lf4*)(wtot + 2 * 32 + 16 * kb + 4 * quad) + *(const lf4*)(wtot + 3 * 32 + 16 * kb + 4 * quad)
                         + *(const lf4*)(wtot + 4 * 32 + 16 * kb + 4 * quad) + *(const lf4*)(wtot + 5 * 32 + 16 * kb + 4 * quad)
                         + *(const lf4*)(wtot + 6 * 32 + 16 * kb + 4 * quad) + *(const lf4*)(wtot + 7 * 32 + 16 * kb + 4 * quad);
            S[0] *= __expf(bl[0]); S[1] *= __expf(bl[1]); S[2] *= __expf(bl[2]); S[3] *= __expf(bl[3]);
#pragma unroll
            for (int ks = 0; ks < 2; ++ks) S = MFMA16(frag_tr(lds + GLA_KD, P32, 32 * ks, 16 * kb, fr, quad), frag_tr(lds + GLA_V, P64, 32 * ks, 16 * vbs, fr, quad), S); }
        __syncthreads();
        { const int lb = w & 3; const int l = 16 * lb + fr; const int to = gla_tok(c, l, dir);
            const bf16x8 fq = frag_row(lds + GLA_QT, P32, 16 * lb, 0, fr, quad);
#pragma unroll
            for (int i = 0; i < 2; ++i) { const int vb = 2 * (w >> 2) + i; f32x4 O = {0.f, 0.f, 0.f, 0.f};
#pragma unroll
                for (int ks = 0; ks < 2; ++ks) if (32 * ks <= 16 * lb + 15) O = MFMA16(frag_tr(lds + GLA_V, P64, 32 * ks, 16 * vb, fr, quad), frag_row(lds + GLA_ATT, P64, 16 * lb, 32 * ks, fr, quad), O);
                O = MFMA16(frag_row(lds + GLA_SB, P32, 16 * vb, 0, fr, quad), fq, O);
                if (to >= 0) { u32x2 v; v.x = pkbf(O[0], O[1]); v.y = pkbf(O[2], O[3]); *(u32x2*)(oout + (size_t)row_of(b, to) * opitch + h * 64 + 16 * vb + 4 * quad) = v; } } }
        __syncthreads();
    }
}
#undef SSD_PREFETCH
#undef GLA_PREFETCH
}

constexpr int NWAVES = 8;
constexpr size_t MiB = 1u << 20;
constexpr size_t WS_CTL = 0, CTL_ZERO_BYTES = 1 * MiB;
constexpr size_t WS_DTGA = 1 * MiB;
constexpr size_t WS_ROUTE = 10 * MiB;
constexpr size_t WS_HMETA = 12 * MiB;
constexpr size_t WS_WIN = 13 * MiB;
constexpr size_t WS_WOUT = WS_WIN + 2ull * 3072 * 1024 * 2;
constexpr size_t WS_WGU = WS_WOUT + 2ull * 1024 * 1024 * 2;
constexpr size_t WS_WD = WS_WGU + 5632ull * 1024 * 2;
constexpr size_t WS_WMOE_GU = 46 * MiB;
constexpr size_t WS_WMOE_D = WS_WMOE_GU + 8ull * 7168 * 1024 * 2;
constexpr size_t WS_BIG = 214 * MiB;
constexpr size_t WS_TMP = 392 * MiB;
constexpr size_t WS_ACT = 457 * MiB;
constexpr size_t WS_END = 522 * MiB;
static_assert(WS_WD + 1024ull * 2816 * 2 <= WS_WMOE_GU && WS_WMOE_D + 8ull * 1024 * 3584 * 2 <= WS_BIG && WS_BIG + (size_t)MP * PW * 2 <= WS_TMP && WS_TMP + (size_t)MP * 1024 * 2 <= WS_ACT && WS_ACT + (size_t)MP * 1024 * 2 <= WS_END, "ws map");
static_assert(WS_DTGA + (size_t)MP * DGW * 4 <= WS_ROUTE, "ws map 2");
constexpr int CAP_TILES = 69;
constexpr size_t MOE_ACT_BYTES = (size_t)CAP_TILES * 256 * 3584 * 2;
static_assert(WS_BIG + 2 * MOE_ACT_BYTES <= WS_ACT, "moe pass buffers");
constexpr int MAX_SROWS = 2 * (NREG + 8 * 256);
constexpr size_t RT_E = 0;
constexpr size_t RT_G = RT_E + (size_t)NREG * 4;
constexpr size_t RT_STOK = RT_G + (size_t)NREG * 8;
constexpr size_t RT_SGATE = RT_STOK + (size_t)MAX_SROWS * 4;
constexpr size_t RT_TEXP = RT_SGATE + (size_t)MAX_SROWS * 4;
constexpr size_t RT_PASS = RT_TEXP + 4096;
constexpr size_t RT_SSA = RT_PASS + 64;
constexpr size_t RT_RANK = RT_SSA + (size_t)MAX_SROWS * 4;
constexpr size_t RT_BLKCNT = RT_RANK + (size_t)NREG * 4;
constexpr size_t RT_STOKP = RT_BLKCNT + 1024 * 64;
static_assert(RT_STOKP + (size_t)MAX_SROWS * 4 <= 2 * MiB, "route tables");
__device__ __forceinline__ int permp(int p) { return (p & ~255) | ((p & 63) << 2) | ((p >> 6) & 3); }
constexpr int CW_BAR = 4096, CW_Q = 8192;
constexpr int LDS_BYTES = 155648, LDSCTL_OFF = 143360, MISC_OFF = LDSCTL_OFF + 320;

__device__ __forceinline__ float wave_sum(float v) {
#pragma unroll
    for (int o = 1; o < 64; o <<= 1) v += __shfl_xor(v, o);
    return v;
}
__device__ __forceinline__ float wave_sum_sw(float v) {
    v += __int_as_float(__builtin_amdgcn_ds_swizzle(__float_as_int(v), (1 << 10) | 0x1f)); v += __int_as_float(__builtin_amdgcn_ds_swizzle(__float_as_int(v), (2 << 10) | 0x1f));
    v += __int_as_float(__builtin_amdgcn_ds_swizzle(__float_as_int(v), (4 << 10) | 0x1f)); v += __int_as_float(__builtin_amdgcn_ds_swizzle(__float_as_int(v), (8 << 10) | 0x1f));
    v += __int_as_float(__builtin_amdgcn_ds_swizzle(__float_as_int(v), (16 << 10) | 0x1f));
    return __int_as_float(__builtin_amdgcn_readlane(__float_as_int(v), 0)) + __int_as_float(__builtin_amdgcn_readlane(__float_as_int(v), 32));
}
__device__ __forceinline__ int wmap(int kind, int n) {
    if (kind == 0) return n;
    if (kind == 1) { if (n < 1024) return n; if (n < 1032) return 2816 + (n - 1024); if (n < 1800) return n - 8; if (n < 1832) return 2824 + (n - 1800); return n - 40; }
    return (n >> 7) * 256 + (n & 127) + (kind == 3 ? 128 : 0);
}
__device__ __forceinline__ float wscale(int kind, int n) { return (kind == 1 && n >= 1832 && n < 2088) ? 0.125f * 1.4426950408889634f : 1.0f; }
__device__ __forceinline__ void transpose_mat(const float* W, int K, int N, bf16* WT, int kind, LAS float* scr, int gw, int NGW, int lane, bool tiled = false) {
    const int nblk = (N + 31) / 32, nitems = (K / 64) * nblk;
    for (int item = gw; item < nitems; item += NGW) {
        const int kb = item / nblk, nb = item % nblk, k0 = 64 * kb, n0 = 32 * nb;
        const int nn = n0 + (lane & 31); const float wsc = wscale(kind, nn);
        float wv[32];
#pragma unroll
        for (int i = 0; i < 32; ++i) { const int kk = 2 * i + (lane >> 5); wv[i] = nn < N ? __builtin_nontemporal_load(W + (size_t)(k0 + kk) * N + nn) : 0.f; }
#pragma unroll
        for (int i = 0; i < 32; ++i) { const int kk = 2 * i + (lane >> 5); scr[kk * 33 + (lane & 31)] = wv[i] * wsc; }
        LDS_WAIT(); asm volatile("" ::: "memory");
        const int c = lane & 7;
#pragma unroll
        for (int j = 0; j < 4; ++j) { const int n = (lane >> 3) + 8 * j; const LAS float* s = scr + (8 * c) * 33 + n;
            v4u o; o.x = pk2(s[0 * 33], s[1 * 33]); o.y = pk2(s[2 * 33], s[3 * 33]); o.z = pk2(s[4 * 33], s[5 * 33]); o.w = pk2(s[6 * 33], s[7 * 33]);
            if (n0 + n < N) { const int rn = wmap(kind, n0 + n);
                if (tiled) *(GAS v4u*)(WT + ((size_t)(rn >> 8) * (K >> 6) + (k0 >> 6)) * 16384 + (size_t)(rn & 255) * 64 + 8 * c) = o; else *(GAS v4u*)(WT + (size_t)rn * K + k0 + 8 * c) = o; } }
        LDS_WAIT(); asm volatile("" ::: "memory");
    }
}
__device__ __forceinline__ void colmax_mat(const float* W, int K, int N, unsigned* cmax, int kind, int gw, int NGW, int lane) {
    const int nblk = (N + 63) / 64, nitems = (K / 64) * nblk;
    for (int item = gw; item < nitems; item += NGW) { const int kb = item / nblk, nb = item % nblk, n = 64 * nb + lane;
        float m = 0.f;
        if (n < N) {
#pragma unroll 16
            for (int kk = 0; kk < 64; ++kk) m = fmaxf(m, fabsf(__builtin_nontemporal_load(W + (size_t)(64 * kb + kk) * N + n))); }
        if (n < N) atomicMax(cmax + wmap(kind, n), __float_as_uint(m * wscale(kind, n))); }
}
__device__ __forceinline__ void quant_mat(const float* W, int K, int N, signed char* W8, float* sB, const unsigned* cmax, int kind, LAS float* scr, int gw, int NGW, int lane, int maxrow = 1 << 30) {
    const int nblk = (N + 31) / 32, nitems = (K / 64) * nblk;
    for (int item = gw; item < nitems; item += NGW) {
        const int kb = item / nblk, nb = item % nblk, k0 = 64 * kb, n0 = 32 * nb; const int nn = n0 + (lane & 31);
        const float cm = nn < N ? __uint_as_float(cmax[wmap(kind, nn)]) : 1.f, qs = (cm > 0.f ? 127.0f / cm : 0.f) * wscale(kind, nn);
        if (kb == 0 && lane < 32 && nn < N && wmap(kind, nn) < maxrow) sB[wmap(kind, nn)] = cm * (1.0f / 127.0f);
        float wv[32];
#pragma unroll
        for (int i = 0; i < 32; ++i) { const int kk = 2 * i + (lane >> 5); wv[i] = nn < N ? __builtin_nontemporal_load(W + (size_t)(k0 + kk) * N + nn) : 0.f; }
#pragma unroll
        for (int i = 0; i < 32; ++i) { const int kk = 2 * i + (lane >> 5); scr[kk * 33 + (lane & 31)] = rintf(wv[i] * qs); }
        LDS_WAIT(); asm volatile("" ::: "memory");
        const int c = lane & 7;
#pragma unroll
        for (int j = 0; j < 4; ++j) { const int n = (lane >> 3) + 8 * j; const LAS float* s = scr + (8 * c) * 33 + n;
            unsigned lo = 0u, hi = 0u;
#pragma unroll
            for (int q = 0; q < 4; ++q) { lo |= ((unsigned)((int)s[q * 33]) & 0xffu) << (8 * q); hi |= ((unsigned)((int)s[(4 + q) * 33]) & 0xffu) << (8 * q); }
            if (n0 + n < N && wmap(kind, n0 + n) < maxrow) *(GAS unsigned long long*)(W8 + (size_t)wmap(kind, n0 + n) * K + k0 + 8 * c) = (unsigned long long)lo | ((unsigned long long)hi << 32); }
        LDS_WAIT(); asm volatile("" ::: "memory");
    }
}
__device__ __forceinline__ void absmax_all(const float* W, long n4, unsigned* amax, long gtid, long nthreads, int lane) {
    float m = 0.f;
    for (long i = gtid; i < n4; i += nthreads) { const f32x4 v = __builtin_nontemporal_load((const GAS f32x4*)W + i); m = fmaxf(fmaxf(m, fmaxf(fabsf(v.x), fabsf(v.y))), fmaxf(fabsf(v.z), fabsf(v.w))); }
    m = fmaxf(m, __int_as_float(__builtin_amdgcn_ds_swizzle(__float_as_int(m), (1 << 10) | 0x1f))); m = fmaxf(m, __int_as_float(__builtin_amdgcn_ds_swizzle(__float_as_int(m), (2 << 10) | 0x1f)));
    m = fmaxf(m, __int_as_float(__builtin_amdgcn_ds_swizzle(__float_as_int(m), (4 << 10) | 0x1f))); m = fmaxf(m, __int_as_float(__builtin_amdgcn_ds_swizzle(__float_as_int(m), (8 << 10) | 0x1f)));
    m = fmaxf(m, __int_as_float(__builtin_amdgcn_ds_swizzle(__float_as_int(m), (16 << 10) | 0x1f)));
    if ((lane & 31) == 0) atomicMax(amax, __float_as_uint(m));
}
__device__ __forceinline__ float f8_scale(unsigned amax_bits, bool inverse) { const int e = (int)(amax_bits >> 23) - 127; if (amax_bits == 0u) return 1.0f; return __uint_as_float((unsigned)(127 + (inverse ? e - 7 : 7 - e)) << 23); }
__device__ __forceinline__ void quant_f8_mat(const float* W, int K, int N, unsigned char* W8, float S, LAS float* scr, int gw, int NGW, int lane) {
    const int nblk = (N + 31) / 32, nitems = (K / 64) * nblk;
    for (int item = gw; item < nitems; item += NGW) {
        const int kb = item / nblk, nb = item % nblk, k0 = 64 * kb, n0 = 32 * nb; const int nn = n0 + (lane & 31);
        float wv[32];
#pragma unroll
        for (int i = 0; i < 32; ++i) { const int kk = 2 * i + (lane >> 5); wv[i] = nn < N ? __builtin_nontemporal_load(W + (size_t)(k0 + kk) * N + nn) : 0.f; }
#pragma unroll
        for (int i = 0; i < 32; ++i) { const int kk = 2 * i + (lane >> 5); scr[kk * 33 + (lane & 31)] = wv[i] * S; }
        LDS_WAIT(); asm volatile("" ::: "memory");
        const int c = lane & 7;
#pragma unroll
        for (int j = 0; j < 4; ++j) { const int n = (lane >> 3) + 8 * j; const LAS float* s = scr + (8 * c) * 33 + n;
            unsigned lo = 0u, hi = 0u; lo = __builtin_amdgcn_cvt_pk_fp8_f32(s[0 * 33], s[1 * 33], lo, false); lo = __builtin_amdgcn_cvt_pk_fp8_f32(s[2 * 33], s[3 * 33], lo, true);
            hi = __builtin_amdgcn_cvt_pk_fp8_f32(s[4 * 33], s[5 * 33], hi, false); hi = __builtin_amdgcn_cvt_pk_fp8_f32(s[6 * 33], s[7 * 33], hi, true);
            const int rn = n0 + n;
            if (rn < N) *(GAS unsigned long long*)(W8 + ((size_t)(rn >> 8) * (K >> 7) + (k0 >> 7)) * 32768 + (size_t)(rn & 255) * 128 + (k0 & 127) + 8 * c) = (unsigned long long)lo | ((unsigned long long)hi << 32); }
        LDS_WAIT(); asm volatile("" ::: "memory");
    }
}
__device__ __forceinline__ void rms_row_to_bf16(const float* xrow, const float* w, bf16* orow, int lane) {
    const GAS f32x4* xr = (const GAS f32x4*)xrow + lane; const GAS f32x4* wr = (const GAS f32x4*)w + lane;
    f32x4 v[4]; float s = 0.f;
#pragma unroll
    for (int j = 0; j < 4; ++j) { v[j] = xr[64 * j]; s += (v[j].x * v[j].x + v[j].y * v[j].y) + (v[j].z * v[j].z + v[j].w * v[j].w); }
    const float rstd = 1.f / sqrtf(wave_sum(s) * (1.f / 1024.f) + 1e-6f);
    GAS unsigned long long* o8 = (GAS unsigned long long*)orow + lane;
#pragma unroll
    for (int j = 0; j < 4; ++j) { const f32x4 ww = wr[64 * j]; o8[64 * j] = (unsigned long long)pk2(v[j].x * rstd * ww.x, v[j].y * rstd * ww.y) | ((unsigned long long)pk2(v[j].z * rstd * ww.z, v[j].w * rstd * ww.w) << 32); }
}

#ifndef N_LAUNCH_MODE
#define N_LAUNCH_MODE 1
#endif

template <int NB> __device__ __forceinline__ void skinny_task(const bf16* A, int K, int rb, const bf16* Bt, int b0, int bstep, f32x4 (&acc)[NB], int lane) {
    const int fr = lane & 15, quad = lane >> 4;
    const bf16* ap = A + (size_t)(16 * rb + fr) * K + 8 * quad; const bf16* bp = Bt + (size_t)(b0 + fr) * K + 8 * quad;
#pragma unroll
    for (int nb = 0; nb < NB; ++nb) acc[nb] = (f32x4){0.f, 0.f, 0.f, 0.f};
#pragma unroll 8
    for (int ks = 0; ks < K / 32; ++ks) { const bf16x8 av = *(const GAS bf16x8*)(ap + 32 * ks);
#pragma unroll
        for (int nb = 0; nb < NB; ++nb) acc[nb] = __builtin_amdgcn_mfma_f32_16x16x32_bf16(av, *(const GAS bf16x8*)(bp + (size_t)nb * bstep * K + 32 * ks), acc[nb], 0, 0, 0); }
}
__device__ __forceinline__ f32x4 bf4_f32(unsigned long long q) { f32x4 v; v.x = __uint_as_float((unsigned)q << 16); v.y = __uint_as_float((unsigned)q & 0xffff0000u); v.z = __uint_as_float((unsigned)(q >> 32) << 16); v.w = __uint_as_float((unsigned)(q >> 32) & 0xffff0000u); return v; }
constexpr int HP = 2048;
template <bool IN16 = false>
__device__ __forceinline__ void rms_row2_to_bf16(const void* xa, const void* xb, const f32x4 (&wreg)[4], bf16* oa, bf16* ob, int lane, signed char* qa8 = nullptr, signed char* qb8 = nullptr, float* sa8 = nullptr, float* sb8 = nullptr) {
    f32x4 va[4], vb[4]; float sa = 0.f, sb = 0.f;
    if constexpr (IN16) { const GAS unsigned long long* pa = (const GAS unsigned long long*)xa + lane; const GAS unsigned long long* pb = (const GAS unsigned long long*)xb + lane; unsigned long long ta[4], tb[4];
#pragma unroll
        for (int j = 0; j < 4; ++j) { ta[j] = pa[64 * j]; tb[j] = pb[64 * j]; }
#pragma unroll
        for (int j = 0; j < 4; ++j) { va[j] = bf4_f32(ta[j]); vb[j] = bf4_f32(tb[j]); } }
    else { const GAS f32x4* pa = (const GAS f32x4*)xa + lane; const GAS f32x4* pb = (const GAS f32x4*)xb + lane;
#pragma unroll
        for (int j = 0; j < 4; ++j) { va[j] = pa[64 * j]; vb[j] = pb[64 * j]; } }
#pragma unroll
    for (int j = 0; j < 4; ++j) { sa += (va[j].x * va[j].x + va[j].y * va[j].y) + (va[j].z * va[j].z + va[j].w * va[j].w); sb += (vb[j].x * vb[j].x + vb[j].y * vb[j].y) + (vb[j].z * vb[j].z + vb[j].w * vb[j].w); }
    const float ra = 1.f / sqrtf(wave_sum(sa) * (1.f / 1024.f) + 1e-6f), rb = 1.f / sqrtf(wave_sum(sb) * (1.f / 1024.f) + 1e-6f);
    GAS unsigned long long* qa = (GAS unsigned long long*)oa + lane; GAS unsigned long long* qb = (GAS unsigned long long*)ob + lane;
#pragma unroll
    for (int j = 0; j < 4; ++j) { const f32x4 ww = wreg[j];
        qa[64 * j] = (unsigned long long)pk2(va[j].x * ra * ww.x, va[j].y * ra * ww.y) | ((unsigned long long)pk2(va[j].z * ra * ww.z, va[j].w * ra * ww.w) << 32);
        qb[64 * j] = (unsigned long long)pk2(vb[j].x * rb * ww.x, vb[j].y * rb * ww.y) | ((unsigned long long)pk2(vb[j].z * rb * ww.z, vb[j].w * rb * ww.w) << 32); }
    if (qa8) {
        float ma = 0.f, mb = 0.f;
#pragma unroll
        for (int j = 0; j < 4; ++j) { const f32x4 ww = wreg[j]; va[j] = va[j] * ra * ww; vb[j] = vb[j] * rb * ww;
            ma = fmaxf(fmaxf(ma, fmaxf(fabsf(va[j].x), fabsf(va[j].y))), fmaxf(fabsf(va[j].z), fabsf(va[j].w))); mb = fmaxf(fmaxf(mb, fmaxf(fabsf(vb[j].x), fabsf(vb[j].y))), fmaxf(fabsf(vb[j].z), fabsf(vb[j].w))); }
#pragma unroll
        for (int o = 1; o < 64; o <<= 1) { ma = fmaxf(ma, __shfl_xor(ma, o)); mb = fmaxf(mb, __shfl_xor(mb, o)); }
        const float qsa = ma > 0.f ? 127.0f / ma : 0.f, qsb = mb > 0.f ? 127.0f / mb : 0.f; if (lane == 0) { *sa8 = ma * (1.0f / 127.0f); *sb8 = mb * (1.0f / 127.0f); }
#pragma unroll
        for (int j = 0; j < 4; ++j) {
            *((GAS unsigned*)qa8 + lane + 64 * j) = ((unsigned)((int)rintf(va[j].x * qsa)) & 0xffu) | (((unsigned)((int)rintf(va[j].y * qsa)) & 0xffu) << 8) | (((unsigned)((int)rintf(va[j].z * qsa)) & 0xffu) << 16) | (((unsigned)((int)rintf(va[j].w * qsa)) & 0xffu) << 24);
            *((GAS unsigned*)qb8 + lane + 64 * j) = ((unsigned)((int)rintf(vb[j].x * qsb)) & 0xffu) | (((unsigned)((int)rintf(vb[j].y * qsb)) & 0xffu) << 8) | (((unsigned)((int)rintf(vb[j].z * qsb)) & 0xffu) << 16) | (((unsigned)((int)rintf(vb[j].w * qsb)) & 0xffu) << 24); } }
}
struct Args { const float* in[27]; float* out; unsigned char* ws; int ph_lo, ph_hi; };
enum { IN_X = 0, IN_META, IN_RELB, IN_NMIX, IN_NFFN, IN_WIN, IN_CONVW, IN_CONVB, IN_DTB, IN_ALOG, IN_SSDD, IN_SSDN, IN_GW2, IN_GB, IN_GLAN, IN_SINK, IN_QN, IN_KN, IN_WOUT,
       IN_FG, IN_FU, IN_FD, IN_ROUTER, IN_MG, IN_MU, IN_MD, IN_FINAL };
enum { PH_PRO = 0, PH_L0 = 1, PH_L1 = 17, PH_SORT = PH_L1 + 10, PH_PASS0 = PH_SORT + 1, PH_FINAL = PH_PASS0 + 5, PH_END = PH_FINAL + 1 };

__global__ void __launch_bounds__(NWAVES * 64, 2) fwd_kernel(Args args) {
    extern __shared__ __attribute__((aligned(16))) unsigned char lds_raw[];
    LAS unsigned char* lds = (LAS unsigned char*)lds_raw;
    volatile LAS unsigned* MISC = (volatile LAS unsigned*)(lds + MISC_OFF);
    const int G = gridDim.x, bid = blockIdx.x, NGW = G * NWAVES; const long nthreads = (long)G * NWAVES * 64;
#define KAS __attribute__((address_space(4)))
#define INP(k) (*(const float* const KAS*)(ka_ + 8 * (k)))
#define IDS() const KAS char* ka_ = (const KAS char*)__builtin_amdgcn_kernarg_segment_ptr(); asm volatile("" : "+s"(ka_)); unsigned char* const ws = *(unsigned char* const KAS*)(ka_ + 224); float* const hreg = *(float* const KAS*)(ka_ + 216); (void)ws; (void)hreg; \
    int tid = threadIdx.x; asm volatile("" : "+v"(tid)); const int lane = tid & 63, wave = __builtin_amdgcn_readfirstlane(tid >> 6), gw = bid * NWAVES + wave; const long gtid = (long)bid * (NWAVES * 64) + tid; (void)lane; (void)gw; (void)gtid
    gu32* ctl = (gu32*)(args.ws + WS_CTL);
    { IDS(); for (int u = tid; u < (LDS_BYTES - LDSCTL_OFF) / 4; u += NWAVES * 64) ((LAS unsigned*)(lds + LDSCTL_OFF))[u] = 0u; }
    __syncthreads();
    XcdBarrier bar = xcd_barrier_post((unsigned*)(ctl + CW_BAR), MISC + 8);
#if N_LAUNCH_MODE == 1
#define IN(k) true
#define SEAM(k) xcd_barrier_lean(bar)
#define OPAQUE_RANGE() do { } while (0)
#else
    int lo = args.ph_lo, hi = args.ph_hi;
#define IN(k) (lo <= (k) && (k) < hi)
#define SEAM(k) do { if (IN(k) && IN((k) + 1)) xcd_barrier(bar); } while (0)
#define OPAQUE_RANGE() asm volatile("" : "+s"(lo), "+s"(hi))
#endif

#define dtga ((float*)(ws + WS_DTGA))
#define CMAX_GU ((unsigned*)(ws + 131072))
#define WGU8 ((signed char*)(ws + WS_DTGA))
#define SB_GU ((float*)(ws + WS_DTGA + 6 * MiB))
#define SA_U ((float*)(ws + WS_DTGA + 6 * MiB + 32768))
#define U8 ((signed char*)(ws + (l == 0 ? WS_TMP : WS_ACT)))
#define CMAX_IN ((unsigned*)(ws + 393216))
#define WIN8 ((signed char*)(ws + WS_WMOE_GU + 72 * MiB))
#define SB_IN ((float*)(ws + WS_WMOE_GU + 80 * MiB))
#define SA_IN ((float*)(ws + WS_HMETA + 524288))
#define U8IN ((signed char*)(ws + WS_TMP))
#define CMAX_MGU ((unsigned*)(ws + 163840))
#define WMGU8 ((signed char*)(ws + WS_WMOE_GU))
#define SB_MGU ((float*)(ws + WS_WMOE_GU + 64 * MiB))
#define YLO ((bf16*)(ws + WS_WIN))
#define YHI ((bf16*)(ws + WS_ACT + 33 * MiB))
#define Y1LO ((bf16*)(ws + WS_BIG + MOE_ACT_BYTES / 2))
#define Y1HI ((bf16*)(ws + WS_BIG + MOE_ACT_BYTES + MOE_ACT_BYTES / 2))
#define WMD8 ((unsigned char*)(ws + WS_WMOE_D))
#define AMAX_MD ((unsigned*)(ws + 131072 - 64))
#define hmeta ((float*)(ws + WS_HMETA))
#define Win ((bf16*)(ws + WS_WIN))
#define Wout ((bf16*)(ws + WS_WOUT))
#define Wgu ((bf16*)(ws + WS_WGU))
#define Wd ((bf16*)(ws + WS_WD))
#define Wmgu ((bf16*)(ws + WS_WMOE_GU))
#define Wmd ((bf16*)(ws + WS_WMOE_D))
#define big ((bf16*)(ws + WS_BIG))
#define act1k ((bf16*)(ws + WS_ACT))
#define tmp ((bf16*)(ws + WS_TMP))
#define rt_e ((int*)(ws + WS_ROUTE + RT_E))
#define rt_g ((float*)(ws + WS_ROUTE + RT_G))
#define stok ((int*)(ws + WS_ROUTE + RT_STOK))
#define stokp ((int*)(ws + WS_ROUTE + RT_STOKP))
#define sgate ((float*)(ws + WS_ROUTE + RT_SGATE))
#define texp ((int*)(ws + WS_ROUTE + RT_TEXP))
#define passt ((int*)(ws + WS_ROUTE + RT_PASS))
#define rt_rank ((int*)(ws + WS_ROUTE + RT_RANK))
#define ssa ((float*)(ws + WS_ROUTE + RT_SSA))
#define blkcnt ((int*)(ws + WS_ROUTE + RT_BLKCNT))

#ifndef PROBE_THIN_REP
#define PROBE_THIN_REP 1
#endif
#ifndef PROBE_PRO_REP
#define PROBE_PRO_REP 1
#endif
    for (int rep_ = 0; rep_ < PROBE_PRO_REP; ++rep_)
    if (IN(PH_PRO)) { IDS();
        LAS float* scr = (LAS float*)(lds + wave * 16384);
        for (int l = 0; l < 2; ++l) {
            transpose_mat(INP(IN_WIN) + (size_t)l * 1024 * 2856, 1024, 2856, Win + (size_t)l * 3072 * 1024, 1, scr, gw, NGW, lane);
            transpose_mat(INP(IN_WOUT) + (size_t)l * 1024 * 1024, 1024, 1024, Wout + (size_t)l * 1024 * 1024, 0, scr, gw, NGW, lane);
            colmax_mat(INP(IN_WIN) + (size_t)l * 1024 * 2856, 1024, 2856, CMAX_IN + l * 3072, 1, gw, NGW, lane);
        }
        transpose_mat(INP(IN_FG), 1024, 2816, Wgu, 2, scr, gw, NGW, lane);
        transpose_mat(INP(IN_FU), 1024, 2816, Wgu, 3, scr, gw, NGW, lane);
        transpose_mat(INP(IN_FD), 2816, 1024, Wd, 0, scr, gw, NGW, lane);
        colmax_mat(INP(IN_FG), 1024, 2816, CMAX_GU, 2, gw, NGW, lane); colmax_mat(INP(IN_FU), 1024, 2816, CMAX_GU, 3, gw, NGW, lane);
        for (int e = 0; e < 8; ++e) {
            colmax_mat(INP(IN_MG) + (size_t)e * 1024 * 3584, 1024, 3584, CMAX_MGU + e * 7168, 2, gw, NGW, lane); colmax_mat(INP(IN_MU) + (size_t)e * 1024 * 3584, 1024, 3584, CMAX_MGU + e * 7168, 3, gw, NGW, lane);
        }
        absmax_all(INP(IN_MD), 8l * 3584 * 1024 / 4, AMAX_MD, gtid, nthreads, lane);
        for (int l = 0; l < 2; ++l) for (long i = gtid; i < (long)(3072 - 2856) * 1024 / 8; i += nthreads) ((GAS v4u*)(Win + ((size_t)l * 3072 + 2856) * 1024))[i] = (v4u){0u, 0u, 0u, 0u};
        __syncthreads();
    }
    if (IN(PH_PRO) && IN(PH_PRO + 1)) xcd_barrier(bar);

    { constexpr int l = 0;
    {
        OPAQUE_RANGE();
        const int pb = PH_L0 + 16 * l;
#define hin_reg (l == 0 ? INP(IN_X) : (const float*)hreg)
#define hin_meta (l == 0 ? INP(IN_META) : (const float*)hmeta)
        const int meta_mod = l == 0 ? 16 : 128;
#define MKMP() MixParams mp; mp.conv_w = INP(IN_CONVW) + l * 5 * 768; mp.conv_b = INP(IN_CONVB) + l * 768; mp.dt_bias = INP(IN_DTB) + l * 8; mp.a_log = INP(IN_ALOG) + l * 8; \
        mp.ssd_d = INP(IN_SSDD) + l * 4; mp.ssd_norm_w = INP(IN_SSDN) + l * 256; mp.gate_w2 = INP(IN_GW2) + l * 2 * 16 * 128; mp.gate_b = INP(IN_GB) + l * 256; \
        mp.gla_norm_w = INP(IN_GLAN) + l * 64; mp.sink = INP(IN_SINK) + l * 4; mp.qn_w = INP(IN_QN) + l * 64; mp.kn_w = INP(IN_KN) + l * 64; mp.rel_bias = INP(IN_RELB); \
        MixBuf mb{big, dtga, tmp, act1k}; (void)mb
        for (int rep_ = 0; rep_ < PROBE_THIN_REP; ++rep_)
        if (IN(pb + 0)) { IDS();
            const float* w = INP(IN_NMIX) + l * 1024; f32x4 wreg[4];
#pragma unroll
            for (int j = 0; j < 4; ++j) wreg[j] = ((const GAS f32x4*)w + lane)[64 * j];
            if (l == 0) {
            for (int r = gw; r < NTOK; r += 2 * NGW) { const int r2 = r + NGW < NTOK ? r + NGW : r;
                const float* s1 = r < NREG ? hin_reg + (size_t)r * 1024 : hin_meta + (size_t)((r - NREG) % meta_mod) * 1024; const float* s2 = r2 < NREG ? hin_reg + (size_t)r2 * 1024 : hin_meta + (size_t)((r2 - NREG) % meta_mod) * 1024;
                rms_row2_to_bf16(s1, s2, wreg, act1k + (size_t)r * 1024, act1k + (size_t)r2 * 1024, lane, U8IN + (size_t)r * 1024, U8IN + (size_t)r2 * 1024, SA_IN + r, SA_IN + r2); }
            } else {
            for (int r = gw; r < NREG; r += 2 * NGW) { const int r2 = r + NGW < NREG ? r + NGW : r;
                rms_row2_to_bf16<true>((const bf16*)hreg + (size_t)r * HP, (const bf16*)hreg + (size_t)r2 * HP, wreg, act1k + (size_t)r * 1024, act1k + (size_t)r2 * 1024, lane, U8IN + (size_t)r * 1024, U8IN + (size_t)r2 * 1024, SA_IN + r, SA_IN + r2); }
            for (int r = NREG + gw; r < NTOK; r += NGW) { const float* s1 = hin_meta + (size_t)((r - NREG) % meta_mod) * 1024;
                rms_row2_to_bf16(s1, s1, wreg, act1k + (size_t)r * 1024, act1k + (size_t)r * 1024, lane, U8IN + (size_t)r * 1024, U8IN + (size_t)r * 1024, SA_IN + r, SA_IN + r); }
            }
            if (l == 0) { __syncthreads(); LAS float* scr = (LAS float*)(lds + wave * 16384);
                for (int l2 = 0; l2 < 2; ++l2) quant_mat(INP(IN_WIN) + (size_t)l2 * 1024 * 2856, 1024, 2856, WIN8 + (size_t)l2 * 2816 * 1024, SB_IN + l2 * 3072, CMAX_IN + l2 * 3072, 1, scr, gw, NGW, lane, 2816);
                for (int e = 0; e < 8; ++e) { quant_mat(INP(IN_MG) + (size_t)e * 1024 * 3584, 1024, 3584, WMGU8 + (size_t)e * 7168 * 1024, SB_MGU + e * 7168, CMAX_MGU + e * 7168, 2, scr, gw, NGW, lane);
                    quant_mat(INP(IN_MU) + (size_t)e * 1024 * 3584, 1024, 3584, WMGU8 + (size_t)e * 7168 * 1024, SB_MGU + e * 7168, CMAX_MGU + e * 7168, 3, scr, gw, NGW, lane);
                    quant_f8_mat(INP(IN_MD) + (size_t)e * 3584 * 1024, 3584, 1024, WMD8 + (size_t)e * 1024 * 3584, f8_scale(*AMAX_MD, false), scr, gw, NGW, lane); } }
        }
        SEAM(pb + 0);
#ifndef PROBE_INPROJ_REP
#define PROBE_INPROJ_REP 1
#endif
        for (int rep_ = 0; rep_ < PROBE_INPROJ_REP; ++rep_)
        if (IN(pb + 1)) { IDS();
            pg8::Gemm g{(const bf16*)U8IN, (const bf16*)(WIN8 + (size_t)l * 2816 * 1024), MP, 2816, 512}; pg8::StaticOrder S; S.init(MP, 2816, G, bid);
            pg8::EpiInProj8 E{big, SA_IN, SB_IN + l * 3072};
            pg8::gemm_phase<pg8::EpiInProj8, pg8::StaticOrder, true, true, false, false, true>(lds, g, S, E);
            const int nunits = (MP / 256) * 11, n6 = nunits % G;
            if (n6 > 0 && bid >= n6) {
                __syncthreads();
                const bf16* wdt = Win + ((size_t)l * 3072 + 2816) * 1024;
                for (int i = tid; i < 48 * 128; i += NWAVES * 64) { const int row = i >> 7, ch = i & 127; *(LAS v4u*)(lds + row * 2064 + ch * 16) = *(const GAS v4u*)(wdt + (size_t)row * 1024 + ch * 8); }
                __syncthreads();
                const int fr = lane & 15, quad = lane >> 4;
                for (int blk = (bid - n6) * NWAVES + wave; blk < MP / 16; blk += (G - n6) * NWAVES) {
                    f32x4 a0 = {0.f, 0.f, 0.f, 0.f}, a1 = a0, a2 = a0;
                    const bf16* ap = act1k + (size_t)(16 * blk + fr) * 1024 + 8 * quad;
#pragma unroll 8
                    for (int ks = 0; ks < 32; ++ks) { const bf16x8 av = *(const GAS bf16x8*)(ap + 32 * ks);
                        const LAS unsigned char* bp = lds + fr * 2064 + (32 * ks + 8 * quad) * 2;
                        a0 = __builtin_amdgcn_mfma_f32_16x16x32_bf16(av, *(const LAS bf16x8*)(bp), a0, 0, 0, 0);
                        a1 = __builtin_amdgcn_mfma_f32_16x16x32_bf16(av, *(const LAS bf16x8*)(bp + 16 * 2064), a1, 0, 0, 0);
                        a2 = __builtin_amdgcn_mfma_f32_16x16x32_bf16(av, *(const LAS bf16x8*)(bp + 32 * 2064), a2, 0, 0, 0); }
#pragma unroll
                    for (int j = 0; j < 4; ++j) { float* op = dtga + (size_t)(16 * blk + 4 * quad + j) * DGW; op[fr] = a0[j]; op[16 + fr] = a1[j]; if (fr < 8) op[32 + fr] = a2[j]; }
                }
                __syncthreads();
            }
        }
        SEAM(pb + 1);
        if (IN(pb + 2)) { IDS(); MKMP();
            for (int item = gw; item < B_ * 129 * 6; item += NGW) {
                const int cg = item % 6, rr = (item / 6) % 129, b = item / (6 * 129), c = cg * 128 + 2 * lane, t0 = rr * 32;
                float w0[5], w1[5];
#pragma unroll
                for (int j = 0; j < 5; ++j) { w0[j] = mp.conv_w[j * XW + c]; w1[j] = mp.conv_w[j * XW + c + 1]; }
                const float b0 = mp.conv_b[c], b1 = mp.conv_b[c + 1];
                unsigned xin[36];
#pragma unroll
                for (int i = 0; i < 36; ++i) { const int t = t0 - 2 + i; xin[i] = (t >= 0 && t < L_) ? *(const GAS unsigned*)(big + (size_t)row_of(b, t) * PW + PX + c) : 0u; }
#pragma unroll
                for (int i = 0; i < 32; ++i) { const int t = t0 + i;
                    if (t < L_) { float a0 = b0, a1 = b1;
#pragma unroll
                        for (int j = 0; j < 5; ++j) { a0 += w0[j] * __uint_as_float(xin[i + j] << 16); a1 += w1[j] * __uint_as_float(xin[i + j] & 0xffff0000u); }
                        a0 = a0 / (1.0f + __expf(-a0)); a1 = a1 / (1.0f + __expf(-a1));
                        *(GAS unsigned*)(tmp + (size_t)row_of(b, t) * XW + c) = pk2(a0, a1); } }
            }
            const int half = lane >> 5, pi = lane & 31;
            const float inv = __builtin_amdgcn_exp2f(-(float)(pi & 15) * 0.8304820237218406f);
            const float qw0 = mp.qn_w[2 * pi], qw1 = mp.qn_w[2 * pi + 1], kw0 = mp.kn_w[2 * pi], kw1 = mp.kn_w[2 * pi + 1];
            for (int r = gw; r < NTOK; r += NGW) {
                const int t = r < NREG ? NM + (r % S_) : (r - NREG) % NM;
                const float pos = t < NM ? (float)(t - NM) : (pi < 16 ? (float)((t - NM) / 64) : (float)((t - NM) % 64));
                const float ang = pos * inv, cs = __cosf(ang), sn = __sinf(ang);
#pragma unroll
                for (int k = 0; k < 3; ++k) { const int slot = half + 2 * k;
                    GAS unsigned* px = (GAS unsigned*)(big + (size_t)r * PW + PAQ + slot * 64) + pi; const unsigned xv = *px;
                    const float x0 = __uint_as_float(xv << 16), x1 = __uint_as_float(xv & 0xffff0000u);
                    float ss = x0 * x0 + x1 * x1;
#pragma unroll
                    for (int o = 1; o < 32; o <<= 1) ss += __shfl_xor(ss, o);
                    const float rstd = 1.0f / sqrtf(ss * (1.0f / 64.0f) + 1e-6f);
                    const float sc = slot < 4 ? attn_body::C2 : 1.0f;
                    const float y0 = x0 * rstd * (slot < 4 ? qw0 : kw0), y1 = x1 * rstd * (slot < 4 ? qw1 : kw1);
                    *px = pk2((y0 * cs - y1 * sn) * sc, (y0 * sn + y1 * cs) * sc); }
            }
        }
        SEAM(pb + 2);
        if (IN(pb + 3)) { IDS(); MKMP();
#ifndef PROBE_ATT_REP
#define PROBE_ATT_REP 1
#endif
#ifndef PROBE_SWA_REP
#define PROBE_SWA_REP 1
#endif
#ifndef PROBE_SSD_REP
#define PROBE_SSD_REP 1
#endif
#ifndef PROBE_GLA_REP
#define PROBE_GLA_REP 1
#endif
#ifndef PROBE_MIX_REP
#define PROBE_MIX_REP 1
#endif
            for (int rep_ = 0; rep_ < PROBE_MIX_REP; ++rep_) {
            gu32* qc = (gu32*)(ws + WS_CTL) + CW_Q + l * 2048 + rep_ * 4096;
#define Q_POP(k) ({ __syncthreads(); if (tid == 0) MISC[16] = __hip_atomic_fetch_add(qc + 64 * (k), 1u, __ATOMIC_RELAXED, __HIP_MEMORY_SCOPE_AGENT); __syncthreads(); (int)MISC[16]; })
            for (;;) { const int u_ = Q_POP(0); if (u_ >= 64 * PROBE_SSD_REP) break; const int u = u_ & 63; const int b = u >> 3, h = (u >> 1) & 3, dir = u & 1;
                mix::ssd_stream(b, h, dir, tmp, dtga, mp.dt_bias[dir * 4 + h], -expf(mp.a_log[dir * 4 + h]), dir == 0 ? act1k : big + PX, dir == 0 ? 1024 : PW, (mix::lp)lds); }
            for (;;) { const int u_ = Q_POP(1); if (u_ >= 64 * PROBE_GLA_REP) break; const int u = u_ & 63; const int b = u >> 3, h = (u >> 1) & 3, dir = u & 1;
                mix::gla_stream(b, h, dir, big, dtga, mp.gate_w2, mp.gate_b, dir == 0 ? act1k + 256 : big + PB, dir == 0 ? 1024 : PW, (mix::lp)lds); }
            const int x0 = (int)(xb_xcc_id() & 7u), nmeta = l == 0 ? 2 : 0, nper = 64 + nmeta;
            for (int k = 0; k < 8; ++k) { const int q = (x0 + k) & 7;
                for (;;) { const int u_ = Q_POP(2 + q); if (u_ >= nper * PROBE_ATT_REP) break; const int u = u_ % nper;
                    const int r = u - nmeta, bg = 2 * q + (u < nmeta ? u : (r >> 5)), qb = u < nmeta ? -1 : (r & 31), b = bg >> 1, g = bg & 1;
                    attn_body::attn_unit<8, false>(b, qb, big + PAQ + g * 128, big + PAK + g * 64, big + PAV + g * 64, act1k + 768 + g * 128, (char*)lds_raw, nullptr, g); } }
            LAS float* btab = (LAS float*)(lds + 86016);
            __syncthreads();
            for (int i = tid; i < 4 * 259; i += NWAVES * 64) { const int h = i / 259, k = i % 259, rc = k - 129; btab[h * 264 + k] = (k == 0 || k == 258) ? -INFINITY : mp.rel_bias[t5_bucket(rc) * 4 + h] * 1.4426950408889634f; }
            if (tid < 4) btab[4 * 264 + tid] = mp.sink[tid] * 1.4426950408889634f;
            for (int k = 0; k < 8; ++k) { const int q = (x0 + k) & 7;
                for (;;) { const int u_ = Q_POP(10 + q); if (u_ >= nper * PROBE_SWA_REP) break; const int u = u_ % nper;
                    const int r = u - nmeta, bg = 2 * q + (u < nmeta ? u : (r >> 5)), qb = u < nmeta ? -1 : (r & 31), b = bg >> 1, g = bg & 1;
                    attn_body::attn_unit<8, true>(b, qb, big + PSQ + g * 128, big + PSK + g * 64, big + PSV + g * 64, act1k + 512 + g * 128, (char*)lds_raw, btab, g); } }
            }
#undef Q_POP
        }
        SEAM(pb + 3);
        if (IN(pb + 7)) { IDS(); MKMP();
            const f32x4 snw = *(const GAS f32x4*)(mp.ssd_norm_w + 4 * lane); const float dskv = mp.ssd_d[lane >> 4]; const f32x4 gnw = *(const GAS f32x4*)(mp.gla_norm_w + ((4 * lane) & 63));
#define BFX(q, j) __uint_as_float((unsigned)(((q) >> (16 * (j))) & 0xffffu) << 16)
            for (int r = gw; r < NTOK; r += 2 * NGW) { const int r2 = r + NGW < NTOK ? r + NGW : r; const int c0 = 4 * lane;
                unsigned long long yf[2], yb[2], xx[2], zz[2], of[2], ob[2], rr[2];
#pragma unroll
                for (int k = 0; k < 2; ++k) { const size_t rk = (size_t)(k == 0 ? r : r2);
                    yf[k] = *(const GAS unsigned long long*)(act1k + rk * 1024 + c0); yb[k] = *(const GAS unsigned long long*)(big + rk * PW + PX + c0);
                    xx[k] = *(const GAS unsigned long long*)(tmp + rk * XW + c0); zz[k] = *(const GAS unsigned long long*)(big + rk * PW + PZ + c0);
                    of[k] = *(const GAS unsigned long long*)(act1k + rk * 1024 + 256 + c0); ob[k] = *(const GAS unsigned long long*)(big + rk * PW + PB + c0); rr[k] = *(const GAS unsigned long long*)(big + rk * PW + PGR + c0); }
#pragma unroll
                for (int k = 0; k < 2; ++k) { const size_t rk = (size_t)(k == 0 ? r : r2);
                    float y[4]; float ss = 0.f;
#pragma unroll
                    for (int j = 0; j < 4; ++j) { const float zv = BFX(zz[k], j); y[j] = (BFX(yf[k], j) + BFX(yb[k], j) + dskv * BFX(xx[k], j)) * (zv / (1.0f + __expf(-zv))); ss += y[j] * y[j]; }
                    const float rstd = 1.0f / sqrtf(wave_sum(ss) * (1.0f / 256.0f) + 1e-6f);
                    float o[4]; float s2 = 0.f;
#pragma unroll
                    for (int j = 0; j < 4; ++j) { o[j] = BFX(of[k], j) + BFX(ob[k], j); s2 += o[j] * o[j]; }
#pragma unroll
                    for (int sh = 1; sh < 16; sh <<= 1) s2 += __shfl_xor(s2, sh);
                    const float rs2 = 1.0f / sqrtf(s2 * (1.0f / 64.0f) + 1e-6f);
                    float o4[4];
#pragma unroll
                    for (int j = 0; j < 4; ++j) { const float rv = BFX(rr[k], j); o4[j] = o[j] * rs2 * gnw[j] * (rv / (1.0f + __expf(-rv))); }
                    if (k == 0 || r2 != r) {
                        *(GAS unsigned long long*)(act1k + rk * 1024 + c0) = (unsigned long long)pk2(y[0] * rstd * snw.x, y[1] * rstd * snw.y) | ((unsigned long long)pk2(y[2] * rstd * snw.z, y[3] * rstd * snw.w) << 32);
                        *(GAS unsigned long long*)(act1k + rk * 1024 + 256 + c0) = (unsigned long long)pk2(o4[0], o4[1]) | ((unsigned long long)pk2(o4[2], o4[3]) << 32); } }
            }
#undef BFX
        }
        SEAM(pb + 7);
        if (IN(pb + 8)) { IDS();
            pg8::Gemm g{act1k, Wout + (size_t)l * 1024 * 1024, NREG, 1024, 1024}; pg8::StaticOrder S; S.init(NREG, 1024, G, bid);
            pg8::EpiResid<(l != 0)> E{l == 0 ? (const void*)INP(IN_X) : (const void*)hreg, (bf16*)hreg};
            pg8::gemm_phase<pg8::EpiResid<(l != 0)>, pg8::StaticOrder, true, true>(lds, g, S, E);
            if (l == 0) {
                const int fr = lane & 15, quad = lane >> 4;
                for (int task = gw; task < 8 * 32; task += NGW) { const int rb = task >> 5, cg = task & 31; f32x4 acc[2];
                    skinny_task<2>(act1k + (size_t)NREG * 1024, 1024, rb, Wout, cg * 32, 16, acc, lane);
#pragma unroll
                    for (int nb = 0; nb < 2; ++nb)
#pragma unroll
                        for (int j = 0; j < 4; ++j) { const int mr = 16 * rb + 4 * quad + j, c = cg * 32 + 16 * nb + fr; hmeta[(size_t)mr * 1024 + c] = INP(IN_META)[(size_t)(mr % 16) * 1024 + c] + acc[nb][j]; } }
            }
        }
        SEAM(pb + 8);
        if (l == 0) {
            for (int rep_ = 0; rep_ < PROBE_THIN_REP; ++rep_)
            if (IN(pb + 9)) { IDS();
                const float* w = INP(IN_NFFN); f32x4 wreg[4];
#pragma unroll
                for (int j = 0; j < 4; ++j) wreg[j] = ((const GAS f32x4*)w + lane)[64 * j];
                for (int r = gw; r < NREG; r += 2 * NGW) { const int r2 = r + NGW < NREG ? r + NGW : r;
                    rms_row2_to_bf16<true>((const bf16*)hreg + (size_t)r * HP, (const bf16*)hreg + (size_t)r2 * HP, wreg, act1k + (size_t)r * 1024, act1k + (size_t)r2 * 1024, lane, U8 + (size_t)r * 1024, U8 + (size_t)r2 * 1024, SA_U + r, SA_U + r2); }
                for (int r = NREG + gw; r < NTOK; r += NGW) { const float* s1 = hmeta + (size_t)(r - NREG) * 1024;
                    rms_row2_to_bf16(s1, s1, wreg, act1k + (size_t)r * 1024, act1k + (size_t)r * 1024, lane, U8 + (size_t)r * 1024, U8 + (size_t)r * 1024, SA_U + r, SA_U + r); }
                __syncthreads();
                { LAS float* scr = (LAS float*)(lds + wave * 16384);
                    quant_mat(INP(IN_FG), 1024, 2816, WGU8, SB_GU, CMAX_GU, 2, scr, gw, NGW, lane); quant_mat(INP(IN_FU), 1024, 2816, WGU8, SB_GU, CMAX_GU, 3, scr, gw, NGW, lane); }
            }
            SEAM(pb + 9);
#ifndef PROBE_FFNUP_REP
#define PROBE_FFNUP_REP 1
#endif
            for (int rep_ = 0; rep_ < PROBE_FFNUP_REP; ++rep_)
            if (IN(pb + 10)) { IDS();
                pg8::Gemm g{(const bf16*)U8, (const bf16*)WGU8, NREG, 5632, 512}; pg8::StaticOrder S; S.init(NREG, 5632, G, bid);
                pg8::EpiSwiGLU8 E{big, PW, 22, SA_U, SB_GU, 0, false};
                pg8::gemm_phase<pg8::EpiSwiGLU8, pg8::StaticOrder, true, true, false, false, true>(lds, g, S, E);
                { const int fr = lane & 15, quad = lane >> 4;
                    for (int task = gw; task < 8 * 176; task += NGW) { const int rb = task / 176, fg = task % 176, f0 = 16 * fg; f32x4 acc[2];
                        skinny_task<2>(act1k + (size_t)NREG * 1024, 1024, rb, Wgu, (f0 >> 7) * 256 + (f0 & 127), 128, acc, lane);
#pragma unroll
                        for (int j = 0; j < 4; ++j) { const float gg = acc[0][j], uu = acc[1][j]; big[(size_t)(NREG + 16 * rb + 4 * quad + j) * PW + f0 + fr] = f2bf(gg / (1.0f + __expf(-gg)) * uu); } } }
            }
            SEAM(pb + 10);
#ifndef PROBE_FFND_REP
#define PROBE_FFND_REP 1
#endif
            if (IN(pb + 11)) { IDS();
                pg8::Gemm g{big, Wd, NREG, 1024, 2816}; pg8::StaticOrder S; S.init(NREG, 1024, G, bid);
                for (int rep_ = 0; rep_ < PROBE_FFND_REP; ++rep_) {
                pg8::EpiResid<true> E{hreg, (bf16*)hreg, rep_ + 1 < PROBE_FFND_REP ? 0.0f : 1.0f};
                pg8::gemm_phase<pg8::EpiResid<true>, pg8::StaticOrder, true, true>(lds, g, S, E); }
                { const int fr = lane & 15, quad = lane >> 4;
                    for (int task = gw; task < 8 * 64; task += NGW) { const int rb = task >> 6, cb = task & 63; f32x4 acc[1];
                        skinny_task<1>(big + (size_t)NREG * PW, PW, rb, Wd, cb * 16, 0, acc, lane);
#pragma unroll
                        for (int j = 0; j < 4; ++j) { float* hp = hmeta + (size_t)(16 * rb + 4 * quad + j) * 1024 + cb * 16 + fr; *hp += acc[0][j]; } } }
            }
            SEAM(pb + 11);
        } else {
            for (int rep_ = 0; rep_ < PROBE_THIN_REP; ++rep_)
            if (IN(pb + 9)) { IDS();
                const float* w = INP(IN_NFFN) + 1024; const float* rw = INP(IN_ROUTER);
                LAS int* lcnt = (LAS int*)lds;
                f32x4 nwr[4];
#pragma unroll
                for (int j = 0; j < 4; ++j) nwr[j] = ((const GAS f32x4*)w + lane)[64 * j];
                f32x4 rwr[4][4][2];
#pragma unroll
                for (int j = 0; j < 4; ++j)
#pragma unroll
                    for (int c = 0; c < 4; ++c) { const GAS f32x4* rp = (const GAS f32x4*)(rw + (size_t)(4 * lane + 256 * j + c) * 8); rwr[j][c][0] = rp[0]; rwr[j][c][1] = rp[1]; }
                if (tid < 16) lcnt[tid] = 0;
                __syncthreads();
                for (int r0 = gw; r0 < NREG; r0 += 2 * NGW) {
                    f32x4 v[2][4];
#pragma unroll
                    for (int q = 0; q < 2; ++q) { const int r = r0 + q * NGW < NREG ? r0 + q * NGW : r0; const GAS unsigned long long* xr = (const GAS unsigned long long*)((const bf16*)hreg + (size_t)r * HP) + lane;
#pragma unroll
                        for (int j = 0; j < 4; ++j) v[q][j] = bf4_f32(xr[64 * j]); }
#pragma unroll
                    for (int q = 0; q < 2; ++q) { const int r = r0 + q * NGW;
                        if (r < NREG) {
                            float s = 0.f;
#pragma unroll
                            for (int j = 0; j < 4; ++j) s += (v[q][j].x * v[q][j].x + v[q][j].y * v[q][j].y) + (v[q][j].z * v[q][j].z + v[q][j].w * v[q][j].w);
                            const float rstd = 1.f / sqrtf(wave_sum(s) * (1.f / 1024.f) + 1e-6f);
                            float lg[8];
#pragma unroll
                            for (int e = 0; e < 8; ++e) lg[e] = 0.f;
                            float umx = 0.f;
#pragma unroll
                            for (int j = 0; j < 4; ++j) { const f32x4 ww = nwr[j]; const f32x4 uu = v[q][j] * rstd * ww; umx = fmaxf(fmaxf(umx, fmaxf(fabsf(uu.x), fabsf(uu.y))), fmaxf(fabsf(uu.z), fabsf(uu.w))); }
#pragma unroll
                            for (int o = 1; o < 64; o <<= 1) umx = fmaxf(umx, __shfl_xor(umx, o));
                            const float uqs = umx > 0.f ? 127.0f / umx : 0.f; if (lane == 0) SA_U[r] = umx * (1.0f / 127.0f);
#pragma unroll
                            for (int j = 0; j < 4; ++j) { const f32x4 ww = nwr[j]; const f32x4 uu = v[q][j] * rstd * ww;
                                *((GAS unsigned*)(U8 + (size_t)r * 1024) + lane + 64 * j) = ((unsigned)((int)rintf(uu.x * uqs)) & 0xffu) | (((unsigned)((int)rintf(uu.y * uqs)) & 0xffu) << 8) | (((unsigned)((int)rintf(uu.z * uqs)) & 0xffu) << 16) | (((unsigned)((int)rintf(uu.w * uqs)) & 0xffu) << 24);
#pragma unroll
                                for (int c = 0; c < 4; ++c) { const f32x4 r0_ = rwr[j][c][0], r1_ = rwr[j][c][1]; const float uc = uu[c];
                                    lg[0] += uc * r0_.x; lg[1] += uc * r0_.y; lg[2] += uc * r0_.z; lg[3] += uc * r0_.w; lg[4] += uc * r1_.x; lg[5] += uc * r1_.y; lg[6] += uc * r1_.z; lg[7] += uc * r1_.w; } }
                            const bool h5 = lane & 32, h4 = lane & 16, h3 = lane & 8; float a4[4], b2[2], c1;
#pragma unroll
                            for (int k = 0; k < 4; ++k) a4[k] = (h5 ? lg[4 + k] : lg[k]) + __shfl_xor(h5 ? lg[k] : lg[4 + k], 32);
#pragma unroll
                            for (int k = 0; k < 2; ++k) b2[k] = (h4 ? a4[2 + k] : a4[k]) + __shfl_xor(h4 ? a4[k] : a4[2 + k], 16);
                            c1 = (h3 ? b2[1] : b2[0]) + __shfl_xor(h3 ? b2[0] : b2[1], 8);
                            c1 += __shfl_xor(c1, 4); c1 += __shfl_xor(c1, 2); c1 += __shfl_xor(c1, 1);
#pragma unroll
                            for (int e = 0; e < 8; ++e) lg[e] = __shfl(c1, ((e & 4) ? 32 : 0) + ((e & 2) ? 16 : 0) + ((e & 1) ? 8 : 0));
                            int i0 = 0; float v0 = lg[0];
#pragma unroll
                            for (int e = 1; e < 8; ++e) if (lg[e] > v0) { v0 = lg[e]; i0 = e; }
                            int i1 = -1; float v1 = -3.0e38f;
#pragma unroll
                            for (int e = 0; e < 8; ++e) if (e != i0 && lg[e] > v1) { v1 = lg[e]; i1 = e; }
                            if (lane == 0) { const float g1 = 1.0f / (1.0f + __expf(v0 - v1)); const int k0 = __hip_atomic_fetch_add(lcnt + i0, 1, __ATOMIC_RELAXED, __HIP_MEMORY_SCOPE_WORKGROUP), k1 = __hip_atomic_fetch_add(lcnt + 8 + i1, 1, __ATOMIC_RELAXED, __HIP_MEMORY_SCOPE_WORKGROUP);
                                rt_e[r] = i0 | (i1 << 8); rt_rank[r] = k0 | (k1 << 16); rt_g[2 * r] = 1.0f - g1; rt_g[2 * r + 1] = g1; }
                        } }
                }
                __syncthreads();
                if (tid < 16) blkcnt[bid * 16 + tid] = lcnt[tid];
            }
            SEAM(pb + 9);
#ifndef PROBE_SORT_REP
#define PROBE_SORT_REP 1
#endif
            for (int rep_ = 0; rep_ < PROBE_SORT_REP; ++rep_)
            if (IN(PH_SORT)) { IDS();
                LAS int* tot = (LAS int*)lds; LAS int* pre = tot + 16; LAS int* roff = tot + 32; LAS int* ntl = tot + 48;
                if (tid < 64) tot[tid] = 0;
                __syncthreads();
                { const int sgm = tid & 15, part = tid >> 4; int a = 0, bfore = 0;
                    for (int k = 0; k < 8; ++k) { const int wgi = part * 8 + k; if (wgi < G) { const int cv = blkcnt[wgi * 16 + sgm]; a += cv; if (wgi < bid) bfore += cv; } }
                    __hip_atomic_fetch_add(tot + sgm, a, __ATOMIC_RELAXED, __HIP_MEMORY_SCOPE_WORKGROUP); __hip_atomic_fetch_add(pre + sgm, bfore, __ATOMIC_RELAXED, __HIP_MEMORY_SCOPE_WORKGROUP); }
                __syncthreads();
                if (tid == 0) {
                    int tile = 0, T0 = 0;
                    for (int sg = 0; sg < 16; ++sg) { const int nt = (tot[sg] + 255) >> 8; roff[sg] = tile * 256; ntl[sg] = nt; if (bid == 0) for (int k = 0; k < nt; ++k) texp[tile + k] = sg & 7; tile += nt; if (sg == 7) T0 = tile; }
                    if (bid == 0) { const int T1 = tile - T0;
                        int p1 = T0 >= 64 && T0 - 64 <= CAP_TILES ? 64 : (T0 + 1) / 2, p2 = T1 >= 64 && T1 - 64 <= CAP_TILES ? T1 - 64 : (T1 + 1) / 2;
                        passt[0] = 0; passt[1] = p1; passt[2] = T0; passt[3] = T0 + p2; passt[4] = tile; }
                }
                __syncthreads();
                if (bid < 16) { const int b0 = roff[bid] + tot[bid], b1 = roff[bid] + ntl[bid] * 256; for (int i = b0 + tid; i < b1; i += NWAVES * 64) { stok[i] = -1; stokp[permp(i)] = -1; sgate[i] = 0.f; ssa[i] = 0.f; } }
                for (int k = lane; gw + k * NGW < NREG; k += 64) { const int r = gw + k * NGW;
                    { const int e = rt_e[r], rk = rt_rank[r]; const int e0 = e & 255, e1 = 8 + (e >> 8);
                        const int p0 = roff[e0] + pre[e0] + (rk & 0xffff), p1 = roff[e1] + pre[e1] + (rk >> 16);
                        const float sar = SA_U[r];
                        stok[p0] = r; stokp[permp(p0)] = r; sgate[p0] = rt_g[2 * r]; ssa[p0] = sar; stok[p1] = r; stokp[permp(p1)] = r; sgate[p1] = rt_g[2 * r + 1]; ssa[p1] = sar; } }
#ifndef PROBE_IDENT
#define PROBE_IDENT 0
#endif
                if (PROBE_IDENT) for (long i = gtid; i < MAX_SROWS; i += (long)G * NWAVES * 64) ((int*)(ws + WS_DTGA))[i] = (int)(i & 32767);
                __syncthreads();
            }
            SEAM(PH_SORT);
#ifndef PROBE_DK_HALF
#define PROBE_DK_HALF 0
#endif
#ifndef PROBE_MOE_REP
#define PROBE_MOE_REP 1
#endif
#pragma unroll 1
            for (int p_ = 0; p_ < 5 * PROBE_MOE_REP; ++p_) { const int p = p_ % 5; const float gscale_ = p_ < 5 * (PROBE_MOE_REP - 1) ? 0.0f : 1.0f;
                OPAQUE_RANGE();
                if (IN(PH_PASS0 + p)) { IDS();
                    int nd = 0;
                    LAS int* lexd = (LAS int*)(lds + 139264); LAS int* lexg = lexd + 128;
                    if (p > 0) { const int t0 = passt[p - 1], n = passt[p] - t0; if (tid < n) lexd[tid] = texp[t0 + tid]; }
                    if (p < 4) { const int t0 = passt[p], n = passt[p + 1] - t0; if (tid < n) lexg[tid] = texp[t0 + tid]; }
                    __syncthreads();
                    if (p > 0) {
                        const int t0 = passt[p - 1], t1 = passt[p]; nd = (t1 - t0) * 4;
                        pg8::Gemm g{(const bf16*)(ws + WS_BIG + (size_t)((p - 1) & 1) * MOE_ACT_BYTES), (const bf16*)WMD8, CAP_TILES * 256, 8 * 1024, (PROBE_DK_HALF && gscale_ == 0.0f) ? 896 : 1792}; pg8::MoeOrder S{t0, t1 - t0, 4, G, bid, 0, lexd, stok, t0 * 256};
                        pg8::EpiMoeDown E{p >= 3 ? Y1LO : YLO, p >= 3 ? (long)(Y1HI - Y1LO) : (long)(YHI - YLO), stok, sgate, t0 * 256, gscale_ * f8_scale(*AMAX_MD, true)};
                        pg8::gemm_phase<pg8::EpiMoeDown, pg8::MoeOrder, true, true, false, true, false, true>(lds, g, S, E);
                    }
                    if (p < 4) {
                        const int t0 = passt[p], t1 = passt[p + 1];
                        pg8::Gemm g{(const bf16*)U8, (const bf16*)WMGU8, NREG, 8 * 7168, 512}; pg8::MoeOrder S{t0, t1 - t0, 28, G, bid, nd > G ? nd - G : 0, lexg, stok, t0 * 256, stokp};
                        pg8::EpiSwiGLU8 E{(bf16*)(ws + WS_BIG + (size_t)(p & 1) * MOE_ACT_BYTES), 3584, 28, ssa, SB_MGU, t0 * 256, true};
                        pg8::gemm_phase<pg8::EpiSwiGLU8, pg8::MoeOrder, true, true, true, false, true>(lds, g, S, E);
                    }
                }
                SEAM(PH_PASS0 + p);
            }
#ifndef PROBE_BAR_REP
#define PROBE_BAR_REP 0
#endif
            for (int rep_ = 0; rep_ < PROBE_BAR_REP; ++rep_) xcd_barrier_lean(bar);
            if (IN(PH_FINAL)) { IDS();
                const float* w = INP(IN_FINAL); f32x4 fwr[4];
#pragma unroll
                for (int j = 0; j < 4; ++j) fwr[j] = ((const GAS f32x4*)w + lane)[64 * j];
                for (int r = gw; r < NREG; r += 2 * NGW) { const int r2 = r + NGW < NREG ? r + NGW : r;
                    GAS f32x4* xa = (GAS f32x4*)(hreg + (size_t)r * 1024) + lane; GAS f32x4* xb = (GAS f32x4*)(hreg + (size_t)r2 * 1024) + lane;
                    f32x4 va[4], vb[4]; float sa = 0.f, sb = 0.f;
                    { const GAS unsigned long long* ha = (const GAS unsigned long long*)((const bf16*)hreg + (size_t)r * HP) + lane; const GAS unsigned long long* hb_ = (const GAS unsigned long long*)((const bf16*)hreg + (size_t)r2 * HP) + lane;
#pragma unroll
                    for (int j = 0; j < 4; ++j) { va[j] = bf4_f32(ha[64 * j]); vb[j] = bf4_f32(hb_[64 * j]); } }
#pragma unroll
                    for (int sl = 0; sl < 2; ++sl)
#pragma unroll
                    for (int j = 0; j < 4; ++j) { const bf16* yb_ = sl == 0 ? (j < 2 ? YLO : YHI) : (j < 2 ? Y1LO : Y1HI); const int cy = 4 * lane + 256 * (j & 1);
                        const unsigned long long qa = *(const GAS unsigned long long*)(yb_ + (size_t)r * 512 + cy), qb = *(const GAS unsigned long long*)(yb_ + (size_t)r2 * 512 + cy);
                        va[j].x += __uint_as_float((unsigned)qa << 16); va[j].y += __uint_as_float((unsigned)qa & 0xffff0000u); va[j].z += __uint_as_float((unsigned)(qa >> 32) << 16); va[j].w += __uint_as_float((unsigned)(qa >> 32) & 0xffff0000u);
                        vb[j].x += __uint_as_float((unsigned)qb << 16); vb[j].y += __uint_as_float((unsigned)qb & 0xffff0000u); vb[j].z += __uint_as_float((unsigned)(qb >> 32) << 16); vb[j].w += __uint_as_float((unsigned)(qb >> 32) & 0xffff0000u); }
#pragma unroll
                    for (int j = 0; j < 4; ++j) { sa += (va[j].x * va[j].x + va[j].y * va[j].y) + (va[j].z * va[j].z + va[j].w * va[j].w); sb += (vb[j].x * vb[j].x + vb[j].y * vb[j].y) + (vb[j].z * vb[j].z + vb[j].w * vb[j].w); }
                    const float ra = 1.f / sqrtf(wave_sum_sw(sa) * (1.f / 1024.f) + 1e-6f), rb = 1.f / sqrtf(wave_sum_sw(sb) * (1.f / 1024.f) + 1e-6f);
#pragma unroll
                    for (int j = 0; j < 4; ++j) { const f32x4 ww = fwr[j]; xa[64 * j] = va[j] * ra * ww; if (r2 != r) xb[64 * j] = vb[j] * rb * ww; }
                }
            }
        }
    }
    }
    { constexpr int l = 1;
    {
        OPAQUE_RANGE();
        const int pb = PH_L0 + 16 * l;
#define hin_reg (l == 0 ? INP(IN_X) : (const float*)hreg)
#define hin_meta (l == 0 ? INP(IN_META) : (const float*)hmeta)
        const int meta_mod = l == 0 ? 16 : 128;
#define MKMP() MixParams mp; mp.conv_w = INP(IN_CONVW) + l * 5 * 768; mp.conv_b = INP(IN_CONVB) + l * 768; mp.dt_bias = INP(IN_DTB) + l * 8; mp.a_log = INP(IN_ALOG) + l * 8; \
        mp.ssd_d = INP(IN_SSDD) + l * 4; mp.ssd_norm_w = INP(IN_SSDN) + l * 256; mp.gate_w2 = INP(IN_GW2) + l * 2 * 16 * 128; mp.gate_b = INP(IN_GB) + l * 256; \
        mp.gla_norm_w = INP(IN_GLAN) + l * 64; mp.sink = INP(IN_SINK) + l * 4; mp.qn_w = INP(IN_QN) + l * 64; mp.kn_w = INP(IN_KN) + l * 64; mp.rel_bias = INP(IN_RELB); \
        MixBuf mb{big, dtga, tmp, act1k}; (void)mb
        for (int rep_ = 0; rep_ < PROBE_THIN_REP; ++rep_)
        if (IN(pb + 0)) { IDS();
            const float* w = INP(IN_NMIX) + l * 1024; f32x4 wreg[4];
#pragma unroll
            for (int j = 0; j < 4; ++j) wreg[j] = ((const GAS f32x4*)w + lane)[64 * j];
            if (l == 0) {
            for (int r = gw; r < NTOK; r += 2 * NGW) { const int r2 = r + NGW < NTOK ? r + NGW : r;
                const float* s1 = r < NREG ? hin_reg + (size_t)r * 1024 : hin_meta + (size_t)((r - NREG) % meta_mod) * 1024; const float* s2 = r2 < NREG ? hin_reg + (size_t)r2 * 1024 : hin_meta + (size_t)((r2 - NREG) % meta_mod) * 1024;
                rms_row2_to_bf16(s1, s2, wreg, act1k + (size_t)r * 1024, act1k + (size_t)r2 * 1024, lane, U8IN + (size_t)r * 1024, U8IN + (size_t)r2 * 1024, SA_IN + r, SA_IN + r2); }
            } else {
            for (int r = gw; r < NREG; r += 2 * NGW) { const int r2 = r + NGW < NREG ? r + NGW : r;
                rms_row2_to_bf16<true>((const bf16*)hreg + (size_t)r * HP, (const bf16*)hreg + (size_t)r2 * HP, wreg, act1k + (size_t)r * 1024, act1k + (size_t)r2 * 1024, lane, U8IN + (size_t)r * 1024, U8IN + (size_t)r2 * 1024, SA_IN + r, SA_IN + r2); }
            for (int r = NREG + gw; r < NTOK; r += NGW) { const float* s1 = hin_meta + (size_t)((r - NREG) % meta_mod) * 1024;
                rms_row2_to_bf16(s1, s1, wreg, act1k + (size_t)r * 1024, act1k + (size_t)r * 1024, lane, U8IN + (size_t)r * 1024, U8IN + (size_t)r * 1024, SA_IN + r, SA_IN + r); }
            }
            if (l == 0) { __syncthreads(); LAS float* scr = (LAS float*)(lds + wave * 16384);
                for (int l2 = 0; l2 < 2; ++l2) quant_mat(INP(IN_WIN) + (size_t)l2 * 1024 * 2856, 1024, 2856, WIN8 + (size_t)l2 * 2816 * 1024, SB_IN + l2 * 3072, CMAX_IN + l2 * 3072, 1, scr, gw, NGW, lane, 2816);
                for (int e = 0; e < 8; ++e) { quant_mat(INP(IN_MG) + (size_t)e * 1024 * 3584, 1024, 3584, WMGU8 + (size_t)e * 7168 * 1024, SB_MGU + e * 7168, CMAX_MGU + e * 7168, 2, scr, gw, NGW, lane);
                    quant_mat(INP(IN_MU) + (size_t)e * 1024 * 3584, 1024, 3584, WMGU8 + (size_t)e * 7168 * 1024, SB_MGU + e * 7168, CMAX_MGU + e * 7168, 3, scr, gw, NGW, lane);
                    quant_f8_mat(INP(IN_MD) + (size_t)e * 3584 * 1024, 3584, 1024, WMD8 + (size_t)e * 1024 * 3584, f8_scale(*AMAX_MD, false), scr, gw, NGW, lane); } }
        }
        SEAM(pb + 0);
#ifndef PROBE_INPROJ_REP
#define PROBE_INPROJ_REP 1
#endif
        for (int rep_ = 0; rep_ < PROBE_INPROJ_REP; ++rep_)
        if (IN(pb + 1)) { IDS();
            pg8::Gemm g{(const bf16*)U8IN, (const bf16*)(WIN8 + (size_t)l * 2816 * 1024), MP, 2816, 512}; pg8::StaticOrder S; S.init(MP, 2816, G, bid);
            pg8::EpiInProj8 E{big, SA_IN, SB_IN + l * 3072};
            pg8::gemm_phase<pg8::EpiInProj8, pg8::StaticOrder, true, true, false, false, true>(lds, g, S, E);
            const int nunits = (MP / 256) * 11, n6 = nunits % G;
            if (n6 > 0 && bid >= n6) {
                __syncthreads();
                const bf16* wdt = Win + ((size_t)l * 3072 + 2816) * 1024;
                for (int i = tid; i < 48 * 128; i += NWAVES * 64) { const int row = i >> 7, ch = i & 127; *(LAS v4u*)(lds + row * 2064 + ch * 16) = *(const GAS v4u*)(wdt + (size_t)row * 1024 + ch * 8); }
                __syncthreads();
                const int fr = lane & 15, quad = lane >> 4;
                for (int blk = (bid - n6) * NWAVES + wave; blk < MP / 16; blk += (G - n6) * NWAVES) {
                    f32x4 a0 = {0.f, 0.f, 0.f, 0.f}, a1 = a0, a2 = a0;
                    const bf16* ap = act1k + (size_t)(16 * blk + fr) * 1024 + 8 * quad;
#pragma unroll 8
                    for (int ks = 0; ks < 32; ++ks) { const bf16x8 av = *(const GAS bf16x8*)(ap + 32 * ks);
                        const LAS unsigned char* bp = lds + fr * 2064 + (32 * ks + 8 * quad) * 2;
                        a0 = __builtin_amdgcn_mfma_f32_16x16x32_bf16(av, *(const LAS bf16x8*)(bp), a0, 0, 0, 0);
                        a1 = __builtin_amdgcn_mfma_f32_16x16x32_bf16(av, *(const LAS bf16x8*)(bp + 16 * 2064), a1, 0, 0, 0);
                        a2 = __builtin_amdgcn_mfma_f32_16x16x32_bf16(av, *(const LAS bf16x8*)(bp + 32 * 2064), a2, 0, 0, 0); }
#pragma unroll
                    for (int j = 0; j < 4; ++j) { float* op = dtga + (size_t)(16 * blk + 4 * quad + j) * DGW; op[fr] = a0[j]; op[16 + fr] = a1[j]; if (fr < 8) op[32 + fr] = a2[j]; }
                }
                __syncthreads();
            }
        }
        SEAM(pb + 1);
        if (IN(pb + 2)) { IDS(); MKMP();
            for (int item = gw; item < B_ * 129 * 6; item += NGW) {
                const int cg = item % 6, rr = (item / 6) % 129, b = item / (6 * 129), c = cg * 128 + 2 * lane, t0 = rr * 32;
                float w0[5], w1[5];
#pragma unroll
                for (int j = 0; j < 5; ++j) { w0[j] = mp.conv_w[j * XW + c]; w1[j] = mp.conv_w[j * XW + c + 1]; }
                const float b0 = mp.conv_b[c], b1 = mp.conv_b[c + 1];
                unsigned xin[36];
#pragma unroll
                for (int i = 0; i < 36; ++i) { const int t = t0 - 2 + i; xin[i] = (t >= 0 && t < L_) ? *(const GAS unsigned*)(big + (size_t)row_of(b, t) * PW + PX + c) : 0u; }
#pragma unroll
                for (int i = 0; i < 32; ++i) { const int t = t0 + i;
                    if (t < L_) { float a0 = b0, a1 = b1;
#pragma unroll
                        for (int j = 0; j < 5; ++j) { a0 += w0[j] * __uint_as_float(xin[i + j] << 16); a1 += w1[j] * __uint_as_float(xin[i + j] & 0xffff0000u); }
                        a0 = a0 / (1.0f + __expf(-a0)); a1 = a1 / (1.0f + __expf(-a1));
                        *(GAS unsigned*)(tmp + (size_t)row_of(b, t) * XW + c) = pk2(a0, a1); } }
            }
            const int half = lane >> 5, pi = lane & 31;
            const float inv = __builtin_amdgcn_exp2f(-(float)(pi & 15) * 0.8304820237218406f);
            const float qw0 = mp.qn_w[2 * pi], qw1 = mp.qn_w[2 * pi + 1], kw0 = mp.kn_w[2 * pi], kw1 = mp.kn_w[2 * pi + 1];
            for (int r = gw; r < NTOK; r += NGW) {
                const int t = r < NREG ? NM + (r % S_) : (r - NREG) % NM;
                const float pos = t < NM ? (float)(t - NM) : (pi < 16 ? (float)((t - NM) / 64) : (float)((t - NM) % 64));
                const float ang = pos * inv, cs = __cosf(ang), sn = __sinf(ang);
#pragma unroll
                for (int k = 0; k < 3; ++k) { const int slot = half + 2 * k;
                    GAS unsigned* px = (GAS unsigned*)(big + (size_t)r * PW + PAQ + slot * 64) + pi; const unsigned xv = *px;
                    const float x0 = __uint_as_float(xv << 16), x1 = __uint_as_float(xv & 0xffff0000u);
                    float ss = x0 * x0 + x1 * x1;
#pragma unroll
                    for (int o = 1; o < 32; o <<= 1) ss += __shfl_xor(ss, o);
                    const float rstd = 1.0f / sqrtf(ss * (1.0f / 64.0f) + 1e-6f);
                    const float sc = slot < 4 ? attn_body::C2 : 1.0f;
                    const float y0 = x0 * rstd * (slot < 4 ? qw0 : kw0), y1 = x1 * rstd * (slot < 4 ? qw1 : kw1);
                    *px = pk2((y0 * cs - y1 * sn) * sc, (y0 * sn + y1 * cs) * sc); }
            }
        }
        SEAM(pb + 2);
        if (IN(pb + 3)) { IDS(); MKMP();
#ifndef PROBE_ATT_REP
#define PROBE_ATT_REP 1
#endif
#ifndef PROBE_SWA_REP
#define PROBE_SWA_REP 1
#endif
#ifndef PROBE_SSD_REP
#define PROBE_SSD_REP 1
#endif
#ifndef PROBE_GLA_REP
#define PROBE_GLA_REP 1
#endif
#ifndef PROBE_MIX_REP
#define PROBE_MIX_REP 1
#endif
            for (int rep_ = 0; rep_ < PROBE_MIX_REP; ++rep_) {
            gu32* qc = (gu32*)(ws + WS_CTL) + CW_Q + l * 2048 + rep_ * 4096;
#define Q_POP(k) ({ __syncthreads(); if (tid == 0) MISC[16] = __hip_atomic_fetch_add(qc + 64 * (k), 1u, __ATOMIC_RELAXED, __HIP_MEMORY_SCOPE_AGENT); __syncthreads(); (int)MISC[16]; })
            for (;;) { const int u_ = Q_POP(0); if (u_ >= 64 * PROBE_SSD_REP) break; const int u = u_ & 63; const int b = u >> 3, h = (u >> 1) & 3, dir = u & 1;
                mix::ssd_stream(b, h, dir, tmp, dtga, mp.dt_bias[dir * 4 + h], -expf(mp.a_log[dir * 4 + h]), dir == 0 ? act1k : big + PX, dir == 0 ? 1024 : PW, (mix::lp)lds); }
            for (;;) { const int u_ = Q_POP(1); if (u_ >= 64 * PROBE_GLA_REP) break; const int u = u_ & 63; const int b = u >> 3, h = (u >> 1) & 3, dir = u & 1;
                mix::gla_stream(b, h, dir, big, dtga, mp.gate_w2, mp.gate_b, dir == 0 ? act1k + 256 : big + PB, dir == 0 ? 1024 : PW, (mix::lp)lds); }
            const int x0 = (int)(xb_xcc_id() & 7u), nmeta = l == 0 ? 2 : 0, nper = 64 + nmeta;
            for (int k = 0; k < 8; ++k) { const int q = (x0 + k) & 7;
                for (;;) { const int u_ = Q_POP(2 + q); if (u_ >= nper * PROBE_ATT_REP) break; const int u = u_ % nper;
                    const int r = u - nmeta, bg = 2 * q + (u < nmeta ? u : (r >> 5)), qb = u < nmeta ? -1 : (r & 31), b = bg >> 1, g = bg & 1;
                    attn_body::attn_unit<8, false>(b, qb, big + PAQ + g * 128, big + PAK + g * 64, big + PAV + g * 64, act1k + 768 + g * 128, (char*)lds_raw, nullptr, g); } }
            LAS float* btab = (LAS float*)(lds + 86016);
            __syncthreads();
            for (int i = tid; i < 4 * 259; i += NWAVES * 64) { const int h = i / 259, k = i % 259, rc = k - 129; btab[h * 264 + k] = (k == 0 || k == 258) ? -INFINITY : mp.rel_bias[t5_bucket(rc) * 4 + h] * 1.4426950408889634f; }
            if (tid < 4) btab[4 * 264 + tid] = mp.sink[tid] * 1.4426950408889634f;
            for (int k = 0; k < 8; ++k) { const int q = (x0 + k) & 7;
                for (;;) { const int u_ = Q_POP(10 + q); if (u_ >= nper * PROBE_SWA_REP) break; const int u = u_ % nper;
                    const int r = u - nmeta, bg = 2 * q + (u < nmeta ? u : (r >> 5)), qb = u < nmeta ? -1 : (r & 31), b = bg >> 1, g = bg & 1;
                    attn_body::attn_unit<8, true>(b, qb, big + PSQ + g * 128, big + PSK + g * 64, big + PSV + g * 64, act1k + 512 + g * 128, (char*)lds_raw, btab, g); } }
            }
#undef Q_POP
        }
        SEAM(pb + 3);
        if (IN(pb + 7)) { IDS(); MKMP();
            const f32x4 snw = *(const GAS f32x4*)(mp.ssd_norm_w + 4 * lane); const float dskv = mp.ssd_d[lane >> 4]; const f32x4 gnw = *(const GAS f32x4*)(mp.gla_norm_w + ((4 * lane) & 63));
#define BFX(q, j) __uint_as_float((unsigned)(((q) >> (16 * (j))) & 0xffffu) << 16)
            for (int r = gw; r < NTOK; r += 2 * NGW) { const int r2 = r + NGW < NTOK ? r + NGW : r; const int c0 = 4 * lane;
                unsigned long long yf[2], yb[2], xx[2], zz[2], of[2], ob[2], rr[2];
#pragma unroll
                for (int k = 0; k < 2; ++k) { const size_t rk = (size_t)(k == 0 ? r : r2);
                    yf[k] = *(const GAS unsigned long long*)(act1k + rk * 1024 + c0); yb[k] = *(const GAS unsigned long long*)(big + rk * PW + PX + c0);
                    xx[k] = *(const GAS unsigned long long*)(tmp + rk * XW + c0); zz[k] = *(const GAS unsigned long long*)(big + rk * PW + PZ + c0);
                    of[k] = *(const GAS unsigned long long*)(act1k + rk * 1024 + 256 + c0); ob[k] = *(const GAS unsigned long long*)(big + rk * PW + PB + c0); rr[k] = *(const GAS unsigned long long*)(big + rk * PW + PGR + c0); }
#pragma unroll
                for (int k = 0; k < 2; ++k) { const size_t rk = (size_t)(k == 0 ? r : r2);
                    float y[4]; float ss = 0.f;
#pragma unroll
                    for (int j = 0; j < 4; ++j) { const float zv = BFX(zz[k], j); y[j] = (BFX(yf[k], j) + BFX(yb[k], j) + dskv * BFX(xx[k], j)) * (zv / (1.0f + __expf(-zv))); ss += y[j] * y[j]; }
                    const float rstd = 1.0f / sqrtf(wave_sum(ss) * (1.0f / 256.0f) + 1e-6f);
                    float o[4]; float s2 = 0.f;
#pragma unroll
                    for (int j = 0; j < 4; ++j) { o[j] = BFX(of[k], j) + BFX(ob[k], j); s2 += o[j] * o[j]; }
#pragma unroll
                    for (int sh = 1; sh < 16; sh <<= 1) s2 += __shfl_xor(s2, sh);
                    const float rs2 = 1.0f / sqrtf(s2 * (1.0f / 64.0f) + 1e-6f);
                    float o4[4];
#pragma unroll
                    for (int j = 0; j < 4; ++j) { const float rv = BFX(rr[k], j); o4[j] = o[j] * rs2 * gnw[j] * (rv / (1.0f + __expf(-rv))); }
                    if (k == 0 || r2 != r) {
                        *(GAS unsigned long long*)(act1k + rk * 1024 + c0) = (unsigned long long)pk2(y[0] * rstd * snw.x, y[1] * rstd * snw.y) | ((unsigned long long)pk2(y[2] * rstd * snw.z, y[3] * rstd * snw.w) << 32);
                        *(GAS unsigned long long*)(act1k + rk * 1024 + 256 + c0) = (unsigned long long)pk2(o4[0], o4[1]) | ((unsigned long long)pk2(o4[2], o4[3]) << 32); } }
            }
#undef BFX
        }
        SEAM(pb + 7);
        if (IN(pb + 8)) { IDS();
            pg8::Gemm g{act1k, Wout + (size_t)l * 1024 * 1024, NREG, 1024, 1024}; pg8::StaticOrder S; S.init(NREG, 1024, G, bid);
            pg8::EpiResid<(l != 0)> E{l == 0 ? (const void*)INP(IN_X) : (const void*)hreg, (bf16*)hreg};
            pg8::gemm_phase<pg8::EpiResid<(l != 0)>, pg8::StaticOrder, true, true>(lds, g, S, E);
            if (l == 0) {
                const int fr = lane & 15, quad = lane >> 4;
                for (int task = gw; task < 8 * 32; task += NGW) { const int rb = task >> 5, cg = task & 31; f32x4 acc[2];
                    skinny_task<2>(act1k + (size_t)NREG * 1024, 1024, rb, Wout, cg * 32, 16, acc, lane);
#pragma unroll
                    for (int nb = 0; nb < 2; ++nb)
#pragma unroll
                        for (int j = 0; j < 4; ++j) { const int mr = 16 * rb + 4 * quad + j, c = cg * 32 + 16 * nb + fr; hmeta[(size_t)mr * 1024 + c] = INP(IN_META)[(size_t)(mr % 16) * 1024 + c] + acc[nb][j]; } }
            }
        }
        SEAM(pb + 8);
        if (l == 0) {
            for (int rep_ = 0; rep_ < PROBE_THIN_REP; ++rep_)
            if (IN(pb + 9)) { IDS();
                const float* w = INP(IN_NFFN); f32x4 wreg[4];
#pragma unroll
                for (int j = 0; j < 4; ++j) wreg[j] = ((const GAS f32x4*)w + lane)[64 * j];
                for (int r = gw; r < NREG; r += 2 * NGW) { const int r2 = r + NGW < NREG ? r + NGW : r;
                    rms_row2_to_bf16<true>((const bf16*)hreg + (size_t)r * HP, (const bf16*)hreg + (size_t)r2 * HP, wreg, act1k + (size_t)r * 1024, act1k + (size_t)r2 * 1024, lane, U8 + (size_t)r * 1024, U8 + (size_t)r2 * 1024, SA_U + r, SA_U + r2); }
                for (int r = NREG + gw; r < NTOK; r += NGW) { const float* s1 = hmeta + (size_t)(r - NREG) * 1024;
                    rms_row2_to_bf16(s1, s1, wreg, act1k + (size_t)r * 1024, act1k + (size_t)r * 1024, lane, U8 + (size_t)r * 1024, U8 + (size_t)r * 1024, SA_U + r, SA_U + r); }
                __syncthreads();
                { LAS float* scr = (LAS float*)(lds + wave * 16384);
                    quant_mat(INP(IN_FG), 1024, 2816, WGU8, SB_GU, CMAX_GU, 2, scr, gw, NGW, lane); quant_mat(INP(IN_FU), 1024, 2816, WGU8, SB_GU, CMAX_GU, 3, scr, gw, NGW, lane); }
            }
            SEAM(pb + 9);
#ifndef PROBE_FFNUP_REP
#define PROBE_FFNUP_REP 1
#endif
            for (int rep_ = 0; rep_ < PROBE_FFNUP_REP; ++rep_)
            if (IN(pb + 10)) { IDS();
                pg8::Gemm g{(const bf16*)U8, (const bf16*)WGU8, NREG, 5632, 512}; pg8::StaticOrder S; S.init(NREG, 5632, G, bid);
                pg8::EpiSwiGLU8 E{big, PW, 22, SA_U, SB_GU, 0, false};
                pg8::gemm_phase<pg8::EpiSwiGLU8, pg8::StaticOrder, true, true, false, false, true>(lds, g, S, E);
                { const int fr = lane & 15, quad = lane >> 4;
                    for (int task = gw; task < 8 * 176; task += NGW) { const int rb = task / 176, fg = task % 176, f0 = 16 * fg; f32x4 acc[2];
                        skinny_task<2>(act1k + (size_t)NREG * 1024, 1024, rb, Wgu, (f0 >> 7) * 256 + (f0 & 127), 128, acc, lane);
#pragma unroll
                        for (int j = 0; j < 4; ++j) { const float gg = acc[0][j], uu = acc[1][j]; big[(size_t)(NREG + 16 * rb + 4 * quad + j) * PW + f0 + fr] = f2bf(gg / (1.0f + __expf(-gg)) * uu); } } }
            }
            SEAM(pb + 10);
#ifndef PROBE_FFND_REP
#define PROBE_FFND_REP 1
#endif
            if (IN(pb + 11)) { IDS();
                pg8::Gemm g{big, Wd, NREG, 1024, 2816}; pg8::StaticOrder S; S.init(NREG, 1024, G, bid);
                for (int rep_ = 0; rep_ < PROBE_FFND_REP; ++rep_) {
                pg8::EpiResid<true> E{hreg, (bf16*)hreg, rep_ + 1 < PROBE_FFND_REP ? 0.0f : 1.0f};
                pg8::gemm_phase<pg8::EpiResid<true>, pg8::StaticOrder, true, true>(lds, g, S, E); }
                { const int fr = lane & 15, quad = lane >> 4;
                    for (int task = gw; task < 8 * 64; task += NGW) { const int rb = task >> 6, cb = task & 63; f32x4 acc[1];
                        skinny_task<1>(big + (size_t)NREG * PW, PW, rb, Wd, cb * 16, 0, acc, lane);
#pragma unroll
                        for (int j = 0; j < 4; ++j) { float* hp = hmeta + (size_t)(16 * rb + 4 * quad + j) * 1024 + cb * 16 + fr; *hp += acc[0][j]; } } }
            }
            SEAM(pb + 11);
        } else {
            for (int rep_ = 0; rep_ < PROBE_THIN_REP; ++rep_)
            if (IN(pb + 9)) { IDS();
                const float* w = INP(IN_NFFN) + 1024; const float* rw = INP(IN_ROUTER);
                LAS int* lcnt = (LAS int*)lds;
                f32x4 nwr[4];
#pragma unroll
                for (int j = 0; j < 4; ++j) nwr[j] = ((const GAS f32x4*)w + lane)[64 * j];
                f32x4 rwr[4][4][2];
#pragma unroll
                for (int j = 0; j < 4; ++j)
#pragma unroll
                    for (int c = 0; c < 4; ++c) { const GAS f32x4* rp = (const GAS f32x4*)(rw + (size_t)(4 * lane + 256 * j + c) * 8); rwr[j][c][0] = rp[0]; rwr[j][c][1] = rp[1]; }
                if (tid < 16) lcnt[tid] = 0;
                __syncthreads();
                for (int r0 = gw; r0 < NREG; r0 += 2 * NGW) {
                    f32x4 v[2][4];
#pragma unroll
                    for (int q = 0; q < 2; ++q) { const int r = r0 + q * NGW < NREG ? r0 + q * NGW : r0; const GAS unsigned long long* xr = (const GAS unsigned long long*)((const bf16*)hreg + (size_t)r * HP) + lane;
#pragma unroll
                        for (int j = 0; j < 4; ++j) v[q][j] = bf4_f32(xr[64 * j]); }
#pragma unroll
                    for (int q = 0; q < 2; ++q) { const int r = r0 + q * NGW;
                        if (r < NREG) {
                            float s = 0.f;
#pragma unroll
                            for (int j = 0; j < 4; ++j) s += (v[q][j].x * v[q][j].x + v[q][j].y * v[q][j].y) + (v[q][j].z * v[q][j].z + v[q][j].w * v[q][j].w);
                            const float rstd = 1.f / sqrtf(wave_sum(s) * (1.f / 1024.f) + 1e-6f);
                            float lg[8];
#pragma unroll
                            for (int e = 0; e < 8; ++e) lg[e] = 0.f;
                            float umx = 0.f;
#pragma unroll
                            for (int j = 0; j < 4; ++j) { const f32x4 ww = nwr[j]; const f32x4 uu = v[q][j] * rstd * ww; umx = fmaxf(fmaxf(umx, fmaxf(fabsf(uu.x), fabsf(uu.y))), fmaxf(fabsf(uu.z), fabsf(uu.w))); }
#pragma unroll
                            for (int o = 1; o < 64; o <<= 1) umx = fmaxf(umx, __shfl_xor(umx, o));
                            const float uqs = umx > 0.f ? 127.0f / umx : 0.f; if (lane == 0) SA_U[r] = umx * (1.0f / 127.0f);
#pragma unroll
                            for (int j = 0; j < 4; ++j) { const f32x4 ww = nwr[j]; const f32x4 uu = v[q][j] * rstd * ww;
                                *((GAS unsigned*)(U8 + (size_t)r * 1024) + lane + 64 * j) = ((unsigned)((int)rintf(uu.x * uqs)) & 0xffu) | (((unsigned)((int)rintf(uu.y * uqs)) & 0xffu) << 8) | (((unsigned)((int)rintf(uu.z * uqs)) & 0xffu) << 16) | (((unsigned)((int)rintf(uu.w * uqs)) & 0xffu) << 24);
#pragma unroll
                                for (int c = 0; c < 4; ++c) { const f32x4 r0_ = rwr[j][c][0], r1_ = rwr[j][c][1]; const float uc = uu[c];
                                    lg[0] += uc * r0_.x; lg[1] += uc * r0_.y; lg[2] += uc * r0_.z; lg[3] += uc * r0_.w; lg[4] += uc * r1_.x; lg[5] += uc * r1_.y; lg[6] += uc * r1_.z; lg[7] += uc * r1_.w; } }
                            const bool h5 = lane & 32, h4 = lane & 16, h3 = lane & 8; float a4[4], b2[2], c1;
#pragma unroll
                            for (int k = 0; k < 4; ++k) a4[k] = (h5 ? lg[4 + k] : lg[k]) + __shfl_xor(h5 ? lg[k] : lg[4 + k], 32);
#pragma unroll
                            for (int k = 0; k < 2; ++k) b2[k] = (h4 ? a4[2 + k] : a4[k]) + __shfl_xor(h4 ? a4[k] : a4[2 + k], 16);
                            c1 = (h3 ? b2[1] : b2[0]) + __shfl_xor(h3 ? b2[0] : b2[1], 8);
                            c1 += __shfl_xor(c1, 4); c1 += __shfl_xor(c1, 2); c1 += __shfl_xor(c1, 1);
#pragma unroll
                            for (int e = 0; e < 8; ++e) lg[e] = __shfl(c1, ((e & 4) ? 32 : 0) + ((e & 2) ? 16 : 0) + ((e & 1) ? 8 : 0));
                            int i0 = 0; float v0 = lg[0];
#pragma unroll
                            for (int e = 1; e < 8; ++e) if (lg[e] > v0) { v0 = lg[e]; i0 = e; }
                            int i1 = -1; float v1 = -3.0e38f;
#pragma unroll
                            for (int e = 0; e < 8; ++e) if (e != i0 && lg[e] > v1) { v1 = lg[e]; i1 = e; }
                            if (lane == 0) { const float g1 = 1.0f / (1.0f + __expf(v0 - v1)); const int k0 = __hip_atomic_fetch_add(lcnt + i0, 1, __ATOMIC_RELAXED, __HIP_MEMORY_SCOPE_WORKGROUP), k1 = __hip_atomic_fetch_add(lcnt + 8 + i1, 1, __ATOMIC_RELAXED, __HIP_MEMORY_SCOPE_WORKGROUP);
                                rt_e[r] = i0 | (i1 << 8); rt_rank[r] = k0 | (k1 << 16); rt_g[2 * r] = 1.0f - g1; rt_g[2 * r + 1] = g1; }
                        } }
                }
                __syncthreads();
                if (tid < 16) blkcnt[bid * 16 + tid] = lcnt[tid];
            }
            SEAM(pb + 9);
#ifndef PROBE_SORT_REP
#define PROBE_SORT_REP 1
#endif
            for (int rep_ = 0; rep_ < PROBE_SORT_REP; ++rep_)
            if (IN(PH_SORT)) { IDS();
                LAS int* tot = (LAS int*)lds; LAS int* pre = tot + 16; LAS int* roff = tot + 32; LAS int* ntl = tot + 48;
                if (tid < 64) tot[tid] = 0;
                __syncthreads();
                { const int sgm = tid & 15, part = tid >> 4; int a = 0, bfore = 0;
                    for (int k = 0; k < 8; ++k) { const int wgi = part * 8 + k; if (wgi < G) { const int cv = blkcnt[wgi * 16 + sgm]; a += cv; if (wgi < bid) bfore += cv; } }
                    __hip_atomic_fetch_add(tot + sgm, a, __ATOMIC_RELAXED, __HIP_MEMORY_SCOPE_WORKGROUP); __hip_atomic_fetch_add(pre + sgm, bfore, __ATOMIC_RELAXED, __HIP_MEMORY_SCOPE_WORKGROUP); }
                __syncthreads();
                if (tid == 0) {
                    int tile = 0, T0 = 0;
                    for (int sg = 0; sg < 16; ++sg) { const int nt = (tot[sg] + 255) >> 8; roff[sg] = tile * 256; ntl[sg] = nt; if (bid == 0) for (int k = 0; k < nt; ++k) texp[tile + k] = sg & 7; tile += nt; if (sg == 7) T0 = tile; }
                    if (bid == 0) { const int T1 = tile - T0;
                        int p1 = T0 >= 64 && T0 - 64 <= CAP_TILES ? 64 : (T0 + 1) / 2, p2 = T1 >= 64 && T1 - 64 <= CAP_TILES ? T1 - 64 : (T1 + 1) / 2;
                        passt[0] = 0; passt[1] = p1; passt[2] = T0; passt[3] = T0 + p2; passt[4] = tile; }
                }
                __syncthreads();
                if (bid < 16) { const int b0 = roff[bid] + tot[bid], b1 = roff[bid] + ntl[bid] * 256; for (int i = b0 + tid; i < b1; i += NWAVES * 64) { stok[i] = -1; stokp[permp(i)] = -1; sgate[i] = 0.f; ssa[i] = 0.f; } }
                for (int k = lane; gw + k * NGW < NREG; k += 64) { const int r = gw + k * NGW;
                    { const int e = rt_e[r], rk = rt_rank[r]; const int e0 = e & 255, e1 = 8 + (e >> 8);
                        const int p0 = roff[e0] + pre[e0] + (rk & 0xffff), p1 = roff[e1] + pre[e1] + (rk >> 16);
                        const float sar = SA_U[r];
                        stok[p0] = r; stokp[permp(p0)] = r; sgate[p0] = rt_g[2 * r]; ssa[p0] = sar; stok[p1] = r; stokp[permp(p1)] = r; sgate[p1] = rt_g[2 * r + 1]; ssa[p1] = sar; } }
#ifndef PROBE_IDENT
#define PROBE_IDENT 0
#endif
                if (PROBE_IDENT) for (long i = gtid; i < MAX_SROWS; i += (long)G * NWAVES * 64) ((int*)(ws + WS_DTGA))[i] = (int)(i & 32767);
                __syncthreads();
            }
            SEAM(PH_SORT);
#ifndef PROBE_DK_HALF
#define PROBE_DK_HALF 0
#endif
#ifndef PROBE_MOE_REP
#define PROBE_MOE_REP 1
#endif
#pragma unroll 1
            for (int p_ = 0; p_ < 5 * PROBE_MOE_REP; ++p_) { const int p = p_ % 5; const float gscale_ = p_ < 5 * (PROBE_MOE_REP - 1) ? 0.0f : 1.0f;
                OPAQUE_RANGE();
                if (IN(PH_PASS0 + p)) { IDS();
                    int nd = 0;
                    LAS int* lexd = (LAS int*)(lds + 139264); LAS int* lexg = lexd + 128;
                    if (p > 0) { const int t0 = passt[p - 1], n = passt[p] - t0; if (tid < n) lexd[tid] = texp[t0 + tid]; }
                    if (p < 4) { const int t0 = passt[p], n = passt[p + 1] - t0; if (tid < n) lexg[tid] = texp[t0 + tid]; }
                    __syncthreads();
                    if (p > 0) {
                        const int t0 = passt[p - 1], t1 = passt[p]; nd = (t1 - t0) * 4;
                        pg8::Gemm g{(const bf16*)(ws + WS_BIG + (size_t)((p - 1) & 1) * MOE_ACT_BYTES), (const bf16*)WMD8, CAP_TILES * 256, 8 * 1024, (PROBE_DK_HALF && gscale_ == 0.0f) ? 896 : 1792}; pg8::MoeOrder S{t0, t1 - t0, 4, G, bid, 0, lexd, stok, t0 * 256};
                        pg8::EpiMoeDown E{p >= 3 ? Y1LO : YLO, p >= 3 ? (long)(Y1HI - Y1LO) : (long)(YHI - YLO), stok, sgate, t0 * 256, gscale_ * f8_scale(*AMAX_MD, true)};
                        pg8::gemm_phase<pg8::EpiMoeDown, pg8::MoeOrder, true, true, false, true, false, true>(lds, g, S, E);
                    }
                    if (p < 4) {
                        const int t0 = passt[p], t1 = passt[p + 1];
                        pg8::Gemm g{(const bf16*)U8, (const bf16*)WMGU8, NREG, 8 * 7168, 512}; pg8::MoeOrder S{t0, t1 - t0, 28, G, bid, nd > G ? nd - G : 0, lexg, stok, t0 * 256, stokp};
                        pg8::EpiSwiGLU8 E{(bf16*)(ws + WS_BIG + (size_t)(p & 1) * MOE_ACT_BYTES), 3584, 28, ssa, SB_MGU, t0 * 256, true};
                        pg8::gemm_phase<pg8::EpiSwiGLU8, pg8::MoeOrder, true, true, true, false, true>(lds, g, S, E);
                    }
                }
                SEAM(PH_PASS0 + p);
            }
#ifndef PROBE_BAR_REP
#define PROBE_BAR_REP 0
#endif
            for (int rep_ = 0; rep_ < PROBE_BAR_REP; ++rep_) xcd_barrier_lean(bar);
            if (IN(PH_FINAL)) { IDS();
                const float* w = INP(IN_FINAL); f32x4 fwr[4];
#pragma unroll
                for (int j = 0; j < 4; ++j) fwr[j] = ((const GAS f32x4*)w + lane)[64 * j];
                for (int r = gw; r < NREG; r += 2 * NGW) { const int r2 = r + NGW < NREG ? r + NGW : r;
                    GAS f32x4* xa = (GAS f32x4*)(hreg + (size_t)r * 1024) + lane; GAS f32x4* xb = (GAS f32x4*)(hreg + (size_t)r2 * 1024) + lane;
                    f32x4 va[4], vb[4]; float sa = 0.f, sb = 0.f;
                    { const GAS unsigned long long* ha = (const GAS unsigned long long*)((const bf16*)hreg + (size_t)r * HP) + lane; const GAS unsigned long long* hb_ = (const GAS unsigned long long*)((const bf16*)hreg + (size_t)r2 * HP) + lane;
#pragma unroll
                    for (int j = 0; j < 4; ++j) { va[j] = bf4_f32(ha[64 * j]); vb[j] = bf4_f32(hb_[64 * j]); } }
#pragma unroll
                    for (int sl = 0; sl < 2; ++sl)
#pragma unroll
                    for (int j = 0; j < 4; ++j) { const bf16* yb_ = sl == 0 ? (j < 2 ? YLO : YHI) : (j < 2 ? Y1LO : Y1HI); const int cy = 4 * lane + 256 * (j & 1);
                        const unsigned long long qa = *(const GAS unsigned long long*)(yb_ + (size_t)r * 512 + cy), qb = *(const GAS unsigned long long*)(yb_ + (size_t)r2 * 512 + cy);
                        va[j].x += __uint_as_float((unsigned)qa << 16); va[j].y += __uint_as_float((unsigned)qa & 0xffff0000u); va[j].z += __uint_as_float((unsigned)(qa >> 32) << 16); va[j].w += __uint_as_float((unsigned)(qa >> 32) & 0xffff0000u);
                        vb[j].x += __uint_as_float((unsigned)qb << 16); vb[j].y += __uint_as_float((unsigned)qb & 0xffff0000u); vb[j].z += __uint_as_float((unsigned)(qb >> 32) << 16); vb[j].w += __uint_as_float((unsigned)(qb >> 32) & 0xffff0000u); }
#pragma unroll
                    for (int j = 0; j < 4; ++j) { sa += (va[j].x * va[j].x + va[j].y * va[j].y) + (va[j].z * va[j].z + va[j].w * va[j].w); sb += (vb[j].x * vb[j].x + vb[j].y * vb[j].y) + (vb[j].z * vb[j].z + vb[j].w * vb[j].w); }
                    const float ra = 1.f / sqrtf(wave_sum_sw(sa) * (1.f / 1024.f) + 1e-6f), rb = 1.f / sqrtf(wave_sum_sw(sb) * (1.f / 1024.f) + 1e-6f);
#pragma unroll
                    for (int j = 0; j < 4; ++j) { const f32x4 ww = fwr[j]; xa[64 * j] = va[j] * ra * ww; if (r2 != r) xb[64 * j] = vb[j] * rb * ww; }
                }
            }
        }
    }
    }

#undef IN
#undef SEAM
}

extern "C" void kernel_launch(void* const* d_in, const int* in_sizes, int n_in, void* d_out, int out_size, void* d_ws, size_t ws_size, hipStream_t stream) {
    static int grid = 0;
    if (grid == 0) {
        if (n_in != 27 || ws_size < WS_END || out_size != NREG * 1024) { fprintf(stderr, "kernel_launch: unexpected problem (n_in %d, ws %zu, out %d)\n", n_in, ws_size, out_size); grid = -1; return; }
        int dev = 0, cus = 0;
        if (hipGetDevice(&dev) != hipSuccess || hipDeviceGetAttribute(&cus, hipDeviceAttributeMultiprocessorCount, dev) != hipSuccess) { grid = -1; return; }
        if (hipFuncSetAttribute((const void*)fwd_kernel, hipFuncAttributeMaxDynamicSharedMemorySize, LDS_BYTES) != hipSuccess) { fprintf(stderr, "kernel_launch: hipFuncSetAttribute failed\n"); grid = -1; return; }
        int per_cu = 0;
        if (hipOccupancyMaxActiveBlocksPerMultiprocessor(&per_cu, (const void*)fwd_kernel, NWAVES * 64, LDS_BYTES) != hipSuccess || per_cu < 1) fprintf(stderr, "kernel_launch: occupancy query reports %d workgroups per CU\n", per_cu);
        (void)hipGetLastError();
        grid = cus;
    }
    if (grid < 0) return;
    (void)hipMemsetAsync((char*)d_ws + WS_CTL, 0, CTL_ZERO_BYTES, stream);
    Args a{};
    for (int i = 0; i < 27; ++i) a.in[i] = (const float*)d_in[i];
    a.out = (float*)d_out; a.ws = (unsigned char*)d_ws;
#if N_LAUNCH_MODE == 1
    a.ph_lo = 0; a.ph_hi = PH_END;
    hipLaunchKernelGGL(fwd_kernel, dim3(grid), dim3(NWAVES * 64), LDS_BYTES, stream, a);
#else
    for (int ph = 0; ph < PH_END; ++ph) {
        const bool used = ph == 0 || (ph >= PH_L0 && ph < PH_L0 + 12) || (ph >= PH_L1 && ph < PH_L1 + 10) || ph >= PH_SORT;
        if (!used) continue;
        a.ph_lo = ph; a.ph_hi = ph + 1;
        hipLaunchKernelGGL(fwd_kernel, dim3(grid), dim3(NWAVES * 64), LDS_BYTES, stream, a);
    }
#endif
}
```

```cpp
#include <hip/hip_runtime.h>
#include <cstdio>
#include <cstdint>
#include <cmath>
#define HD_INLINE __device__ __forceinline__
#ifndef CFG_BATCH
#define CFG_BATCH 8
#endif
#ifndef CFG_SEQ
#define CFG_SEQ 4096
#endif
constexpr int B_ = CFG_BATCH, S_ = CFG_SEQ, NM = 16, L_ = S_ + NM;
constexpr int NREG = B_ * S_, NTOK = NREG + B_ * NM, MP = ((NTOK + 255) / 256) * 256;
constexpr int PW = 2816;
constexpr int PZ = 0, PX = 256, PB = 512, PC = 768, PGQ = 1024, PGK = 1152, PGV = 1280, PGR = 1536, PSQ = 1792, PSK = 2048, PSV = 2176, PAQ = 2304, PAK = 2560, PAV = 2688;
constexpr int DGW = 64;
constexpr int XW = 768;
typedef unsigned short bf16;

#ifdef __HIP_DEVICE_COMPILE__
#define FAST_COS(x) __cosf(x)
#define FAST_SIN(x) __sinf(x)
#else
#define FAST_COS(x) cosf(x)
#define FAST_SIN(x) sinf(x)
#endif
#define ROPE_INV(j) __builtin_exp2f(-(float)(j) * 0.8304820237218406f)
HD_INLINE int row_of(int b, int t) { return t < NM ? NREG + b * NM + t : b * S_ + (t - NM); }
HD_INLINE float bf2f(bf16 v) { unsigned u = ((unsigned)v) << 16; float f; __builtin_memcpy(&f, &u, 4); return f; }
HD_INLINE bf16 f2bf(float f) { unsigned u; __builtin_memcpy(&u, &f, 4); return (bf16)((u + 0x7fffu + ((u >> 16) & 1u)) >> 16); }
HD_INLINE float siluf(float x) { return x / (1.0f + expf(-x)); }
HD_INLINE float softplusf(float x) { return x > 20.f ? x : log1pf(expf(x)); }
HD_INLINE float logsigmoidf(float x) { return x >= 0.f ? -log1pf(expf(-x)) : x - log1pf(expf(x)); }
HD_INLINE int t5_bucket(int rel) {
    const int a = rel < 0 ? -rel : rel, base = rel > 0 ? 16 : 0;
    if (a < 8) return base + a;
    const int k = (a >= 12) + (a >= 16) + (a >= 23) + (a >= 32) + (a >= 46) + (a >= 64) + (a >= 91);
    return base + 8 + k;
}

struct MixParams {
    const float *conv_w, *conv_b, *dt_bias, *a_log, *ssd_d, *ssd_norm_w, *gate_w2, *gate_b, *gla_norm_w, *sink, *qn_w, *kn_w, *rel_bias;
};
struct MixBuf { bf16* proj; const float* dtga; bf16* xbca; bf16* mixed; };

HD_INLINE void nv_conv(const MixBuf& m, const MixParams& p, long gtid, long nthreads) {
    for (long idx = gtid; idx < (long)B_ * L_ * XW; idx += nthreads) {
        const int c = (int)(idx % XW); const long bt = idx / XW; const int t = (int)(bt % L_), b = (int)(bt / L_);
        float acc = p.conv_b[c];
        for (int j = 0; j < 5; ++j) { const int tt = t + j - 2; if (tt >= 0 && tt < L_) acc += p.conv_w[j * XW + c] * bf2f(m.proj[(size_t)row_of(b, tt) * PW + PX + c]); }
        m.xbca[(size_t)row_of(b, t) * XW + c] = f2bf(siluf(acc));
    }
}

namespace pg8 {
#define PG8_LAS __attribute__((address_space(3)))
typedef unsigned short bf16_t;
typedef short bf16x8 __attribute__((ext_vector_type(8)));
typedef float f32x4 __attribute__((ext_vector_type(4)));
typedef unsigned u32x4 __attribute__((ext_vector_type(4)));
constexpr int BM = 256, BK = 64, HALF = 128, HTB = HALF * BK * 2  , STAGE_BYTES = 8 * HTB, NXCD = 8, WGM = 8;

__host__ __device__ __forceinline__ int lds_byte(int r, int c) { const int st = (r >> 4) * 2 + (c >> 5), rr = r & 15, cc = c & 31, ob = rr * 64 + cc * 2; return st * 1024 + (ob ^ (((ob >> 9) & 1) << 5)); }
__host__ __device__ __forceinline__ void stage_rc(int b, int& R, int& C) { const int st = b / 1024, sb = b % 1024, swz = sb ^ (((sb >> 9) & 1) << 5); R = (st >> 1) * 16 + swz / 64; C = (st & 1) * 32 + (swz % 64) / 2; }
__host__ __device__ __forceinline__ int perm32(int rho) { const int n = rho >> 4, i = rho & 15; return 8 * (i >> 2) + 4 * n + (i & 3); }

struct Unit { int pm, pn; };
struct Gemm { const bf16_t* A; const bf16_t* Bt; int M, N, K; };

struct StaticOrder {
    int nM, nN, nwg, G, c;
    __host__ __device__ void init(int M, int N, int G_, int c_) { nM = M / BM; nN = N / BM; nwg = nM * nN; G = G_; c = c_; }
    __host__ __device__ bool next(int i, Unit& u) const {
        const long L = (long)i * G + c; if (L >= nwg) return false;
        int wgid = (int)L; { const int q = nwg / NXCD, r = nwg % NXCD, xcd = wgid % NXCD, off = wgid / NXCD; wgid = (xcd < r ? xcd * (q + 1) : r * (q + 1) + (xcd - r) * q) + off; }
        const int nig = WGM * nN, gid = wgid / nig, fm = gid * WGM, gsz = (nM - fm) < WGM ? (nM - fm) : WGM;
        u.pm = fm + ((wgid % nig) % gsz); u.pn = (wgid % nig) / gsz; return true;
    }
    __device__ __forceinline__ void a_ready(const Unit&) const {}
    __device__ __forceinline__ void done(const Unit&) const {}
};

__device__ __forceinline__ unsigned cvt_pk_bf16(float lo, float hi) { unsigned r; asm volatile("v_cvt_pk_bf16_f32 %0, %1, %2" : "=v"(r) : "v"(lo), "v"(hi)); return r; }
typedef float f32x2 __attribute__((ext_vector_type(2)));
__device__ __forceinline__ f32x2 gelu_pk(f32x2 v) {
    const f32x2 av = __builtin_elementwise_abs(v), d = av * 0.2316418882f + 1.0f;
    f32x2 t; t.x = __builtin_amdgcn_rcpf(d.x); t.y = __builtin_amdgcn_rcpf(d.y);
    f32x2 q = t * 0.5307027145f + (-0.7265760135f); q = q * t + 0.7107068705f; q = q * t + (-0.142248368f); q = q * t + 0.127414796f; q = q * t;
    const f32x2 s = (v * v) * (-0.72134752044f);
    f32x2 e; e.x = __builtin_amdgcn_exp2f(s.x); e.y = __builtin_amdgcn_exp2f(s.y);
    const f32x2 m = v * (q * e), r = v - m;
    f32x2 o; o.x = v.x < 0.f ? m.x : r.x; o.y = v.y < 0.f ? m.y : r.y; return o;
}

template <int ACT  > struct EpiBf16 {
    static constexpr bool PERM = true, AFTER_DRAIN = false; static_assert(ACT == 0 || ACT == 1, "EpiBf16: ACT is 0 (none) or 1 (gelu_pk)");
    bf16_t* O; int ldc; const float* bias; int split_cols; size_t split_stride; float scale0;
    __device__ __forceinline__ void operator()(const f32x4 (&acc)[2][2][4][2], const Unit& u, int wr, int wc, int fr, int fq) const {
        const int row0 = u.pm * BM + wr * 64 + fr; int colt = u.pn * BM; bf16_t* base = O;
        float sc = 1.f; if (split_cols) { const int t = colt / split_cols; base += (size_t)t * split_stride; colt -= t * split_cols; if (t == 0) sc = scale0; }
        const int col0 = colt + wc * 32 + 8 * fq, bcol0 = u.pn * BM + wc * 32 + 8 * fq;
        f32x4 bv[2][2];
#pragma unroll
        for (int bj = 0; bj < 2; ++bj)
#pragma unroll
            for (int n = 0; n < 2; ++n) bv[bj][n] = bias ? *(const f32x4*)(bias + bcol0 + bj * HALF + 4 * n) : (f32x4){0.f, 0.f, 0.f, 0.f};
#pragma unroll
        for (int ai = 0; ai < 2; ++ai)
#pragma unroll
            for (int m = 0; m < 4; ++m) { bf16_t* rowp = base + (size_t)(row0 + ai * HALF + m * 16) * ldc + col0;
#pragma unroll
                for (int bj = 0; bj < 2; ++bj) { f32x4 v0 = acc[ai][bj][m][0] + bv[bj][0], v1 = acc[ai][bj][m][1] + bv[bj][1];
                    if (ACT == 1) { f32x2 a = gelu_pk((f32x2){v0[0], v0[1]}), b = gelu_pk((f32x2){v0[2], v0[3]}), c = gelu_pk((f32x2){v1[0], v1[1]}), d = gelu_pk((f32x2){v1[2], v1[3]});
                        v0 = (f32x4){a.x, a.y, b.x, b.y}; v1 = (f32x4){c.x, c.y, d.x, d.y}; }
                    v0 = v0 * sc; v1 = v1 * sc; u32x4 w; w.x = cvt_pk_bf16(v0[0], v0[1]); w.y = cvt_pk_bf16(v0[2], v0[3]); w.z = cvt_pk_bf16(v1[0], v1[1]); w.w = cvt_pk_bf16(v1[2], v1[3]);
                    *(u32x4*)(rowp + bj * HALF) = w; } }
    }
};

typedef int i32x4 __attribute__((ext_vector_type(4)));
template <bool I8> struct AccT { typedef f32x4 type; };
template <> struct AccT<true> { typedef i32x4 type; };
template <bool I8> __device__ __forceinline__ typename AccT<I8>::type mma1(bf16x8 b, bf16x8 a, typename AccT<I8>::type c) {
    if constexpr (I8) return __builtin_amdgcn_mfma_i32_16x16x64_i8(__builtin_bit_cast(i32x4, b), __builtin_bit_cast(i32x4, a), c, 0, 0, 0);
    else return __builtin_amdgcn_mfma_f32_16x16x32_bf16(b, a, c, 0, 0, 0);
}
typedef int i32x8 __attribute__((ext_vector_type(8)));
template <bool I8, bool F8> __device__ __forceinline__ typename AccT<I8>::type mma2(bf16x8 b0, bf16x8 b1, bf16x8 a0, bf16x8 a1, typename AccT<I8>::type c) {
    if constexpr (F8) { const i32x4 B0 = __builtin_bit_cast(i32x4, b0), B1 = __builtin_bit_cast(i32x4, b1), A0 = __builtin_bit_cast(i32x4, a0), A1 = __builtin_bit_cast(i32x4, a1);
        const i32x8 B = {B0.x, B0.y, B0.z, B0.w, B1.x, B1.y, B1.z, B1.w}, A = {A0.x, A0.y, A0.z, A0.w, A1.x, A1.y, A1.z, A1.w};
        return __builtin_amdgcn_mfma_scale_f32_16x16x128_f8f6f4(B, A, c, 0, 0, 0, 0, 0, 0); }
    else { c = mma1<I8>(b0, a0, c); return mma1<I8>(b1, a1, c); }
}
struct EpiPreNone {}; struct EpiPreI { int i[2][4]; };
struct EpiPreS { unsigned long long q[2]; float f[2]; };
template <class Epi, class Sched, bool ALIGN_EPI = false, bool SP2 = false, bool GATHER = false, bool TILED = false, bool I8 = false, bool F8 = false>
__device__ __forceinline__ void gemm_phase(PG8_LAS unsigned char* lds, const Gemm g, const Sched& S, const Epi& E) {
    int tid = threadIdx.x; asm volatile("" : "+v"(tid));
    const int wid = __builtin_amdgcn_readfirstlane(tid >> 6), lane = tid & 63, wr = wid >> 2, wc = wid & 3, fr = lane & 15, fq = lane >> 4;
    const int K = g.K, nt = K / BK;
    PG8_LAS float* const xl = (PG8_LAS float*)(lds + 144384 + wid * 1024);
    unsigned voffA, voffB;
    { int R, C; stage_rc(tid * 16, R, C); const int Rb = Epi::PERM ? ((R & ~31) + perm32(R & 31)) : R;
        voffA = (unsigned)(R * (TILED ? 64 : K) + C) * 2u; voffB = (unsigned)(Rb * (TILED ? 64 : K) + C) * 2u; }
    const size_t vstep = (size_t)64 * (TILED ? 64 : K) * 2;
    static_assert(!(GATHER && TILED), "gathered rows are row-major");
    static_assert(!GATHER || SP2, "the gathered A path is written for the SP2 loop");
    unsigned vgc[2][2] = {{0u, 0u}, {0u, 0u}}, vgn[2][2] = {{0u, 0u}, {0u, 0u}};
    const char* const A0 = (const char*)g.A;
#define PG8_GLOAD(dst, unit) do { _Pragma("unroll") for (int h_ = 0; h_ < 2; ++h_) _Pragma("unroll") for (int i_ = 0; i_ < 2; ++i_) { int R_, C_; stage_rc(tid * 16 + i_ * 8192, R_, C_); \
        int tk_ = S.ridx[S.row_base + (unit).pm * BM + h_ * HALF + R_]; tk_ = tk_ < 0 ? 0 : tk_; dst[h_][i_] = (unsigned)(tk_ * K + C_) * 2u; } } while (0)
#define PG8_STAGE_G(bufoff, gb, o0, o1) do { __builtin_amdgcn_global_load_lds((const unsigned*)((gb) + (o0)), (PG8_LAS unsigned*)(lds + (bufoff) + ldsw), 16, 0, 0); \
        __builtin_amdgcn_global_load_lds((const unsigned*)((gb) + (o1)), (PG8_LAS unsigned*)(lds + (bufoff) + ldsw + 8192), 16, 0, 0); } while (0)
    const size_t kstep = TILED ? (size_t)(BM * BK * 2) : (size_t)(BK * 2);
    const size_t hstep = TILED ? (size_t)(HALF * BK * 2) : (size_t)HALF * K * 2;
    const size_t tstep = (size_t)BM * K * 2;
    const unsigned ldsw = (unsigned)wid * 1024u;
    const int aoff = lds_byte(wr * 64 + fr, fq * 8), boff = lds_byte(wc * 32 + fr, fq * 8);
#define PG8_SA(b, h) (((b) * 2 + (h)) * HTB)
#define PG8_SB(b, h) ((4 + (b) * 2 + (h)) * HTB)
#define PG8_STAGE(bufoff, gbase, voff) do { _Pragma("unroll") for (int _i = 0; _i < 2; ++_i) \
        __builtin_amdgcn_global_load_lds((const unsigned*)((const char*)(gbase) + _i * vstep + (voff)), (PG8_LAS unsigned*)(lds + (bufoff) + ldsw + _i * 8192), 16, 0, 0); } while (0)
#define PG8_LDA(dst, b, h) do { _Pragma("unroll") for (int m = 0; m < 4; ++m) _Pragma("unroll") for (int k = 0; k < 2; ++k) dst[m][k] = *(const PG8_LAS bf16x8*)(lds + PG8_SA(b, h) + aoff + m * 2048 + k * 1024); } while (0)
#define PG8_LDB(dst, b, h) do { _Pragma("unroll") for (int n = 0; n < 2; ++n) _Pragma("unroll") for (int k = 0; k < 2; ++k) dst[n][k] = *(const PG8_LAS bf16x8*)(lds + PG8_SB(b, h) + boff + n * 2048 + k * 1024); } while (0)
#define PG8_MMA(ai, bj, At, Bt) do { __builtin_amdgcn_s_setprio(1); _Pragma("unroll") for (int m = 0; m < 4; ++m) _Pragma("unroll") for (int n = 0; n < 2; ++n) \
        acc[ai][bj][m][n] = mma2<I8, F8>(Bt[n][0], Bt[n][1], At[m][0], At[m][1], acc[ai][bj][m][n]); __builtin_amdgcn_s_setprio(0); } while (0)
#define PG8_WAIT_V(n) asm volatile("s_waitcnt vmcnt(" #n ")" ::: "memory")
#define PG8_WAIT_L(n) asm volatile("s_waitcnt lgkmcnt(" #n ")" ::: "memory")
#define PG8_BAR __builtin_amdgcn_s_barrier()
#define PG8_SCHED __builtin_amdgcn_sched_barrier(0)
    Unit cur, nxt; int ui = 0;
    if (!S.next(0, cur)) return;
    typedef typename AccT<I8>::type acc_t; acc_t acc[2][2][4][2];
#pragma unroll
    for (int a = 0; a < 2; ++a)
#pragma unroll
        for (int b = 0; b < 2; ++b)
#pragma unroll
            for (int m = 0; m < 4; ++m)
#pragma unroll
                for (int n = 0; n < 2; ++n) acc[a][b][m][n] = acc_t{};
    bf16x8 At[4][2], B0[2][2], B1[2][2];
    const char* cA = (const char*)g.A + (size_t)cur.pm * tstep; const char* cB = (const char*)g.Bt + (size_t)cur.pn * tstep;
    S.a_ready(cur);
    if constexpr (SP2) {
        if constexpr (GATHER) { PG8_GLOAD(vgc, cur); }
        PG8_STAGE(PG8_SB(0, 0), cB, voffB); PG8_STAGE(PG8_SB(0, 1), cB + hstep, voffB);
        if constexpr (GATHER) { PG8_STAGE_G(PG8_SA(0, 0), A0, vgc[0][0], vgc[0][1]); PG8_STAGE_G(PG8_SA(0, 1), A0, vgc[1][0], vgc[1][1]); } else { PG8_STAGE(PG8_SA(0, 0), cA, voffA); PG8_STAGE(PG8_SA(0, 1), cA + hstep, voffA); }
        if (wr == 1) PG8_BAR;
        PG8_WAIT_V(2); PG8_BAR;
        PG8_STAGE(PG8_SB(1, 0), cB + kstep, voffB);
        if constexpr (GATHER) { PG8_STAGE_G(PG8_SA(1, 0), A0 + kstep, vgc[0][0], vgc[0][1]); } else { PG8_STAGE(PG8_SA(1, 0), cA + kstep, voffA); }
        PG8_STAGE(PG8_SB(1, 1), cB + hstep + kstep, voffB);
        PG8_WAIT_V(6); PG8_BAR;
    } else {
        PG8_STAGE(PG8_SB(0, 0), cB, voffB); PG8_STAGE(PG8_SA(0, 0), cA, voffA); PG8_STAGE(PG8_SB(0, 1), cB + hstep, voffB); PG8_STAGE(PG8_SA(0, 1), cA + hstep, voffA);
        if (wr == 1) PG8_BAR;
        PG8_WAIT_V(4); PG8_BAR;
        PG8_STAGE(PG8_SB(1, 0), cB + kstep, voffB); PG8_STAGE(PG8_SA(1, 0), cA + kstep, voffA); PG8_STAGE(PG8_SB(1, 1), cB + hstep + kstep, voffB);
        PG8_WAIT_V(6); PG8_BAR;
    }
    for (;;) {
        const bool has_next = S.next(ui + 1, nxt);
        typename Epi::Pre epre; E.pre(cur, wr, fr, fq, epre, xl);
        if constexpr (GATHER) { if (has_next) { int R_, C_; stage_rc(tid * 16, R_, C_);
            __builtin_amdgcn_global_load_lds((const unsigned*)((const char*)S.ridxp + ((size_t)(S.row_base + nxt.pm * BM) * 4 + (size_t)R_ * 16)), (PG8_LAS unsigned*)(lds + 131072 + ldsw), 16, 0, 0); } }
        const char* nA = has_next ? (const char*)g.A + (size_t)nxt.pm * tstep : cA; const char* nB = has_next ? (const char*)g.Bt + (size_t)nxt.pn * tstep : cB;
        for (int t = 0; t < nt; t += 2) {
            const bool last = (t == nt - 2);
            const char* a1 = cA + (size_t)(t + 1) * kstep;
            const char* a2 = last ? nA : cA + (size_t)(t + 2) * kstep; const char* b2 = last ? nB : cB + (size_t)(t + 2) * kstep;
            const char* a3 = a2 + kstep; const char* b3 = b2 + kstep;
            const char* ga2 = A0 + (size_t)(last ? 0 : t + 2) * kstep; (void)ga2;
            if (last && has_next) S.a_ready(nxt);
            if constexpr (GATHER) { if (last) {
                if (has_next) { const i32x4 raw = *(const volatile PG8_LAS i32x4*)(lds + 131072 + ldsw + (tid & 63) * 16); int R_, C_; stage_rc(tid * 16, R_, C_);
#pragma unroll
                    for (int k_ = 0; k_ < 4; ++k_) { int tk_ = raw[k_]; tk_ = tk_ < 0 ? 0 : tk_; vgn[k_ >> 1][k_ & 1] = (unsigned)(tk_ * K + C_) * 2u; } }
                else { vgn[0][0] = vgc[0][0]; vgn[0][1] = vgc[0][1]; vgn[1][0] = vgc[1][0]; vgn[1][1] = vgc[1][1]; } } }
            if constexpr (SP2) {
            PG8_LDB(B0, 0, 0); PG8_LDB(B1, 0, 1); PG8_SCHED; PG8_LDA(At, 0, 0); if constexpr (GATHER) { PG8_STAGE_G(PG8_SA(1, 1), A0 + (size_t)(t + 1) * kstep, vgc[1][0], vgc[1][1]); } else { PG8_STAGE(PG8_SA(1, 1), a1 + hstep, voffA); }
            PG8_WAIT_V(8); PG8_WAIT_L(0); PG8_BAR; PG8_MMA(0, 0, At, B0); PG8_MMA(0, 1, At, B1); PG8_BAR; PG8_SCHED;
            PG8_LDA(At, 0, 1); PG8_STAGE(PG8_SB(0, 0), b2, voffB); PG8_STAGE(PG8_SB(0, 1), b2 + hstep, voffB); if constexpr (GATHER) { PG8_STAGE_G(PG8_SA(0, 0), ga2, last ? vgn[0][0] : vgc[0][0], last ? vgn[0][1] : vgc[0][1]); } else { PG8_STAGE(PG8_SA(0, 0), a2, voffA); }
            PG8_WAIT_V(8); PG8_WAIT_L(0); PG8_BAR; PG8_MMA(1, 0, At, B0); PG8_MMA(1, 1, At, B1); PG8_BAR; PG8_SCHED;
            PG8_LDB(B0, 1, 0); PG8_LDB(B1, 1, 1); PG8_SCHED; PG8_LDA(At, 1, 0); if constexpr (GATHER) { PG8_STAGE_G(PG8_SA(0, 1), ga2, last ? vgn[1][0] : vgc[1][0], last ? vgn[1][1] : vgc[1][1]); } else { PG8_STAGE(PG8_SA(0, 1), a2 + hstep, voffA); }
            PG8_WAIT_V(8); PG8_WAIT_L(0); PG8_BAR; PG8_MMA(0, 0, At, B0); PG8_MMA(0, 1, At, B1); PG8_BAR; PG8_SCHED;
            PG8_LDA(At, 1, 1); PG8_STAGE(PG8_SB(1, 0), b3, voffB); PG8_STAGE(PG8_SB(1, 1), b3 + hstep, voffB); if constexpr (GATHER) { PG8_STAGE_G(PG8_SA(1, 0), ga2 + kstep, last ? vgn[0][0] : vgc[0][0], last ? vgn[0][1] : vgc[0][1]); } else { PG8_STAGE(PG8_SA(1, 0), a3, voffA); }
            PG8_WAIT_V(8); PG8_WAIT_L(0); PG8_BAR; PG8_MMA(1, 0, At, B0); PG8_MMA(1, 1, At, B1); PG8_BAR; PG8_SCHED;
            } else {
            PG8_LDB(B0, 0, 0); PG8_SCHED; PG8_LDA(At, 0, 0); PG8_STAGE(PG8_SA(1, 1), a1 + hstep, voffA);
            PG8_WAIT_L(8); PG8_BAR; PG8_WAIT_L(0); PG8_MMA(0, 0, At, B0); PG8_BAR; PG8_SCHED;
            PG8_LDB(B1, 0, 1); PG8_STAGE(PG8_SB(0, 0), b2, voffB);
            PG8_BAR; PG8_WAIT_L(0); PG8_MMA(0, 1, At, B1); PG8_BAR;
            PG8_LDA(At, 0, 1); PG8_STAGE(PG8_SA(0, 0), a2, voffA);
            PG8_BAR; PG8_WAIT_L(0); PG8_MMA(1, 0, At, B0); PG8_BAR; PG8_SCHED;
            PG8_STAGE(PG8_SB(0, 1), b2 + hstep, voffB);
            PG8_WAIT_V(6); PG8_BAR; PG8_MMA(1, 1, At, B1); PG8_BAR;
            PG8_LDB(B0, 1, 0); PG8_SCHED; PG8_LDA(At, 1, 0); PG8_STAGE(PG8_SA(0, 1), a2 + hstep, voffA);
            PG8_WAIT_L(8); PG8_BAR; PG8_WAIT_L(0); PG8_MMA(0, 0, At, B0); PG8_BAR; PG8_SCHED;
            PG8_LDB(B1, 1, 1); PG8_STAGE(PG8_SB(1, 0), b3, voffB);
            PG8_BAR; PG8_WAIT_L(0); PG8_MMA(0, 1, At, B1); PG8_BAR;
            PG8_LDA(At, 1, 1); PG8_STAGE(PG8_SA(1, 0), a3, voffA);
            PG8_BAR; PG8_WAIT_L(0); PG8_MMA(1, 0, At, B0); PG8_BAR; PG8_SCHED;
            PG8_STAGE(PG8_SB(1, 1), b3 + hstep, voffB);
            PG8_WAIT_V(6); PG8_BAR; PG8_MMA(1, 1, At, B1); PG8_BAR;
            }
        }
        if constexpr (ALIGN_EPI) { if (wr == 0) PG8_BAR; }
        if constexpr (!Epi::AFTER_DRAIN) { E(acc, cur, wr, wc, fr, fq, epre, xl); S.done(cur); }
        if (!has_next) break;
#pragma unroll
        for (int a = 0; a < 2; ++a)
#pragma unroll
            for (int b = 0; b < 2; ++b)
#pragma unroll
                for (int m = 0; m < 4; ++m)
#pragma unroll
                    for (int n = 0; n < 2; ++n) acc[a][b][m][n] = acc_t{};
        cur = nxt; cA = nA; cB = nB; ++ui;
        if constexpr (GATHER) { vgc[0][0] = vgn[0][0]; vgc[0][1] = vgn[0][1]; vgc[1][0] = vgn[1][0]; vgc[1][1] = vgn[1][1]; }
        if constexpr (ALIGN_EPI) { if (wr == 1) PG8_BAR; }
    }
    PG8_WAIT_V(0);
    if constexpr (!ALIGN_EPI) { if (wr == 0) PG8_BAR; }
    PG8_BAR;
    if constexpr (Epi::AFTER_DRAIN) { E.fused(acc, cur, wr, wc, fr, fq, lds, wid, lane); S.done(cur); }
#undef PG8_SA
#undef PG8_GLOAD
#undef PG8_STAGE_G
#undef PG8_SB
#undef PG8_STAGE
#undef PG8_LDA
#undef PG8_LDB
#undef PG8_MMA
#undef PG8_WAIT_V
#undef PG8_WAIT_L
#undef PG8_BAR
#undef PG8_SCHED
}
}

namespace pg8 {
typedef unsigned long long ssq_t;
__device__ __forceinline__ float ssq_rstd(const ssq_t* ssq, int r) { return __builtin_amdgcn_rsqf((float)ssq[r] * (1.0f / (1048576.0f * 1024.0f)) + 1e-6f); }
__device__ __forceinline__ void ssq_add(ssq_t* ssq, int r, float ss) { atomicAdd(ssq + r, (ssq_t)(ss * 1048576.0f)); }
__device__ __forceinline__ void share_scales(PG8_LAS float* xl, int fr, int fq, float s0, float s1) { xl[fr * 8 + 2 * fq] = s0; xl[fr * 8 + 2 * fq + 1] = s1; asm volatile("s_waitcnt lgkmcnt(0)" ::: "memory"); }
__device__ __forceinline__ float silu_fast(float x) { return x * __builtin_amdgcn_rcpf(1.0f + __expf(-x)); }
struct EpiInProj {
    static constexpr bool PERM = true, AFTER_DRAIN = false;
    typedef EpiPreS Pre; bf16_t* proj; float* dtga; const ssq_t* ssq;
    __device__ __forceinline__ void pre(const Unit& u, int wr, int fr, int fq, Pre& p, PG8_LAS float*) const {
        if (ssq) {
#pragma unroll
            for (int k = 0; k < 2; ++k) { const int kk = 2 * fq + k; p.q[k] = ssq[u.pm * BM + wr * 64 + fr + (kk >> 2) * HALF + (kk & 3) * 16]; } }
    }
    __device__ __forceinline__ void operator()(const f32x4 (&acc)[2][2][4][2], const Unit& u, int wr, int wc, int fr, int fq, const Pre& p, PG8_LAS float* xl) const {
        const int row0 = u.pm * BM + wr * 64 + fr;
        if (ssq) share_scales(xl, fr, fq, ssq_rstd(p.q, 0), ssq_rstd(p.q, 1));
        if (u.pn < 11) {
            const int col0 = u.pn * BM + wc * 32 + 8 * fq;
#pragma unroll
            for (int ai = 0; ai < 2; ++ai)
#pragma unroll
                for (int m = 0; m < 4; ++m) { bf16_t* rowp = proj + (size_t)(row0 + ai * HALF + m * 16) * PW + col0;
                    const float rs = ssq ? xl[fr * 8 + ai * 4 + m] : 1.0f;
#pragma unroll
                    for (int bj = 0; bj < 2; ++bj) { const f32x4 v0 = acc[ai][bj][m][0] * rs, v1 = acc[ai][bj][m][1] * rs;
                        u32x4 w; w.x = cvt_pk_bf16(v0[0], v0[1]); w.y = cvt_pk_bf16(v0[2], v0[3]); w.z = cvt_pk_bf16(v1[0], v1[1]); w.w = cvt_pk_bf16(v1[2], v1[3]);
                        *(u32x4*)(rowp + bj * HALF) = w; } }
        } else if (wc == 0 || (wc == 1 && fq == 0)) {
#pragma unroll
            for (int ai = 0; ai < 2; ++ai)
#pragma unroll
                for (int m = 0; m < 4; ++m) { float* rp = dtga + (size_t)(row0 + ai * HALF + m * 16) * DGW + wc * 32 + 8 * fq;
                    *(f32x4*)rp = acc[ai][0][m][0]; *(f32x4*)(rp + 4) = acc[ai][0][m][1]; }
        }
    }
};
constexpr int HPITCH = 2048;
template <bool IN16> struct EpiResid {
    static constexpr bool PERM = true, AFTER_DRAIN = false;
    typedef EpiPreNone Pre; const void* hin; bf16_t* hout; float ascale = 1.0f;
    __device__ __forceinline__ void pre(const Unit&, int, int, int, Pre&, PG8_LAS float*) const {}
    __device__ __forceinline__ void operator()(const f32x4 (&acc)[2][2][4][2], const Unit& u, int wr, int wc, int fr, int fq, const Pre&, PG8_LAS float*) const {
        const int row0 = u.pm * BM + wr * 64 + fr, col0 = u.pn * BM + wc * 32 + 8 * fq;
#pragma unroll
        for (int ai = 0; ai < 2; ++ai)
#pragma unroll
            for (int m = 0; m < 4; ++m) { const int r = row0 + ai * HALF + m * 16; bf16_t* op = hout + (size_t)r * HPITCH + col0;
                f32x4 i0[2], i1[2];
                if constexpr (IN16) { const bf16_t* ip = (const bf16_t*)hin + (size_t)r * HPITCH + col0; u32x4 q[2];
#pragma unroll
                    for (int bj = 0; bj < 2; ++bj) q[bj] = *(const u32x4*)(ip + bj * HALF);
#pragma unroll
                    for (int bj = 0; bj < 2; ++bj) { i0[bj] = (f32x4){__uint_as_float(q[bj].x << 16), __uint_as_float(q[bj].x & 0xffff0000u), __uint_as_float(q[bj].y << 16), __uint_as_float(q[bj].y & 0xffff0000u)};
                        i1[bj] = (f32x4){__uint_as_float(q[bj].z << 16), __uint_as_float(q[bj].z & 0xffff0000u), __uint_as_float(q[bj].w << 16), __uint_as_float(q[bj].w & 0xffff0000u)}; } }
                else { const float* ip = (const float*)hin + (size_t)r * 1024 + col0;
#pragma unroll
                    for (int bj = 0; bj < 2; ++bj) { i0[bj] = *(const f32x4*)(ip + bj * HALF); i1[bj] = *(const f32x4*)(ip + bj * HALF + 4); } }
#pragma unroll
                for (int bj = 0; bj < 2; ++bj) { const f32x4 v0 = i0[bj] + acc[ai][bj][m][0] * ascale, v1 = i1[bj] + acc[ai][bj][m][1] * ascale;
                    u32x4 w; w.x = cvt_pk_bf16(v0[0], v0[1]); w.y = cvt_pk_bf16(v0[2], v0[3]); w.z = cvt_pk_bf16(v1[0], v1[1]); w.w = cvt_pk_bf16(v1[2], v1[3]); *(u32x4*)(op + bj * HALF) = w; }
                asm volatile("" ::: "memory"); }
    }
};
struct EpiSwiGLU {
    static constexpr bool PERM = true, AFTER_DRAIN = false;
    typedef EpiPreS Pre; bf16_t* out; int ld; int ntile; const ssq_t* ssq; const float* srs; int row_base; bool tiled;
    __device__ __forceinline__ void pre(const Unit& u, int wr, int fr, int fq, Pre& p, PG8_LAS float*) const {
#pragma unroll
        for (int k = 0; k < 2; ++k) { const int kk = 2 * fq + k, r = u.pm * BM + wr * 64 + fr + (kk >> 2) * HALF + (kk & 3) * 16;
            if (ssq) p.q[k] = ssq[r]; else if (srs) p.f[k] = srs[row_base + r]; }
    }
    __device__ __forceinline__ void operator()(const f32x4 (&acc)[2][2][4][2], const Unit& u, int wr, int wc, int fr, int fq, const Pre& p, PG8_LAS float* xl) const {
        const int row0 = u.pm * BM + wr * 64 + fr, col0 = (u.pn % ntile) * HALF + wc * 32 + 8 * fq;
        if (ssq) share_scales(xl, fr, fq, ssq_rstd(p.q, 0), ssq_rstd(p.q, 1)); else if (srs) share_scales(xl, fr, fq, p.f[0], p.f[1]);
#pragma unroll
        for (int ai = 0; ai < 2; ++ai)
#pragma unroll
            for (int m = 0; m < 4; ++m) { const int rr_ = row0 + ai * HALF + m * 16;
                bf16_t* rowp = tiled ? out + ((size_t)(rr_ >> 8) * (ld >> 6) + (col0 >> 6)) * 16384 + (size_t)(rr_ & 255) * 64 + (col0 & 63) : out + (size_t)rr_ * ld + col0;
                const float rs = (ssq || srs) ? xl[fr * 8 + ai * 4 + m] : 1.0f;
                const f32x4 g0 = acc[ai][0][m][0] * rs, g1 = acc[ai][0][m][1] * rs, u0 = acc[ai][1][m][0] * rs, u1 = acc[ai][1][m][1] * rs;
                u32x4 w; w.x = cvt_pk_bf16(silu_fast(g0[0]) * u0[0], silu_fast(g0[1]) * u0[1]); w.y = cvt_pk_bf16(silu_fast(g0[2]) * u0[2], silu_fast(g0[3]) * u0[3]);
                w.z = cvt_pk_bf16(silu_fast(g1[0]) * u1[0], silu_fast(g1[1]) * u1[1]); w.w = cvt_pk_bf16(silu_fast(g1[2]) * u1[2], silu_fast(g1[3]) * u1[3]);
                *(u32x4*)rowp = w; }
    }
};
struct EpiPre8 { float f[2]; float sbv; };
struct EpiSwiGLU8 {
    static constexpr bool PERM = true, AFTER_DRAIN = false;
    typedef EpiPre8 Pre; bf16_t* out; int ld; int ntile; const float* sa; const float* sb; int row_base; bool tiled;
    __device__ __forceinline__ void pre(const Unit& u, int wr, int fr, int fq, Pre& p, PG8_LAS float*) const {
#pragma unroll
        for (int k = 0; k < 2; ++k) { const int kk = 2 * fq + k; p.f[k] = sa[row_base + u.pm * BM + wr * 64 + fr + (kk >> 2) * HALF + (kk & 3) * 16]; }
        int t_ = threadIdx.x; asm volatile("" : "+v"(t_));
        const int lane = fr + 16 * fq, wc = (t_ >> 6) & 3; p.sbv = sb[(size_t)u.pn * BM + (lane >> 5) * HALF + wc * 32 + (lane & 31)];
    }
    __device__ __forceinline__ void operator()(const i32x4 (&acc)[2][2][4][2], const Unit& u, int wr, int wc, int fr, int fq, const Pre& p, PG8_LAS float* xl) const {
        const int row0 = u.pm * BM + wr * 64 + fr, col0 = (u.pn % ntile) * HALF + wc * 32 + 8 * fq;
        xl[fr * 8 + 2 * fq] = p.f[0]; xl[fr * 8 + 2 * fq + 1] = p.f[1]; xl[128 + fr + 16 * fq] = p.sbv; asm volatile("s_waitcnt lgkmcnt(0)" ::: "memory");
        const f32x4 sg0 = *(const PG8_LAS f32x4*)(xl + 128 + 8 * fq), sg1 = *(const PG8_LAS f32x4*)(xl + 128 + 8 * fq + 4), su0 = *(const PG8_LAS f32x4*)(xl + 160 + 8 * fq), su1 = *(const PG8_LAS f32x4*)(xl + 160 + 8 * fq + 4);
#pragma unroll
        for (int ai = 0; ai < 2; ++ai)
#pragma unroll
            for (int m = 0; m < 4; ++m) { const int rr_ = row0 + ai * HALF + m * 16;
                const float s = xl[fr * 8 + ai * 4 + m];
                bf16_t* rowp = out + (size_t)rr_ * ld + col0;
                float g[8], uu[8];
#pragma unroll
                for (int j = 0; j < 4; ++j) { g[j] = (float)acc[ai][0][m][0][j] * s * sg0[j]; g[4 + j] = (float)acc[ai][0][m][1][j] * s * sg1[j]; uu[j] = (float)acc[ai][1][m][0][j] * s * su0[j]; uu[4 + j] = (float)acc[ai][1][m][1][j] * s * su1[j]; }
                if (tiled) {
#pragma unroll
                    for (int j = 0; j < 8; ++j) g[j] = __builtin_amdgcn_fmed3f(silu_fast(g[j]) * uu[j], -448.0f, 448.0f);
                    unsigned lo = 0u, hi = 0u; lo = __builtin_amdgcn_cvt_pk_fp8_f32(g[0], g[1], lo, false); lo = __builtin_amdgcn_cvt_pk_fp8_f32(g[2], g[3], lo, true);
                    hi = __builtin_amdgcn_cvt_pk_fp8_f32(g[4], g[5], hi, false); hi = __builtin_amdgcn_cvt_pk_fp8_f32(g[6], g[7], hi, true);
                    *(unsigned long long*)((unsigned char*)out + ((size_t)(rr_ >> 8) * (ld >> 7) + (col0 >> 7)) * 32768 + (size_t)(rr_ & 255) * 128 + (col0 & 127)) = (unsigned long long)lo | ((unsigned long long)hi << 32);
                } else {
                u32x4 w; w.x = cvt_pk_bf16(silu_fast(g[0]) * uu[0], silu_fast(g[1]) * uu[1]); w.y = cvt_pk_bf16(silu_fast(g[2]) * uu[2], silu_fast(g[3]) * uu[3]);
                w.z = cvt_pk_bf16(silu_fast(g[4]) * uu[4], silu_fast(g[5]) * uu[5]); w.w = cvt_pk_bf16(silu_fast(g[6]) * uu[6], silu_fast(g[7]) * uu[7]);
                *(u32x4*)rowp = w; } }
    }
};
struct EpiInProj8 {
    static constexpr bool PERM = true, AFTER_DRAIN = false;
    typedef EpiPre8 Pre; bf16_t* proj; const float* sa; const float* sb;
    __device__ __forceinline__ void pre(const Unit& u, int wr, int fr, int fq, Pre& p, PG8_LAS float*) const {
#pragma unroll
        for (int k = 0; k < 2; ++k) { const int kk = 2 * fq + k; p.f[k] = sa[u.pm * BM + wr * 64 + fr + (kk >> 2) * HALF + (kk & 3) * 16]; }
        int t_ = threadIdx.x; asm volatile("" : "+v"(t_));
        const int lane = fr + 16 * fq, wc = (t_ >> 6) & 3; p.sbv = sb[(size_t)u.pn * BM + (lane >> 5) * HALF + wc * 32 + (lane & 31)];
    }
    __device__ __forceinline__ void operator()(const i32x4 (&acc)[2][2][4][2], const Unit& u, int wr, int wc, int fr, int fq, const Pre& p, PG8_LAS float* xl) const {
        const int row0 = u.pm * BM + wr * 64 + fr, col0 = u.pn * BM + wc * 32 + 8 * fq;
        xl[fr * 8 + 2 * fq] = p.f[0]; xl[fr * 8 + 2 * fq + 1] = p.f[1]; xl[128 + fr + 16 * fq] = p.sbv; asm volatile("s_waitcnt lgkmcnt(0)" ::: "memory");
        f32x4 sc[2][2];
#pragma unroll
        for (int bj = 0; bj < 2; ++bj) { sc[bj][0] = *(const PG8_LAS f32x4*)(xl + 128 + 32 * bj + 8 * fq); sc[bj][1] = *(const PG8_LAS f32x4*)(xl + 128 + 32 * bj + 8 * fq + 4); }
#pragma unroll
        for (int ai = 0; ai < 2; ++ai)
#pragma unroll
            for (int m = 0; m < 4; ++m) { const int r = row0 + ai * HALF + m * 16; const float s = xl[fr * 8 + ai * 4 + m]; bf16_t* rowp = proj + (size_t)r * PW + col0;
#pragma unroll
                for (int bj = 0; bj < 2; ++bj) { const i32x4 a0 = acc[ai][bj][m][0], a1 = acc[ai][bj][m][1]; const f32x4 s0 = sc[bj][0] * s, s1 = sc[bj][1] * s;
                    u32x4 w; w.x = cvt_pk_bf16((float)a0[0] * s0[0], (float)a0[1] * s0[1]); w.y = cvt_pk_bf16((float)a0[2] * s0[2], (float)a0[3] * s0[3]);
                    w.z = cvt_pk_bf16((float)a1[0] * s1[0], (float)a1[1] * s1[1]); w.w = cvt_pk_bf16((float)a1[2] * s1[2], (float)a1[3] * s1[3]);
                    *(u32x4*)(rowp + bj * HALF) = w; } }
    }
};
struct EpiMoeDown {
    static constexpr bool PERM = true, AFTER_DRAIN = false;
    typedef EpiPreNone Pre; bf16_t* ylo; long hi_off; const int* stok; const float* sgate; int row_base; float gscale;
    __device__ __forceinline__ void pre(const Unit& u, int wr, int, int, Pre&, PG8_LAS float* xl) const {
        int t_ = threadIdx.x; asm volatile("" : "+v"(t_));
        const unsigned voff = (unsigned)(t_ & 63) * 4u; const size_t sb_ = (size_t)(row_base + u.pm * BM + wr * 64) * 4;
#pragma unroll
        for (int ai = 0; ai < 2; ++ai) { __builtin_amdgcn_global_load_lds((const unsigned*)((const char*)stok + sb_ + ai * HALF * 4 + voff), (PG8_LAS unsigned*)(xl + ai * 64), 4, 0, 0);
            __builtin_amdgcn_global_load_lds((const unsigned*)((const char*)sgate + sb_ + ai * HALF * 4 + voff), (PG8_LAS unsigned*)(xl + 128 + ai * 64), 4, 0, 0); }
    }
    __device__ __forceinline__ void operator()(const f32x4 (&acc)[2][2][4][2], const Unit& u, int wr, int wc, int fr, int fq, const Pre&, PG8_LAS float* xl) const {
        { int t_ = threadIdx.x; asm volatile("" : "+v"(t_)); fr = t_ & 15; fq = (t_ >> 4) & 3; }
        bf16_t* ylo_ = ylo; asm volatile("" : "+s"(ylo_));
        const int ct = u.pn & 3, col0 = (ct & 1) * BM + wc * 32 + 8 * fq; bf16_t* const yb = ylo_ + (long)(ct >> 1) * hi_off;
#pragma unroll
        for (int ai = 0; ai < 2; ++ai)
#pragma unroll
            for (int m = 0; m < 4; ++m) { const int tok = ((const volatile PG8_LAS int*)xl)[ai * 64 + m * 16 + fr]; const float gt = ((const volatile PG8_LAS float*)xl)[128 + ai * 64 + m * 16 + fr] * gscale;
                if (tok >= 0) { bf16_t* op = yb + (size_t)tok * 512 + col0;
#pragma unroll
                    for (int bj = 0; bj < 2; ++bj) { const f32x4 v0 = acc[ai][bj][m][0] * gt, v1 = acc[ai][bj][m][1] * gt;
                        u32x4 w; w.x = cvt_pk_bf16(v0[0], v0[1]); w.y = cvt_pk_bf16(v0[2], v0[3]); w.z = cvt_pk_bf16(v1[0], v1[1]); w.w = cvt_pk_bf16(v1[2], v1[3]); *(u32x4*)(op + bj * HALF) = w; }
                } }
    }
};
struct MoeOrder {
    static constexpr int SKIP = 3; int t0, nT, nN, G, c, nx; const PG8_LAS int* tile_expert; const int* ridx; int row_base; const int* ridxp = nullptr;
    __device__ __forceinline__ bool next(int i, Unit& u) const {
        const int r = i + (c < nx ? SKIP : 0);
        const int L = r < SKIP ? r * (G - nx) + (c - nx) : SKIP * (G - nx) + (r - SKIP) * G + c;
        if (L >= nT * nN) return false;
        const int tl = L / nN, j = L % nN; u.pm = tl; u.pn = tile_expert[tl] * nN + j; return true;
    }
    __device__ __forceinline__ void a_ready(const Unit&) const {}
    __device__ __forceinline__ void done(const Unit&) const {}
};
}

namespace attn_body {
using bf16=unsigned short;
using bf16x8=__attribute__((ext_vector_type(8)))short;
using s16x4=__attribute__((ext_vector_type(4)))short;
using f32x16=__attribute__((ext_vector_type(16)))float;
using u32x4=__attribute__((ext_vector_type(4)))unsigned;
constexpr int D=64,DM=PW;
constexpr int NW=8,QBLK=32,KVBLK=64;
__device__ __forceinline__ int crow(int r,int hi){return (r&3)+8*(r>>2)+4*hi;}
#define SBAR() __builtin_amdgcn_sched_barrier(0)
__device__ __forceinline__ void meta_mask(f32x16&p0,f32x16&p1){
  const float NEG=-INFINITY;
  #pragma unroll
  for(int r=8;r<16;++r)p0[r]=NEG;
  #pragma unroll
  for(int r=0;r<16;++r)p1[r]=NEG;
}
__device__ __forceinline__ void swa_mask(f32x16&p0,f32x16&p1,int rel0,int lo,int hi_,bool metatile,bool dead,const __attribute__((address_space(3))) float*bt,float mh){
  const float NEG=-INFINITY;
  if(dead){
    #pragma unroll
    for(int r=0;r<16;++r){p0[r]=NEG;p1[r]=NEG;}
  } else {
    #pragma unroll
    for(int r4=0;r4<4;++r4){
      #pragma unroll
      for(int half=0;half<2;++half){
        #pragma unroll
        for(int j=0;j<4;++j){
          const int r=4*r4+j, rel=rel0+(j+8*r4+32*half);
          const int idx=rel>hi_?hi_:(rel<lo?lo:rel);
          const float bv=bt[idx+129]-mh;
          if(half==0)p0[r]+=bv; else p1[r]+=bv; } }
      __builtin_amdgcn_sched_barrier(0); }
    if(metatile){
      #pragma unroll
      for(int r=8;r<16;++r)p0[r]=NEG;
      #pragma unroll
      for(int r=0;r<16;++r)p1[r]=NEG; }
  }
}

constexpr int NSLOT=3, SLOTB=8192;
constexpr int LDS_K=0, LDS_V=NSLOT*SLOTB, LDS_WS=2*NSLOT*SLOTB, LDS_OST=LDS_WS+NW*64*4, LDS_BYTES=LDS_OST+NW*4096;
constexpr float C2=0.125f*1.4426950408889634f;
__device__ __forceinline__ void glds16(const void*gsrc,unsigned lds_dst){unsigned keep;
  asm volatile("s_mov_b32 %0, m0\n\ts_mov_b32 m0, %2\n\ts_nop 0\n\tglobal_load_lds_dwordx4 %1, off\n\ts_mov_b32 m0, %0":"=&s"(keep):"v"(gsrc),"s"(lds_dst):"memory");}
__device__ __forceinline__ float max3f(float a,float b,float c){float r;asm("v_max3_f32 %0, %1, %2, %3":"=v"(r):"v"(a),"v"(b),"v"(c));return r;}
__device__ __forceinline__ float max2f(float a,float b){float r;asm("v_max_f32_e32 %0, %1, %2":"=v"(r):"v"(a),"v"(b));return r;}
__device__ __forceinline__ float fadd_s(float a,float b){float r;asm("v_add_f32_e32 %0, %1, %2":"=v"(r):"v"(a),"v"(b));return r;}
__device__ __forceinline__ float fsub_s(float a,float b){float r;asm("v_sub_f32_e32 %0, %1, %2":"=v"(r):"v"(a),"v"(b));return r;}
typedef float f32x2_t __attribute__((ext_vector_type(2))); typedef __bf16 bf16x2_t __attribute__((ext_vector_type(2)));
__device__ __forceinline__ unsigned cvtpk_s(float lo,float hi){f32x2_t v={lo,hi};bf16x2_t b=__builtin_convertvector(v,bf16x2_t);return __builtin_bit_cast(unsigned,b);}
#define WAIT_BAR(N) asm volatile("s_waitcnt vmcnt(" #N ") lgkmcnt(0)\n\ts_barrier":::"memory")

__device__ __forceinline__ void qkt(f32x16&p0,f32x16&p1,const char*Kslot,const bf16x8*qr,const f32x16&negm,int r32,int hi){
  const char*kb=Kslot+hi*1024+r32*16;
  #pragma unroll
  for(int d0=0;d0<4;++d0){
    const bf16x8 b0=*reinterpret_cast<const bf16x8*>(kb+d0*2048);
    const bf16x8 b1=*reinterpret_cast<const bf16x8*>(kb+d0*2048+512);
    if(d0==0){p0=__builtin_amdgcn_mfma_f32_32x32x16_bf16(b0,qr[0],negm,0,0,0);p1=__builtin_amdgcn_mfma_f32_32x32x16_bf16(b1,qr[0],negm,0,0,0);}
    else{p0=__builtin_amdgcn_mfma_f32_32x32x16_bf16(b0,qr[d0],p0,0,0,0);p1=__builtin_amdgcn_mfma_f32_32x32x16_bf16(b1,qr[d0],p1,0,0,0);}}
}
typedef __attribute__((address_space(3))) const char* lds_cptr;
typedef short v4i16_t __attribute__((ext_vector_type(4)));
__device__ __forceinline__ void kload8(bf16x8*kf,lds_cptr kp){
  kf[0]=*(const __attribute__((address_space(3))) bf16x8*)(kp);      kf[1]=*(const __attribute__((address_space(3))) bf16x8*)(kp+512);
  kf[2]=*(const __attribute__((address_space(3))) bf16x8*)(kp+2048); kf[3]=*(const __attribute__((address_space(3))) bf16x8*)(kp+2560);
  kf[4]=*(const __attribute__((address_space(3))) bf16x8*)(kp+4096); kf[5]=*(const __attribute__((address_space(3))) bf16x8*)(kp+4608);
  kf[6]=*(const __attribute__((address_space(3))) bf16x8*)(kp+6144); kf[7]=*(const __attribute__((address_space(3))) bf16x8*)(kp+6656);
}
__device__ __forceinline__ void kload2(bf16x8*kf,lds_cptr kp,int j){ kf[2*j]=*(const __attribute__((address_space(3))) bf16x8*)(kp+j*2048); kf[2*j+1]=*(const __attribute__((address_space(3))) bf16x8*)(kp+j*2048+512); }
__device__ __forceinline__ s16x4 vtr(lds_cptr p){ return __builtin_bit_cast(s16x4,__builtin_amdgcn_ds_read_tr16_b64_v4i16((__attribute__((address_space(3))) v4i16_t*)p)); }
__device__ __forceinline__ float rowmax(const f32x16&p0,const f32x16&p1){
  float a=max3f(p0[0],p0[1],p1[0]),b=max3f(p0[2],p0[3],p1[1]);a=max3f(a,p1[2],p1[3]);
  #pragma unroll
  for(int r=4;r<16;r+=4){a=max3f(a,p0[r],p0[r+1]);b=max3f(b,p0[r+2],p0[r+3]);a=max3f(a,p1[r],p1[r+1]);b=max3f(b,p1[r+2],p1[r+3]);}
  const float m=max2f(a,b);
  auto rr=__builtin_amdgcn_permlane32_swap(__float_as_uint(m),__float_as_uint(m),false,false);
  return max2f(__uint_as_float(rr[0]),__uint_as_float(rr[1]));
}
__device__ __forceinline__ void pv(f32x16*o,int vb,bf16x8 pa0,bf16x8 pa1,bf16x8 pa2,bf16x8 pa3){
  #pragma unroll
  for(int d0=0;d0<2;++d0){s16x4 lo[4],hi[4];
    #pragma unroll
    for(int ks=0;ks<4;++ks){
      asm volatile("ds_read_b64_tr_b16 %0,%1 offset:%c2":"=&v"(lo[ks]):"v"(vb),"i"(d0*4096+ks*1024):"memory");
      asm volatile("ds_read_b64_tr_b16 %0,%1 offset:%c2":"=&v"(hi[ks]):"v"(vb),"i"(d0*4096+ks*1024+512):"memory");}
    asm volatile("s_waitcnt lgkmcnt(0)":::"memory");SBAR();
    #define PK(k) (bf16x8){lo[k][0],lo[k][1],lo[k][2],lo[k][3],hi[k][0],hi[k][1],hi[k][2],hi[k][3]}
    o[d0]=__builtin_amdgcn_mfma_f32_32x32x16_bf16(pa0,PK(0),o[d0],0,0,0);
    o[d0]=__builtin_amdgcn_mfma_f32_32x32x16_bf16(pa1,PK(1),o[d0],0,0,0);
    o[d0]=__builtin_amdgcn_mfma_f32_32x32x16_bf16(pa2,PK(2),o[d0],0,0,0);
    o[d0]=__builtin_amdgcn_mfma_f32_32x32x16_bf16(pa3,PK(3),o[d0],0,0,0);
    #undef PK
  }
}

__device__ __forceinline__ int swa_off(int j){ return j<2 ? 64*j : (j<4 ? 64*j-256 : 64*j-128); }
__device__ __forceinline__ int swa_clamp(int s){ return s<0?0:(s>S_-KVBLK?S_-KVBLK:s); }
#ifndef ATTN_STORE16
#define ATTN_STORE16(p,v) (*(u32x4*)(p)=(v))
#endif
template<int THRL,bool SWA> __device__ __forceinline__ void attn_unit(int b,int qb,const bf16*Qc,const bf16*__restrict__ Kc,const bf16*__restrict__ Vc,bf16*Oc,char*shm,const __attribute__((address_space(3))) float*btab,int g){
  int nt_ = SWA ? 7 : S_/KVBLK+1; asm volatile("":"+s"(nt_)); const int NT=nt_;
  int tid=threadIdx.x; asm volatile("":"+v"(tid));
  const int lane=tid&63,r32=lane&31,hi=lane>>5; const int wid=__builtin_amdgcn_readfirstlane(tid>>6);
  const bool meta=qb<0; const int hh=wid&1, blk=wid>>1;
  const int qrow0= meta ? NREG+b*NM : b*S_+128*qb+32*blk;
  const int tq= meta ? r32 : NM+128*qb+32*blk+r32;
  const int T0s= meta ? 0 : 128*qb;
  const bf16*Qw=Qc+(long)qrow0*DM+hh*D;
  #define TROW(t) ( SWA ? ((t)==NT-1 ? NREG+b*NM : b*S_+swa_clamp(T0s+swa_off(t))) : ((t)<NT-1 ? b*S_+KVBLK*(t) : NREG+b*NM) )
  const unsigned lds0=(unsigned)(uintptr_t)shm;
  float*wsf=(float*)(shm+LDS_WS)+wid*64;
  const bf16*ksrc=Kc+(long)lane*DM+wid*8;
  const bf16*vsrc=Vc+(long)(16*(wid&3)+(lane>>2))*DM+(wid>>2)*32+(lane&3)*8;
  const unsigned kdst=lds0+LDS_K+wid*1024, vdst=lds0+LDS_V+wid*1024;
  #define DMA_K(t,slot) glds16(ksrc+(long)TROW(t)*DM,(unsigned)__builtin_amdgcn_readfirstlane(kdst+(slot)))
  #define DMA_V(t,slot) glds16(vsrc+(long)TROW(t)*DM,(unsigned)__builtin_amdgcn_readfirstlane(vdst+(slot)))
  const int vb0=(int)(lds0+LDS_V)+((lane>>4)&1)*32+(lane&3)*8+(4*hi+((lane&15)>>2))*64;
  const char*Kbase=shm+LDS_K; bf16x8 kf[8];
  const lds_cptr shm3=(lds_cptr)shm; const lds_cptr kp0=shm3+LDS_K+hi*1024+r32*16; const lds_cptr vp0=shm3+LDS_V+((lane>>4)&1)*32+(lane&3)*8+(4*hi+((lane&15)>>2))*64;
  DMA_K(0,0);DMA_V(0,0);DMA_K(1,SLOTB);
  bf16x8 qr[4];
  #pragma unroll
  for(int d0=0;d0<4;++d0)qr[d0]=*reinterpret_cast<const bf16x8*>(&Qw[(long)r32*DM+d0*16+hi*8]);
  #define NEGC (SWA ? f32x16{} : negm)
  float mhat=0.f,l_reg=0.f;f32x16 o[2];o[0]=f32x16{};o[1]=f32x16{};f32x16 negm=f32x16{};if constexpr(!SWA){asm volatile("":"+v"(negm));}
  const __attribute__((address_space(3))) float*bt=btab+(2*g+hh)*264; const int relq=4*hi-tq;
  #define CMASK(P0,P1,t) do{ if constexpr(SWA){ swa_mask(P0,P1,((t)==NT-1?0:NM+T0s+swa_off(t))+relq,(t)==NT-1?-128:-129,(t)==NT-1?128:129,(t)==NT-1,(t)!=NT-1&&((T0s+swa_off(t))<0||(T0s+swa_off(t))>=S_),bt,mhat); } else { if((t)==NT-1)meta_mask(P0,P1); } }while(0)
  bool resc=false;
  #define START(P0,P1) do{ const float rm=rowmax(P0,P1); resc=false; \
    { const float dl=rm; mhat=fadd_s(mhat,dl); \
      _Pragma("unroll") for(int r=0;r<16;++r){P0[r]=fsub_s(P0[r],dl);P1[r]=fsub_s(P1[r],dl);} \
      _Pragma("unroll") for(int r=0;r<16;++r)negm[r]=-mhat; if constexpr(!SWA){asm volatile("":"+v"(negm));} } \
    _Pragma("unroll") for(int r=0;r<16;++r)P0[r]=__builtin_amdgcn_exp2f(P0[r]); }while(0)
  #define RESC() do{ if(resc){ asm volatile("s_waitcnt lgkmcnt(0)":::"memory"); \
      _Pragma("unroll") for(int d_=0;d_<2;++d_) _Pragma("unroll") for(int r=0;r<16;++r)o[d_][r]*=wsf[crow(r,hi)]; } }while(0)
  f32x16 pA0,pA1,pB0,pB1;
  int sl_prev=0,sl_cur=0,sl_next=SLOTB;
  #define ROT() do{sl_prev=sl_cur;sl_cur=sl_next;sl_next=(sl_next==(NSLOT-1)*SLOTB)?0:sl_next+SLOTB;}while(0)
  DMA_K(2,2*SLOTB);
  WAIT_BAR(3);
  qkt(pA0,pA1,Kbase,qr,NEGC,r32,hi);asm volatile("s_nop 15\n\ts_nop 7":"+v"(pA0),"+v"(pA1));CMASK(pA0,pA1,0);
  START(pA0,pA1);
  _Pragma("unroll") for(int r=0;r<16;++r)pA1[r]=__builtin_amdgcn_exp2f(pA1[r]);
  WAIT_BAR(0);
  DMA_K(3,0);DMA_V(1,SLOTB);
  ROT();
  kload8(kf,kp0+sl_cur);
  WAIT_BAR(2);
  s16x4 vlo[8],vhi[8]; u32x4 pw0,pw1,pw2,pw3;
  #define PKW(P,B) cvtpk_s(P[B],P[B+1])
  #define PAF(k) __builtin_bit_cast(bf16x8,pw##k)
  #define VFR(i) (bf16x8){vlo[i][0],vlo[i][1],vlo[i][2],vlo[i][3],vhi[i][0],vhi[i][1],vhi[i][2],vhi[i][3]}
  #define PIN(x) asm volatile("":"+v"(x))
  #define MX3(a,b,c) __builtin_fmaxf(__builtin_fmaxf((a),(b)),(c))
  #define GAPA(MF,A0,A1,A2,A3,W0,W1,PW) do{ MF; sacc+=A0; sacc+=A1; sacc+=A2; sacc+=A3; PIN(sacc); W0; W1; PIN(PW); SBAR(); }while(0)
  #define EX(v) __builtin_amdgcn_exp2f(v)
  #define GAPB(MF,X,B) do{ MF; X[B]=EX(X[B]); X[B+1]=EX(X[B+1]); X[B+2]=EX(X[B+2]); X[B+3]=EX(X[B+3]); PIN(X); SBAR(); }while(0)
  #define VRD(i) do{ vlo[i]=vtr(vp_+(((i)>>2)*4096+((i)&3)*1024)); vhi[i]=vtr(vp_+(((i)>>2)*4096+((i)&3)*1024+512)); }while(0)
  #define KRD(G,j) do{ if(G){ kload2(kf,kp0+sl_next,j); SBAR(); } }while(0)
  #define STEP(C0,C1,P0,P1,t,GK,GV,GL) do{ SBAR(); \
    const lds_cptr vp_=vp0+sl_prev; \
    VRD(0); SBAR(); float sacc=(P0[0]+P0[1]); \
    GAPA(C0=__builtin_amdgcn_mfma_f32_32x32x16_bf16(kf[0],qr[0],NEGC,0,0,0), P0[2],P0[3],P0[4],P0[5],     pw0[0]=PKW(P0,0), pw0[1]=PKW(P0,2), pw0); \
    VRD(4); SBAR(); GAPA(C1=__builtin_amdgcn_mfma_f32_32x32x16_bf16(kf[1],qr[0],NEGC,0,0,0), P0[6],P0[7],P0[8],P0[9],     pw0[2]=PKW(P0,4), pw0[3]=PKW(P0,6), pw0); \
    VRD(1); SBAR(); GAPA(C0=__builtin_amdgcn_mfma_f32_32x32x16_bf16(kf[2],qr[1],C0,0,0,0),   P0[10],P0[11],P0[12],P0[13], pw1[0]=PKW(P0,8), pw1[1]=PKW(P0,10), pw1); \
    VRD(5); SBAR(); GAPA(C1=__builtin_amdgcn_mfma_f32_32x32x16_bf16(kf[3],qr[1],C1,0,0,0),   P0[14],P0[15],P1[0],P1[1],   pw1[2]=PKW(P0,12),pw1[3]=PKW(P0,14), pw1); \
    VRD(2); SBAR(); GAPA(C0=__builtin_amdgcn_mfma_f32_32x32x16_bf16(kf[4],qr[2],C0,0,0,0),   P1[2],P1[3],P1[4],P1[5],     pw2[0]=PKW(P1,0), pw2[1]=PKW(P1,2), pw2); \
    VRD(6); SBAR(); GAPA(C1=__builtin_amdgcn_mfma_f32_32x32x16_bf16(kf[5],qr[2],C1,0,0,0),   P1[6],P1[7],P1[8],P1[9],     pw2[2]=PKW(P1,4), pw2[3]=PKW(P1,6), pw2); \
    VRD(3); SBAR(); GAPA(C0=__builtin_amdgcn_mfma_f32_32x32x16_bf16(kf[6],qr[3],C0,0,0,0),   P1[10],P1[11],P1[12],P1[13], pw3[0]=PKW(P1,8), pw3[1]=PKW(P1,10), pw3); \
    VRD(7); SBAR(); GAPA(C1=__builtin_amdgcn_mfma_f32_32x32x16_bf16(kf[7],qr[3],C1,0,0,0),   P1[14],P1[15],0.f,0.f,       pw3[2]=PKW(P1,12),pw3[3]=PKW(P1,14), pw3); \
    l_reg+=sacc; \
    if(GK){DMA_K((t)+3,sl_cur);} if(GV){DMA_V((t)+1,sl_next);} \
    CMASK(C0,C1,t); \
    { float a=MX3(C0[0],C0[1],C1[0]),b=MX3(C0[2],C0[3],C1[1]); a=MX3(a,C1[2],C1[3]); \
      _Pragma("unroll") for(int r=4;r<16;r+=4){a=MX3(a,C0[r],C0[r+1]);b=MX3(b,C0[r+2],C0[r+3]);a=MX3(a,C1[r],C1[r+1]);b=MX3(b,C1[r+2],C1[r+3]);} \
      float rm=__builtin_fmaxf(a,b); { auto rr=__builtin_amdgcn_permlane32_swap(__float_as_uint(rm),__float_as_uint(rm),false,false); rm=__builtin_fmaxf(__uint_as_float(rr[0]),__uint_as_float(rr[1])); } \
      resc=false; \
      if(__builtin_expect(__any(rm>(float)THRL),0)){ const float dl=__builtin_fmaxf(rm,0.f); mhat+=dl; \
        _Pragma("unroll") for(int r=0;r<16;++r){C0[r]-=dl;C1[r]-=dl;} \
        _Pragma("unroll") for(int r=0;r<16;++r)negm[r]=-mhat; if constexpr(!SWA){asm volatile("":"+v"(negm));} \
        const float f=__builtin_amdgcn_exp2f(-dl); l_reg*=f; if(hi==0)wsf[r32]=f; resc=true; } } \
    SBAR(); \
    GAPB(o[0]=__builtin_amdgcn_mfma_f32_32x32x16_bf16(PAF(0),VFR(0),o[0],0,0,0), C0,0); \
    GAPB(o[1]=__builtin_amdgcn_mfma_f32_32x32x16_bf16(PAF(0),VFR(4),o[1],0,0,0), C0,4); \
    KRD(GL,0); GAPB(o[0]=__builtin_amdgcn_mfma_f32_32x32x16_bf16(PAF(1),VFR(1),o[0],0,0,0), C0,8); \
    KRD(GL,1); GAPB(o[1]=__builtin_amdgcn_mfma_f32_32x32x16_bf16(PAF(1),VFR(5),o[1],0,0,0), C0,12); \
    KRD(GL,2); GAPB(o[0]=__builtin_amdgcn_mfma_f32_32x32x16_bf16(PAF(2),VFR(2),o[0],0,0,0), C1,0); \
    KRD(GL,3); GAPB(o[1]=__builtin_amdgcn_mfma_f32_32x32x16_bf16(PAF(2),VFR(6),o[1],0,0,0), C1,4); \
    GAPB(o[0]=__builtin_amdgcn_mfma_f32_32x32x16_bf16(PAF(3),VFR(3),o[0],0,0,0), C1,8); \
    GAPB(o[1]=__builtin_amdgcn_mfma_f32_32x32x16_bf16(PAF(3),VFR(7),o[1],0,0,0), C1,12); \
    }while(0)
  int t=1;
  #undef CMASK
  #define CMASK(P0,P1,t) do{ if constexpr(SWA){ swa_mask(P0,P1,((t)==NT-1?0:NM+T0s+swa_off(t))+relq,(t)==NT-1?-128:-129,(t)==NT-1?128:129,(t)==NT-1,(t)!=NT-1&&((T0s+swa_off(t))<0||(T0s+swa_off(t))>=S_),bt,mhat); } }while(0)
  for(;t+5<NT;t+=2){
    STEP(pB0,pB1,pA0,pA1,t,true,true,true);     WAIT_BAR(2); RESC(); ROT();
    STEP(pA0,pA1,pB0,pB1,t+1,true,true,true);   WAIT_BAR(2); RESC(); ROT();
  }
  #undef CMASK
  #define CMASK(P0,P1,t) do{ if constexpr(SWA){ swa_mask(P0,P1,((t)==NT-1?0:NM+T0s+swa_off(t))+relq,(t)==NT-1?-128:-129,(t)==NT-1?128:129,(t)==NT-1,(t)!=NT-1&&((T0s+swa_off(t))<0||(T0s+swa_off(t))>=S_),bt,mhat); } else { if((t)==NT-1)meta_mask(P0,P1); } }while(0)
  #define ENDW(tt) do{ if((tt)+3<NT){WAIT_BAR(2);} else if((tt)+2<NT){WAIT_BAR(1);} else {WAIT_BAR(0);} }while(0)
  for(;t+2<NT;t+=2){
    STEP(pB0,pB1,pA0,pA1,t,(t+3<NT),(t+1<NT),(t+1<NT));       ENDW(t);   RESC(); ROT();
    STEP(pA0,pA1,pB0,pB1,t+1,(t+4<NT),(t+2<NT),(t+2<NT));     ENDW(t+1); RESC(); ROT();
  }
  STEP(pB0,pB1,pA0,pA1,NT-2,false,true,true); WAIT_BAR(0); RESC(); ROT();
  STEP(pA0,pA1,pB0,pB1,NT-1,false,false,false); RESC();
  { float sacc=pA0[0]+pA0[1]; _Pragma("unroll") for(int r=2;r<16;++r)sacc+=pA0[r]; _Pragma("unroll") for(int r=0;r<16;++r)sacc+=pA1[r]; l_reg+=sacc;
    pw0=(u32x4){PKW(pA0,0),PKW(pA0,2),PKW(pA0,4),PKW(pA0,6)};pw1=(u32x4){PKW(pA0,8),PKW(pA0,10),PKW(pA0,12),PKW(pA0,14)};pw2=(u32x4){PKW(pA1,0),PKW(pA1,2),PKW(pA1,4),PKW(pA1,6)};pw3=(u32x4){PKW(pA1,8),PKW(pA1,10),PKW(pA1,12),PKW(pA1,14)};
    SBAR(); pv(o,vb0+sl_cur,PAF(0),PAF(1),PAF(2),PAF(3)); }
  #undef PKW
  #undef PAF
  #undef VFR
  #undef PIN
  #undef MX3
  #undef GAPA
  #undef GAPB
  #undef EX
  #undef VRD
  #undef KRD
  #undef STEP
  #undef ENDW
  {auto rr=__builtin_amdgcn_permlane32_swap(__float_as_uint(l_reg),__float_as_uint(l_reg),false,false);l_reg=__uint_as_float(rr[0])+__uint_as_float(rr[1]);}
  if constexpr(SWA){ l_reg+=__builtin_amdgcn_exp2f(btab[4*264+2*g+hh]-mhat); }
  int lane_e=threadIdx.x&63; asm volatile("":"+v"(lane_e)); const int r32e=lane_e&31,hie=lane_e>>5;
  if(hie==0)wsf[32+r32e]=l_reg;asm volatile("s_waitcnt lgkmcnt(0)":::"memory");
  float rli[16];
  #pragma unroll
  for(int r=0;r<16;++r)rli[r]=__builtin_amdgcn_rcpf(wsf[32+crow(r,hie)]);
  bf16*Ow=Oc+(long)qrow0*1024+hh*D;
  { bf16*stg=(bf16*)(shm+LDS_OST)+wid*2048;
    #pragma unroll
    for(int r=0;r<16;++r){const int orow=crow(r,hie);
      #pragma unroll
      for(int d0=0;d0<2;++d0)stg[orow*64+d0*32+r32e]=(bf16)(cvtpk_s(o[d0][r]*rli[r],0.f)&0xffffu);}
    asm volatile("s_waitcnt lgkmcnt(0)":::"memory");
    #pragma unroll
    for(int i=0;i<4;++i){const int row=i*8+(lane_e>>3),ch=lane_e&7; const u32x4 v=*(const u32x4*)(stg+row*64+ch*8); if(!meta||(blk==0&&row<NM))ATTN_STORE16(Ow+(long)row*1024+ch*8,v);} }
  asm volatile("s_waitcnt lgkmcnt(0)\n\ts_barrier":::"memory");
  #undef DMA_K
  #undef DMA_V
  #undef TROW
  #undef NEGC
  #undef CMASK
  #undef START
  #undef RESC
  #undef ROT
}
constexpr int ATTN_LDS_BYTES=LDS_BYTES;
#undef SBAR
#undef WAIT_BAR
}

#define GAS __attribute__((address_space(1)))
#define LAS __attribute__((address_space(3)))
typedef unsigned short bf16;
typedef unsigned v4u __attribute__((ext_vector_type(4)));
typedef float f32x4 __attribute__((ext_vector_type(4)));
typedef short bf16x8 __attribute__((ext_vector_type(8)));
typedef GAS unsigned gu32;
typedef GAS unsigned long long gu64;
#define RLX_AGENT __ATOMIC_RELAXED, __HIP_MEMORY_SCOPE_AGENT
#define LDS_WAIT() asm volatile("s_waitcnt lgkmcnt(0)" ::: "memory")
#define VM_WAIT() asm volatile("s_waitcnt vmcnt(0)" ::: "memory")
__device__ __forceinline__ unsigned long long rt() { return __builtin_amdgcn_s_memrealtime(); }
__device__ __forceinline__ unsigned pk2(float lo, float hi) { return (unsigned)f2bf(lo) | ((unsigned)f2bf(hi) << 16); }

#define XB_TMO      128
#define XB_XCNT(j)  (256  + 64 * (j))
#define XB_XSUB(j)  (1280 + 64 * (j))
#define XB_XGEN(j)  (2304 + 64 * (j))
#define XB_TOP      3328
#define XB_TOPGEN   3392
#define XCD_BAR_WORDS 3456
#define XB_SPIN_CAP (1u << 22)

__device__ __forceinline__ unsigned xb_ld(unsigned* p)              { return __hip_atomic_load(p, __ATOMIC_RELAXED, __HIP_MEMORY_SCOPE_AGENT); }
__device__ __forceinline__ unsigned xb_add(unsigned* p, unsigned v) { return __hip_atomic_fetch_add(p, v, __ATOMIC_RELAXED, __HIP_MEMORY_SCOPE_AGENT); }
__device__ __forceinline__ unsigned xb_xcc_id() { return (unsigned)__builtin_amdgcn_s_getreg((3 << 11) | 20) & 0xFu; }
#define XB_SPIN(cond, bar) do { unsigned _sp = 0; while (cond) { __builtin_amdgcn_s_sleep(1); \
    if ((++_sp & 255u) == 0u) { if (xb_ld(&(bar)[XB_TMO])) break; if (_sp > XB_SPIN_CAP) { atomicAdd(&(bar)[XB_TMO], 1u); break; } } } } while (0)

struct XcdBarrier {
    unsigned* bar; unsigned x;
    volatile LAS unsigned* st;
};

__device__ __forceinline__ XcdBarrier xcd_barrier_post(unsigned* bar, volatile LAS unsigned* st) {
    XcdBarrier b; b.bar = bar; b.x = xb_xcc_id(); b.st = st;
    if (threadIdx.x == 0) (void)xb_add(&bar[XB_XCNT(b.x)], 1u);
    return b;
}
__device__ __forceinline__ void xcd_barrier_complete(unsigned* bar, unsigned x, unsigned& nloc, unsigned& nx) {
    const unsigned G = gridDim.x * gridDim.y * gridDim.z;
    unsigned sum, cnt, mine, sp = 0u;
    for (;;) {
        sum = 0u; cnt = 0u; mine = 0u;
#pragma unroll
        for (unsigned j = 0; j < 16; ++j) { const unsigned c = xb_ld(&bar[XB_XCNT(j)]); sum += c; cnt += (c > 0u) ? 1u : 0u; mine = (j == x) ? c : mine; }
        if (sum == G) break;
        __builtin_amdgcn_s_sleep(1);
        if ((++sp & 255u) == 0u) { if (xb_ld(&bar[XB_TMO])) break; if (sp > XB_SPIN_CAP) { atomicAdd(&bar[XB_TMO], 1u); break; } }
    }
    nloc = mine > 0u ? mine : 1u; nx = cnt > 0u ? cnt : 1u;
}

__device__ __forceinline__ void xcd_barrier(const XcdBarrier& b) {
    asm volatile("s_waitcnt vmcnt(0)" ::: "memory");
    __syncthreads();
    if (threadIdx.x == 0) {
        unsigned* bar = b.bar;
        __builtin_amdgcn_s_waitcnt(0);
        unsigned nloc = b.st[0], nx = b.st[1];
        if (nloc == 0u) { xcd_barrier_complete(bar, b.x, nloc, nx); b.st[0] = nloc; b.st[1] = nx; }
        const unsigned old = xb_add(&bar[XB_XSUB(b.x)], 1u);
        const unsigned gen = old / nloc;
        if (old + 1u == (gen + 1u) * nloc) {
            __builtin_amdgcn_fence(__ATOMIC_RELEASE, "agent");
            asm volatile("s_waitcnt vmcnt(0)" ::: "memory");
            const unsigned og = xb_add(&bar[XB_TOP], 1u);
            const unsigned tg = og / nx;
            if (og + 1u == (tg + 1u) * nx) xb_add(&bar[XB_TOPGEN], 1u);
            else XB_SPIN(xb_ld(&bar[XB_TOPGEN]) == tg, bar);
            __builtin_amdgcn_fence(__ATOMIC_ACQUIRE, "agent");
            xb_add(&bar[XB_XGEN(b.x)], 1u);
            asm volatile("s_waitcnt vmcnt(0)" ::: "memory");
        } else {
            XB_SPIN(xb_ld(&bar[XB_XGEN(b.x)]) == gen, bar);
            __builtin_amdgcn_fence(__ATOMIC_ACQUIRE, "agent");
            asm volatile("s_waitcnt vmcnt(0)" ::: "memory");
        }
    }
    __syncthreads();
}

__device__ __forceinline__ void xcd_barrier_lean(const XcdBarrier& b) {
    asm volatile("s_waitcnt vmcnt(0)" ::: "memory");
    __syncthreads();
    if (threadIdx.x == 0) {
        unsigned* bar = b.bar; unsigned bx = b.x; asm volatile("" : "+s"(bar), "+s"(bx));
        __builtin_amdgcn_s_waitcnt(0);
        unsigned nloc = b.st[0], nx = b.st[1];
        const unsigned old = xb_add(&bar[XB_XSUB(bx)], 1u);
        const unsigned gen = old / nloc;
        if (old + 1u == (gen + 1u) * nloc) {
            __builtin_amdgcn_fence(__ATOMIC_RELEASE, "agent");
            asm volatile("s_waitcnt vmcnt(0)" ::: "memory");
            const unsigned og = xb_add(&bar[XB_TOP], 1u);
            const unsigned tg = og / nx;
            if (og + 1u == (tg + 1u) * nx) xb_add(&bar[XB_TOPGEN], 1u);
            else XB_SPIN(xb_ld(&bar[XB_TOPGEN]) == tg, bar);
            __builtin_amdgcn_fence(__ATOMIC_ACQUIRE, "agent");
            xb_add(&bar[XB_XGEN(bx)], 1u);
            asm volatile("s_waitcnt vmcnt(0)" ::: "memory");
        } else {
            XB_SPIN(xb_ld(&bar[XB_XGEN(bx)]) == gen, bar);
            __builtin_amdgcn_fence(__ATOMIC_ACQUIRE, "agent");
            asm volatile("s_waitcnt vmcnt(0)" ::: "memory");
        }
    }
    __syncthreads();
}

namespace mix {
typedef short bf16x8 __attribute__((ext_vector_type(8)));
typedef short s16x4 __attribute__((ext_vector_type(4)));
typedef float f32x4 __attribute__((ext_vector_type(4)));
typedef unsigned u32x4 __attribute__((ext_vector_type(4)));
typedef unsigned u32x2 __attribute__((ext_vector_type(2)));
typedef __attribute__((address_space(3))) const char* lcp;
typedef __attribute__((address_space(3))) char* lp;
#define MFMA16(a, b, c) __builtin_amdgcn_mfma_f32_16x16x32_bf16((a), (b), (c), 0, 0, 0)
__device__ __forceinline__ bf16x8 frag_row(lcp tile, int P, int row0, int k0, int fr, int quad) { return *(const __attribute__((address_space(3))) bf16x8*)(tile + (row0 + fr) * P + (k0 + 8 * quad) * 2); }
__device__ __forceinline__ bf16x8 frag_tr(lcp tile, int P, int k0, int col0, int fr, int quad) {
    typedef short v4i16_t __attribute__((ext_vector_type(4)));
    lcp a = tile + (k0 + 8 * quad + (fr >> 2)) * P + (col0 + 4 * (fr & 3)) * 2;
    const s16x4 lo = __builtin_bit_cast(s16x4, __builtin_amdgcn_ds_read_tr16_b64_v4i16((__attribute__((address_space(3))) v4i16_t*)a));
    const s16x4 hi = __builtin_bit_cast(s16x4, __builtin_amdgcn_ds_read_tr16_b64_v4i16((__attribute__((address_space(3))) v4i16_t*)(a + 4 * P)));
    return (bf16x8){lo[0], lo[1], lo[2], lo[3], hi[0], hi[1], hi[2], hi[3]};
}
__device__ __forceinline__ unsigned pkbf(float lo, float hi) { typedef float f2 __attribute__((ext_vector_type(2))); typedef __bf16 b2 __attribute__((ext_vector_type(2))); f2 v = {lo, hi}; return __builtin_bit_cast(unsigned, __builtin_convertvector(v, b2)); }
__device__ __forceinline__ float softplus_fast(float x) { return x > 20.f ? x : 0.6931471805599453f * __builtin_amdgcn_logf(1.0f + __builtin_amdgcn_exp2f(x * 1.4426950408889634f)); }
__device__ __forceinline__ float logsigmoid_fast(float x) { return x < -20.f ? x : -0.6931471805599453f * __builtin_amdgcn_logf(1.0f + __builtin_amdgcn_exp2f(-x * 1.4426950408889634f)); }
__device__ __forceinline__ float bflo(unsigned u) { return __uint_as_float(u << 16); }
__device__ __forceinline__ float bfhi(unsigned u) { return __uint_as_float(u & 0xffff0000u); }

constexpr int SSD_CT = 0, SSD_BT = 34816, SSD_XD = 69632, SSD_XW = 88064, SSD_SB = 106496, SSD_ACS = 123904, SSD_DTL = 124416, SSD_LDS = 124928;
__device__ __forceinline__ int ssd_tok(int c, int l, int dir) { return dir == 0 ? 128 * c - 112 + l : 128 * (32 - c) + 15 - l; }
__device__ __forceinline__ void ssd_stream(int b, int h, int dir, const bf16* xbca, const float* dtga, float dt_bias, float a_neg, bf16* yout, int ypitch, lp lds) {
    int tid = threadIdx.x; asm volatile("" : "+v"(tid));
    const int lane = tid & 63, fr = lane & 15, quad = lane >> 4; const int w = __builtin_amdgcn_readfirstlane(tid >> 6);
    const int g = h >> 1;
    constexpr int P128 = 272, P64 = 144;
    f32x4 S[4];
#pragma unroll
    for (int pb = 0; pb < 4; ++pb) S[pb] = (f32x4){0.f, 0.f, 0.f, 0.f};
    __attribute__((address_space(3))) float* acs = (__attribute__((address_space(3))) float*)(lds + SSD_ACS);
    __attribute__((address_space(3))) float* dtl = (__attribute__((address_space(3))) float*)(lds + SSD_DTL);
    u32x4 pc[4], pbv[4], px[2]; float pd0 = 0.f, pd1 = 0.f;
#define SSD_PREFETCH(cc) do { \
        _Pragma("unroll") for (int i = 0; i < 4; ++i) { const int id = tid + 512 * i, row = id >> 4, ch = id & 15; const int t = ssd_tok((cc), row, dir); pc[i] = (u32x4){0u, 0u, 0u, 0u}; pbv[i] = (u32x4){0u, 0u, 0u, 0u}; \
            if (t >= 0) { const bf16* src = xbca + (size_t)row_of(b, t) * XW + g * 128 + ch * 8; pbv[i] = *(const u32x4*)(src + 256); pc[i] = *(const u32x4*)(src + 512); } } \
        _Pragma("unroll") for (int i = 0; i < 2; ++i) { const int id = tid + 512 * i, row = id >> 3, ch = id & 7; const int t = ssd_tok((cc), row, dir); px[i] = (u32x4){0u, 0u, 0u, 0u}; \
            if (t >= 0) px[i] = *(const u32x4*)(xbca + (size_t)row_of(b, t) * XW + h * 64 + ch * 8); } \
        if (w == 0) { const int t0 = ssd_tok((cc), 2 * lane, dir), t1 = ssd_tok((cc), 2 * lane + 1, dir); \
            pd0 = t0 >= 0 ? dtga[(size_t)row_of(b, t0 < 0 ? 0 : t0) * DGW + dir * 4 + h] : 0.f; pd1 = t1 >= 0 ? dtga[(size_t)row_of(b, t1 < 0 ? 0 : t1) * DGW + dir * 4 + h] : 0.f; } } while (0)
    SSD_PREFETCH(0);
    for (int c = 0; c < 33; ++c) {
        if (w == 0) {
            const int t0 = ssd_tok(c, 2 * lane, dir), t1 = ssd_tok(c, 2 * lane + 1, dir);
            const float d0 = t0 >= 0 ? softplus_fast(pd0 + dt_bias) : 0.f, d1 = t1 >= 0 ? softplus_fast(pd1 + dt_bias) : 0.f;
            const float v0 = d0 * a_neg, v1 = v0 + d1 * a_neg;
            float inc = v1;
#pragma unroll
            for (int o = 1; o < 64; o <<= 1) { const float u = __shfl_up(inc, o); if (lane >= o) inc += u; }
            const float pre = inc - v1;
            acs[2 * lane] = pre + v0; acs[2 * lane + 1] = pre + v1; dtl[2 * lane] = d0; dtl[2 * lane + 1] = d1;
        }
#pragma unroll
        for (int i = 0; i < 4; ++i) { const int id = tid + 512 * i, row = id >> 4, ch = id & 15;
            *(__attribute__((address_space(3))) u32x4*)(lds + SSD_CT + row * P128 + ch * 16) = pc[i]; *(__attribute__((address_space(3))) u32x4*)(lds + SSD_BT + row * P128 + ch * 16) = pbv[i]; }
#pragma unroll
        for (int pb = 0; pb < 4; ++pb) { u32x2 v; v.x = pkbf(S[pb][0], S[pb][1]); v.y = pkbf(S[pb][2], S[pb][3]);
            *(__attribute__((address_space(3))) u32x2*)(lds + SSD_SB + (16 * pb + fr) * P128 + (16 * w + 4 * quad) * 2) = v; }
        __syncthreads();
        const float alast = acs[127];
#pragma unroll
        for (int i = 0; i < 2; ++i) { const int id = tid + 512 * i, row = id >> 3, ch = id & 7; const u32x4 vx = px[i];
            const float d = dtl[row], dw = d * __expf(alast - acs[row]);
            u32x4 o1, o2;
            o1.x = pkbf(bflo(vx.x) * d, bfhi(vx.x) * d); o1.y = pkbf(bflo(vx.y) * d, bfhi(vx.y) * d); o1.z = pkbf(bflo(vx.z) * d, bfhi(vx.z) * d); o1.w = pkbf(bflo(vx.w) * d, bfhi(vx.w) * d);
            o2.x = pkbf(bflo(vx.x) * dw, bfhi(vx.x) * dw); o2.y = pkbf(bflo(vx.y) * dw, bfhi(vx.y) * dw); o2.z = pkbf(bflo(vx.z) * dw, bfhi(vx.z) * dw); o2.w = pkbf(bflo(vx.w) * dw, bfhi(vx.w) * dw);
            *(__attribute__((address_space(3))) u32x4*)(lds + SSD_XD + row * P64 + ch * 16) = o1; *(__attribute__((address_space(3))) u32x4*)(lds + SSD_XW + row * P64 + ch * 16) = o2; }
        if (c + 1 < 33) SSD_PREFETCH(c + 1);
        __syncthreads();
        f32x4 G[8];
#pragma unroll
        for (int sb = 0; sb < 8; ++sb) { G[sb] = (f32x4){0.f, 0.f, 0.f, 0.f};
            if (sb <= w) {
#pragma unroll
                for (int ks = 0; ks < 4; ++ks) G[sb] = MFMA16(frag_row(lds + SSD_BT, P128, 16 * sb, 32 * ks, fr, quad), frag_row(lds + SSD_CT, P128, 16 * w, 32 * ks, fr, quad), G[sb]); } }
        { const float dec = __expf(alast);
#pragma unroll
            for (int pb = 0; pb < 4; ++pb) S[pb] = S[pb] * dec;
#pragma unroll
            for (int ks = 0; ks < 4; ++ks) { const bf16x8 fb = frag_tr(lds + SSD_BT, P128, 32 * ks, 16 * w, fr, quad);
#pragma unroll
                for (int pb = 0; pb < 4; ++pb) S[pb] = MFMA16(fb, frag_tr(lds + SSD_XW, P64, 32 * ks, 16 * pb, fr, quad), S[pb]); } }
        __syncthreads();
        { const int l = 16 * w + fr; const float al = acs[l]; int dq = fr - 4 * quad; asm volatile("" : "+v"(dq));
#pragma unroll
            for (int sb = 0; sb < 8; ++sb) { u32x2 v = {0u, 0u};
                if (sb <= w) { const int s0 = 16 * sb + 4 * quad; const f32x4 as = *(const __attribute__((address_space(3))) f32x4*)(acs + s0);
                    const bool dg = sb == w;
                    const float e0 = (!dg || 0 <= dq) ? G[sb][0] * __expf(al - as[0]) : 0.f, e1 = (!dg || 1 <= dq) ? G[sb][1] * __expf(al - as[1]) : 0.f;
                    const float e2 = (!dg || 2 <= dq) ? G[sb][2] * __expf(al - as[2]) : 0.f, e3 = (!dg || 3 <= dq) ? G[sb][3] * __expf(al - as[3]) : 0.f;
                    v.x = pkbf(e0, e1); v.y = pkbf(e2, e3); }
                *(__attribute__((address_space(3))) u32x2*)(lds + SSD_BT + l * P128 + (16 * sb + 4 * quad) * 2) = v; } }
        __syncthreads();
        f32x4 Y[4], YO[4];
#pragma unroll
        for (int pb = 0; pb < 4; ++pb) { Y[pb] = (f32x4){0.f, 0.f, 0.f, 0.f}; YO[pb] = (f32x4){0.f, 0.f, 0.f, 0.f}; }
#pragma unroll
        for (int ks = 0; ks < 4; ++ks) {
            if (32 * ks <= 16 * w + 15) { const bf16x8 fs = frag_row(lds + SSD_BT, P128, 16 * w, 32 * ks, fr, quad);
#pragma unroll
                for (int pb = 0; pb < 4; ++pb) Y[pb] = MFMA16(frag_tr(lds + SSD_XD, P64, 32 * ks, 16 * pb, fr, quad), fs, Y[pb]); }
            const bf16x8 fc = frag_row(lds + SSD_CT, P128, 16 * w, 32 * ks, fr, quad);
#pragma unroll
            for (int pb = 0; pb < 4; ++pb) YO[pb] = MFMA16(frag_row(lds + SSD_SB, P128, 16 * pb, 32 * ks, fr, quad), fc, YO[pb]);
        }
        { const int l = 16 * w + fr; const float el = __expf(acs[l]); const int t = ssd_tok(c, l, dir);
            if (t >= 0) { bf16* op = yout + (size_t)row_of(b, t) * ypitch + h * 64 + 4 * quad;
#pragma unroll
                for (int pb = 0; pb < 4; ++pb) { const f32x4 y = Y[pb] + YO[pb] * el; u32x2 v; v.x = pkbf(y[0], y[1]); v.y = pkbf(y[2], y[3]); *(u32x2*)(op + 16 * pb) = v; } } }
        __syncthreads();
    }
}

constexpr int GLA_QT = 0, GLA_KT = 5120, GLA_KD = 10240, GLA_V = 15360, GLA_ATT = 24576, GLA_SB = 33792, GLA_WTOT = 38912, GLA_W2 = 39936, GLA_GB = 41984, GLA_LDS = 42112;
__device__ __forceinline__ int gla_tok(int c, int l, int dir) { return dir == 0 ? 64 * c - 48 + l : 64 * (64 - c) + 15 - l; }
__device__ __forceinline__ void gla_stream(int b, int h, int dir, const bf16* proj, const float* dtga, const float* gate_w2, const float* gate_b, bf16* oout, int opitch, lp lds) {
    int tid = threadIdx.x; asm volatile("" : "+v"(tid));
    const int lane = tid & 63, fr = lane & 15, quad = lane >> 4; const int w = __builtin_amdgcn_readfirstlane(tid >> 6);
    constexpr int P32 = 80, P64 = 144;
    typedef __attribute__((address_space(3))) float lfloat; typedef __attribute__((address_space(3))) f32x4 lf4;
    lfloat* wtot = (lfloat*)(lds + GLA_WTOT); lfloat* w2s = (lfloat*)(lds + GLA_W2); lfloat* gbs = (lfloat*)(lds + GLA_GB);
    for (int i = tid; i < 16 * 32; i += 512) w2s[i] = gate_w2[(dir * 16 + (i >> 5)) * 128 + h * 32 + (i & 31)];
    if (tid < 32) gbs[tid] = gate_b[dir * 128 + h * 32 + tid];
    __syncthreads();
    const int kb = w & 1, vbs = w >> 1;
    f32x4 S = {0.f, 0.f, 0.f, 0.f};
    const int rl = tid >> 3, kq = tid & 7;
    f32x4 pa0, pa1, pa2, pa3; unsigned long long pqq, pkk; u32x4 pvv; bool pok;
#define GLA_PREFETCH(cc) do { const int t_ = gla_tok((cc), rl, dir); pok = t_ >= 0; const size_t row_ = (size_t)row_of(b, pok ? t_ : 0); \
        pa0 = (f32x4){0.f, 0.f, 0.f, 0.f}; pa1 = pa0; pa2 = pa0; pa3 = pa0; pqq = 0ull; pkk = 0ull; pvv = (u32x4){0u, 0u, 0u, 0u}; \
        if (pok) { const float* ap = dtga + row_ * DGW + 8 + dir * 16; pa0 = *(const f32x4*)ap; pa1 = *(const f32x4*)(ap + 4); pa2 = *(const f32x4*)(ap + 8); pa3 = *(const f32x4*)(ap + 12); \
            pqq = *(const unsigned long long*)(proj + row_ * PW + PGQ + h * 32 + 4 * kq); pkk = *(const unsigned long long*)(proj + row_ * PW + PGK + h * 32 + 4 * kq); \
            pvv = *(const u32x4*)(proj + row_ * PW + PGV + h * 64 + 8 * kq); } } while (0)
    GLA_PREFETCH(0);
    for (int c = 0; c < 65; ++c) {
        const bool ok = pok;
        float gv[4] = {0.f, 0.f, 0.f, 0.f}; float qv[4] = {0.f, 0.f, 0.f, 0.f}, kv[4] = {0.f, 0.f, 0.f, 0.f}; const u32x4 vv = pvv;
        if (ok) {
            const f32x4 a0 = pa0, a1 = pa1, a2 = pa2, a3 = pa3;
            f32x4 z = *(const lf4*)(gbs + 4 * kq);
#pragma unroll
            for (int r = 0; r < 16; ++r) { const float ar = r < 4 ? a0[r & 3] : (r < 8 ? a1[r & 3] : (r < 12 ? a2[r & 3] : a3[r & 3])); const f32x4 ww = *(const lf4*)(w2s + r * 32 + 4 * kq); z = z + ww * ar; }
#pragma unroll
            for (int j = 0; j < 4; ++j) gv[j] = logsigmoid_fast(z[j]) * (1.0f / 16.0f);
            const unsigned long long qq = pqq, kk = pkk;
#pragma unroll
            for (int j = 0; j < 4; ++j) { qv[j] = __uint_as_float((unsigned)((qq >> (16 * j)) & 0xffffu) << 16) * 0.17677669529663687f; kv[j] = __uint_as_float((unsigned)((kk >> (16 * j)) & 0xffffu) << 16); }
        }
        if (c + 1 < 65) GLA_PREFETCH(c + 1);
        float bc[4];
#pragma unroll
        for (int j = 0; j < 4; ++j) { float x = gv[j];
#pragma unroll
            for (int o = 8; o < 64; o <<= 1) { const float u = __shfl_up(x, o); if (lane >= o) x += u; }
            bc[j] = x; }
        if (lane >= 56) { *(lf4*)(wtot + w * 32 + 4 * kq) = (f32x4){bc[0], bc[1], bc[2], bc[3]}; }
        *(__attribute__((address_space(3))) u32x4*)(lds + GLA_V + rl * P64 + kq * 16) = vv;
        { u32x2 sv; sv.x = pkbf(S[0], S[1]); sv.y = pkbf(S[2], S[3]); *(__attribute__((address_space(3))) u32x2*)(lds + GLA_SB + (16 * vbs + fr) * P32 + (16 * kb + 4 * quad) * 2) = sv; }
        __syncthreads();
        f32x4 pre = {0.f, 0.f, 0.f, 0.f}, blast = {0.f, 0.f, 0.f, 0.f};
#pragma unroll
        for (int ww = 0; ww < 8; ++ww) { const f32x4 tt = *(const lf4*)(wtot + ww * 32 + 4 * kq); blast = blast + tt; if (ww < w) pre = pre + tt; }
        { u32x2 oq, ok2, od; float e[4], en[4], ed[4];
#pragma unroll
            for (int j = 0; j < 4; ++j) { const float bb = bc[j] + pre[j]; e[j] = qv[j] * __expf(bb); en[j] = kv[j] * __expf(-bb); ed[j] = kv[j] * __expf(blast[j] - bb); }
            oq.x = pkbf(e[0], e[1]); oq.y = pkbf(e[2], e[3]); ok2.x = pkbf(en[0], en[1]); ok2.y = pkbf(en[2], en[3]); od.x = pkbf(ed[0], ed[1]); od.y = pkbf(ed[2], ed[3]);
            *(__attribute__((address_space(3))) u32x2*)(lds + GLA_QT + rl * P32 + kq * 8) = oq; *(__attribute__((address_space(3))) u32x2*)(lds + GLA_KT + rl * P32 + kq * 8) = ok2; *(__attribute__((address_space(3))) u32x2*)(lds + GLA_KD + rl * P32 + kq * 8) = od; }
        __syncthreads();
        { const int lb = w & 3;
#pragma unroll
            for (int i = 0; i < 2; ++i) { const int sb = 2 * (w >> 2) + i; f32x4 A = {0.f, 0.f, 0.f, 0.f};
                if (sb <= lb) A = MFMA16(frag_row(lds + GLA_KT, P32, 16 * sb, 0, fr, quad), frag_row(lds + GLA_QT, P32, 16 * lb, 0, fr, quad), A);
                const int l = 16 * lb + fr, s0 = 16 * sb + 4 * quad; u32x2 v;
                v.x = pkbf(s0 + 0 <= l ? A[0] : 0.f, s0 + 1 <= l ? A[1] : 0.f); v.y = pkbf(s0 + 2 <= l ? A[2] : 0.f, s0 + 3 <= l ? A[3] : 0.f);
                *(__attribute__((address_space(3))) u32x2*)(lds + GLA_ATT + l * P64 + s0 * 2) = v; } }
        { const f32x4 bl = *(const lf4*)(wtot + 0 * 32 + 16 * kb + 4 * quad) + *(const lf4*)(wtot + 1 * 32 + 16 * kb + 4 * quad)
                         + *(const lf4*)(wtot + 2 * 32 + 16 * kb + 4 * quad) + *(const lf4*)(wtot + 3 * 32 + 16 * kb + 4 * quad)
                         + *(const lf4*)(wtot + 4 * 32 + 16 * kb + 4 * quad) + *(const lf4*)(wtot + 5 * 32 + 16 * kb + 4 * quad)
                         + *(const lf4*)(wtot + 6 * 32 + 16 * kb + 4 * quad) + *(const lf4*)(wtot + 7 * 32 + 16 * kb + 4 * quad);
            S[0] *= __expf(bl[0]); S[1] *= __expf(bl[1]); S[2] *= __expf(bl[2]); S[3] *= __expf(bl[3]);
#pragma unroll
            for (int ks = 0; ks < 2; ++ks) S = MFMA16(frag_tr(lds + GLA_KD, P32, 32 * ks, 16 * kb, fr, quad), frag_tr(lds + GLA_V, P64, 32 * ks, 16 * vbs, fr, quad), S); }
        __syncthreads();
        { const int lb = w & 3; const int l = 16 * lb + fr; const int to = gla_tok(c, l, dir);
            const bf16x8 fq = frag_row(lds + GLA_QT, P32, 16 * lb, 0, fr, quad);
#pragma unroll
            for (int i = 0; i < 2; ++i) { const int vb = 2 * (w >> 2) + i; f32x4 O = {0.f, 0.f, 0.f, 0.f};
#pragma unroll
                for (int ks = 0; ks < 2; ++ks) if (32 * ks <= 16 * lb + 15) O = MFMA16(frag_tr(lds + GLA_V, P64, 32 * ks, 16 * vb, fr, quad), frag_row(lds + GLA_ATT, P64, 16 * lb, 32 * ks, fr, quad), O);
                O = MFMA16(frag_row(lds + GLA_SB, P32, 16 * vb, 0, fr, quad), fq, O);
                if (to >= 0) { u32x2 v; v.x = pkbf(O[0], O[1]); v.y = pkbf(O[2], O[3]); *(u32x2*)(oout + (size_t)row_of(b, to) * opitch + h * 64 + 16 * vb + 4 * quad) = v; } } }
        __syncthreads();
    }
}
#undef SSD_PREFETCH
#undef GLA_PREFETCH
}

constexpr int NWAVES = 8;
constexpr size_t MiB = 1u << 20;
constexpr size_t WS_CTL = 0, CTL_ZERO_BYTES = 1 * MiB;
constexpr size_t WS_DTGA = 1 * MiB;
constexpr size_t WS_ROUTE = 10 * MiB;
constexpr size_t WS_HMETA = 12 * MiB;
constexpr size_t WS_WIN = 13 * MiB;
constexpr size_t WS_WOUT = WS_WIN + 2ull * 3072 * 1024 * 2;
constexpr size_t WS_WGU = WS_WOUT + 2ull * 1024 * 1024 * 2;
constexpr size_t WS_WD = WS_WGU + 5632ull * 1024 * 2;
constexpr size_t WS_WMOE_GU = 46 * MiB;
constexpr size_t WS_WMOE_D = WS_WMOE_GU + 8ull * 7168 * 1024 * 2;
constexpr size_t WS_BIG = 214 * MiB;
constexpr size_t WS_TMP = 392 * MiB;
constexpr size_t WS_ACT = 457 * MiB;
constexpr size_t WS_END = 522 * MiB;
static_assert(WS_WD + 1024ull * 2816 * 2 <= WS_WMOE_GU && WS_WMOE_D + 8ull * 1024 * 3584 * 2 <= WS_BIG && WS_BIG + (size_t)MP * PW * 2 <= WS_TMP && WS_TMP + (size_t)MP * 1024 * 2 <= WS_ACT && WS_ACT + (size_t)MP * 1024 * 2 <= WS_END, "ws map");
static_assert(WS_DTGA + (size_t)MP * DGW * 4 <= WS_ROUTE, "ws map 2");
constexpr int CAP_TILES = 69;
constexpr size_t MOE_ACT_BYTES = (size_t)CAP_TILES * 256 * 3584 * 2;
static_assert(WS_BIG + 2 * MOE_ACT_BYTES <= WS_ACT, "moe pass buffers");
constexpr int MAX_SROWS = 2 * (NREG + 8 * 256);
constexpr size_t RT_E = 0;
constexpr size_t RT_G = RT_E + (size_t)NREG * 4;
constexpr size_t RT_STOK = RT_G + (size_t)NREG * 8;
constexpr size_t RT_SGATE = RT_STOK + (size_t)MAX_SROWS * 4;
constexpr size_t RT_TEXP = RT_SGATE + (size_t)MAX_SROWS * 4;
constexpr size_t RT_PASS = RT_TEXP + 4096;
constexpr size_t RT_SSA = RT_PASS + 64;
constexpr size_t RT_RANK = RT_SSA + (size_t)MAX_SROWS * 4;
constexpr size_t RT_BLKCNT = RT_RANK + (size_t)NREG * 4;
constexpr size_t RT_STOKP = RT_BLKCNT + 1024 * 64;
static_assert(RT_STOKP + (size_t)MAX_SROWS * 4 <= 2 * MiB, "route tables");
__device__ __forceinline__ int permp(int p) { return (p & ~255) | ((p & 63) << 2) | ((p >> 6) & 3); }
constexpr int CW_BAR = 4096, CW_Q = 8192;
constexpr int LDS_BYTES = 155648, LDSCTL_OFF = 143360, MISC_OFF = LDSCTL_OFF + 320;

__device__ __forceinline__ float wave_sum(float v) {
#pragma unroll
    for (int o = 1; o < 64; o <<= 1) v += __shfl_xor(v, o);
    return v;
}
__device__ __forceinline__ float wave_sum_sw(float v) {
    v += __int_as_float(__builtin_amdgcn_ds_swizzle(__float_as_int(v), (1 << 10) | 0x1f)); v += __int_as_float(__builtin_amdgcn_ds_swizzle(__float_as_int(v), (2 << 10) | 0x1f));
    v += __int_as_float(__builtin_amdgcn_ds_swizzle(__float_as_int(v), (4 << 10) | 0x1f)); v += __int_as_float(__builtin_amdgcn_ds_swizzle(__float_as_int(v), (8 << 10) | 0x1f));
    v += __int_as_float(__builtin_amdgcn_ds_swizzle(__float_as_int(v), (16 << 10) | 0x1f));
    return __int_as_float(__builtin_amdgcn_readlane(__float_as_int(v), 0)) + __int_as_float(__builtin_amdgcn_readlane(__float_as_int(v), 32));
}
__device__ __forceinline__ int wmap(int kind, int n) {
    if (kind == 0) return n;
    if (kind == 1) { if (n < 1024) return n; if (n < 1032) return 2816 + (n - 1024); if (n < 1800) return n - 8; if (n < 1832) return 2824 + (n - 1800); return n - 40; }
    return (n >> 7) * 256 + (n & 127) + (kind == 3 ? 128 : 0);
}
__device__ __forceinline__ float wscale(int kind, int n) { return (kind == 1 && n >= 1832 && n < 2088) ? 0.125f * 1.4426950408889634f : 1.0f; }
__device__ __forceinline__ void transpose_mat(const float* W, int K, int N, bf16* WT, int kind, LAS float* scr, int gw, int NGW, int lane, bool tiled = false) {
    const int nblk = (N + 31) / 32, nitems = (K / 64) * nblk;
    for (int item = gw; item < nitems; item += NGW) {
        const int kb = item / nblk, nb = item % nblk, k0 = 64 * kb, n0 = 32 * nb;
        const int nn = n0 + (lane & 31); const float wsc = wscale(kind, nn);
        float wv[32];
#pragma unroll
        for (int i = 0; i < 32; ++i) { const int kk = 2 * i + (lane >> 5); wv[i] = nn < N ? __builtin_nontemporal_load(W + (size_t)(k0 + kk) * N + nn) : 0.f; }
#pragma unroll
        for (int i = 0; i < 32; ++i) { const int kk = 2 * i + (lane >> 5); scr[kk * 33 + (lane & 31)] = wv[i] * wsc; }
        LDS_WAIT(); asm volatile("" ::: "memory");
        const int c = lane & 7;
#pragma unroll
        for (int j = 0; j < 4; ++j) { const int n = (lane >> 3) + 8 * j; const LAS float* s = scr + (8 * c) * 33 + n;
            v4u o; o.x = pk2(s[0 * 33], s[1 * 33]); o.y = pk2(s[2 * 33], s[3 * 33]); o.z = pk2(s[4 * 33], s[5 * 33]); o.w = pk2(s[6 * 33], s[7 * 33]);
            if (n0 + n < N) { const int rn = wmap(kind, n0 + n);
                if (tiled) *(GAS v4u*)(WT + ((size_t)(rn >> 8) * (K >> 6) + (k0 >> 6)) * 16384 + (size_t)(rn & 255) * 64 + 8 * c) = o; else *(GAS v4u*)(WT + (size_t)rn * K + k0 + 8 * c) = o; } }
        LDS_WAIT(); asm volatile("" ::: "memory");
    }
}
__device__ __forceinline__ void colmax_mat(const float* W, int K, int N, unsigned* cmax, int kind, int gw, int NGW, int lane) {
    const int nblk = (N + 63) / 64, nitems = (K / 64) * nblk;
    for (int item = gw; item < nitems; item += NGW) { const int kb = item / nblk, nb = item % nblk, n = 64 * nb + lane;
        float m = 0.f;
        if (n < N) {
#pragma unroll 16
            for (int kk = 0; kk < 64; ++kk) m = fmaxf(m, fabsf(__builtin_nontemporal_load(W + (size_t)(64 * kb + kk) * N + n))); }
        if (n < N) atomicMax(cmax + wmap(kind, n), __float_as_uint(m * wscale(kind, n))); }
}
__device__ __forceinline__ void quant_mat(const float* W, int K, int N, signed char* W8, float* sB, const unsigned* cmax, int kind, LAS float* scr, int gw, int NGW, int lane, int maxrow = 1 << 30) {
    const int nblk = (N + 31) / 32, nitems = (K / 64) * nblk;
    for (int item = gw; item < nitems; item += NGW) {
        const int kb = item / nblk, nb = item % nblk, k0 = 64 * kb, n0 = 32 * nb; const int nn = n0 + (lane & 31);
        const float cm = nn < N ? __uint_as_float(cmax[wmap(kind, nn)]) : 1.f, qs = (cm > 0.f ? 127.0f / cm : 0.f) * wscale(kind, nn);
        if (kb == 0 && lane < 32 && nn < N && wmap(kind, nn) < maxrow) sB[wmap(kind, nn)] = cm * (1.0f / 127.0f);
        float wv[32];
#pragma unroll
        for (int i = 0; i < 32; ++i) { const int kk = 2 * i + (lane >> 5); wv[i] = nn < N ? __builtin_nontemporal_load(W + (size_t)(k0 + kk) * N + nn) : 0.f; }
#pragma unroll
        for (int i = 0; i < 32; ++i) { const int kk = 2 * i + (lane >> 5); scr[kk * 33 + (lane & 31)] = rintf(wv[i] * qs); }
        LDS_WAIT(); asm volatile("" ::: "memory");
        const int c = lane & 7;
#pragma unroll
        for (int j = 0; j < 4; ++j) { const int n = (lane >> 3) + 8 * j; const LAS float* s = scr + (8 * c) * 33 + n;
            unsigned lo = 0u, hi = 0u;
#pragma unroll
            for (int q = 0; q < 4; ++q) { lo |= ((unsigned)((int)s[q * 33]) & 0xffu) << (8 * q); hi |= ((unsigned)((int)s[(4 + q) * 33]) & 0xffu) << (8 * q); }
            if (n0 + n < N && wmap(kind, n0 + n) < maxrow) *(GAS unsigned long long*)(W8 + (size_t)wmap(kind, n0 + n) * K + k0 + 8 * c) = (unsigned long long)lo | ((unsigned long long)hi << 32); }
        LDS_WAIT(); asm volatile("" ::: "memory");
    }
}
__device__ __forceinline__ void absmax_all(const float* W, long n4, unsigned* amax, long gtid, long nthreads, int lane) {
    float m = 0.f;
    for (long i = gtid; i < n4; i += 8 * nthreads) { f32x4 v[8];
#pragma unroll
        for (int u = 0; u < 8; ++u) { const long ii = i + u * nthreads; v[u] = ii < n4 ? __builtin_nontemporal_load((const GAS f32x4*)W + ii) : (f32x4){0.f, 0.f, 0.f, 0.f}; }
#pragma unroll
        for (int u = 0; u < 8; ++u) m = fmaxf(fmaxf(m, fmaxf(fabsf(v[u].x), fabsf(v[u].y))), fmaxf(fabsf(v[u].z), fabsf(v[u].w))); }
    m = fmaxf(m, __int_as_float(__builtin_amdgcn_ds_swizzle(__float_as_int(m), (1 << 10) | 0x1f))); m = fmaxf(m, __int_as_float(__builtin_amdgcn_ds_swizzle(__float_as_int(m), (2 << 10) | 0x1f)));
    m = fmaxf(m, __int_as_float(__builtin_amdgcn_ds_swizzle(__float_as_int(m), (4 << 10) | 0x1f))); m = fmaxf(m, __int_as_float(__builtin_amdgcn_ds_swizzle(__float_as_int(m), (8 << 10) | 0x1f)));
    m = fmaxf(m, __int_as_float(__builtin_amdgcn_ds_swizzle(__float_as_int(m), (16 << 10) | 0x1f)));
    if ((lane & 31) == 0) atomicMax(amax, __float_as_uint(m));
}
__device__ __forceinline__ float f8_scale(unsigned amax_bits, bool inverse) { const int e = (int)(amax_bits >> 23) - 127; if (amax_bits == 0u) return 1.0f; return __uint_as_float((unsigned)(127 + (inverse ? e - 7 : 7 - e)) << 23); }
__device__ __forceinline__ void quant_f8_mat(const float* W, int K, int N, unsigned char* W8, float S, LAS float* scr, int gw, int NGW, int lane) {
    const int nblk = (N + 31) / 32, nitems = (K / 64) * nblk;
    for (int item = gw; item < nitems; item += NGW) {
        const int kb = item / nblk, nb = item % nblk, k0 = 64 * kb, n0 = 32 * nb; const int nn = n0 + (lane & 31);
        float wv[32];
#pragma unroll
        for (int i = 0; i < 32; ++i) { const int kk = 2 * i + (lane >> 5); wv[i] = nn < N ? __builtin_nontemporal_load(W + (size_t)(k0 + kk) * N + nn) : 0.f; }
#pragma unroll
        for (int i = 0; i < 32; ++i) { const int kk = 2 * i + (lane >> 5); scr[kk * 33 + (lane & 31)] = wv[i] * S; }
        LDS_WAIT(); asm volatile("" ::: "memory");
        const int c = lane & 7;
#pragma unroll
        for (int j = 0; j < 4; ++j) { const int n = (lane >> 3) + 8 * j; const LAS float* s = scr + (8 * c) * 33 + n;
            unsigned lo = 0u, hi = 0u; lo = __builtin_amdgcn_cvt_pk_fp8_f32(s[0 * 33], s[1 * 33], lo, false); lo = __builtin_amdgcn_cvt_pk_fp8_f32(s[2 * 33], s[3 * 33], lo, true);
            hi = __builtin_amdgcn_cvt_pk_fp8_f32(s[4 * 33], s[5 * 33], hi, false); hi = __builtin_amdgcn_cvt_pk_fp8_f32(s[6 * 33], s[7 * 33], hi, true);
            const int rn = n0 + n;
            if (rn < N) *(GAS unsigned long long*)(W8 + ((size_t)(rn >> 8) * (K >> 7) + (k0 >> 7)) * 32768 + (size_t)(rn & 255) * 128 + (k0 & 127) + 8 * c) = (unsigned long long)lo | ((unsigned long long)hi << 32); }
        LDS_WAIT(); asm volatile("" ::: "memory");
    }
}
__device__ __forceinline__ void rms_row_to_bf16(const float* xrow, const float* w, bf16* orow, int lane) {
    const GAS f32x4* xr = (const GAS f32x4*)xrow + lane; const GAS f32x4* wr = (const GAS f32x4*)w + lane;
    f32x4 v[4]; float s = 0.f;
#pragma unroll
    for (int j = 0; j < 4; ++j) { v[j] = xr[64 * j]; s += (v[j].x * v[j].x + v[j].y * v[j].y) + (v[j].z * v[j].z + v[j].w * v[j].w); }
    const float rstd = 1.f / sqrtf(wave_sum(s) * (1.f / 1024.f) + 1e-6f);
    GAS unsigned long long* o8 = (GAS unsigned long long*)orow + lane;
#pragma unroll
    for (int j = 0; j < 4; ++j) { const f32x4 ww = wr[64 * j]; o8[64 * j] = (unsigned long long)pk2(v[j].x * rstd * ww.x, v[j].y * rstd * ww.y) | ((unsigned long long)pk2(v[j].z * rstd * ww.z, v[j].w * rstd * ww.w) << 32); }
}

#ifndef N_LAUNCH_MODE
#define N_LAUNCH_MODE 1
#endif

template <int NB> __device__ __forceinline__ void skinny_task(const bf16* A, int K, int rb, const bf16* Bt, int b0, int bstep, f32x4 (&acc)[NB], int lane) {
    const int fr = lane & 15, quad = lane >> 4;
    const bf16* ap = A + (size_t)(16 * rb + fr) * K + 8 * quad; const bf16* bp = Bt + (size_t)(b0 + fr) * K + 8 * quad;
#pragma unroll
    for (int nb = 0; nb < NB; ++nb) acc[nb] = (f32x4){0.f, 0.f, 0.f, 0.f};
#pragma unroll 8
    for (int ks = 0; ks < K / 32; ++ks) { const bf16x8 av = *(const GAS bf16x8*)(ap + 32 * ks);
#pragma unroll
        for (int nb = 0; nb < NB; ++nb) acc[nb] = __builtin_amdgcn_mfma_f32_16x16x32_bf16(av, *(const GAS bf16x8*)(bp + (size_t)nb * bstep * K + 32 * ks), acc[nb], 0, 0, 0); }
}
__device__ __forceinline__ f32x4 bf4_f32(unsigned long long q) { f32x4 v; v.x = __uint_as_float((unsigned)q << 16); v.y = __uint_as_float((unsigned)q & 0xffff0000u); v.z = __uint_as_float((unsigned)(q >> 32) << 16); v.w = __uint_as_float((unsigned)(q >> 32) & 0xffff0000u); return v; }
constexpr int HP = 2048;
template <bool IN16 = false>
__device__ __forceinline__ void rms_row2_to_bf16(const void* xa, const void* xb, const f32x4 (&wreg)[4], bf16* oa, bf16* ob, int lane, signed char* qa8 = nullptr, signed char* qb8 = nullptr, float* sa8 = nullptr, float* sb8 = nullptr) {
    f32x4 va[4], vb[4]; float sa = 0.f, sb = 0.f;
    if constexpr (IN16) { const GAS unsigned long long* pa = (const GAS unsigned long long*)xa + lane; const GAS unsigned long long* pb = (const GAS unsigned long long*)xb + lane; unsigned long long ta[4], tb[4];
#pragma unroll
        for (int j = 0; j < 4; ++j) { ta[j] = pa[64 * j]; tb[j] = pb[64 * j]; }
#pragma unroll
        for (int j = 0; j < 4; ++j) { va[j] = bf4_f32(ta[j]); vb[j] = bf4_f32(tb[j]); } }
    else { const GAS f32x4* pa = (const GAS f32x4*)xa + lane; const GAS f32x4* pb = (const GAS f32x4*)xb + lane;
#pragma unroll
        for (int j = 0; j < 4; ++j) { va[j] = pa[64 * j]; vb[j] = pb[64 * j]; } }
#pragma unroll
    for (int j = 0; j < 4; ++j) { sa += (va[j].x * va[j].x + va[j].y * va[j].y) + (va[j].z * va[j].z + va[j].w * va[j].w); sb += (vb[j].x * vb[j].x + vb[j].y * vb[j].y) + (vb[j].z * vb[j].z + vb[j].w * vb[j].w); }
    const float ra = 1.f / sqrtf(wave_sum(sa) * (1.f / 1024.f) + 1e-6f), rb = 1.f / sqrtf(wave_sum(sb) * (1.f / 1024.f) + 1e-6f);
    GAS unsigned long long* qa = (GAS unsigned long long*)oa + lane; GAS unsigned long long* qb = (GAS unsigned long long*)ob + lane;
#pragma unroll
    for (int j = 0; j < 4; ++j) { const f32x4 ww = wreg[j];
        qa[64 * j] = (unsigned long long)pk2(va[j].x * ra * ww.x, va[j].y * ra * ww.y) | ((unsigned long long)pk2(va[j].z * ra * ww.z, va[j].w * ra * ww.w) << 32);
        qb[64 * j] = (unsigned long long)pk2(vb[j].x * rb * ww.x, vb[j].y * rb * ww.y) | ((unsigned long long)pk2(vb[j].z * rb * ww.z, vb[j].w * rb * ww.w) << 32); }
    if (qa8) {
        float ma = 0.f, mb = 0.f;
#pragma unroll
        for (int j = 0; j < 4; ++j) { const f32x4 ww = wreg[j]; va[j] = va[j] * ra * ww; vb[j] = vb[j] * rb * ww;
            ma = fmaxf(fmaxf(ma, fmaxf(fabsf(va[j].x), fabsf(va[j].y))), fmaxf(fabsf(va[j].z), fabsf(va[j].w))); mb = fmaxf(fmaxf(mb, fmaxf(fabsf(vb[j].x), fabsf(vb[j].y))), fmaxf(fabsf(vb[j].z), fabsf(vb[j].w))); }
#pragma unroll
        for (int o = 1; o < 64; o <<= 1) { ma = fmaxf(ma, __shfl_xor(ma, o)); mb = fmaxf(mb, __shfl_xor(mb, o)); }
        const float qsa = ma > 0.f ? 127.0f / ma : 0.f, qsb = mb > 0.f ? 127.0f / mb : 0.f; if (lane == 0) { *sa8 = ma * (1.0f / 127.0f); *sb8 = mb * (1.0f / 127.0f); }
#pragma unroll
        for (int j = 0; j < 4; ++j) {
            *((GAS unsigned*)qa8 + lane + 64 * j) = ((unsigned)((int)rintf(va[j].x * qsa)) & 0xffu) | (((unsigned)((int)rintf(va[j].y * qsa)) & 0xffu) << 8) | (((unsigned)((int)rintf(va[j].z * qsa)) & 0xffu) << 16) | (((unsigned)((int)rintf(va[j].w * qsa)) & 0xffu) << 24);
            *((GAS unsigned*)qb8 + lane + 64 * j) = ((unsigned)((int)rintf(vb[j].x * qsb)) & 0xffu) | (((unsigned)((int)rintf(vb[j].y * qsb)) & 0xffu) << 8) | (((unsigned)((int)rintf(vb[j].z * qsb)) & 0xffu) << 16) | (((unsigned)((int)rintf(vb[j].w * qsb)) & 0xffu) << 24); } }
}
struct Args { const float* in[27]; float* out; unsigned char* ws; int ph_lo, ph_hi; };
enum { IN_X = 0, IN_META, IN_RELB, IN_NMIX, IN_NFFN, IN_WIN, IN_CONVW, IN_CONVB, IN_DTB, IN_ALOG, IN_SSDD, IN_SSDN, IN_GW2, IN_GB, IN_GLAN, IN_SINK, IN_QN, IN_KN, IN_WOUT,
       IN_FG, IN_FU, IN_FD, IN_ROUTER, IN_MG, IN_MU, IN_MD, IN_FINAL };
enum { PH_PRO = 0, PH_L0 = 1, PH_L1 = 17, PH_SORT = PH_L1 + 10, PH_PASS0 = PH_SORT + 1, PH_FINAL = PH_PASS0 + 5, PH_END = PH_FINAL + 1 };

__global__ void __launch_bounds__(NWAVES * 64, 2) fwd_kernel(Args args) {
    extern __shared__ __attribute__((aligned(16))) unsigned char lds_raw[];
    LAS unsigned char* lds = (LAS unsigned char*)lds_raw;
    volatile LAS unsigned* MISC = (volatile LAS unsigned*)(lds + MISC_OFF);
    const int G = gridDim.x, bid = blockIdx.x, NGW = G * NWAVES; const long nthreads = (long)G * NWAVES * 64;
#define KAS __attribute__((address_space(4)))
#define INP(k) (*(const float* const KAS*)(ka_ + 8 * (k)))
#define IDS() const KAS char* ka_ = (const KAS char*)__builtin_amdgcn_kernarg_segment_ptr(); asm volatile("" : "+s"(ka_)); unsigned char* const ws = *(unsigned char* const KAS*)(ka_ + 224); float* const hreg = *(float* const KAS*)(ka_ + 216); (void)ws; (void)hreg; \
    int tid = threadIdx.x; asm volatile("" : "+v"(tid)); const int lane = tid & 63, wave = __builtin_amdgcn_readfirstlane(tid >> 6), gw = bid * NWAVES + wave; const long gtid = (long)bid * (NWAVES * 64) + tid; (void)lane; (void)gw; (void)gtid
    gu32* ctl = (gu32*)(args.ws + WS_CTL);
    { IDS(); for (int u = tid; u < (LDS_BYTES - LDSCTL_OFF) / 4; u += NWAVES * 64) ((LAS unsigned*)(lds + LDSCTL_OFF))[u] = 0u; }
    __syncthreads();
    XcdBarrier bar = xcd_barrier_post((unsigned*)(ctl + CW_BAR), MISC + 8);
#if N_LAUNCH_MODE == 1
#define IN(k) true
#define SEAM(k) xcd_barrier_lean(bar)
#define OPAQUE_RANGE() do { } while (0)
#else
    int lo = args.ph_lo, hi = args.ph_hi;
#define IN(k) (lo <= (k) && (k) < hi)
#define SEAM(k) do { if (IN(k) && IN((k) + 1)) xcd_barrier(bar); } while (0)
#define OPAQUE_RANGE() asm volatile("" : "+s"(lo), "+s"(hi))
#endif

#define dtga ((float*)(ws + WS_DTGA))
#define CMAX_GU ((unsigned*)(ws + 131072))
#define WGU8 ((signed char*)(ws + WS_DTGA))
#define SB_GU ((float*)(ws + WS_DTGA + 6 * MiB))
#define SA_U ((float*)(ws + WS_DTGA + 6 * MiB + 32768))
#define U8 ((signed char*)(ws + (l == 0 ? WS_TMP : WS_ACT)))
#define CMAX_IN ((unsigned*)(ws + 393216))
#define WIN8 ((signed char*)(ws + WS_WMOE_GU + 72 * MiB))
#define SB_IN ((float*)(ws + WS_WMOE_GU + 80 * MiB))
#define SA_IN ((float*)(ws + WS_HMETA + 524288))
#define U8IN ((signed char*)(ws + WS_TMP))
#define CMAX_MGU ((unsigned*)(ws + 163840))
#define WMGU8 ((signed char*)(ws + WS_WMOE_GU))
#define SB_MGU ((float*)(ws + WS_WMOE_GU + 64 * MiB))
#define YLO ((bf16*)(ws + WS_WIN))
#define YHI ((bf16*)(ws + WS_ACT + 33 * MiB))
#define Y1LO ((bf16*)(ws + WS_BIG + MOE_ACT_BYTES / 2))
#define Y1HI ((bf16*)(ws + WS_BIG + MOE_ACT_BYTES + MOE_ACT_BYTES / 2))
#define WMD8 ((unsigned char*)(ws + WS_WMOE_D))
#define AMAX_MD ((unsigned*)(ws + 131072 - 64))
#define hmeta ((float*)(ws + WS_HMETA))
#define Win ((bf16*)(ws + WS_WIN))
#define Wout ((bf16*)(ws + WS_WOUT))
#define Wgu ((bf16*)(ws + WS_WGU))
#define Wd ((bf16*)(ws + WS_WD))
#define Wmgu ((bf16*)(ws + WS_WMOE_GU))
#define Wmd ((bf16*)(ws + WS_WMOE_D))
#define big ((bf16*)(ws + WS_BIG))
#define act1k ((bf16*)(ws + WS_ACT))
#define tmp ((bf16*)(ws + WS_TMP))
#define rt_e ((int*)(ws + WS_ROUTE + RT_E))
#define rt_g ((float*)(ws + WS_ROUTE + RT_G))
#define stok ((int*)(ws + WS_ROUTE + RT_STOK))
#define stokp ((int*)(ws + WS_ROUTE + RT_STOKP))
#define sgate ((float*)(ws + WS_ROUTE + RT_SGATE))
#define texp ((int*)(ws + WS_ROUTE + RT_TEXP))
#define passt ((int*)(ws + WS_ROUTE + RT_PASS))
#define rt_rank ((int*)(ws + WS_ROUTE + RT_RANK))
#define ssa ((float*)(ws + WS_ROUTE + RT_SSA))
#define blkcnt ((int*)(ws + WS_ROUTE + RT_BLKCNT))

#ifndef PROBE_THIN_REP
#define PROBE_THIN_REP 1
#endif
#ifndef PROBE_PRO_REP
#define PROBE_PRO_REP 1
#endif
    for (int rep_ = 0; rep_ < PROBE_PRO_REP; ++rep_)
    if (IN(PH_PRO)) { IDS();
        LAS float* scr = (LAS float*)(lds + wave * 16384);
        for (int l = 0; l < 2; ++l) {
            transpose_mat(INP(IN_WIN) + (size_t)l * 1024 * 2856, 1024, 2856, Win + (size_t)l * 3072 * 1024, 1, scr, gw, NGW, lane);
            transpose_mat(INP(IN_WOUT) + (size_t)l * 1024 * 1024, 1024, 1024, Wout + (size_t)l * 1024 * 1024, 0, scr, gw, NGW, lane);
            colmax_mat(INP(IN_WIN) + (size_t)l * 1024 * 2856, 1024, 2856, CMAX_IN + l * 3072, 1, gw, NGW, lane);
        }
        transpose_mat(INP(IN_FG), 1024, 2816, Wgu, 2, scr, gw, NGW, lane);
        transpose_mat(INP(IN_FU), 1024, 2816, Wgu, 3, scr, gw, NGW, lane);
        transpose_mat(INP(IN_FD), 2816, 1024, Wd, 0, scr, gw, NGW, lane);
        colmax_mat(INP(IN_FG), 1024, 2816, CMAX_GU, 2, gw, NGW, lane); colmax_mat(INP(IN_FU), 1024, 2816, CMAX_GU, 3, gw, NGW, lane);
        for (int e = 0; e < 8; ++e) {
            colmax_mat(INP(IN_MG) + (size_t)e * 1024 * 3584, 1024, 3584, CMAX_MGU + e * 7168, 2, gw, NGW, lane); colmax_mat(INP(IN_MU) + (size_t)e * 1024 * 3584, 1024, 3584, CMAX_MGU + e * 7168, 3, gw, NGW, lane);
        }
        absmax_all(INP(IN_MD), 8l * 3584 * 1024 / 4, AMAX_MD, gtid, nthreads, lane);
        for (int l = 0; l < 2; ++l) for (long i = gtid; i < (long)(3072 - 2856) * 1024 / 8; i += nthreads) ((GAS v4u*)(Win + ((size_t)l * 3072 + 2856) * 1024))[i] = (v4u){0u, 0u, 0u, 0u};
        __syncthreads();
    }
    if (IN(PH_PRO) && IN(PH_PRO + 1)) xcd_barrier(bar);

    { constexpr int l = 0;
    {
        OPAQUE_RANGE();
        const int pb = PH_L0 + 16 * l;
#define hin_reg (l == 0 ? INP(IN_X) : (const float*)hreg)
#define hin_meta (l == 0 ? INP(IN_META) : (const float*)hmeta)
        const int meta_mod = l == 0 ? 16 : 128;
#define MKMP() MixParams mp; mp.conv_w = INP(IN_CONVW) + l * 5 * 768; mp.conv_b = INP(IN_CONVB) + l * 768; mp.dt_bias = INP(IN_DTB) + l * 8; mp.a_log = INP(IN_ALOG) + l * 8; \
        mp.ssd_d = INP(IN_SSDD) + l * 4; mp.ssd_norm_w = INP(IN_SSDN) + l * 256; mp.gate_w2 = INP(IN_GW2) + l * 2 * 16 * 128; mp.gate_b = INP(IN_GB) + l * 256; \
        mp.gla_norm_w = INP(IN_GLAN) + l * 64; mp.sink = INP(IN_SINK) + l * 4; mp.qn_w = INP(IN_QN) + l * 64; mp.kn_w = INP(IN_KN) + l * 64; mp.rel_bias = INP(IN_RELB); \
        MixBuf mb{big, dtga, tmp, act1k}; (void)mb
        for (int rep_ = 0; rep_ < PROBE_THIN_REP; ++rep_)
        if (IN(pb + 0)) { IDS();
            const float* w = INP(IN_NMIX) + l * 1024; f32x4 wreg[4];
#pragma unroll
            for (int j = 0; j < 4; ++j) wreg[j] = ((const GAS f32x4*)w + lane)[64 * j];
            if (l == 0) {
            for (int r = gw; r < NTOK; r += 2 * NGW) { const int r2 = r + NGW < NTOK ? r + NGW : r;
                const float* s1 = r < NREG ? hin_reg + (size_t)r * 1024 : hin_meta + (size_t)((r - NREG) % meta_mod) * 1024; const float* s2 = r2 < NREG ? hin_reg + (size_t)r2 * 1024 : hin_meta + (size_t)((r2 - NREG) % meta_mod) * 1024;
                rms_row2_to_bf16(s1, s2, wreg, act1k + (size_t)r * 1024, act1k + (size_t)r2 * 1024, lane, U8IN + (size_t)r * 1024, U8IN + (size_t)r2 * 1024, SA_IN + r, SA_IN + r2); }
            } else {
            for (int r = gw; r < NREG; r += 2 * NGW) { const int r2 = r + NGW < NREG ? r + NGW : r;
                rms_row2_to_bf16<true>((const bf16*)hreg + (size_t)r * HP, (const bf16*)hreg + (size_t)r2 * HP, wreg, act1k + (size_t)r * 1024, act1k + (size_t)r2 * 1024, lane, U8IN + (size_t)r * 1024, U8IN + (size_t)r2 * 1024, SA_IN + r, SA_IN + r2); }
            for (int r = NREG + gw; r < NTOK; r += NGW) { const float* s1 = hin_meta + (size_t)((r - NREG) % meta_mod) * 1024;
                rms_row2_to_bf16(s1, s1, wreg, act1k + (size_t)r * 1024, act1k + (size_t)r * 1024, lane, U8IN + (size_t)r * 1024, U8IN + (size_t)r * 1024, SA_IN + r, SA_IN + r); }
            }
            if (l == 0) { __syncthreads(); LAS float* scr = (LAS float*)(lds + wave * 16384);
                for (int l2 = 0; l2 < 2; ++l2) quant_mat(INP(IN_WIN) + (size_t)l2 * 1024 * 2856, 1024, 2856, WIN8 + (size_t)l2 * 2816 * 1024, SB_IN + l2 * 3072, CMAX_IN + l2 * 3072, 1, scr, gw, NGW, lane, 2816);
                for (int e = 0; e < 8; ++e) { quant_mat(INP(IN_MG) + (size_t)e * 1024 * 3584, 1024, 3584, WMGU8 + (size_t)e * 7168 * 1024, SB_MGU + e * 7168, CMAX_MGU + e * 7168, 2, scr, gw, NGW, lane);
                    quant_mat(INP(IN_MU) + (size_t)e * 1024 * 3584, 1024, 3584, WMGU8 + (size_t)e * 7168 * 1024, SB_MGU + e * 7168, CMAX_MGU + e * 7168, 3, scr, gw, NGW, lane);
                    quant_f8_mat(INP(IN_MD) + (size_t)e * 3584 * 1024, 3584, 1024, WMD8 + (size_t)e * 1024 * 3584, f8_scale(*AMAX_MD, false), scr, gw, NGW, lane); } }
        }
        SEAM(pb + 0);
#ifndef PROBE_INPROJ_REP
#define PROBE_INPROJ_REP 1
#endif
        for (int rep_ = 0; rep_ < PROBE_INPROJ_REP; ++rep_)
        if (IN(pb + 1)) { IDS();
            pg8::Gemm g{(const bf16*)U8IN, (const bf16*)(WIN8 + (size_t)l * 2816 * 1024), MP, 2816, 512}; pg8::StaticOrder S; S.init(MP, 2816, G, bid);
            pg8::EpiInProj8 E{big, SA_IN, SB_IN + l * 3072};
            pg8::gemm_phase<pg8::EpiInProj8, pg8::StaticOrder, true, true, false, false, true>(lds, g, S, E);
            const int nunits = (MP / 256) * 11, n6 = nunits % G;
            if (n6 > 0 && bid >= n6) {
                __syncthreads();
                const bf16* wdt = Win + ((size_t)l * 3072 + 2816) * 1024;
                for (int i = tid; i < 48 * 128; i += NWAVES * 64) { const int row = i >> 7, ch = i & 127; *(LAS v4u*)(lds + row * 2064 + ch * 16) = *(const GAS v4u*)(wdt + (size_t)row * 1024 + ch * 8); }
                __syncthreads();
                const int fr = lane & 15, quad = lane >> 4;
                for (int blk = (bid - n6) * NWAVES + wave; blk < MP / 16; blk += (G - n6) * NWAVES) {
                    f32x4 a0 = {0.f, 0.f, 0.f, 0.f}, a1 = a0, a2 = a0;
                    const bf16* ap = act1k + (size_t)(16 * blk + fr) * 1024 + 8 * quad;
#pragma unroll 8
                    for (int ks = 0; ks < 32; ++ks) { const bf16x8 av = *(const GAS bf16x8*)(ap + 32 * ks);
                        const LAS unsigned char* bp = lds + fr * 2064 + (32 * ks + 8 * quad) * 2;
                        a0 = __builtin_amdgcn_mfma_f32_16x16x32_bf16(av, *(const LAS bf16x8*)(bp), a0, 0, 0, 0);
                        a1 = __builtin_amdgcn_mfma_f32_16x16x32_bf16(av, *(const LAS bf16x8*)(bp + 16 * 2064), a1, 0, 0, 0);
                        a2 = __builtin_amdgcn_mfma_f32_16x16x32_bf16(av, *(const LAS bf16x8*)(bp + 32 * 2064), a2, 0, 0, 0); }
#pragma unroll
                    for (int j = 0; j < 4; ++j) { float* op = dtga + (size_t)(16 * blk + 4 * quad + j) * DGW; op[fr] = a0[j]; op[16 + fr] = a1[j]; if (fr < 8) op[32 + fr] = a2[j]; }
                }
                __syncthreads();
            }
        }
        SEAM(pb + 1);
        if (IN(pb + 2)) { IDS(); MKMP();
            for (int item = gw; item < B_ * 129 * 6; item += NGW) {
                const int cg = item % 6, rr = (item / 6) % 129, b = item / (6 * 129), c = cg * 128 + 2 * lane, t0 = rr * 32;
                float w0[5], w1[5];
#pragma unroll
                for (int j = 0; j < 5; ++j) { w0[j] = mp.conv_w[j * XW + c]; w1[j] = mp.conv_w[j * XW + c + 1]; }
                const float b0 = mp.conv_b[c], b1 = mp.conv_b[c + 1];
                unsigned xin[36];
#pragma unroll
                for (int i = 0; i < 36; ++i) { const int t = t0 - 2 + i; xin[i] = (t >= 0 && t < L_) ? *(const GAS unsigned*)(big + (size_t)row_of(b, t) * PW + PX + c) : 0u; }
#pragma unroll
                for (int i = 0; i < 32; ++i) { const int t = t0 + i;
                    if (t < L_) { float a0 = b0, a1 = b1;
#pragma unroll
                        for (int j = 0; j < 5; ++j) { a0 += w0[j] * __uint_as_float(xin[i + j] << 16); a1 += w1[j] * __uint_as_float(xin[i + j] & 0xffff0000u); }
                        a0 = a0 / (1.0f + __expf(-a0)); a1 = a1 / (1.0f + __expf(-a1));
                        *(GAS unsigned*)(tmp + (size_t)row_of(b, t) * XW + c) = pk2(a0, a1); } }
            }
            const int half = lane >> 5, pi = lane & 31;
            const float inv = __builtin_amdgcn_exp2f(-(float)(pi & 15) * 0.8304820237218406f);
            const float qw0 = mp.qn_w[2 * pi], qw1 = mp.qn_w[2 * pi + 1], kw0 = mp.kn_w[2 * pi], kw1 = mp.kn_w[2 * pi + 1];
            for (int r0 = gw; r0 < NTOK; r0 += 4 * NGW) {
                unsigned xr[4][3];
#pragma unroll
                for (int q = 0; q < 4; ++q) { const int r = r0 + q * NGW;
#pragma unroll
                    for (int k = 0; k < 3; ++k) xr[q][k] = r < NTOK ? *((const GAS unsigned*)(big + (size_t)r * PW + PAQ + (half + 2 * k) * 64) + pi) : 0u; }
#pragma unroll
                for (int q = 0; q < 4; ++q) { const int r = r0 + q * NGW;
                    if (r < NTOK) {
                const int t = r < NREG ? NM + (r % S_) : (r - NREG) % NM;
                const float pos = t < NM ? (float)(t - NM) : (pi < 16 ? (float)((t - NM) / 64) : (float)((t - NM) % 64));
                const float ang = pos * inv, cs = __cosf(ang), sn = __sinf(ang);
#pragma unroll
                for (int k = 0; k < 3; ++k) { const int slot = half + 2 * k;
                    GAS unsigned* px = (GAS unsigned*)(big + (size_t)r * PW + PAQ + slot * 64) + pi; const unsigned xv = xr[q][k];
                    const float x0 = __uint_as_float(xv << 16), x1 = __uint_as_float(xv & 0xffff0000u);
                    float ss = x0 * x0 + x1 * x1;
#pragma unroll
                    for (int o = 1; o < 32; o <<= 1) ss += __shfl_xor(ss, o);
                    const float rstd = 1.0f / sqrtf(ss * (1.0f / 64.0f) + 1e-6f);
                    const float sc = slot < 4 ? attn_body::C2 : 1.0f;
                    const float y0 = x0 * rstd * (slot < 4 ? qw0 : kw0), y1 = x1 * rstd * (slot < 4 ? qw1 : kw1);
                    *px = pk2((y0 * cs - y1 * sn) * sc, (y0 * sn + y1 * cs) * sc); }
                    } }
            }
        }
        SEAM(pb + 2);
        if (IN(pb + 3)) { IDS(); MKMP();
#ifndef PROBE_ATT_REP
#define PROBE_ATT_REP 1
#endif
#ifndef PROBE_SWA_REP
#define PROBE_SWA_REP 1
#endif
#ifndef PROBE_SSD_REP
#define PROBE_SSD_REP 1
#endif
#ifndef PROBE_GLA_REP
#define PROBE_GLA_REP 1
#endif
#ifndef PROBE_MIX_REP
#define PROBE_MIX_REP 1
#endif
            for (int rep_ = 0; rep_ < PROBE_MIX_REP; ++rep_) {
            gu32* qc = (gu32*)(ws + WS_CTL) + CW_Q + l * 2048 + rep_ * 4096;
#define Q_POP(k) ({ __syncthreads(); if (tid == 0) MISC[16] = __hip_atomic_fetch_add(qc + 64 * (k), 1u, __ATOMIC_RELAXED, __HIP_MEMORY_SCOPE_AGENT); __syncthreads(); (int)MISC[16]; })
            for (;;) { const int u_ = Q_POP(0); if (u_ >= 64 * PROBE_SSD_REP) break; const int u = u_ & 63; const int b = u >> 3, h = (u >> 1) & 3, dir = u & 1;
                mix::ssd_stream(b, h, dir, tmp, dtga, mp.dt_bias[dir * 4 + h], -expf(mp.a_log[dir * 4 + h]), dir == 0 ? act1k : big + PX, dir == 0 ? 1024 : PW, (mix::lp)lds); }
            for (;;) { const int u_ = Q_POP(1); if (u_ >= 64 * PROBE_GLA_REP) break; const int u = u_ & 63; const int b = u >> 3, h = (u >> 1) & 3, dir = u & 1;
                mix::gla_stream(b, h, dir, big, dtga, mp.gate_w2, mp.gate_b, dir == 0 ? act1k + 256 : big + PB, dir == 0 ? 1024 : PW, (mix::lp)lds); }
            const int x0 = (int)(xb_xcc_id() & 7u), nmeta = l == 0 ? 2 : 0, nper = 64 + nmeta;
            for (int k = 0; k < 8; ++k) { const int q = (x0 + k) & 7;
                for (;;) { const int u_ = Q_POP(2 + q); if (u_ >= nper * PROBE_ATT_REP) break; const int u = u_ % nper;
                    const int r = u - nmeta, bg = 2 * q + (u < nmeta ? u : (r >> 5)), qb = u < nmeta ? -1 : (r & 31), b = bg >> 1, g = bg & 1;
                    attn_body::attn_unit<8, false>(b, qb, big + PAQ + g * 128, big + PAK + g * 64, big + PAV + g * 64, act1k + 768 + g * 128, (char*)lds_raw, nullptr, g); } }
            LAS float* btab = (LAS float*)(lds + 86016);
            __syncthreads();
            for (int i = tid; i < 4 * 259; i += NWAVES * 64) { const int h = i / 259, k = i % 259, rc = k - 129; btab[h * 264 + k] = (k == 0 || k == 258) ? -INFINITY : mp.rel_bias[t5_bucket(rc) * 4 + h] * 1.4426950408889634f; }
            if (tid < 4) btab[4 * 264 + tid] = mp.sink[tid] * 1.4426950408889634f;
            for (int k = 0; k < 8; ++k) { const int q = (x0 + k) & 7;
                for (;;) { const int u_ = Q_POP(10 + q); if (u_ >= nper * PROBE_SWA_REP) break; const int u = u_ % nper;
                    const int r = u - nmeta, bg = 2 * q + (u < nmeta ? u : (r >> 5)), qb = u < nmeta ? -1 : (r & 31), b = bg >> 1, g = bg & 1;
                    attn_body::attn_unit<8, true>(b, qb, big + PSQ + g * 128, big + PSK + g * 64, big + PSV + g * 64, act1k + 512 + g * 128, (char*)lds_raw, btab, g); } }
            }
#undef Q_POP
        }
        SEAM(pb + 3);
        if (IN(pb + 7)) { IDS(); MKMP();
            const f32x4 snw = *(const GAS f32x4*)(mp.ssd_norm_w + 4 * lane); const float dskv = mp.ssd_d[lane >> 4]; const f32x4 gnw = *(const GAS f32x4*)(mp.gla_norm_w + ((4 * lane) & 63));
#define BFX(q, j) __uint_as_float((unsigned)(((q) >> (16 * (j))) & 0xffffu) << 16)
            for (int r = gw; r < NTOK; r += 2 * NGW) { const int r2 = r + NGW < NTOK ? r + NGW : r; const int c0 = 4 * lane;
                unsigned long long yf[2], yb[2], xx[2], zz[2], of[2], ob[2], rr[2];
#pragma unroll
                for (int k = 0; k < 2; ++k) { const size_t rk = (size_t)(k == 0 ? r : r2);
                    yf[k] = *(const GAS unsigned long long*)(act1k + rk * 1024 + c0); yb[k] = *(const GAS unsigned long long*)(big + rk * PW + PX + c0);
                    xx[k] = *(const GAS unsigned long long*)(tmp + rk * XW + c0); zz[k] = *(const GAS unsigned long long*)(big + rk * PW + PZ + c0);
                    of[k] = *(const GAS unsigned long long*)(act1k + rk * 1024 + 256 + c0); ob[k] = *(const GAS unsigned long long*)(big + rk * PW + PB + c0); rr[k] = *(const GAS unsigned long long*)(big + rk * PW + PGR + c0); }
#pragma unroll
                for (int k = 0; k < 2; ++k) { const size_t rk = (size_t)(k == 0 ? r : r2);
                    float y[4]; float ss = 0.f;
#pragma unroll
                    for (int j = 0; j < 4; ++j) { const float zv = BFX(zz[k], j); y[j] = (BFX(yf[k], j) + BFX(yb[k], j) + dskv * BFX(xx[k], j)) * (zv / (1.0f + __expf(-zv))); ss += y[j] * y[j]; }
                    const float rstd = 1.0f / sqrtf(wave_sum(ss) * (1.0f / 256.0f) + 1e-6f);
                    float o[4]; float s2 = 0.f;
#pragma unroll
                    for (int j = 0; j < 4; ++j) { o[j] = BFX(of[k], j) + BFX(ob[k], j); s2 += o[j] * o[j]; }
#pragma unroll
                    for (int sh = 1; sh < 16; sh <<= 1) s2 += __shfl_xor(s2, sh);
                    const float rs2 = 1.0f / sqrtf(s2 * (1.0f / 64.0f) + 1e-6f);
                    float o4[4];
#pragma unroll
                    for (int j = 0; j < 4; ++j) { const float rv = BFX(rr[k], j); o4[j] = o[j] * rs2 * gnw[j] * (rv / (1.0f + __expf(-rv))); }
                    if (k == 0 || r2 != r) {
                        *(GAS unsigned long long*)(act1k + rk * 1024 + c0) = (unsigned long long)pk2(y[0] * rstd * snw.x, y[1] * rstd * snw.y) | ((unsigned long long)pk2(y[2] * rstd * snw.z, y[3] * rstd * snw.w) << 32);
                        *(GAS unsigned long long*)(act1k + rk * 1024 + 256 + c0) = (unsigned long long)pk2(o4[0], o4[1]) | ((unsigned long long)pk2(o4[2], o4[3]) << 32); } }
            }
#undef BFX
        }
        SEAM(pb + 7);
        if (IN(pb + 8)) { IDS();
            pg8::Gemm g{act1k, Wout + (size_t)l * 1024 * 1024, NREG, 1024, 1024}; pg8::StaticOrder S; S.init(NREG, 1024, G, bid);
            pg8::EpiResid<(l != 0)> E{l == 0 ? (const void*)INP(IN_X) : (const void*)hreg, (bf16*)hreg};
            pg8::gemm_phase<pg8::EpiResid<(l != 0)>, pg8::StaticOrder, true, true>(lds, g, S, E);
            if (l == 0) {
                const int fr = lane & 15, quad = lane >> 4;
                for (int task = gw; task < 8 * 32; task += NGW) { const int rb = task >> 5, cg = task & 31; f32x4 acc[2];
                    skinny_task<2>(act1k + (size_t)NREG * 1024, 1024, rb, Wout, cg * 32, 16, acc, lane);
#pragma unroll
                    for (int nb = 0; nb < 2; ++nb)
#pragma unroll
                        for (int j = 0; j < 4; ++j) { const int mr = 16 * rb + 4 * quad + j, c = cg * 32 + 16 * nb + fr; hmeta[(size_t)mr * 1024 + c] = INP(IN_META)[(size_t)(mr % 16) * 1024 + c] + acc[nb][j]; } }
            }
        }
        SEAM(pb + 8);
        if (l == 0) {
            for (int rep_ = 0; rep_ < PROBE_THIN_REP; ++rep_)
            if (IN(pb + 9)) { IDS();
                const float* w = INP(IN_NFFN); f32x4 wreg[4];
#pragma unroll
                for (int j = 0; j < 4; ++j) wreg[j] = ((const GAS f32x4*)w + lane)[64 * j];
                for (int r = gw; r < NREG; r += 2 * NGW) { const int r2 = r + NGW < NREG ? r + NGW : r;
                    rms_row2_to_bf16<true>((const bf16*)hreg + (size_t)r * HP, (const bf16*)hreg + (size_t)r2 * HP, wreg, act1k + (size_t)r * 1024, act1k + (size_t)r2 * 1024, lane, U8 + (size_t)r * 1024, U8 + (size_t)r2 * 1024, SA_U + r, SA_U + r2); }
                for (int r = NREG + gw; r < NTOK; r += NGW) { const float* s1 = hmeta + (size_t)(r - NREG) * 1024;
                    rms_row2_to_bf16(s1, s1, wreg, act1k + (size_t)r * 1024, act1k + (size_t)r * 1024, lane, U8 + (size_t)r * 1024, U8 + (size_t)r * 1024, SA_U + r, SA_U + r); }
                __syncthreads();
                { LAS float* scr = (LAS float*)(lds + wave * 16384);
                    quant_mat(INP(IN_FG), 1024, 2816, WGU8, SB_GU, CMAX_GU, 2, scr, gw, NGW, lane); quant_mat(INP(IN_FU), 1024, 2816, WGU8, SB_GU, CMAX_GU, 3, scr, gw, NGW, lane); }
            }
            SEAM(pb + 9);
#ifndef PROBE_FFNUP_REP
#define PROBE_FFNUP_REP 1
#endif
            for (int rep_ = 0; rep_ < PROBE_FFNUP_REP; ++rep_)
            if (IN(pb + 10)) { IDS();
                pg8::Gemm g{(const bf16*)U8, (const bf16*)WGU8, NREG, 5632, 512}; pg8::StaticOrder S; S.init(NREG, 5632, G, bid);
                pg8::EpiSwiGLU8 E{big, PW, 22, SA_U, SB_GU, 0, false};
                pg8::gemm_phase<pg8::EpiSwiGLU8, pg8::StaticOrder, true, true, false, false, true>(lds, g, S, E);
                { const int fr = lane & 15, quad = lane >> 4;
                    for (int task = gw; task < 8 * 176; task += NGW) { const int rb = task / 176, fg = task % 176, f0 = 16 * fg; f32x4 acc[2];
                        skinny_task<2>(act1k + (size_t)NREG * 1024, 1024, rb, Wgu, (f0 >> 7) * 256 + (f0 & 127), 128, acc, lane);
#pragma unroll
                        for (int j = 0; j < 4; ++j) { const float gg = acc[0][j], uu = acc[1][j]; big[(size_t)(NREG + 16 * rb + 4 * quad + j) * PW + f0 + fr] = f2bf(gg / (1.0f + __expf(-gg)) * uu); } } }
            }
            SEAM(pb + 10);
#ifndef PROBE_FFND_REP
#define PROBE_FFND_REP 1
#endif
            if (IN(pb + 11)) { IDS();
                pg8::Gemm g{big, Wd, NREG, 1024, 2816}; pg8::StaticOrder S; S.init(NREG, 1024, G, bid);
                for (int rep_ = 0; rep_ < PROBE_FFND_REP; ++rep_) {
                pg8::EpiResid<true> E{hreg, (bf16*)hreg, rep_ + 1 < PROBE_FFND_REP ? 0.0f : 1.0f};
                pg8::gemm_phase<pg8::EpiResid<true>, pg8::StaticOrder, true, true>(lds, g, S, E); }
                { const int fr = lane & 15, quad = lane >> 4;
                    for (int task = gw; task < 8 * 64; task += NGW) { const int rb = task >> 6, cb = task & 63; f32x4 acc[1];
                        skinny_task<1>(big + (size_t)NREG * PW, PW, rb, Wd, cb * 16, 0, acc, lane);
#pragma unroll
                        for (int j = 0; j < 4; ++j) { float* hp = hmeta + (size_t)(16 * rb + 4 * quad + j) * 1024 + cb * 16 + fr; *hp += acc[0][j]; } } }
            }
            SEAM(pb + 11);
        } else {
            for (int rep_ = 0; rep_ < PROBE_THIN_REP; ++rep_)
            if (IN(pb + 9)) { IDS();
                const float* w = INP(IN_NFFN) + 1024; const float* rw = INP(IN_ROUTER);
                LAS int* lcnt = (LAS int*)lds;
                f32x4 nwr[4];
#pragma unroll
                for (int j = 0; j < 4; ++j) nwr[j] = ((const GAS f32x4*)w + lane)[64 * j];
                f32x4 rwr[4][4][2];
#pragma unroll
                for (int j = 0; j < 4; ++j)
#pragma unroll
                    for (int c = 0; c < 4; ++c) { const GAS f32x4* rp = (const GAS f32x4*)(rw + (size_t)(4 * lane + 256 * j + c) * 8); rwr[j][c][0] = rp[0]; rwr[j][c][1] = rp[1]; }
                if (tid < 16) lcnt[tid] = 0;
                __syncthreads();
                for (int r0 = gw; r0 < NREG; r0 += 2 * NGW) {
                    f32x4 v[2][4];
#pragma unroll
                    for (int q = 0; q < 2; ++q) { const int r = r0 + q * NGW < NREG ? r0 + q * NGW : r0; const GAS unsigned long long* xr = (const GAS unsigned long long*)((const bf16*)hreg + (size_t)r * HP) + lane;
#pragma unroll
                        for (int j = 0; j < 4; ++j) v[q][j] = bf4_f32(xr[64 * j]); }
#pragma unroll
                    for (int q = 0; q < 2; ++q) { const int r = r0 + q * NGW;
                        if (r < NREG) {
                            float s = 0.f;
#pragma unroll
                            for (int j = 0; j < 4; ++j) s += (v[q][j].x * v[q][j].x + v[q][j].y * v[q][j].y) + (v[q][j].z * v[q][j].z + v[q][j].w * v[q][j].w);
                            const float rstd = 1.f / sqrtf(wave_sum(s) * (1.f / 1024.f) + 1e-6f);
                            float lg[8];
#pragma unroll
                            for (int e = 0; e < 8; ++e) lg[e] = 0.f;
                            float umx = 0.f;
#pragma unroll
                            for (int j = 0; j < 4; ++j) { const f32x4 ww = nwr[j]; const f32x4 uu = v[q][j] * rstd * ww; umx = fmaxf(fmaxf(umx, fmaxf(fabsf(uu.x), fabsf(uu.y))), fmaxf(fabsf(uu.z), fabsf(uu.w))); }
#pragma unroll
                            for (int o = 1; o < 64; o <<= 1) umx = fmaxf(umx, __shfl_xor(umx, o));
                            const float uqs = umx > 0.f ? 127.0f / umx : 0.f; if (lane == 0) SA_U[r] = umx * (1.0f / 127.0f);
#pragma unroll
                            for (int j = 0; j < 4; ++j) { const f32x4 ww = nwr[j]; const f32x4 uu = v[q][j] * rstd * ww;
                                *((GAS unsigned*)(U8 + (size_t)r * 1024) + lane + 64 * j) = ((unsigned)((int)rintf(uu.x * uqs)) & 0xffu) | (((unsigned)((int)rintf(uu.y * uqs)) & 0xffu) << 8) | (((unsigned)((int)rintf(uu.z * uqs)) & 0xffu) << 16) | (((unsigned)((int)rintf(uu.w * uqs)) & 0xffu) << 24);
#pragma unroll
                                for (int c = 0; c < 4; ++c) { const f32x4 r0_ = rwr[j][c][0], r1_ = rwr[j][c][1]; const float uc = uu[c];
                                    lg[0] += uc * r0_.x; lg[1] += uc * r0_.y; lg[2] += uc * r0_.z; lg[3] += uc * r0_.w; lg[4] += uc * r1_.x; lg[5] += uc * r1_.y; lg[6] += uc * r1_.z; lg[7] += uc * r1_.w; } }
                            const bool h5 = lane & 32, h4 = lane & 16, h3 = lane & 8; float a4[4], b2[2], c1;
#pragma unroll
                            for (int k = 0; k < 4; ++k) a4[k] = (h5 ? lg[4 + k] : lg[k]) + __shfl_xor(h5 ? lg[k] : lg[4 + k], 32);
#pragma unroll
                            for (int k = 0; k < 2; ++k) b2[k] = (h4 ? a4[2 + k] : a4[k]) + __shfl_xor(h4 ? a4[k] : a4[2 + k], 16);
                            c1 = (h3 ? b2[1] : b2[0]) + __shfl_xor(h3 ? b2[0] : b2[1], 8);
                            c1 += __shfl_xor(c1, 4); c1 += __shfl_xor(c1, 2); c1 += __shfl_xor(c1, 1);
#pragma unroll
                            for (int e = 0; e < 8; ++e) lg[e] = __shfl(c1, ((e & 4) ? 32 : 0) + ((e & 2) ? 16 : 0) + ((e & 1) ? 8 : 0));
                            int i0 = 0; float v0 = lg[0];
#pragma unroll
                            for (int e = 1; e < 8; ++e) if (lg[e] > v0) { v0 = lg[e]; i0 = e; }
                            int i1 = -1; float v1 = -3.0e38f;
#pragma unroll
                            for (int e = 0; e < 8; ++e) if (e != i0 && lg[e] > v1) { v1 = lg[e]; i1 = e; }
                            if (lane == 0) { const float g1 = 1.0f / (1.0f + __expf(v0 - v1)); const int k0 = __hip_atomic_fetch_add(lcnt + i0, 1, __ATOMIC_RELAXED, __HIP_MEMORY_SCOPE_WORKGROUP), k1 = __hip_atomic_fetch_add(lcnt + 8 + i1, 1, __ATOMIC_RELAXED, __HIP_MEMORY_SCOPE_WORKGROUP);
                                rt_e[r] = i0 | (i1 << 8); rt_rank[r] = k0 | (k1 << 16); rt_g[2 * r] = 1.0f - g1; rt_g[2 * r + 1] = g1; }
                        } }
                }
                __syncthreads();
                if (tid < 16) blkcnt[bid * 16 + tid] = lcnt[tid];
            }
            SEAM(pb + 9);
#ifndef PROBE_SORT_REP
#define PROBE_SORT_REP 1
#endif
            for (int rep_ = 0; rep_ < PROBE_SORT_REP; ++rep_)
            if (IN(PH_SORT)) { IDS();
                LAS int* tot = (LAS int*)lds; LAS int* pre = tot + 16; LAS int* roff = tot + 32; LAS int* ntl = tot + 48;
                if (tid < 64) tot[tid] = 0;
                __syncthreads();
                { const int sgm = tid & 15, part = tid >> 4; int a = 0, bfore = 0;
                    for (int k = 0; k < 8; ++k) { const int wgi = part * 8 + k; if (wgi < G) { const int cv = blkcnt[wgi * 16 + sgm]; a += cv; if (wgi < bid) bfore += cv; } }
                    __hip_atomic_fetch_add(tot + sgm, a, __ATOMIC_RELAXED, __HIP_MEMORY_SCOPE_WORKGROUP); __hip_atomic_fetch_add(pre + sgm, bfore, __ATOMIC_RELAXED, __HIP_MEMORY_SCOPE_WORKGROUP); }
                __syncthreads();
                if (tid == 0) {
                    int tile = 0, T0 = 0;
                    for (int sg = 0; sg < 16; ++sg) { const int nt = (tot[sg] + 255) >> 8; roff[sg] = tile * 256; ntl[sg] = nt; if (bid == 0) for (int k = 0; k < nt; ++k) texp[tile + k] = sg & 7; tile += nt; if (sg == 7) T0 = tile; }
                    if (bid == 0) { const int T1 = tile - T0;
                        int p1 = T0 >= 64 && T0 - 64 <= CAP_TILES ? 64 : (T0 + 1) / 2, p2 = T1 >= 64 && T1 - 64 <= CAP_TILES ? T1 - 64 : (T1 + 1) / 2;
                        passt[0] = 0; passt[1] = p1; passt[2] = T0; passt[3] = T0 + p2; passt[4] = tile; }
                }
                __syncthreads();
                if (bid < 16) { const int b0 = roff[bid] + tot[bid], b1 = roff[bid] + ntl[bid] * 256; for (int i = b0 + tid; i < b1; i += NWAVES * 64) { stok[i] = -1; stokp[permp(i)] = -1; sgate[i] = 0.f; ssa[i] = 0.f; } }
                for (int k = lane; gw + k * NGW < NREG; k += 64) { const int r = gw + k * NGW;
                    { const int e = rt_e[r], rk = rt_rank[r]; const int e0 = e & 255, e1 = 8 + (e >> 8);
                        const int p0 = roff[e0] + pre[e0] + (rk & 0xffff), p1 = roff[e1] + pre[e1] + (rk >> 16);
                        const float sar = SA_U[r];
                        stok[p0] = r; stokp[permp(p0)] = r; sgate[p0] = rt_g[2 * r]; ssa[p0] = sar; stok[p1] = r; stokp[permp(p1)] = r; sgate[p1] = rt_g[2 * r + 1]; ssa[p1] = sar; } }
#ifndef PROBE_IDENT
#define PROBE_IDENT 0
#endif
                if (PROBE_IDENT) for (long i = gtid; i < MAX_SROWS; i += (long)G * NWAVES * 64) ((int*)(ws + WS_DTGA))[i] = (int)(i & 32767);
                __syncthreads();
            }
            SEAM(PH_SORT);
#ifndef PROBE_DK_HALF
#define PROBE_DK_HALF 0
#endif
#ifndef PROBE_MOE_REP
#define PROBE_MOE_REP 1
#endif
#pragma unroll 1
            for (int p_ = 0; p_ < 5 * PROBE_MOE_REP; ++p_) { const int p = p_ % 5; const float gscale_ = p_ < 5 * (PROBE_MOE_REP - 1) ? 0.0f : 1.0f;
                OPAQUE_RANGE();
                if (IN(PH_PASS0 + p)) { IDS();
                    int nd = 0;
                    LAS int* lexd = (LAS int*)(lds + 139264); LAS int* lexg = lexd + 128;
                    if (p > 0) { const int t0 = passt[p - 1], n = passt[p] - t0; if (tid < n) lexd[tid] = texp[t0 + tid]; }
                    if (p < 4) { const int t0 = passt[p], n = passt[p + 1] - t0; if (tid < n) lexg[tid] = texp[t0 + tid]; }
                    __syncthreads();
                    if (p > 0) {
                        const int t0 = passt[p - 1], t1 = passt[p]; nd = (t1 - t0) * 4;
                        pg8::Gemm g{(const bf16*)(ws + WS_BIG + (size_t)((p - 1) & 1) * MOE_ACT_BYTES), (const bf16*)WMD8, CAP_TILES * 256, 8 * 1024, (PROBE_DK_HALF && gscale_ == 0.0f) ? 896 : 1792}; pg8::MoeOrder S{t0, t1 - t0, 4, G, bid, 0, lexd, stok, t0 * 256};
                        pg8::EpiMoeDown E{p >= 3 ? Y1LO : YLO, p >= 3 ? (long)(Y1HI - Y1LO) : (long)(YHI - YLO), stok, sgate, t0 * 256, gscale_ * f8_scale(*AMAX_MD, true)};
                        pg8::gemm_phase<pg8::EpiMoeDown, pg8::MoeOrder, true, true, false, true, false, true>(lds, g, S, E);
                    }
                    if (p < 4) {
                        const int t0 = passt[p], t1 = passt[p + 1];
                        pg8::Gemm g{(const bf16*)U8, (const bf16*)WMGU8, NREG, 8 * 7168, 512}; pg8::MoeOrder S{t0, t1 - t0, 28, G, bid, nd > G ? nd - G : 0, lexg, stok, t0 * 256, stokp};
                        pg8::EpiSwiGLU8 E{(bf16*)(ws + WS_BIG + (size_t)(p & 1) * MOE_ACT_BYTES), 3584, 28, ssa, SB_MGU, t0 * 256, true};
                        pg8::gemm_phase<pg8::EpiSwiGLU8, pg8::MoeOrder, true, true, true, false, true>(lds, g, S, E);
                    }
                }
                SEAM(PH_PASS0 + p);
            }
#ifndef PROBE_BAR_REP
#define PROBE_BAR_REP 0
#endif
            for (int rep_ = 0; rep_ < PROBE_BAR_REP; ++rep_) xcd_barrier_lean(bar);
            if (IN(PH_FINAL)) { IDS();
                const float* w = INP(IN_FINAL); f32x4 fwr[4];
#pragma unroll
                for (int j = 0; j < 4; ++j) fwr[j] = ((const GAS f32x4*)w + lane)[64 * j];
                for (int r = gw; r < NREG; r += 2 * NGW) { const int r2 = r + NGW < NREG ? r + NGW : r;
                    GAS f32x4* xa = (GAS f32x4*)(hreg + (size_t)r * 1024) + lane; GAS f32x4* xb = (GAS f32x4*)(hreg + (size_t)r2 * 1024) + lane;
                    f32x4 va[4], vb[4]; float sa = 0.f, sb = 0.f;
                    { const GAS unsigned long long* ha = (const GAS unsigned long long*)((const bf16*)hreg + (size_t)r * HP) + lane; const GAS unsigned long long* hb_ = (const GAS unsigned long long*)((const bf16*)hreg + (size_t)r2 * HP) + lane;
#pragma unroll
                    for (int j = 0; j < 4; ++j) { va[j] = bf4_f32(ha[64 * j]); vb[j] = bf4_f32(hb_[64 * j]); } }
#pragma unroll
                    for (int sl = 0; sl < 2; ++sl)
#pragma unroll
                    for (int j = 0; j < 4; ++j) { const bf16* yb_ = sl == 0 ? (j < 2 ? YLO : YHI) : (j < 2 ? Y1LO : Y1HI); const int cy = 4 * lane + 256 * (j & 1);
                        const unsigned long long qa = *(const GAS unsigned long long*)(yb_ + (size_t)r * 512 + cy), qb = *(const GAS unsigned long long*)(yb_ + (size_t)r2 * 512 + cy);
                        va[j].x += __uint_as_float((unsigned)qa << 16); va[j].y += __uint_as_float((unsigned)qa & 0xffff0000u); va[j].z += __uint_as_float((unsigned)(qa >> 32) << 16); va[j].w += __uint_as_float((unsigned)(qa >> 32) & 0xffff0000u);
                        vb[j].x += __uint_as_float((unsigned)qb << 16); vb[j].y += __uint_as_float((unsigned)qb & 0xffff0000u); vb[j].z += __uint_as_float((unsigned)(qb >> 32) << 16); vb[j].w += __uint_as_float((unsigned)(qb >> 32) & 0xffff0000u); }
#pragma unroll
                    for (int j = 0; j < 4; ++j) { sa += (va[j].x * va[j].x + va[j].y * va[j].y) + (va[j].z * va[j].z + va[j].w * va[j].w); sb += (vb[j].x * vb[j].x + vb[j].y * vb[j].y) + (vb[j].z * vb[j].z + vb[j].w * vb[j].w); }
                    const float ra = 1.f / sqrtf(wave_sum_sw(sa) * (1.f / 1024.f) + 1e-6f), rb = 1.f / sqrtf(wave_sum_sw(sb) * (1.f / 1024.f) + 1e-6f);
#pragma unroll
                    for (int j = 0; j < 4; ++j) { const f32x4 ww = fwr[j]; xa[64 * j] = va[j] * ra * ww; if (r2 != r) xb[64 * j] = vb[j] * rb * ww; }
                }
            }
        }
    }
    }
    { constexpr int l = 1;
    {
        OPAQUE_RANGE();
        const int pb = PH_L0 + 16 * l;
#define hin_reg (l == 0 ? INP(IN_X) : (const float*)hreg)
#define hin_meta (l == 0 ? INP(IN_META) : (const float*)hmeta)
        const int meta_mod = l == 0 ? 16 : 128;
#define MKMP() MixParams mp; mp.conv_w = INP(IN_CONVW) + l * 5 * 768; mp.conv_b = INP(IN_CONVB) + l * 768; mp.dt_bias = INP(IN_DTB) + l * 8; mp.a_log = INP(IN_ALOG) + l * 8; \
        mp.ssd_d = INP(IN_SSDD) + l * 4; mp.ssd_norm_w = INP(IN_SSDN) + l * 256; mp.gate_w2 = INP(IN_GW2) + l * 2 * 16 * 128; mp.gate_b = INP(IN_GB) + l * 256; \
        mp.gla_norm_w = INP(IN_GLAN) + l * 64; mp.sink = INP(IN_SINK) + l * 4; mp.qn_w = INP(IN_QN) + l * 64; mp.kn_w = INP(IN_KN) + l * 64; mp.rel_bias = INP(IN_RELB); \
        MixBuf mb{big, dtga, tmp, act1k}; (void)mb
        for (int rep_ = 0; rep_ < PROBE_THIN_REP; ++rep_)
        if (IN(pb + 0)) { IDS();
            const float* w = INP(IN_NMIX) + l * 1024; f32x4 wreg[4];
#pragma unroll
            for (int j = 0; j < 4; ++j) wreg[j] = ((const GAS f32x4*)w + lane)[64 * j];
            if (l == 0) {
            for (int r = gw; r < NTOK; r += 2 * NGW) { const int r2 = r + NGW < NTOK ? r + NGW : r;
                const float* s1 = r < NREG ? hin_reg + (size_t)r * 1024 : hin_meta + (size_t)((r - NREG) % meta_mod) * 1024; const float* s2 = r2 < NREG ? hin_reg + (size_t)r2 * 1024 : hin_meta + (size_t)((r2 - NREG) % meta_mod) * 1024;
                rms_row2_to_bf16(s1, s2, wreg, act1k + (size_t)r * 1024, act1k + (size_t)r2 * 1024, lane, U8IN + (size_t)r * 1024, U8IN + (size_t)r2 * 1024, SA_IN + r, SA_IN + r2); }
            } else {
            for (int r = gw; r < NREG; r += 2 * NGW) { const int r2 = r + NGW < NREG ? r + NGW : r;
                rms_row2_to_bf16<true>((const bf16*)hreg + (size_t)r * HP, (const bf16*)hreg + (size_t)r2 * HP, wreg, act1k + (size_t)r * 1024, act1k + (size_t)r2 * 1024, lane, U8IN + (size_t)r * 1024, U8IN + (size_t)r2 * 1024, SA_IN + r, SA_IN + r2); }
            for (int r = NREG + gw; r < NTOK; r += NGW) { const float* s1 = hin_meta + (size_t)((r - NREG) % meta_mod) * 1024;
                rms_row2_to_bf16(s1, s1, wreg, act1k + (size_t)r * 1024, act1k + (size_t)r * 1024, lane, U8IN + (size_t)r * 1024, U8IN + (size_t)r * 1024, SA_IN + r, SA_IN + r); }
            }
            if (l == 0) { __syncthreads(); LAS float* scr = (LAS float*)(lds + wave * 16384);
                for (int l2 = 0; l2 < 2; ++l2) quant_mat(INP(IN_WIN) + (size_t)l2 * 1024 * 2856, 1024, 2856, WIN8 + (size_t)l2 * 2816 * 1024, SB_IN + l2 * 3072, CMAX_IN + l2 * 3072, 1, scr, gw, NGW, lane, 2816);
                for (int e = 0; e < 8; ++e) { quant_mat(INP(IN_MG) + (size_t)e * 1024 * 3584, 1024, 3584, WMGU8 + (size_t)e * 7168 * 1024, SB_MGU + e * 7168, CMAX_MGU + e * 7168, 2, scr, gw, NGW, lane);
                    quant_mat(INP(IN_MU) + (size_t)e * 1024 * 3584, 1024, 3584, WMGU8 + (size_t)e * 7168 * 1024, SB_MGU + e * 7168, CMAX_MGU + e * 7168, 3, scr, gw, NGW, lane);
                    quant_f8_mat(INP(IN_MD) + (size_t)e * 3584 * 1024, 3584, 1024, WMD8 + (size_t)e * 1024 * 3584, f8_scale(*AMAX_MD, false), scr, gw, NGW, lane); } }
        }
        SEAM(pb + 0);
#ifndef PROBE_INPROJ_REP
#define PROBE_INPROJ_REP 1
#endif
        for (int rep_ = 0; rep_ < PROBE_INPROJ_REP; ++rep_)
        if (IN(pb + 1)) { IDS();
            pg8::Gemm g{(const bf16*)U8IN, (const bf16*)(WIN8 + (size_t)l * 2816 * 1024), MP, 2816, 512}; pg8::StaticOrder S; S.init(MP, 2816, G, bid);
            pg8::EpiInProj8 E{big, SA_IN, SB_IN + l * 3072};
            pg8::gemm_phase<pg8::EpiInProj8, pg8::StaticOrder, true, true, false, false, true>(lds, g, S, E);
            const int nunits = (MP / 256) * 11, n6 = nunits % G;
            if (n6 > 0 && bid >= n6) {
                __syncthreads();
                const bf16* wdt = Win + ((size_t)l * 3072 + 2816) * 1024;
                for (int i = tid; i < 48 * 128; i += NWAVES * 64) { const int row = i >> 7, ch = i & 127; *(LAS v4u*)(lds + row * 2064 + ch * 16) = *(const GAS v4u*)(wdt + (size_t)row * 1024 + ch * 8); }
                __syncthreads();
                const int fr = lane & 15, quad = lane >> 4;
                for (int blk = (bid - n6) * NWAVES + wave; blk < MP / 16; blk += (G - n6) * NWAVES) {
                    f32x4 a0 = {0.f, 0.f, 0.f, 0.f}, a1 = a0, a2 = a0;
                    const bf16* ap = act1k + (size_t)(16 * blk + fr) * 1024 + 8 * quad;
#pragma unroll 8
                    for (int ks = 0; ks < 32; ++ks) { const bf16x8 av = *(const GAS bf16x8*)(ap + 32 * ks);
                        const LAS unsigned char* bp = lds + fr * 2064 + (32 * ks + 8 * quad) * 2;
                        a0 = __builtin_amdgcn_mfma_f32_16x16x32_bf16(av, *(const LAS bf16x8*)(bp), a0, 0, 0, 0);
                        a1 = __builtin_amdgcn_mfma_f32_16x16x32_bf16(av, *(const LAS bf16x8*)(bp + 16 * 2064), a1, 0, 0, 0);
                        a2 = __builtin_amdgcn_mfma_f32_16x16x32_bf16(av, *(const LAS bf16x8*)(bp + 32 * 2064), a2, 0, 0, 0); }
#pragma unroll
                    for (int j = 0; j < 4; ++j) { float* op = dtga + (size_t)(16 * blk + 4 * quad + j) * DGW; op[fr] = a0[j]; op[16 + fr] = a1[j]; if (fr < 8) op[32 + fr] = a2[j]; }
                }
                __syncthreads();
            }
        }
        SEAM(pb + 1);
        if (IN(pb + 2)) { IDS(); MKMP();
            for (int item = gw; item < B_ * 129 * 6; item += NGW) {
                const int cg = item % 6, rr = (item / 6) % 129, b = item / (6 * 129), c = cg * 128 + 2 * lane, t0 = rr * 32;
                float w0[5], w1[5];
#pragma unroll
                for (int j = 0; j < 5; ++j) { w0[j] = mp.conv_w[j * XW + c]; w1[j] = mp.conv_w[j * XW + c + 1]; }
                const float b0 = mp.conv_b[c], b1 = mp.conv_b[c + 1];
                unsigned xin[36];
#pragma unroll
                for (int i = 0; i < 36; ++i) { const int t = t0 - 2 + i; xin[i] = (t >= 0 && t < L_) ? *(const GAS unsigned*)(big + (size_t)row_of(b, t) * PW + PX + c) : 0u; }
#pragma unroll
                for (int i = 0; i < 32; ++i) { const int t = t0 + i;
                    if (t < L_) { float a0 = b0, a1 = b1;
#pragma unroll
                        for (int j = 0; j < 5; ++j) { a0 += w0[j] * __uint_as_float(xin[i + j] << 16); a1 += w1[j] * __uint_as_float(xin[i + j] & 0xffff0000u); }
                        a0 = a0 / (1.0f + __expf(-a0)); a1 = a1 / (1.0f + __expf(-a1));
                        *(GAS unsigned*)(tmp + (size_t)row_of(b, t) * XW + c) = pk2(a0, a1); } }
            }
            const int half = lane >> 5, pi = lane & 31;
            const float inv = __builtin_amdgcn_exp2f(-(float)(pi & 15) * 0.8304820237218406f);
            const float qw0 = mp.qn_w[2 * pi], qw1 = mp.qn_w[2 * pi + 1], kw0 = mp.kn_w[2 * pi], kw1 = mp.kn_w[2 * pi + 1];
            for (int r0 = gw; r0 < NTOK; r0 += 4 * NGW) {
                unsigned xr[4][3];
#pragma unroll
                for (int q = 0; q < 4; ++q) { const int r = r0 + q * NGW;
#pragma unroll
                    for (int k = 0; k < 3; ++k) xr[q][k] = r < NTOK ? *((const GAS unsigned*)(big + (size_t)r * PW + PAQ + (half + 2 * k) * 64) + pi) : 0u; }
#pragma unroll
                for (int q = 0; q < 4; ++q) { const int r = r0 + q * NGW;
                    if (r < NTOK) {
                const int t = r < NREG ? NM + (r % S_) : (r - NREG) % NM;
                const float pos = t < NM ? (float)(t - NM) : (pi < 16 ? (float)((t - NM) / 64) : (float)((t - NM) % 64));
                const float ang = pos * inv, cs = __cosf(ang), sn = __sinf(ang);
#pragma unroll
                for (int k = 0; k < 3; ++k) { const int slot = half + 2 * k;
                    GAS unsigned* px = (GAS unsigned*)(big + (size_t)r * PW + PAQ + slot * 64) + pi; const unsigned xv = xr[q][k];
                    const float x0 = __uint_as_float(xv << 16), x1 = __uint_as_float(xv & 0xffff0000u);
                    float ss = x0 * x0 + x1 * x1;
#pragma unroll
                    for (int o = 1; o < 32; o <<= 1) ss += __shfl_xor(ss, o);
                    const float rstd = 1.0f / sqrtf(ss * (1.0f / 64.0f) + 1e-6f);
                    const float sc = slot < 4 ? attn_body::C2 : 1.0f;
                    const float y0 = x0 * rstd * (slot < 4 ? qw0 : kw0), y1 = x1 * rstd * (slot < 4 ? qw1 : kw1);
                    *px = pk2((y0 * cs - y1 * sn) * sc, (y0 * sn + y1 * cs) * sc); }
                    } }
            }
        }
        SEAM(pb + 2);
        if (IN(pb + 3)) { IDS(); MKMP();
#ifndef PROBE_ATT_REP
#define PROBE_ATT_REP 1
#endif
#ifndef PROBE_SWA_REP
#define PROBE_SWA_REP 1
#endif
#ifndef PROBE_SSD_REP
#define PROBE_SSD_REP 1
#endif
#ifndef PROBE_GLA_REP
#define PROBE_GLA_REP 1
#endif
#ifndef PROBE_MIX_REP
#define PROBE_MIX_REP 1
#endif
            for (int rep_ = 0; rep_ < PROBE_MIX_REP; ++rep_) {
            gu32* qc = (gu32*)(ws + WS_CTL) + CW_Q + l * 2048 + rep_ * 4096;
#define Q_POP(k) ({ __syncthreads(); if (tid == 0) MISC[16] = __hip_atomic_fetch_add(qc + 64 * (k), 1u, __ATOMIC_RELAXED, __HIP_MEMORY_SCOPE_AGENT); __syncthreads(); (int)MISC[16]; })
            for (;;) { const int u_ = Q_POP(0); if (u_ >= 64 * PROBE_SSD_REP) break; const int u = u_ & 63; const int b = u >> 3, h = (u >> 1) & 3, dir = u & 1;
                mix::ssd_stream(b, h, dir, tmp, dtga, mp.dt_bias[dir * 4 + h], -expf(mp.a_log[dir * 4 + h]), dir == 0 ? act1k : big + PX, dir == 0 ? 1024 : PW, (mix::lp)lds); }
            for (;;) { const int u_ = Q_POP(1); if (u_ >= 64 * PROBE_GLA_REP) break; const int u = u_ & 63; const int b = u >> 3, h = (u >> 1) & 3, dir = u & 1;
                mix::gla_stream(b, h, dir, big, dtga, mp.gate_w2, mp.gate_b, dir == 0 ? act1k + 256 : big + PB, dir == 0 ? 1024 : PW, (mix::lp)lds); }
            const int x0 = (int)(xb_xcc_id() & 7u), nmeta = l == 0 ? 2 : 0, nper = 64 + nmeta;
            for (int k = 0; k < 8; ++k) { const int q = (x0 + k) & 7;
                for (;;) { const int u_ = Q_POP(2 + q); if (u_ >= nper * PROBE_ATT_REP) break; const int u = u_ % nper;
                    const int r = u - nmeta, bg = 2 * q + (u < nmeta ? u : (r >> 5)), qb = u < nmeta ? -1 : (r & 31), b = bg >> 1, g = bg & 1;
                    attn_body::attn_unit<8, false>(b, qb, big + PAQ + g * 128, big + PAK + g * 64, big + PAV + g * 64, act1k + 768 + g * 128, (char*)lds_raw, nullptr, g); } }
            LAS float* btab = (LAS float*)(lds + 86016);
            __syncthreads();
            for (int i = tid; i < 4 * 259; i += NWAVES * 64) { const int h = i / 259, k = i % 259, rc = k - 129; btab[h * 264 + k] = (k == 0 || k == 258) ? -INFINITY : mp.rel_bias[t5_bucket(rc) * 4 + h] * 1.4426950408889634f; }
            if (tid < 4) btab[4 * 264 + tid] = mp.sink[tid] * 1.4426950408889634f;
            for (int k = 0; k < 8; ++k) { const int q = (x0 + k) & 7;
                for (;;) { const int u_ = Q_POP(10 + q); if (u_ >= nper * PROBE_SWA_REP) break; const int u = u_ % nper;
                    const int r = u - nmeta, bg = 2 * q + (u < nmeta ? u : (r >> 5)), qb = u < nmeta ? -1 : (r & 31), b = bg >> 1, g = bg & 1;
                    attn_body::attn_unit<8, true>(b, qb, big + PSQ + g * 128, big + PSK + g * 64, big + PSV + g * 64, act1k + 512 + g * 128, (char*)lds_raw, btab, g); } }
            }
#undef Q_POP
        }
        SEAM(pb + 3);
        if (IN(pb + 7)) { IDS(); MKMP();
            const f32x4 snw = *(const GAS f32x4*)(mp.ssd_norm_w + 4 * lane); const float dskv = mp.ssd_d[lane >> 4]; const f32x4 gnw = *(const GAS f32x4*)(mp.gla_norm_w + ((4 * lane) & 63));
#define BFX(q, j) __uint_as_float((unsigned)(((q) >> (16 * (j))) & 0xffffu) << 16)
            for (int r = gw; r < NTOK; r += 2 * NGW) { const int r2 = r + NGW < NTOK ? r + NGW : r; const int c0 = 4 * lane;
                unsigned long long yf[2], yb[2], xx[2], zz[2], of[2], ob[2], rr[2];
#pragma unroll
                for (int k = 0; k < 2; ++k) { const size_t rk = (size_t)(k == 0 ? r : r2);
                    yf[k] = *(const GAS unsigned long long*)(act1k + rk * 1024 + c0); yb[k] = *(const GAS unsigned long long*)(big + rk * PW + PX + c0);
                    xx[k] = *(const GAS unsigned long long*)(tmp + rk * XW + c0); zz[k] = *(const GAS unsigned long long*)(big + rk * PW + PZ + c0);
                    of[k] = *(const GAS unsigned long long*)(act1k + rk * 1024 + 256 + c0); ob[k] = *(const GAS unsigned long long*)(big + rk * PW + PB + c0); rr[k] = *(const GAS unsigned long long*)(big + rk * PW + PGR + c0); }
#pragma unroll
                for (int k = 0; k < 2; ++k) { const size_t rk = (size_t)(k == 0 ? r : r2);
                    float y[4]; float ss = 0.f;
#pragma unroll
                    for (int j = 0; j < 4; ++j) { const float zv = BFX(zz[k], j); y[j] = (BFX(yf[k], j) + BFX(yb[k], j) + dskv * BFX(xx[k], j)) * (zv / (1.0f + __expf(-zv))); ss += y[j] * y[j]; }
                    const float rstd = 1.0f / sqrtf(wave_sum(ss) * (1.0f / 256.0f) + 1e-6f);
                    float o[4]; float s2 = 0.f;
#pragma unroll
                    for (int j = 0; j < 4; ++j) { o[j] = BFX(of[k], j) + BFX(ob[k], j); s2 += o[j] * o[j]; }
#pragma unroll
                    for (int sh = 1; sh < 16; sh <<= 1) s2 += __shfl_xor(s2, sh);
                    const float rs2 = 1.0f / sqrtf(s2 * (1.0f / 64.0f) + 1e-6f);
                    float o4[4];
#pragma unroll
                    for (int j = 0; j < 4; ++j) { const float rv = BFX(rr[k], j); o4[j] = o[j] * rs2 * gnw[j] * (rv / (1.0f + __expf(-rv))); }
                    if (k == 0 || r2 != r) {
                        *(GAS unsigned long long*)(act1k + rk * 1024 + c0) = (unsigned long long)pk2(y[0] * rstd * snw.x, y[1] * rstd * snw.y) | ((unsigned long long)pk2(y[2] * rstd * snw.z, y[3] * rstd * snw.w) << 32);
                        *(GAS unsigned long long*)(act1k + rk * 1024 + 256 + c0) = (unsigned long long)pk2(o4[0], o4[1]) | ((unsigned long long)pk2(o4[2], o4[3]) << 32); } }
            }
#undef BFX
        }
        SEAM(pb + 7);
        if (IN(pb + 8)) { IDS();
            pg8::Gemm g{act1k, Wout + (size_t)l * 1024 * 1024, NREG, 1024, 1024}; pg8::StaticOrder S; S.init(NREG, 1024, G, bid);
            pg8::EpiResid<(l != 0)> E{l == 0 ? (const void*)INP(IN_X) : (const void*)hreg, (bf16*)hreg};
            pg8::gemm_phase<pg8::EpiResid<(l != 0)>, pg8::StaticOrder, true, true>(lds, g, S, E);
            if (l == 0) {
                const int fr = lane & 15, quad = lane >> 4;
                for (int task = gw; task < 8 * 32; task += NGW) { const int rb = task >> 5, cg = task & 31; f32x4 acc[2];
                    skinny_task<2>(act1k + (size_t)NREG * 1024, 1024, rb, Wout, cg * 32, 16, acc, lane);
#pragma unroll
                    for (int nb = 0; nb < 2; ++nb)
#pragma unroll
                        for (int j = 0; j < 4; ++j) { const int mr = 16 * rb + 4 * quad + j, c = cg * 32 + 16 * nb + fr; hmeta[(size_t)mr * 1024 + c] = INP(IN_META)[(size_t)(mr % 16) * 1024 + c] + acc[nb][j]; } }
            }
        }
        SEAM(pb + 8);
        if (l == 0) {
            for (int rep_ = 0; rep_ < PROBE_THIN_REP; ++rep_)
            if (IN(pb + 9)) { IDS();
                const float* w = INP(IN_NFFN); f32x4 wreg[4];
#pragma unroll
                for (int j = 0; j < 4; ++j) wreg[j] = ((const GAS f32x4*)w + lane)[64 * j];
                for (int r = gw; r < NREG; r += 2 * NGW) { const int r2 = r + NGW < NREG ? r + NGW : r;
                    rms_row2_to_bf16<true>((const bf16*)hreg + (size_t)r * HP, (const bf16*)hreg + (size_t)r2 * HP, wreg, act1k + (size_t)r * 1024, act1k + (size_t)r2 * 1024, lane, U8 + (size_t)r * 1024, U8 + (size_t)r2 * 1024, SA_U + r, SA_U + r2); }
                for (int r = NREG + gw; r < NTOK; r += NGW) { const float* s1 = hmeta + (size_t)(r - NREG) * 1024;
                    rms_row2_to_bf16(s1, s1, wreg, act1k + (size_t)r * 1024, act1k + (size_t)r * 1024, lane, U8 + (size_t)r * 1024, U8 + (size_t)r * 1024, SA_U + r, SA_U + r); }
                __syncthreads();
                { LAS float* scr = (LAS float*)(lds + wave * 16384);
                    quant_mat(INP(IN_FG), 1024, 2816, WGU8, SB_GU, CMAX_GU, 2, scr, gw, NGW, lane); quant_mat(INP(IN_FU), 1024, 2816, WGU8, SB_GU, CMAX_GU, 3, scr, gw, NGW, lane); }
            }
            SEAM(pb + 9);
#ifndef PROBE_FFNUP_REP
#define PROBE_FFNUP_REP 1
#endif
            for (int rep_ = 0; rep_ < PROBE_FFNUP_REP; ++rep_)
            if (IN(pb + 10)) { IDS();
                pg8::Gemm g{(const bf16*)U8, (const bf16*)WGU8, NREG, 5632, 512}; pg8::StaticOrder S; S.init(NREG, 5632, G, bid);
                pg8::EpiSwiGLU8 E{big, PW, 22, SA_U, SB_GU, 0, false};
                pg8::gemm_phase<pg8::EpiSwiGLU8, pg8::StaticOrder, true, true, false, false, true>(lds, g, S, E);
                { const int fr = lane & 15, quad = lane >> 4;
                    for (int task = gw; task < 8 * 176; task += NGW) { const int rb = task / 176, fg = task % 176, f0 = 16 * fg; f32x4 acc[2];
                        skinny_task<2>(act1k + (size_t)NREG * 1024, 1024, rb, Wgu, (f0 >> 7) * 256 + (f0 & 127), 128, acc, lane);
#pragma unroll
                        for (int j = 0; j < 4; ++j) { const float gg = acc[0][j], uu = acc[1][j]; big[(size_t)(NREG + 16 * rb + 4 * quad + j) * PW + f0 + fr] = f2bf(gg / (1.0f + __expf(-gg)) * uu); } } }
            }
            SEAM(pb + 10);
#ifndef PROBE_FFND_REP
#define PROBE_FFND_REP 1
#endif
            if (IN(pb + 11)) { IDS();
                pg8::Gemm g{big, Wd, NREG, 1024, 2816}; pg8::StaticOrder S; S.init(NREG, 1024, G, bid);
                for (int rep_ = 0; rep_ < PROBE_FFND_REP; ++rep_) {
                pg8::EpiResid<true> E{hreg, (bf16*)hreg, rep_ + 1 < PROBE_FFND_REP ? 0.0f : 1.0f};
                pg8::gemm_phase<pg8::EpiResid<true>, pg8::StaticOrder, true, true>(lds, g, S, E); }
                { const int fr = lane & 15, quad = lane >> 4;
                    for (int task = gw; task < 8 * 64; task += NGW) { const int rb = task >> 6, cb = task & 63; f32x4 acc[1];
                        skinny_task<1>(big + (size_t)NREG * PW, PW, rb, Wd, cb * 16, 0, acc, lane);
#pragma unroll
                        for (int j = 0; j < 4; ++j) { float* hp = hmeta + (size_t)(16 * rb + 4 * quad + j) * 1024 + cb * 16 + fr; *hp += acc[0][j]; } } }
            }
            SEAM(pb + 11);
        } else {
            for (int rep_ = 0; rep_ < PROBE_THIN_REP; ++rep_)
            if (IN(pb + 9)) { IDS();
                const float* w = INP(IN_NFFN) + 1024; const float* rw = INP(IN_ROUTER);
                LAS int* lcnt = (LAS int*)lds;
                f32x4 nwr[4];
#pragma unroll
                for (int j = 0; j < 4; ++j) nwr[j] = ((const GAS f32x4*)w + lane)[64 * j];
                f32x4 rwr[4][4][2];
#pragma unroll
                for (int j = 0; j < 4; ++j)
#pragma unroll
                    for (int c = 0; c < 4; ++c) { const GAS f32x4* rp = (const GAS f32x4*)(rw + (size_t)(4 * lane + 256 * j + c) * 8); rwr[j][c][0] = rp[0]; rwr[j][c][1] = rp[1]; }
                if (tid < 16) lcnt[tid] = 0;
                __syncthreads();
                for (int r0 = gw; r0 < NREG; r0 += 2 * NGW) {
                    f32x4 v[2][4];
#pragma unroll
                    for (int q = 0; q < 2; ++q) { const int r = r0 + q * NGW < NREG ? r0 + q * NGW : r0; const GAS unsigned long long* xr = (const GAS unsigned long long*)((const bf16*)hreg + (size_t)r * HP) + lane;
#pragma unroll
                        for (int j = 0; j < 4; ++j) v[q][j] = bf4_f32(xr[64 * j]); }
#pragma unroll
                    for (int q = 0; q < 2; ++q) { const int r = r0 + q * NGW;
                        if (r < NREG) {
                            float s = 0.f;
#pragma unroll
                            for (int j = 0; j < 4; ++j) s += (v[q][j].x * v[q][j].x + v[q][j].y * v[q][j].y) + (v[q][j].z * v[q][j].z + v[q][j].w * v[q][j].w);
                            const float rstd = 1.f / sqrtf(wave_sum(s) * (1.f / 1024.f) + 1e-6f);
                            float lg[8];
#pragma unroll
                            for (int e = 0; e < 8; ++e) lg[e] = 0.f;
                            float umx = 0.f;
#pragma unroll
                            for (int j = 0; j < 4; ++j) { const f32x4 ww = nwr[j]; const f32x4 uu = v[q][j] * rstd * ww; umx = fmaxf(fmaxf(umx, fmaxf(fabsf(uu.x), fabsf(uu.y))), fmaxf(fabsf(uu.z), fabsf(uu.w))); }
#pragma unroll
                            for (int o = 1; o < 64; o <<= 1) umx = fmaxf(umx, __shfl_xor(umx, o));
                            const float uqs = umx > 0.f ? 127.0f / umx : 0.f; if (lane == 0) SA_U[r] = umx * (1.0f / 127.0f);
#pragma unroll
                            for (int j = 0; j < 4; ++j) { const f32x4 ww = nwr[j]; const f32x4 uu = v[q][j] * rstd * ww;
                                *((GAS unsigned*)(U8 + (size_t)r * 1024) + lane + 64 * j) = ((unsigned)((int)rintf(uu.x * uqs)) & 0xffu) | (((unsigned)((int)rintf(uu.y * uqs)) & 0xffu) << 8) | (((unsigned)((int)rintf(uu.z * uqs)) & 0xffu) << 16) | (((unsigned)((int)rintf(uu.w * uqs)) & 0xffu) << 24);
#pragma unroll
                                for (int c = 0; c < 4; ++c) { const f32x4 r0_ = rwr[j][c][0], r1_ = rwr[j][c][1]; const float uc = uu[c];
                                    lg[0] += uc * r0_.x; lg[1] += uc * r0_.y; lg[2] += uc * r0_.z; lg[3] += uc * r0_.w; lg[4] += uc * r1_.x; lg[5] += uc * r1_.y; lg[6] += uc * r1_.z; lg[7] += uc * r1_.w; } }
                            const bool h5 = lane & 32, h4 = lane & 16, h3 = lane & 8; float a4[4], b2[2], c1;
#pragma unroll
                            for (int k = 0; k < 4; ++k) a4[k] = (h5 ? lg[4 + k] : lg[k]) + __shfl_xor(h5 ? lg[k] : lg[4 + k], 32);
#pragma unroll
                            for (int k = 0; k < 2; ++k) b2[k] = (h4 ? a4[2 + k] : a4[k]) + __shfl_xor(h4 ? a4[k] : a4[2 + k], 16);
                            c1 = (h3 ? b2[1] : b2[0]) + __shfl_xor(h3 ? b2[0] : b2[1], 8);
                            c1 += __shfl_xor(c1, 4); c1 += __shfl_xor(c1, 2); c1 += __shfl_xor(c1, 1);
#pragma unroll
                            for (int e = 0; e < 8; ++e) lg[e] = __shfl(c1, ((e & 4) ? 32 : 0) + ((e & 2) ? 16 : 0) + ((e & 1) ? 8 : 0));
                            int i0 = 0; float v0 = lg[0];
#pragma unroll
                            for (int e = 1; e < 8; ++e) if (lg[e] > v0) { v0 = lg[e]; i0 = e; }
                            int i1 = -1; float v1 = -3.0e38f;
#pragma unroll
                            for (int e = 0; e < 8; ++e) if (e != i0 && lg[e] > v1) { v1 = lg[e]; i1 = e; }
                            if (lane == 0) { const float g1 = 1.0f / (1.0f + __expf(v0 - v1)); const int k0 = __hip_atomic_fetch_add(lcnt + i0, 1, __ATOMIC_RELAXED, __HIP_MEMORY_SCOPE_WORKGROUP), k1 = __hip_atomic_fetch_add(lcnt + 8 + i1, 1, __ATOMIC_RELAXED, __HIP_MEMORY_SCOPE_WORKGROUP);
                                rt_e[r] = i0 | (i1 << 8); rt_rank[r] = k0 | (k1 << 16); rt_g[2 * r] = 1.0f - g1; rt_g[2 * r + 1] = g1; }
                        } }
                }
                __syncthreads();
                if (tid < 16) blkcnt[bid * 16 + tid] = lcnt[tid];
            }
            SEAM(pb + 9);
#ifndef PROBE_SORT_REP
#define PROBE_SORT_REP 1
#endif
            for (int rep_ = 0; rep_ < PROBE_SORT_REP; ++rep_)
            if (IN(PH_SORT)) { IDS();
                LAS int* tot = (LAS int*)lds; LAS int* pre = tot + 16; LAS int* roff = tot + 32; LAS int* ntl = tot + 48;
                if (tid < 64) tot[tid] = 0;
                __syncthreads();
                { const int sgm = tid & 15, part = tid >> 4; int a = 0, bfore = 0;
                    for (int k = 0; k < 8; ++k) { const int wgi = part * 8 + k; if (wgi < G) { const int cv = blkcnt[wgi * 16 + sgm]; a += cv; if (wgi < bid) bfore += cv; } }
                    __hip_atomic_fetch_add(tot + sgm, a, __ATOMIC_RELAXED, __HIP_MEMORY_SCOPE_WORKGROUP); __hip_atomic_fetch_add(pre + sgm, bfore, __ATOMIC_RELAXED, __HIP_MEMORY_SCOPE_WORKGROUP); }
                __syncthreads();
                if (tid == 0) {
                    int tile = 0, T0 = 0;
                    for (int sg = 0; sg < 16; ++sg) { const int nt = (tot[sg] + 255) >> 8; roff[sg] = tile * 256; ntl[sg] = nt; if (bid == 0) for (int k = 0; k < nt; ++k) texp[tile + k] = sg & 7; tile += nt; if (sg == 7) T0 = tile; }
                    if (bid == 0) { const int T1 = tile - T0;
                        int p1 = T0 >= 64 && T0 - 64 <= CAP_TILES ? 64 : (T0 + 1) / 2, p2 = T1 >= 64 && T1 - 64 <= CAP_TILES ? T1 - 64 : (T1 + 1) / 2;
                        passt[0] = 0; passt[1] = p1; passt[2] = T0; passt[3] = T0 + p2; passt[4] = tile; }
                }
                __syncthreads();
                if (bid < 16) { const int b0 = roff[bid] + tot[bid], b1 = roff[bid] + ntl[bid] * 256; for (int i = b0 + tid; i < b1; i += NWAVES * 64) { stok[i] = -1; stokp[permp(i)] = -1; sgate[i] = 0.f; ssa[i] = 0.f; } }
                for (int k = lane; gw + k * NGW < NREG; k += 64) { const int r = gw + k * NGW;
                    { const int e = rt_e[r], rk = rt_rank[r]; const int e0 = e & 255, e1 = 8 + (e >> 8);
                        const int p0 = roff[e0] + pre[e0] + (rk & 0xffff), p1 = roff[e1] + pre[e1] + (rk >> 16);
                        const float sar = SA_U[r];
                        stok[p0] = r; stokp[permp(p0)] = r; sgate[p0] = rt_g[2 * r]; ssa[p0] = sar; stok[p1] = r; stokp[permp(p1)] = r; sgate[p1] = rt_g[2 * r + 1]; ssa[p1] = sar; } }
#ifndef PROBE_IDENT
#define PROBE_IDENT 0
#endif
                if (PROBE_IDENT) for (long i = gtid; i < MAX_SROWS; i += (long)G * NWAVES * 64) ((int*)(ws + WS_DTGA))[i] = (int)(i & 32767);
                __syncthreads();
            }
            SEAM(PH_SORT);
#ifndef PROBE_DK_HALF
#define PROBE_DK_HALF 0
#endif
#ifndef PROBE_MOE_REP
#define PROBE_MOE_REP 1
#endif
#pragma unroll 1
            for (int p_ = 0; p_ < 5 * PROBE_MOE_REP; ++p_) { const int p = p_ % 5; const float gscale_ = p_ < 5 * (PROBE_MOE_REP - 1) ? 0.0f : 1.0f;
                OPAQUE_RANGE();
                if (IN(PH_PASS0 + p)) { IDS();
                    int nd = 0;
                    LAS int* lexd = (LAS int*)(lds + 139264); LAS int* lexg = lexd + 128;
                    if (p > 0) { const int t0 = passt[p - 1], n = passt[p] - t0; if (tid < n) lexd[tid] = texp[t0 + tid]; }
                    if (p < 4) { const int t0 = passt[p], n = passt[p + 1] - t0; if (tid < n) lexg[tid] = texp[t0 + tid]; }
                    __syncthreads();
                    if (p > 0) {
                        const int t0 = passt[p - 1], t1 = passt[p]; nd = (t1 - t0) * 4;
                        pg8::Gemm g{(const bf16*)(ws + WS_BIG + (size_t)((p - 1) & 1) * MOE_ACT_BYTES), (const bf16*)WMD8, CAP_TILES * 256, 8 * 1024, (PROBE_DK_HALF && gscale_ == 0.0f) ? 896 : 1792}; pg8::MoeOrder S{t0, t1 - t0, 4, G, bid, 0, lexd, stok, t0 * 256};
                        pg8::EpiMoeDown E{p >= 3 ? Y1LO : YLO, p >= 3 ? (long)(Y1HI - Y1LO) : (long)(YHI - YLO), stok, sgate, t0 * 256, gscale_ * f8_scale(*AMAX_MD, true)};
                        pg8::gemm_phase<pg8::EpiMoeDown, pg8::MoeOrder, true, true, false, true, false, true>(lds, g, S, E);
                    }
                    if (p < 4) {
                        const int t0 = passt[p], t1 = passt[p + 1];
                        pg8::Gemm g{(const bf16*)U8, (const bf16*)WMGU8, NREG, 8 * 7168, 512}; pg8::MoeOrder S{t0, t1 - t0, 28, G, bid, nd > G ? nd - G : 0, lexg, stok, t0 * 256, stokp};
                        pg8::EpiSwiGLU8 E{(bf16*)(ws + WS_BIG + (size_t)(p & 1) * MOE_ACT_BYTES), 3584, 28, ssa, SB_MGU, t0 * 256, true};
                        pg8::gemm_phase<pg8::EpiSwiGLU8, pg8::MoeOrder, true, true, true, false, true>(lds, g, S, E);
                    }
                }
                SEAM(PH_PASS0 + p);
            }
#ifndef PROBE_BAR_REP
#define PROBE_BAR_REP 0
#endif
            for (int rep_ = 0; rep_ < PROBE_BAR_REP; ++rep_) xcd_barrier_lean(bar);
            if (IN(PH_FINAL)) { IDS();
                const float* w = INP(IN_FINAL); f32x4 fwr[4];
#pragma unroll
                for (int j = 0; j < 4; ++j) fwr[j] = ((const GAS f32x4*)w + lane)[64 * j];
                for (int r = gw; r < NREG; r += 2 * NGW) { const int r2 = r + NGW < NREG ? r + NGW : r;
                    GAS f32x4* xa = (GAS f32x4*)(hreg + (size_t)r * 1024) + lane; GAS f32x4* xb = (GAS f32x4*)(hreg + (size_t)r2 * 1024) + lane;
                    f32x4 va[4], vb[4]; float sa = 0.f, sb = 0.f;
                    { const GAS unsigned long long* ha = (const GAS unsigned long long*)((const bf16*)hreg + (size_t)r * HP) + lane; const GAS unsigned long long* hb_ = (const GAS unsigned long long*)((const bf16*)hreg + (size_t)r2 * HP) + lane;
#pragma unroll
                    for (int j = 0; j < 4; ++j) { va[j] = bf4_f32(ha[64 * j]); vb[j] = bf4_f32(hb_[64 * j]); } }
#pragma unroll
                    for (int sl = 0; sl < 2; ++sl)
#pragma unroll
                    for (int j = 0; j < 4; ++j) { const bf16* yb_ = sl == 0 ? (j < 2 ? YLO : YHI) : (j < 2 ? Y1LO : Y1HI); const int cy = 4 * lane + 256 * (j & 1);
                        const unsigned long long qa = *(const GAS unsigned long long*)(yb_ + (size_t)r * 512 + cy), qb = *(const GAS unsigned long long*)(yb_ + (size_t)r2 * 512 + cy);
                        va[j].x += __uint_as_float((unsigned)qa << 16); va[j].y += __uint_as_float((unsigned)qa & 0xffff0000u); va[j].z += __uint_as_float((unsigned)(qa >> 32) << 16); va[j].w += __uint_as_float((unsigned)(qa >> 32) & 0xffff0000u);
                        vb[j].x += __uint_as_float((unsigned)qb << 16); vb[j].y += __uint_as_float((unsigned)qb & 0xffff0000u); vb[j].z += __uint_as_float((unsigned)(qb >> 32) << 16); vb[j].w += __uint_as_float((unsigned)(qb >> 32) & 0xffff0000u); }
#pragma unroll
                    for (int j = 0; j < 4; ++j) { sa += (va[j].x * va[j].x + va[j].y * va[j].y) + (va[j].z * va[j].z + va[j].w * va[j].w); sb += (vb[j].x * vb[j].x + vb[j].y * vb[j].y) + (vb[j].z * vb[j].z + vb[j].w * vb[j].w); }
                    const float ra = 1.f / sqrtf(wave_sum_sw(sa) * (1.f / 1024.f) + 1e-6f), rb = 1.f / sqrtf(wave_sum_sw(sb) * (1.f / 1024.f) + 1e-6f);
#pragma unroll
                    for (int j = 0; j < 4; ++j) { const f32x4 ww = fwr[j]; xa[64 * j] = va[j] * ra * ww; if (r2 != r) xb[64 * j] = vb[j] * rb * ww; }
                }
            }
        }
    }
    }

#undef IN
#undef SEAM
}

extern "C" void kernel_launch(void* const* d_in, const int* in_sizes, int n_in, void* d_out, int out_size, void* d_ws, size_t ws_size, hipStream_t stream) {
    static int grid = 0;
    if (grid == 0) {
        if (n_in != 27 || ws_size < WS_END || out_size != NREG * 1024) { fprintf(stderr, "kernel_launch: unexpected problem (n_in %d, ws %zu, out %d)\n", n_in, ws_size, out_size); grid = -1; return; }
        int dev = 0, cus = 0;
        if (hipGetDevice(&dev) != hipSuccess || hipDeviceGetAttribute(&cus, hipDeviceAttributeMultiprocessorCount, dev) != hipSuccess) { grid = -1; return; }
        if (hipFuncSetAttribute((const void*)fwd_kernel, hipFuncAttributeMaxDynamicSharedMemorySize, LDS_BYTES) != hipSuccess) { fprintf(stderr, "kernel_launch: hipFuncSetAttribute failed\n"); grid = -1; return; }
        int per_cu = 0;
        if (hipOccupancyMaxActiveBlocksPerMultiprocessor(&per_cu, (const void*)fwd_kernel, NWAVES * 64, LDS_BYTES) != hipSuccess || per_cu < 1) fprintf(stderr, "kernel_launch: occupancy query reports %d workgroups per CU\n", per_cu);
        (void)hipGetLastError();
        grid = cus;
    }
    if (grid < 0) return;
    (void)hipMemsetAsync((char*)d_ws + WS_CTL, 0, CTL_ZERO_BYTES, stream);
    Args a{};
    for (int i = 0; i < 27; ++i) a.in[i] = (const float*)d_in[i];
    a.out = (float*)d_out; a.ws = (unsigned char*)d_ws;
#if N_LAUNCH_MODE == 1
    a.ph_lo = 0; a.ph_hi = PH_END;
    hipLaunchKernelGGL(fwd_kernel, dim3(grid), dim3(NWAVES * 64), LDS_BYTES, stream, a);
#else
    for (int ph = 0; ph < PH_END; ++ph) {
        const bool used = ph == 0 || (ph >= PH_L0 && ph < PH_L0 + 12) || (ph >= PH_L1 && ph < PH_L1 + 10) || ph >= PH_SORT;
        if (!used) continue;
        a.ph_lo = ph; a.ph_hi = ph + 1;
        hipLaunchKernelGGL(fwd_kernel, dim3(grid), dim3(NWAVES * 64), LDS_BYTES, stream, a);
    }
#endif
}
```

```cpp
#include <hip/hip_runtime.h>
#include <cstdio>
#include <cstdint>
#include <cmath>
#define HD_INLINE __device__ __forceinline__
#ifndef CFG_BATCH
#define CFG_BATCH 8
#endif
#ifndef CFG_SEQ
#define CFG_SEQ 4096
#endif
constexpr int B_ = CFG_BATCH, S_ = CFG_SEQ, NM = 16, L_ = S_ + NM;
constexpr int NREG = B_ * S_, NTOK = NREG + B_ * NM, MP = ((NTOK + 255) / 256) * 256;
constexpr int PW = 2816;
constexpr int PZ = 0, PX = 256, PB = 512, PC = 768, PGQ = 1024, PGK = 1152, PGV = 1280, PGR = 1536, PSQ = 1792, PSK = 2048, PSV = 2176, PAQ = 2304, PAK = 2560, PAV = 2688;
constexpr int DGW = 64;
constexpr int XW = 768;
typedef unsigned short bf16;

#ifdef __HIP_DEVICE_COMPILE__
#define FAST_COS(x) __cosf(x)
#define FAST_SIN(x) __sinf(x)
#else
#define FAST_COS(x) cosf(x)
#define FAST_SIN(x) sinf(x)
#endif
#define ROPE_INV(j) __builtin_exp2f(-(float)(j) * 0.8304820237218406f)
HD_INLINE int row_of(int b, int t) { return t < NM ? NREG + b * NM + t : b * S_ + (t - NM); }
HD_INLINE float bf2f(bf16 v) { unsigned u = ((unsigned)v) << 16; float f; __builtin_memcpy(&f, &u, 4); return f; }
HD_INLINE bf16 f2bf(float f) { unsigned u; __builtin_memcpy(&u, &f, 4); return (bf16)((u + 0x7fffu + ((u >> 16) & 1u)) >> 16); }
HD_INLINE float siluf(float x) { return x / (1.0f + expf(-x)); }
HD_INLINE float softplusf(float x) { return x > 20.f ? x : log1pf(expf(x)); }
HD_INLINE float logsigmoidf(float x) { return x >= 0.f ? -log1pf(expf(-x)) : x - log1pf(expf(x)); }
HD_INLINE int t5_bucket(int rel) {
    const int a = rel < 0 ? -rel : rel, base = rel > 0 ? 16 : 0;
    if (a < 8) return base + a;
    const int k = (a >= 12) + (a >= 16) + (a >= 23) + (a >= 32) + (a >= 46) + (a >= 64) + (a >= 91);
    return base + 8 + k;
}

struct MixParams {
    const float *conv_w, *conv_b, *dt_bias, *a_log, *ssd_d, *ssd_norm_w, *gate_w2, *gate_b, *gla_norm_w, *sink, *qn_w, *kn_w, *rel_bias;
};
struct MixBuf { bf16* proj; const float* dtga; bf16* xbca; bf16* mixed; };

HD_INLINE void nv_conv(const MixBuf& m, const MixParams& p, long gtid, long nthreads) {
    for (long idx = gtid; idx < (long)B_ * L_ * XW; idx += nthreads) {
        const int c = (int)(idx % XW); const long bt = idx / XW; const int t = (int)(bt % L_), b = (int)(bt / L_);
        float acc = p.conv_b[c];
        for (int j = 0; j < 5; ++j) { const int tt = t + j - 2; if (tt >= 0 && tt < L_) acc += p.conv_w[j * XW + c] * bf2f(m.proj[(size_t)row_of(b, tt) * PW + PX + c]); }
        m.xbca[(size_t)row_of(b, t) * XW + c] = f2bf(siluf(acc));
    }
}

namespace pg8 {
#define PG8_LAS __attribute__((address_space(3)))
typedef unsigned short bf16_t;
typedef short bf16x8 __attribute__((ext_vector_type(8)));
typedef float f32x4 __attribute__((ext_vector_type(4)));
typedef unsigned u32x4 __attribute__((ext_vector_type(4)));
constexpr int BM = 256, BK = 64, HALF = 128, HTB = HALF * BK * 2  , STAGE_BYTES = 8 * HTB, NXCD = 8, WGM = 8;

__host__ __device__ __forceinline__ int lds_byte(int r, int c) { const int st = (r >> 4) * 2 + (c >> 5), rr = r & 15, cc = c & 31, ob = rr * 64 + cc * 2; return st * 1024 + (ob ^ (((ob >> 9) & 1) << 5)); }
__host__ __device__ __forceinline__ void stage_rc(int b, int& R, int& C) { const int st = b / 1024, sb = b % 1024, swz = sb ^ (((sb >> 9) & 1) << 5); R = (st >> 1) * 16 + swz / 64; C = (st & 1) * 32 + (swz % 64) / 2; }
__host__ __device__ __forceinline__ int perm32(int rho) { const int n = rho >> 4, i = rho & 15; return 8 * (i >> 2) + 4 * n + (i & 3); }

struct Unit { int pm, pn; };
struct Gemm { const bf16_t* A; const bf16_t* Bt; int M, N, K; };

struct StaticOrder {
    int nM, nN, nwg, G, c;
    __host__ __device__ void init(int M, int N, int G_, int c_) { nM = M / BM; nN = N / BM; nwg = nM * nN; G = G_; c = c_; }
    __host__ __device__ bool next(int i, Unit& u) const {
        const long L = (long)i * G + c; if (L >= nwg) return false;
        int wgid = (int)L; { const int q = nwg / NXCD, r = nwg % NXCD, xcd = wgid % NXCD, off = wgid / NXCD; wgid = (xcd < r ? xcd * (q + 1) : r * (q + 1) + (xcd - r) * q) + off; }
        const int nig = WGM * nN, gid = wgid / nig, fm = gid * WGM, gsz = (nM - fm) < WGM ? (nM - fm) : WGM;
        u.pm = fm + ((wgid % nig) % gsz); u.pn = (wgid % nig) / gsz; return true;
    }
    __device__ __forceinline__ void a_ready(const Unit&) const {}
    __device__ __forceinline__ void done(const Unit&) const {}
};

__device__ __forceinline__ unsigned cvt_pk_bf16(float lo, float hi) { unsigned r; asm volatile("v_cvt_pk_bf16_f32 %0, %1, %2" : "=v"(r) : "v"(lo), "v"(hi)); return r; }
typedef float f32x2 __attribute__((ext_vector_type(2)));
__device__ __forceinline__ f32x2 gelu_pk(f32x2 v) {
    const f32x2 av = __builtin_elementwise_abs(v), d = av * 0.2316418882f + 1.0f;
    f32x2 t; t.x = __builtin_amdgcn_rcpf(d.x); t.y = __builtin_amdgcn_rcpf(d.y);
    f32x2 q = t * 0.5307027145f + (-0.7265760135f); q = q * t + 0.7107068705f; q = q * t + (-0.142248368f); q = q * t + 0.127414796f; q = q * t;
    const f32x2 s = (v * v) * (-0.72134752044f);
    f32x2 e; e.x = __builtin_amdgcn_exp2f(s.x); e.y = __builtin_amdgcn_exp2f(s.y);
    const f32x2 m = v * (q * e), r = v - m;
    f32x2 o; o.x = v.x < 0.f ? m.x : r.x; o.y = v.y < 0.f ? m.y : r.y; return o;
}

template <int ACT  > struct EpiBf16 {
    static constexpr bool PERM = true, AFTER_DRAIN = false; static_assert(ACT == 0 || ACT == 1, "EpiBf16: ACT is 0 (none) or 1 (gelu_pk)");
    bf16_t* O; int ldc; const float* bias; int split_cols; size_t split_stride; float scale0;
    __device__ __forceinline__ void operator()(const f32x4 (&acc)[2][2][4][2], const Unit& u, int wr, int wc, int fr, int fq) const {
        const int row0 = u.pm * BM + wr * 64 + fr; int colt = u.pn * BM; bf16_t* base = O;
        float sc = 1.f; if (split_cols) { const int t = colt / split_cols; base += (size_t)t * split_stride; colt -= t * split_cols; if (t == 0) sc = scale0; }
        const int col0 = colt + wc * 32 + 8 * fq, bcol0 = u.pn * BM + wc * 32 + 8 * fq;
        f32x4 bv[2][2];
#pragma unroll
        for (int bj = 0; bj < 2; ++bj)
#pragma unroll
            for (int n = 0; n < 2; ++n) bv[bj][n] = bias ? *(const f32x4*)(bias + bcol0 + bj * HALF + 4 * n) : (f32x4){0.f, 0.f, 0.f, 0.f};
#pragma unroll
        for (int ai = 0; ai < 2; ++ai)
#pragma unroll
            for (int m = 0; m < 4; ++m) { bf16_t* rowp = base + (size_t)(row0 + ai * HALF + m * 16) * ldc + col0;
#pragma unroll
                for (int bj = 0; bj < 2; ++bj) { f32x4 v0 = acc[ai][bj][m][0] + bv[bj][0], v1 = acc[ai][bj][m][1] + bv[bj][1];
                    if (ACT == 1) { f32x2 a = gelu_pk((f32x2){v0[0], v0[1]}), b = gelu_pk((f32x2){v0[2], v0[3]}), c = gelu_pk((f32x2){v1[0], v1[1]}), d = gelu_pk((f32x2){v1[2], v1[3]});
                        v0 = (f32x4){a.x, a.y, b.x, b.y}; v1 = (f32x4){c.x, c.y, d.x, d.y}; }
                    v0 = v0 * sc; v1 = v1 * sc; u32x4 w; w.x = cvt_pk_bf16(v0[0], v0[1]); w.y = cvt_pk_bf16(v0[2], v0[3]); w.z = cvt_pk_bf16(v1[0], v1[1]); w.w = cvt_pk_bf16(v1[2], v1[3]);
                    *(u32x4*)(rowp + bj * HALF) = w; } }
    }
};

typedef int i32x4 __attribute__((ext_vector_type(4)));
template <bool I8> struct AccT { typedef f32x4 type; };
template <> struct AccT<true> { typedef i32x4 type; };
template <bool I8> __device__ __forceinline__ typename AccT<I8>::type mma1(bf16x8 b, bf16x8 a, typename AccT<I8>::type c) {
    if constexpr (I8) return __builtin_amdgcn_mfma_i32_16x16x64_i8(__builtin_bit_cast(i32x4, b), __builtin_bit_cast(i32x4, a), c, 0, 0, 0);
    else return __builtin_amdgcn_mfma_f32_16x16x32_bf16(b, a, c, 0, 0, 0);
}
typedef int i32x8 __attribute__((ext_vector_type(8)));
template <bool I8, bool F8> __device__ __forceinline__ typename AccT<I8>::type mma2(bf16x8 b0, bf16x8 b1, bf16x8 a0, bf16x8 a1, typename AccT<I8>::type c) {
    if constexpr (F8) { const i32x4 B0 = __builtin_bit_cast(i32x4, b0), B1 = __builtin_bit_cast(i32x4, b1), A0 = __builtin_bit_cast(i32x4, a0), A1 = __builtin_bit_cast(i32x4, a1);
        const i32x8 B = {B0.x, B0.y, B0.z, B0.w, B1.x, B1.y, B1.z, B1.w}, A = {A0.x, A0.y, A0.z, A0.w, A1.x, A1.y, A1.z, A1.w};
        return __builtin_amdgcn_mfma_scale_f32_16x16x128_f8f6f4(B, A, c, 0, 0, 0, 0, 0, 0); }
    else { c = mma1<I8>(b0, a0, c); return mma1<I8>(b1, a1, c); }
}
struct EpiPreNone {}; struct EpiPreI { int i[2][4]; };
struct EpiPreS { unsigned long long q[2]; float f[2]; };
template <class Epi, class Sched, bool ALIGN_EPI = false, bool SP2 = false, bool GATHER = false, bool TILED = false, bool I8 = false, bool F8 = false>
__device__ __forceinline__ void gemm_phase(PG8_LAS unsigned char* lds, const Gemm g, const Sched& S, const Epi& E) {
    int tid = threadIdx.x; asm volatile("" : "+v"(tid));
    const int wid = __builtin_amdgcn_readfirstlane(tid >> 6), lane = tid & 63, wr = wid >> 2, wc = wid & 3, fr = lane & 15, fq = lane >> 4;
    const int K = g.K, nt = K / BK;
    PG8_LAS float* const xl = (PG8_LAS float*)(lds + 144384 + wid * 1024);
    unsigned voffA, voffB;
    { int R, C; stage_rc(tid * 16, R, C); const int Rb = Epi::PERM ? ((R & ~31) + perm32(R & 31)) : R;
        voffA = (unsigned)(R * (TILED ? 64 : K) + C) * 2u; voffB = (unsigned)(Rb * (TILED ? 64 : K) + C) * 2u; }
    const size_t vstep = (size_t)64 * (TILED ? 64 : K) * 2;
    static_assert(!(GATHER && TILED), "gathered rows are row-major");
    static_assert(!GATHER || SP2, "the gathered A path is written for the SP2 loop");
    unsigned vgc[2][2] = {{0u, 0u}, {0u, 0u}}, vgn[2][2] = {{0u, 0u}, {0u, 0u}};
    const char* const A0 = (const char*)g.A;
#define PG8_GLOAD(dst, unit) do { _Pragma("unroll") for (int h_ = 0; h_ < 2; ++h_) _Pragma("unroll") for (int i_ = 0; i_ < 2; ++i_) { int R_, C_; stage_rc(tid * 16 + i_ * 8192, R_, C_); \
        int tk_ = S.ridx[S.row_base + (unit).pm * BM + h_ * HALF + R_]; tk_ = tk_ < 0 ? 0 : tk_; dst[h_][i_] = (unsigned)(tk_ * K + C_) * 2u; } } while (0)
#define PG8_STAGE_G(bufoff, gb, o0, o1) do { __builtin_amdgcn_global_load_lds((const unsigned*)((gb) + (o0)), (PG8_LAS unsigned*)(lds + (bufoff) + ldsw), 16, 0, 0); \
        __builtin_amdgcn_global_load_lds((const unsigned*)((gb) + (o1)), (PG8_LAS unsigned*)(lds + (bufoff) + ldsw + 8192), 16, 0, 0); } while (0)
    const size_t kstep = TILED ? (size_t)(BM * BK * 2) : (size_t)(BK * 2);
    const size_t hstep = TILED ? (size_t)(HALF * BK * 2) : (size_t)HALF * K * 2;
    const size_t tstep = (size_t)BM * K * 2;
    const unsigned ldsw = (unsigned)wid * 1024u;
    const int aoff = lds_byte(wr * 64 + fr, fq * 8), boff = lds_byte(wc * 32 + fr, fq * 8);
#define PG8_SA(b, h) (((b) * 2 + (h)) * HTB)
#define PG8_SB(b, h) ((4 + (b) * 2 + (h)) * HTB)
#define PG8_STAGE(bufoff, gbase, voff) do { _Pragma("unroll") for (int _i = 0; _i < 2; ++_i) \
        __builtin_amdgcn_global_load_lds((const unsigned*)((const char*)(gbase) + _i * vstep + (voff)), (PG8_LAS unsigned*)(lds + (bufoff) + ldsw + _i * 8192), 16, 0, 0); } while (0)
#define PG8_LDA(dst, b, h) do { _Pragma("unroll") for (int m = 0; m < 4; ++m) _Pragma("unroll") for (int k = 0; k < 2; ++k) dst[m][k] = *(const PG8_LAS bf16x8*)(lds + PG8_SA(b, h) + aoff + m * 2048 + k * 1024); } while (0)
#define PG8_LDB(dst, b, h) do { _Pragma("unroll") for (int n = 0; n < 2; ++n) _Pragma("unroll") for (int k = 0; k < 2; ++k) dst[n][k] = *(const PG8_LAS bf16x8*)(lds + PG8_SB(b, h) + boff + n * 2048 + k * 1024); } while (0)
#define PG8_MMA(ai, bj, At, Bt) do { __builtin_amdgcn_s_setprio(1); _Pragma("unroll") for (int m = 0; m < 4; ++m) _Pragma("unroll") for (int n = 0; n < 2; ++n) \
        acc[ai][bj][m][n] = mma2<I8, F8>(Bt[n][0], Bt[n][1], At[m][0], At[m][1], acc[ai][bj][m][n]); __builtin_amdgcn_s_setprio(0); } while (0)
#define PG8_WAIT_V(n) asm volatile("s_waitcnt vmcnt(" #n ")" ::: "memory")
#define PG8_WAIT_L(n) asm volatile("s_waitcnt lgkmcnt(" #n ")" ::: "memory")
#define PG8_BAR __builtin_amdgcn_s_barrier()
#define PG8_SCHED __builtin_amdgcn_sched_barrier(0)
    Unit cur, nxt; int ui = 0;
    if (!S.next(0, cur)) return;
    typedef typename AccT<I8>::type acc_t; acc_t acc[2][2][4][2];
#pragma unroll
    for (int a = 0; a < 2; ++a)
#pragma unroll
        for (int b = 0; b < 2; ++b)
#pragma unroll
            for (int m = 0; m < 4; ++m)
#pragma unroll
                for (int n = 0; n < 2; ++n) acc[a][b][m][n] = acc_t{};
    bf16x8 At[4][2], B0[2][2], B1[2][2];
    const char* cA = (const char*)g.A + (size_t)cur.pm * tstep; const char* cB = (const char*)g.Bt + (size_t)cur.pn * tstep;
    S.a_ready(cur);
    if constexpr (SP2) {
        if constexpr (GATHER) {
            int R_, C_; stage_rc(tid * 16, R_, C_);
            const i32x4 raw = *(const i32x4*)((const char*)S.ridxp + ((size_t)(S.row_base + cur.pm * BM) * 4 + (size_t)R_ * 16));
#pragma unroll
            for (int k_ = 0; k_ < 4; ++k_) { int tk_ = raw[k_]; tk_ = tk_ < 0 ? 0 : tk_; vgc[k_ >> 1][k_ & 1] = (unsigned)(tk_ * K + C_) * 2u; } }
        PG8_STAGE(PG8_SB(0, 0), cB, voffB); PG8_STAGE(PG8_SB(0, 1), cB + hstep, voffB);
        if constexpr (GATHER) { PG8_STAGE_G(PG8_SA(0, 0), A0, vgc[0][0], vgc[0][1]); PG8_STAGE_G(PG8_SA(0, 1), A0, vgc[1][0], vgc[1][1]); } else { PG8_STAGE(PG8_SA(0, 0), cA, voffA); PG8_STAGE(PG8_SA(0, 1), cA + hstep, voffA); }
        if (wr == 1) PG8_BAR;
        PG8_WAIT_V(2); PG8_BAR;
        PG8_STAGE(PG8_SB(1, 0), cB + kstep, voffB);
        if constexpr (GATHER) { PG8_STAGE_G(PG8_SA(1, 0), A0 + kstep, vgc[0][0], vgc[0][1]); } else { PG8_STAGE(PG8_SA(1, 0), cA + kstep, voffA); }
        PG8_STAGE(PG8_SB(1, 1), cB + hstep + kstep, voffB);
        PG8_WAIT_V(6); PG8_BAR;
    } else {
        PG8_STAGE(PG8_SB(0, 0), cB, voffB); PG8_STAGE(PG8_SA(0, 0), cA, voffA); PG8_STAGE(PG8_SB(0, 1), cB + hstep, voffB); PG8_STAGE(PG8_SA(0, 1), cA + hstep, voffA);
        if (wr == 1) PG8_BAR;
        PG8_WAIT_V(4); PG8_BAR;
        PG8_STAGE(PG8_SB(1, 0), cB + kstep, voffB); PG8_STAGE(PG8_SA(1, 0), cA + kstep, voffA); PG8_STAGE(PG8_SB(1, 1), cB + hstep + kstep, voffB);
        PG8_WAIT_V(6); PG8_BAR;
    }
    for (;;) {
        const bool has_next = S.next(ui + 1, nxt);
        typename Epi::Pre epre; E.pre(cur, wr, fr, fq, epre, xl);
        if constexpr (GATHER) { if (has_next) { int R_, C_; stage_rc(tid * 16, R_, C_);
            __builtin_amdgcn_global_load_lds((const unsigned*)((const char*)S.ridxp + ((size_t)(S.row_base + nxt.pm * BM) * 4 + (size_t)R_ * 16)), (PG8_LAS unsigned*)(lds + 131072 + ldsw), 16, 0, 0); } }
        const char* nA = has_next ? (const char*)g.A + (size_t)nxt.pm * tstep : cA; const char* nB = has_next ? (const char*)g.Bt + (size_t)nxt.pn * tstep : cB;
        for (int t = 0; t < nt; t += 2) {
            const bool last = (t == nt - 2);
            const char* a1 = cA + (size_t)(t + 1) * kstep;
            const char* a2 = last ? nA : cA + (size_t)(t + 2) * kstep; const char* b2 = last ? nB : cB + (size_t)(t + 2) * kstep;
            const char* a3 = a2 + kstep; const char* b3 = b2 + kstep;
            const char* ga2 = A0 + (size_t)(last ? 0 : t + 2) * kstep; (void)ga2;
            if (last && has_next) S.a_ready(nxt);
            if constexpr (GATHER) { if (last) {
                if (has_next) { const i32x4 raw = *(const volatile PG8_LAS i32x4*)(lds + 131072 + ldsw + (tid & 63) * 16); int R_, C_; stage_rc(tid * 16, R_, C_);
#pragma unroll
                    for (int k_ = 0; k_ < 4; ++k_) { int tk_ = raw[k_]; tk_ = tk_ < 0 ? 0 : tk_; vgn[k_ >> 1][k_ & 1] = (unsigned)(tk_ * K + C_) * 2u; } }
                else { vgn[0][0] = vgc[0][0]; vgn[0][1] = vgc[0][1]; vgn[1][0] = vgc[1][0]; vgn[1][1] = vgc[1][1]; } } }
            if constexpr (SP2) {
            PG8_LDB(B0, 0, 0); PG8_LDB(B1, 0, 1); PG8_SCHED; PG8_LDA(At, 0, 0); if constexpr (GATHER) { PG8_STAGE_G(PG8_SA(1, 1), A0 + (size_t)(t + 1) * kstep, vgc[1][0], vgc[1][1]); } else { PG8_STAGE(PG8_SA(1, 1), a1 + hstep, voffA); }
            PG8_WAIT_V(8); PG8_WAIT_L(0); PG8_BAR; PG8_MMA(0, 0, At, B0); PG8_MMA(0, 1, At, B1); PG8_BAR; PG8_SCHED;
            PG8_LDA(At, 0, 1); PG8_STAGE(PG8_SB(0, 0), b2, voffB); PG8_STAGE(PG8_SB(0, 1), b2 + hstep, voffB); if constexpr (GATHER) { PG8_STAGE_G(PG8_SA(0, 0), ga2, last ? vgn[0][0] : vgc[0][0], last ? vgn[0][1] : vgc[0][1]); } else { PG8_STAGE(PG8_SA(0, 0), a2, voffA); }
            PG8_WAIT_V(8); PG8_WAIT_L(0); PG8_BAR; PG8_MMA(1, 0, At, B0); PG8_MMA(1, 1, At, B1); PG8_BAR; PG8_SCHED;
            PG8_LDB(B0, 1, 0); PG8_LDB(B1, 1, 1); PG8_SCHED; PG8_LDA(At, 1, 0); if constexpr (GATHER) { PG8_STAGE_G(PG8_SA(0, 1), ga2, last ? vgn[1][0] : vgc[1][0], last ? vgn[1][1] : vgc[1][1]); } else { PG8_STAGE(PG8_SA(0, 1), a2 + hstep, voffA); }
            PG8_WAIT_V(8); PG8_WAIT_L(0); PG8_BAR; PG8_MMA(0, 0, At, B0); PG8_MMA(0, 1, At, B1); PG8_BAR; PG8_SCHED;
            PG8_LDA(At, 1, 1); PG8_STAGE(PG8_SB(1, 0), b3, voffB); PG8_STAGE(PG8_SB(1, 1), b3 + hstep, voffB); if constexpr (GATHER) { PG8_STAGE_G(PG8_SA(1, 0), ga2 + kstep, last ? vgn[0][0] : vgc[0][0], last ? vgn[0][1] : vgc[0][1]); } else { PG8_STAGE(PG8_SA(1, 0), a3, voffA); }
            PG8_WAIT_V(8); PG8_WAIT_L(0); PG8_BAR; PG8_MMA(1, 0, At, B0); PG8_MMA(1, 1, At, B1); PG8_BAR; PG8_SCHED;
            } else {
            PG8_LDB(B0, 0, 0); PG8_SCHED; PG8_LDA(At, 0, 0); PG8_STAGE(PG8_SA(1, 1), a1 + hstep, voffA);
            PG8_WAIT_L(8); PG8_BAR; PG8_WAIT_L(0); PG8_MMA(0, 0, At, B0); PG8_BAR; PG8_SCHED;
            PG8_LDB(B1, 0, 1); PG8_STAGE(PG8_SB(0, 0), b2, voffB);
            PG8_BAR; PG8_WAIT_L(0); PG8_MMA(0, 1, At, B1); PG8_BAR;
            PG8_LDA(At, 0, 1); PG8_STAGE(PG8_SA(0, 0), a2, voffA);
            PG8_BAR; PG8_WAIT_L(0); PG8_MMA(1, 0, At, B0); PG8_BAR; PG8_SCHED;
            PG8_STAGE(PG8_SB(0, 1), b2 + hstep, voffB);
            PG8_WAIT_V(6); PG8_BAR; PG8_MMA(1, 1, At, B1); PG8_BAR;
            PG8_LDB(B0, 1, 0); PG8_SCHED; PG8_LDA(At, 1, 0); PG8_STAGE(PG8_SA(0, 1), a2 + hstep, voffA);
            PG8_WAIT_L(8); PG8_BAR; PG8_WAIT_L(0); PG8_MMA(0, 0, At, B0); PG8_BAR; PG8_SCHED;
            PG8_LDB(B1, 1, 1); PG8_STAGE(PG8_SB(1, 0), b3, voffB);
            PG8_BAR; PG8_WAIT_L(0); PG8_MMA(0, 1, At, B1); PG8_BAR;
            PG8_LDA(At, 1, 1); PG8_STAGE(PG8_SA(1, 0), a3, voffA);
            PG8_BAR; PG8_WAIT_L(0); PG8_MMA(1, 0, At, B0); PG8_BAR; PG8_SCHED;
            PG8_STAGE(PG8_SB(1, 1), b3 + hstep, voffB);
            PG8_WAIT_V(6); PG8_BAR; PG8_MMA(1, 1, At, B1); PG8_BAR;
            }
        }
        if constexpr (ALIGN_EPI) { if (wr == 0) PG8_BAR; }
        if constexpr (!Epi::AFTER_DRAIN) { E(acc, cur, wr, wc, fr, fq, epre, xl); S.done(cur); }
        if (!has_next) break;
#pragma unroll
        for (int a = 0; a < 2; ++a)
#pragma unroll
            for (int b = 0; b < 2; ++b)
#pragma unroll
                for (int m = 0; m < 4; ++m)
#pragma unroll
                    for (int n = 0; n < 2; ++n) acc[a][b][m][n] = acc_t{};
        cur = nxt; cA = nA; cB = nB; ++ui;
        if constexpr (GATHER) { vgc[0][0] = vgn[0][0]; vgc[0][1] = vgn[0][1]; vgc[1][0] = vgn[1][0]; vgc[1][1] = vgn[1][1]; }
        if constexpr (ALIGN_EPI) { if (wr == 1) PG8_BAR; }
    }
    PG8_WAIT_V(0);
    if constexpr (!ALIGN_EPI) { if (wr == 0) PG8_BAR; }
    PG8_BAR;
    if constexpr (Epi::AFTER_DRAIN) { E.fused(acc, cur, wr, wc, fr, fq, lds, wid, lane); S.done(cur); }
#undef PG8_SA
#undef PG8_GLOAD
#undef PG8_STAGE_G
#undef PG8_SB
#undef PG8_STAGE
#undef PG8_LDA
#undef PG8_LDB
#undef PG8_MMA
#undef PG8_WAIT_V
#undef PG8_WAIT_L
#undef PG8_BAR
#undef PG8_SCHED
}
}

namespace pg8 {
typedef unsigned long long ssq_t;
__device__ __forceinline__ float ssq_rstd(const ssq_t* ssq, int r) { return __builtin_amdgcn_rsqf((float)ssq[r] * (1.0f / (1048576.0f * 1024.0f)) + 1e-6f); }
__device__ __forceinline__ void ssq_add(ssq_t* ssq, int r, float ss) { atomicAdd(ssq + r, (ssq_t)(ss * 1048576.0f)); }
__device__ __forceinline__ void share_scales(PG8_LAS float* xl, int fr, int fq, float s0, float s1) { xl[fr * 8 + 2 * fq] = s0; xl[fr * 8 + 2 * fq + 1] = s1; asm volatile("s_waitcnt lgkmcnt(0)" ::: "memory"); }
__device__ __forceinline__ float silu_fast(float x) { return x * __builtin_amdgcn_rcpf(1.0f + __expf(-x)); }
struct EpiInProj {
    static constexpr bool PERM = true, AFTER_DRAIN = false;
    typedef EpiPreS Pre; bf16_t* proj; float* dtga; const ssq_t* ssq;
    __device__ __forceinline__ void pre(const Unit& u, int wr, int fr, int fq, Pre& p, PG8_LAS float*) const {
        if (ssq) {
#pragma unroll
            for (int k = 0; k < 2; ++k) { const int kk = 2 * fq + k; p.q[k] = ssq[u.pm * BM + wr * 64 + fr + (kk >> 2) * HALF + (kk & 3) * 16]; } }
    }
    __device__ __forceinline__ void operator()(const f32x4 (&acc)[2][2][4][2], const Unit& u, int wr, int wc, int fr, int fq, const Pre& p, PG8_LAS float* xl) const {
        const int row0 = u.pm * BM + wr * 64 + fr;
        if (ssq) share_scales(xl, fr, fq, ssq_rstd(p.q, 0), ssq_rstd(p.q, 1));
        if (u.pn < 11) {
            const int col0 = u.pn * BM + wc * 32 + 8 * fq;
#pragma unroll
            for (int ai = 0; ai < 2; ++ai)
#pragma unroll
                for (int m = 0; m < 4; ++m) { bf16_t* rowp = proj + (size_t)(row0 + ai * HALF + m * 16) * PW + col0;
                    const float rs = ssq ? xl[fr * 8 + ai * 4 + m] : 1.0f;
#pragma unroll
                    for (int bj = 0; bj < 2; ++bj) { const f32x4 v0 = acc[ai][bj][m][0] * rs, v1 = acc[ai][bj][m][1] * rs;
                        u32x4 w; w.x = cvt_pk_bf16(v0[0], v0[1]); w.y = cvt_pk_bf16(v0[2], v0[3]); w.z = cvt_pk_bf16(v1[0], v1[1]); w.w = cvt_pk_bf16(v1[2], v1[3]);
                        *(u32x4*)(rowp + bj * HALF) = w; } }
        } else if (wc == 0 || (wc == 1 && fq == 0)) {
#pragma unroll
            for (int ai = 0; ai < 2; ++ai)
#pragma unroll
                for (int m = 0; m < 4; ++m) { float* rp = dtga + (size_t)(row0 + ai * HALF + m * 16) * DGW + wc * 32 + 8 * fq;
                    *(f32x4*)rp = acc[ai][0][m][0]; *(f32x4*)(rp + 4) = acc[ai][0][m][1]; }
        }
    }
};
constexpr int HPITCH = 2048;
template <bool IN16> struct EpiResid {
    static constexpr bool PERM = true, AFTER_DRAIN = false;
    typedef EpiPreNone Pre; const void* hin; bf16_t* hout; float ascale = 1.0f;
    __device__ __forceinline__ void pre(const Unit&, int, int, int, Pre&, PG8_LAS float*) const {}
    __device__ __forceinline__ void operator()(const f32x4 (&acc)[2][2][4][2], const Unit& u, int wr, int wc, int fr, int fq, const Pre&, PG8_LAS float*) const {
        const int row0 = u.pm * BM + wr * 64 + fr, col0 = u.pn * BM + wc * 32 + 8 * fq;
#pragma unroll
        for (int ai = 0; ai < 2; ++ai)
#pragma unroll
            for (int m = 0; m < 4; ++m) { const int r = row0 + ai * HALF + m * 16; bf16_t* op = hout + (size_t)r * HPITCH + col0;
                f32x4 i0[2], i1[2];
                if constexpr (IN16) { const bf16_t* ip = (const bf16_t*)hin + (size_t)r * HPITCH + col0; u32x4 q[2];
#pragma unroll
                    for (int bj = 0; bj < 2; ++bj) q[bj] = *(const u32x4*)(ip + bj * HALF);
#pragma unroll
                    for (int bj = 0; bj < 2; ++bj) { i0[bj] = (f32x4){__uint_as_float(q[bj].x << 16), __uint_as_float(q[bj].x & 0xffff0000u), __uint_as_float(q[bj].y << 16), __uint_as_float(q[bj].y & 0xffff0000u)};
                        i1[bj] = (f32x4){__uint_as_float(q[bj].z << 16), __uint_as_float(q[bj].z & 0xffff0000u), __uint_as_float(q[bj].w << 16), __uint_as_float(q[bj].w & 0xffff0000u)}; } }
                else { const float* ip = (const float*)hin + (size_t)r * 1024 + col0;
#pragma unroll
                    for (int bj = 0; bj < 2; ++bj) { i0[bj] = *(const f32x4*)(ip + bj * HALF); i1[bj] = *(const f32x4*)(ip + bj * HALF + 4); } }
#pragma unroll
                for (int bj = 0; bj < 2; ++bj) { const f32x4 v0 = i0[bj] + acc[ai][bj][m][0] * ascale, v1 = i1[bj] + acc[ai][bj][m][1] * ascale;
                    u32x4 w; w.x = cvt_pk_bf16(v0[0], v0[1]); w.y = cvt_pk_bf16(v0[2], v0[3]); w.z = cvt_pk_bf16(v1[0], v1[1]); w.w = cvt_pk_bf16(v1[2], v1[3]); *(u32x4*)(op + bj * HALF) = w; }
                asm volatile("" ::: "memory"); }
    }
};
struct EpiSwiGLU {
    static constexpr bool PERM = true, AFTER_DRAIN = false;
    typedef EpiPreS Pre; bf16_t* out; int ld; int ntile; const ssq_t* ssq; const float* srs; int row_base; bool tiled;
    __device__ __forceinline__ void pre(const Unit& u, int wr, int fr, int fq, Pre& p, PG8_LAS float*) const {
#pragma unroll
        for (int k = 0; k < 2; ++k) { const int kk = 2 * fq + k, r = u.pm * BM + wr * 64 + fr + (kk >> 2) * HALF + (kk & 3) * 16;
            if (ssq) p.q[k] = ssq[r]; else if (srs) p.f[k] = srs[row_base + r]; }
    }
    __device__ __forceinline__ void operator()(const f32x4 (&acc)[2][2][4][2], const Unit& u, int wr, int wc, int fr, int fq, const Pre& p, PG8_LAS float* xl) const {
        const int row0 = u.pm * BM + wr * 64 + fr, col0 = (u.pn % ntile) * HALF + wc * 32 + 8 * fq;
        if (ssq) share_scales(xl, fr, fq, ssq_rstd(p.q, 0), ssq_rstd(p.q, 1)); else if (srs) share_scales(xl, fr, fq, p.f[0], p.f[1]);
#pragma unroll
        for (int ai = 0; ai < 2; ++ai)
#pragma unroll
            for (int m = 0; m < 4; ++m) { const int rr_ = row0 + ai * HALF + m * 16;
                bf16_t* rowp = tiled ? out + ((size_t)(rr_ >> 8) * (ld >> 6) + (col0 >> 6)) * 16384 + (size_t)(rr_ & 255) * 64 + (col0 & 63) : out + (size_t)rr_ * ld + col0;
                const float rs = (ssq || srs) ? xl[fr * 8 + ai * 4 + m] : 1.0f;
                const f32x4 g0 = acc[ai][0][m][0] * rs, g1 = acc[ai][0][m][1] * rs, u0 = acc[ai][1][m][0] * rs, u1 = acc[ai][1][m][1] * rs;
                u32x4 w; w.x = cvt_pk_bf16(silu_fast(g0[0]) * u0[0], silu_fast(g0[1]) * u0[1]); w.y = cvt_pk_bf16(silu_fast(g0[2]) * u0[2], silu_fast(g0[3]) * u0[3]);
                w.z = cvt_pk_bf16(silu_fast(g1[0]) * u1[0], silu_fast(g1[1]) * u1[1]); w.w = cvt_pk_bf16(silu_fast(g1[2]) * u1[2], silu_fast(g1[3]) * u1[3]);
                *(u32x4*)rowp = w; }
    }
};
struct EpiPre8 { float f[2]; float sbv; };
struct EpiSwiGLU8 {
    static constexpr bool PERM = true, AFTER_DRAIN = false;
    typedef EpiPre8 Pre; bf16_t* out; int ld; int ntile; const float* sa; const float* sb; int row_base; bool tiled;
    __device__ __forceinline__ void pre(const Unit& u, int wr, int fr, int fq, Pre& p, PG8_LAS float*) const {
#pragma unroll
        for (int k = 0; k < 2; ++k) { const int kk = 2 * fq + k; p.f[k] = sa[row_base + u.pm * BM + wr * 64 + fr + (kk >> 2) * HALF + (kk & 3) * 16]; }
        int t_ = threadIdx.x; asm volatile("" : "+v"(t_));
        const int lane = fr + 16 * fq, wc = (t_ >> 6) & 3; p.sbv = sb[(size_t)u.pn * BM + (lane >> 5) * HALF + wc * 32 + (lane & 31)];
    }
    __device__ __forceinline__ void operator()(const i32x4 (&acc)[2][2][4][2], const Unit& u, int wr, int wc, int fr, int fq, const Pre& p, PG8_LAS float* xl) const {
        const int row0 = u.pm * BM + wr * 64 + fr, col0 = (u.pn % ntile) * HALF + wc * 32 + 8 * fq;
        xl[fr * 8 + 2 * fq] = p.f[0]; xl[fr * 8 + 2 * fq + 1] = p.f[1]; xl[128 + fr + 16 * fq] = p.sbv; asm volatile("s_waitcnt lgkmcnt(0)" ::: "memory");
        const f32x4 sg0 = *(const PG8_LAS f32x4*)(xl + 128 + 8 * fq), sg1 = *(const PG8_LAS f32x4*)(xl + 128 + 8 * fq + 4), su0 = *(const PG8_LAS f32x4*)(xl + 160 + 8 * fq), su1 = *(const PG8_LAS f32x4*)(xl + 160 + 8 * fq + 4);
#pragma unroll
        for (int ai = 0; ai < 2; ++ai)
#pragma unroll
            for (int m = 0; m < 4; ++m) { const int rr_ = row0 + ai * HALF + m * 16;
                const float s = xl[fr * 8 + ai * 4 + m];
                bf16_t* rowp = out + (size_t)rr_ * ld + col0;
                float g[8], uu[8];
#pragma unroll
                for (int j = 0; j < 4; ++j) { g[j] = (float)acc[ai][0][m][0][j] * s * sg0[j]; g[4 + j] = (float)acc[ai][0][m][1][j] * s * sg1[j]; uu[j] = (float)acc[ai][1][m][0][j] * s * su0[j]; uu[4 + j] = (float)acc[ai][1][m][1][j] * s * su1[j]; }
                if (tiled) {
#pragma unroll
                    for (int j = 0; j < 8; ++j) g[j] = __builtin_amdgcn_fmed3f(silu_fast(g[j]) * uu[j], -448.0f, 448.0f);
                    unsigned lo = 0u, hi = 0u; lo = __builtin_amdgcn_cvt_pk_fp8_f32(g[0], g[1], lo, false); lo = __builtin_amdgcn_cvt_pk_fp8_f32(g[2], g[3], lo, true);
                    hi = __builtin_amdgcn_cvt_pk_fp8_f32(g[4], g[5], hi, false); hi = __builtin_amdgcn_cvt_pk_fp8_f32(g[6], g[7], hi, true);
                    *(unsigned long long*)((unsigned char*)out + ((size_t)(rr_ >> 8) * (ld >> 7) + (col0 >> 7)) * 32768 + (size_t)(rr_ & 255) * 128 + (col0 & 127)) = (unsigned long long)lo | ((unsigned long long)hi << 32);
                } else {
                u32x4 w; w.x = cvt_pk_bf16(silu_fast(g[0]) * uu[0], silu_fast(g[1]) * uu[1]); w.y = cvt_pk_bf16(silu_fast(g[2]) * uu[2], silu_fast(g[3]) * uu[3]);
                w.z = cvt_pk_bf16(silu_fast(g[4]) * uu[4], silu_fast(g[5]) * uu[5]); w.w = cvt_pk_bf16(silu_fast(g[6]) * uu[6], silu_fast(g[7]) * uu[7]);
                *(u32x4*)rowp = w; } }
    }
};
struct EpiInProj8 {
    static constexpr bool PERM = true, AFTER_DRAIN = false;
    typedef EpiPre8 Pre; bf16_t* proj; const float* sa; const float* sb;
    __device__ __forceinline__ void pre(const Unit& u, int wr, int fr, int fq, Pre& p, PG8_LAS float*) const {
#pragma unroll
        for (int k = 0; k < 2; ++k) { const int kk = 2 * fq + k; p.f[k] = sa[u.pm * BM + wr * 64 + fr + (kk >> 2) * HALF + (kk & 3) * 16]; }
        int t_ = threadIdx.x; asm volatile("" : "+v"(t_));
        const int lane = fr + 16 * fq, wc = (t_ >> 6) & 3; p.sbv = sb[(size_t)u.pn * BM + (lane >> 5) * HALF + wc * 32 + (lane & 31)];
    }
    __device__ __forceinline__ void operator()(const i32x4 (&acc)[2][2][4][2], const Unit& u, int wr, int wc, int fr, int fq, const Pre& p, PG8_LAS float* xl) const {
        const int row0 = u.pm * BM + wr * 64 + fr, col0 = u.pn * BM + wc * 32 + 8 * fq;
        xl[fr * 8 + 2 * fq] = p.f[0]; xl[fr * 8 + 2 * fq + 1] = p.f[1]; xl[128 + fr + 16 * fq] = p.sbv; asm volatile("s_waitcnt lgkmcnt(0)" ::: "memory");
        f32x4 sc[2][2];
#pragma unroll
        for (int bj = 0; bj < 2; ++bj) { sc[bj][0] = *(const PG8_LAS f32x4*)(xl + 128 + 32 * bj + 8 * fq); sc[bj][1] = *(const PG8_LAS f32x4*)(xl + 128 + 32 * bj + 8 * fq + 4); }
#pragma unroll
        for (int ai = 0; ai < 2; ++ai)
#pragma unroll
            for (int m = 0; m < 4; ++m) { const int r = row0 + ai * HALF + m * 16; const float s = xl[fr * 8 + ai * 4 + m]; bf16_t* rowp = proj + (size_t)r * PW + col0;
#pragma unroll
                for (int bj = 0; bj < 2; ++bj) { const i32x4 a0 = acc[ai][bj][m][0], a1 = acc[ai][bj][m][1]; const f32x4 s0 = sc[bj][0] * s, s1 = sc[bj][1] * s;
                    u32x4 w; w.x = cvt_pk_bf16((float)a0[0] * s0[0], (float)a0[1] * s0[1]); w.y = cvt_pk_bf16((float)a0[2] * s0[2], (float)a0[3] * s0[3]);
                    w.z = cvt_pk_bf16((float)a1[0] * s1[0], (float)a1[1] * s1[1]); w.w = cvt_pk_bf16((float)a1[2] * s1[2], (float)a1[3] * s1[3]);
                    *(u32x4*)(rowp + bj * HALF) = w; } }
    }
};
struct EpiMoeDown {
    static constexpr bool PERM = true, AFTER_DRAIN = false;
    typedef EpiPreNone Pre; bf16_t* ylo; long hi_off; const int* stok; const float* sgate; int row_base; float gscale;
    __device__ __forceinline__ void pre(const Unit& u, int wr, int, int, Pre&, PG8_LAS float* xl) const {
        int t_ = threadIdx.x; asm volatile("" : "+v"(t_));
        const unsigned voff = (unsigned)(t_ & 63) * 4u; const size_t sb_ = (size_t)(row_base + u.pm * BM + wr * 64) * 4;
#pragma unroll
        for (int ai = 0; ai < 2; ++ai) { __builtin_amdgcn_global_load_lds((const unsigned*)((const char*)stok + sb_ + ai * HALF * 4 + voff), (PG8_LAS unsigned*)(xl + ai * 64), 4, 0, 0);
            __builtin_amdgcn_global_load_lds((const unsigned*)((const char*)sgate + sb_ + ai * HALF * 4 + voff), (PG8_LAS unsigned*)(xl + 128 + ai * 64), 4, 0, 0); }
    }
    __device__ __forceinline__ void operator()(const f32x4 (&acc)[2][2][4][2], const Unit& u, int wr, int wc, int fr, int fq, const Pre&, PG8_LAS float* xl) const {
        { int t_ = threadIdx.x; asm volatile("" : "+v"(t_)); fr = t_ & 15; fq = (t_ >> 4) & 3; }
        bf16_t* ylo_ = ylo; asm volatile("" : "+s"(ylo_));
        const int ct = u.pn & 3, col0 = (ct & 1) * BM + wc * 32 + 8 * fq; bf16_t* const yb = ylo_ + (long)(ct >> 1) * hi_off;
#pragma unroll
        for (int ai = 0; ai < 2; ++ai)
#pragma unroll
            for (int m = 0; m < 4; ++m) { const int tok = ((const volatile PG8_LAS int*)xl)[ai * 64 + m * 16 + fr]; const float gt = ((const volatile PG8_LAS float*)xl)[128 + ai * 64 + m * 16 + fr] * gscale;
                if (tok >= 0) { bf16_t* op = yb + (size_t)tok * 512 + col0;
#pragma unroll
                    for (int bj = 0; bj < 2; ++bj) { const f32x4 v0 = acc[ai][bj][m][0] * gt, v1 = acc[ai][bj][m][1] * gt;
                        u32x4 w; w.x = cvt_pk_bf16(v0[0], v0[1]); w.y = cvt_pk_bf16(v0[2], v0[3]); w.z = cvt_pk_bf16(v1[0], v1[1]); w.w = cvt_pk_bf16(v1[2], v1[3]); *(u32x4*)(op + bj * HALF) = w; }
                } }
    }
};
struct MoeOrder {
    static constexpr int SKIP = 3; int t0, nT, nN, G, c, nx; const PG8_LAS int* tile_expert; const int* ridx; int row_base; const int* ridxp = nullptr;
    __device__ __forceinline__ bool next(int i, Unit& u) const {
        const int r = i + (c < nx ? SKIP : 0);
        const int L = r < SKIP ? r * (G - nx) + (c - nx) : SKIP * (G - nx) + (r - SKIP) * G + c;
        if (L >= nT * nN) return false;
        const int tl = L / nN, j = L % nN; u.pm = tl; u.pn = tile_expert[tl] * nN + j; return true;
    }
    __device__ __forceinline__ void a_ready(const Unit&) const {}
    __device__ __forceinline__ void done(const Unit&) const {}
};
}

namespace attn_body {
using bf16=unsigned short;
using bf16x8=__attribute__((ext_vector_type(8)))short;
using s16x4=__attribute__((ext_vector_type(4)))short;
using f32x16=__attribute__((ext_vector_type(16)))float;
using u32x4=__attribute__((ext_vector_type(4)))unsigned;
using f32x4=__attribute__((ext_vector_type(4)))float;
constexpr int D=64,DM=PW;
constexpr int NW=8,QBLK=32,KVBLK=64;
__device__ __forceinline__ int crow(int r,int hi){return (r&3)+8*(r>>2)+4*hi;}
#define SBAR() __builtin_amdgcn_sched_barrier(0)
__device__ __forceinline__ void meta_mask(f32x16&p0,f32x16&p1){
  const float NEG=-INFINITY;
  #pragma unroll
  for(int r=8;r<16;++r)p0[r]=NEG;
  #pragma unroll
  for(int r=0;r<16;++r)p1[r]=NEG;
}
__device__ __forceinline__ void swa_mask(f32x16&p0,f32x16&p1,int rel0,int lo,int hi_,bool metatile,bool dead,const __attribute__((address_space(3))) float*bt,const __attribute__((address_space(3))) float*bt4s,float mh,bool farmeta){
  const float NEG=-INFINITY;
  if(dead){
    #pragma unroll
    for(int r=0;r<16;++r){p0[r]=NEG;p1[r]=NEG;}
  } else if(!metatile){
    const __attribute__((address_space(3))) float*tp=bt4s+rel0+260;
    #pragma unroll
    for(int r4=0;r4<4;++r4){
      #pragma unroll
      for(int half=0;half<2;++half){ const f32x4 bq=*(const __attribute__((address_space(3))) f32x4*)(tp+8*r4+32*half);
        #pragma unroll
        for(int j=0;j<4;++j){ const int r=4*r4+j; if(half==0)p0[r]+=bq[j]-mh; else p1[r]+=bq[j]-mh; } }
      __builtin_amdgcn_sched_barrier(0); }
  } else if(farmeta){
    const float bv=bt[1]-mh;
    #pragma unroll
    for(int r=0;r<8;++r)p0[r]+=bv;
    #pragma unroll
    for(int r=8;r<16;++r)p0[r]=NEG;
    #pragma unroll
    for(int r=0;r<16;++r)p1[r]=NEG;
  } else {
    #pragma unroll
    for(int r4=0;r4<4;++r4){
      #pragma unroll
      for(int half=0;half<2;++half){
        #pragma unroll
        for(int j=0;j<4;++j){
          const int r=4*r4+j, rel=rel0+(j+8*r4+32*half);
          const int idx=rel>hi_?hi_:(rel<lo?lo:rel);
          const float bv=bt[idx+129]-mh;
          if(half==0)p0[r]+=bv; else p1[r]+=bv; } }
      __builtin_amdgcn_sched_barrier(0); }
    if(metatile){
      #pragma unroll
      for(int r=8;r<16;++r)p0[r]=NEG;
      #pragma unroll
      for(int r=0;r<16;++r)p1[r]=NEG; }
  }
}

constexpr int NSLOT=3, SLOTB=8192;
constexpr int LDS_K=0, LDS_V=NSLOT*SLOTB, LDS_WS=2*NSLOT*SLOTB, LDS_OST=LDS_WS+NW*64*4, LDS_BYTES=LDS_OST+NW*4096;
constexpr float C2=0.125f*1.4426950408889634f;
__device__ __forceinline__ void glds16(const void*gsrc,unsigned lds_dst){unsigned keep;
  asm volatile("s_mov_b32 %0, m0\n\ts_mov_b32 m0, %2\n\ts_nop 0\n\tglobal_load_lds_dwordx4 %1, off\n\ts_mov_b32 m0, %0":"=&s"(keep):"v"(gsrc),"s"(lds_dst):"memory");}
__device__ __forceinline__ float max3f(float a,float b,float c){float r;asm("v_max3_f32 %0, %1, %2, %3":"=v"(r):"v"(a),"v"(b),"v"(c));return r;}
__device__ __forceinline__ float max2f(float a,float b){float r;asm("v_max_f32_e32 %0, %1, %2":"=v"(r):"v"(a),"v"(b));return r;}
__device__ __forceinline__ float fadd_s(float a,float b){float r;asm("v_add_f32_e32 %0, %1, %2":"=v"(r):"v"(a),"v"(b));return r;}
__device__ __forceinline__ float fsub_s(float a,float b){float r;asm("v_sub_f32_e32 %0, %1, %2":"=v"(r):"v"(a),"v"(b));return r;}
typedef float f32x2_t __attribute__((ext_vector_type(2))); typedef __bf16 bf16x2_t __attribute__((ext_vector_type(2)));
__device__ __forceinline__ unsigned cvtpk_s(float lo,float hi){f32x2_t v={lo,hi};bf16x2_t b=__builtin_convertvector(v,bf16x2_t);return __builtin_bit_cast(unsigned,b);}
#define WAIT_BAR(N) asm volatile("s_waitcnt vmcnt(" #N ") lgkmcnt(0)\n\ts_barrier":::"memory")

__device__ __forceinline__ void qkt(f32x16&p0,f32x16&p1,const char*Kslot,const bf16x8*qr,const f32x16&negm,int r32,int hi){
  const char*kb=Kslot+hi*1024+r32*16;
  #pragma unroll
  for(int d0=0;d0<4;++d0){
    const bf16x8 b0=*reinterpret_cast<const bf16x8*>(kb+d0*2048);
    const bf16x8 b1=*reinterpret_cast<const bf16x8*>(kb+d0*2048+512);
    if(d0==0){p0=__builtin_amdgcn_mfma_f32_32x32x16_bf16(b0,qr[0],negm,0,0,0);p1=__builtin_amdgcn_mfma_f32_32x32x16_bf16(b1,qr[0],negm,0,0,0);}
    else{p0=__builtin_amdgcn_mfma_f32_32x32x16_bf16(b0,qr[d0],p0,0,0,0);p1=__builtin_amdgcn_mfma_f32_32x32x16_bf16(b1,qr[d0],p1,0,0,0);}}
}
typedef __attribute__((address_space(3))) const char* lds_cptr;
typedef short v4i16_t __attribute__((ext_vector_type(4)));
__device__ __forceinline__ void kload8(bf16x8*kf,lds_cptr kp){
  kf[0]=*(const __attribute__((address_space(3))) bf16x8*)(kp);      kf[1]=*(const __attribute__((address_space(3))) bf16x8*)(kp+512);
  kf[2]=*(const __attribute__((address_space(3))) bf16x8*)(kp+2048); kf[3]=*(const __attribute__((address_space(3))) bf16x8*)(kp+2560);
  kf[4]=*(const __attribute__((address_space(3))) bf16x8*)(kp+4096); kf[5]=*(const __attribute__((address_space(3))) bf16x8*)(kp+4608);
  kf[6]=*(const __attribute__((address_space(3))) bf16x8*)(kp+6144); kf[7]=*(const __attribute__((address_space(3))) bf16x8*)(kp+6656);
}
__device__ __forceinline__ void kload2(bf16x8*kf,lds_cptr kp,int j){ kf[2*j]=*(const __attribute__((address_space(3))) bf16x8*)(kp+j*2048); kf[2*j+1]=*(const __attribute__((address_space(3))) bf16x8*)(kp+j*2048+512); }
__device__ __forceinline__ s16x4 vtr(lds_cptr p){ return __builtin_bit_cast(s16x4,__builtin_amdgcn_ds_read_tr16_b64_v4i16((__attribute__((address_space(3))) v4i16_t*)p)); }
__device__ __forceinline__ float rowmax(const f32x16&p0,const f32x16&p1){
  float a=max3f(p0[0],p0[1],p1[0]),b=max3f(p0[2],p0[3],p1[1]);a=max3f(a,p1[2],p1[3]);
  #pragma unroll
  for(int r=4;r<16;r+=4){a=max3f(a,p0[r],p0[r+1]);b=max3f(b,p0[r+2],p0[r+3]);a=max3f(a,p1[r],p1[r+1]);b=max3f(b,p1[r+2],p1[r+3]);}
  const float m=max2f(a,b);
  auto rr=__builtin_amdgcn_permlane32_swap(__float_as_uint(m),__float_as_uint(m),false,false);
  return max2f(__uint_as_float(rr[0]),__uint_as_float(rr[1]));
}
__device__ __forceinline__ void pv(f32x16*o,int vb,bf16x8 pa0,bf16x8 pa1,bf16x8 pa2,bf16x8 pa3){
  #pragma unroll
  for(int d0=0;d0<2;++d0){s16x4 lo[4],hi[4];
    #pragma unroll
    for(int ks=0;ks<4;++ks){
      asm volatile("ds_read_b64_tr_b16 %0,%1 offset:%c2":"=&v"(lo[ks]):"v"(vb),"i"(d0*4096+ks*1024):"memory");
      asm volatile("ds_read_b64_tr_b16 %0,%1 offset:%c2":"=&v"(hi[ks]):"v"(vb),"i"(d0*4096+ks*1024+512):"memory");}
    asm volatile("s_waitcnt lgkmcnt(0)":::"memory");SBAR();
    #define PK(k) (bf16x8){lo[k][0],lo[k][1],lo[k][2],lo[k][3],hi[k][0],hi[k][1],hi[k][2],hi[k][3]}
    o[d0]=__builtin_amdgcn_mfma_f32_32x32x16_bf16(pa0,PK(0),o[d0],0,0,0);
    o[d0]=__builtin_amdgcn_mfma_f32_32x32x16_bf16(pa1,PK(1),o[d0],0,0,0);
    o[d0]=__builtin_amdgcn_mfma_f32_32x32x16_bf16(pa2,PK(2),o[d0],0,0,0);
    o[d0]=__builtin_amdgcn_mfma_f32_32x32x16_bf16(pa3,PK(3),o[d0],0,0,0);
    #undef PK
  }
}

__device__ __forceinline__ int swa_off(int j){ return j<2 ? 64*j : (j<4 ? 64*j-256 : 64*j-128); }
__device__ __forceinline__ int swa_clamp(int s){ return s<0?0:(s>S_-KVBLK?S_-KVBLK:s); }
#ifndef ATTN_STORE16
#define ATTN_STORE16(p,v) (*(u32x4*)(p)=(v))
#endif
template<int THRL,bool SWA> __device__ __forceinline__ void attn_unit(int b,int qb,const bf16*Qc,const bf16*__restrict__ Kc,const bf16*__restrict__ Vc,bf16*Oc,char*shm,const __attribute__((address_space(3))) float*btab,int g){
  int nt_ = SWA ? 7 : S_/KVBLK+1; asm volatile("":"+s"(nt_)); const int NT=nt_;
  int tid=threadIdx.x; asm volatile("":"+v"(tid));
  const int lane=tid&63,r32=lane&31,hi=lane>>5; const int wid=__builtin_amdgcn_readfirstlane(tid>>6);
  const bool meta=qb<0; const int hh=wid&1, blk=wid>>1;
  const int qrow0= meta ? NREG+b*NM : b*S_+128*qb+32*blk;
  const int tq= meta ? r32 : NM+128*qb+32*blk+r32;
  const int T0s= meta ? 0 : 128*qb;
  const bf16*Qw=Qc+(long)qrow0*DM+hh*D;
  #define TROW(t) ( SWA ? ((t)==NT-1 ? NREG+b*NM : b*S_+swa_clamp(T0s+swa_off(t))) : ((t)<NT-1 ? b*S_+KVBLK*(t) : NREG+b*NM) )
  const unsigned lds0=(unsigned)(uintptr_t)shm;
  float*wsf=(float*)(shm+LDS_WS)+wid*64;
  const bf16*ksrc=Kc+(long)lane*DM+wid*8;
  const bf16*vsrc=Vc+(long)(16*(wid&3)+(lane>>2))*DM+(wid>>2)*32+(lane&3)*8;
  const unsigned kdst=lds0+LDS_K+wid*1024, vdst=lds0+LDS_V+wid*1024;
  #define DMA_K(t,slot) glds16(ksrc+(long)TROW(t)*DM,(unsigned)__builtin_amdgcn_readfirstlane(kdst+(slot)))
  #define DMA_V(t,slot) glds16(vsrc+(long)TROW(t)*DM,(unsigned)__builtin_amdgcn_readfirstlane(vdst+(slot)))
  const int vb0=(int)(lds0+LDS_V)+((lane>>4)&1)*32+(lane&3)*8+(4*hi+((lane&15)>>2))*64;
  const char*Kbase=shm+LDS_K; bf16x8 kf[8];
  const lds_cptr shm3=(lds_cptr)shm; const lds_cptr kp0=shm3+LDS_K+hi*1024+r32*16; const lds_cptr vp0=shm3+LDS_V+((lane>>4)&1)*32+(lane&3)*8+(4*hi+((lane&15)>>2))*64;
  DMA_K(0,0);DMA_V(0,0);DMA_K(1,SLOTB);
  bf16x8 qr[4];
  #pragma unroll
  for(int d0=0;d0<4;++d0)qr[d0]=*reinterpret_cast<const bf16x8*>(&Qw[(long)r32*DM+d0*16+hi*8]);
  #define NEGC (SWA ? f32x16{} : negm)
  float mhat=0.f,l_reg=0.f;f32x16 o[2];o[0]=f32x16{};o[1]=f32x16{};f32x16 negm=f32x16{};if constexpr(!SWA){asm volatile("":"+v"(negm));}
  const __attribute__((address_space(3))) float*bt=btab+(2*g+hh)*264; const int relq=4*hi-tq;
  const __attribute__((address_space(3))) float*bt4s=btab+1088+((2*g+hh)*4+(relq&3))*544-(relq&3);
  #define CMASK(P0,P1,t) do{ if constexpr(SWA){ swa_mask(P0,P1,((t)==NT-1?0:NM+T0s+swa_off(t))+relq,(t)==NT-1?-128:-129,(t)==NT-1?128:129,(t)==NT-1,(t)!=NT-1&&((T0s+swa_off(t))<0||(T0s+swa_off(t))>=S_),bt,bt4s,mhat,T0s>=128); } else { if((t)==NT-1)meta_mask(P0,P1); } }while(0)
  bool resc=false;
  #define START(P0,P1) do{ const float rm=rowmax(P0,P1); resc=false; \
    { const float dl=rm; mhat=fadd_s(mhat,dl); \
      _Pragma("unroll") for(int r=0;r<16;++r){P0[r]=fsub_s(P0[r],dl);P1[r]=fsub_s(P1[r],dl);} \
      _Pragma("unroll") for(int r=0;r<16;++r)negm[r]=-mhat; if constexpr(!SWA){asm volatile("":"+v"(negm));} } \
    _Pragma("unroll") for(int r=0;r<16;++r)P0[r]=__builtin_amdgcn_exp2f(P0[r]); }while(0)
  #define RESC() do{ if(resc){ asm volatile("s_waitcnt lgkmcnt(0)":::"memory"); \
      _Pragma("unroll") for(int d_=0;d_<2;++d_) _Pragma("unroll") for(int r=0;r<16;++r)o[d_][r]*=wsf[crow(r,hi)]; } }while(0)
  f32x16 pA0,pA1,pB0,pB1;
  int sl_prev=0,sl_cur=0,sl_next=SLOTB;
  #define ROT() do{sl_prev=sl_cur;sl_cur=sl_next;sl_next=(sl_next==(NSLOT-1)*SLOTB)?0:sl_next+SLOTB;}while(0)
  DMA_K(2,2*SLOTB);
  WAIT_BAR(3);
  qkt(pA0,pA1,Kbase,qr,NEGC,r32,hi);asm volatile("s_nop 15\n\ts_nop 7":"+v"(pA0),"+v"(pA1));CMASK(pA0,pA1,0);
  START(pA0,pA1);
  _Pragma("unroll") for(int r=0;r<16;++r)pA1[r]=__builtin_amdgcn_exp2f(pA1[r]);
  WAIT_BAR(0);
  DMA_K(3,0);DMA_V(1,SLOTB);
  ROT();
  kload8(kf,kp0+sl_cur);
  WAIT_BAR(2);
  s16x4 vlo[8],vhi[8]; u32x4 pw0,pw1,pw2,pw3;
  #define PKW(P,B) cvtpk_s(P[B],P[B+1])
  #define PAF(k) __builtin_bit_cast(bf16x8,pw##k)
  #define VFR(i) (bf16x8){vlo[i][0],vlo[i][1],vlo[i][2],vlo[i][3],vhi[i][0],vhi[i][1],vhi[i][2],vhi[i][3]}
  #define PIN(x) asm volatile("":"+v"(x))
  #define MX3(a,b,c) __builtin_fmaxf(__builtin_fmaxf((a),(b)),(c))
  #define GAPA(MF,A0,A1,A2,A3,W0,W1,PW) do{ MF; sacc+=A0; sacc+=A1; sacc+=A2; sacc+=A3; PIN(sacc); W0; W1; PIN(PW); SBAR(); }while(0)
  #define EX(v) __builtin_amdgcn_exp2f(v)
  #define GAPB(MF,X,B) do{ MF; X[B]=EX(X[B]); X[B+1]=EX(X[B+1]); X[B+2]=EX(X[B+2]); X[B+3]=EX(X[B+3]); PIN(X); SBAR(); }while(0)
  #define VRD(i) do{ vlo[i]=vtr(vp_+(((i)>>2)*4096+((i)&3)*1024)); vhi[i]=vtr(vp_+(((i)>>2)*4096+((i)&3)*1024+512)); }while(0)
  #define KRD(G,j) do{ if(G){ kload2(kf,kp0+sl_next,j); SBAR(); } }while(0)
  #define STEP(C0,C1,P0,P1,t,GK,GV,GL) do{ SBAR(); \
    const lds_cptr vp_=vp0+sl_prev; \
    VRD(0); SBAR(); float sacc=(P0[0]+P0[1]); \
    GAPA(C0=__builtin_amdgcn_mfma_f32_32x32x16_bf16(kf[0],qr[0],NEGC,0,0,0), P0[2],P0[3],P0[4],P0[5],     pw0[0]=PKW(P0,0), pw0[1]=PKW(P0,2), pw0); \
    VRD(4); SBAR(); GAPA(C1=__builtin_amdgcn_mfma_f32_32x32x16_bf16(kf[1],qr[0],NEGC,0,0,0), P0[6],P0[7],P0[8],P0[9],     pw0[2]=PKW(P0,4), pw0[3]=PKW(P0,6), pw0); \
    VRD(1); SBAR(); GAPA(C0=__builtin_amdgcn_mfma_f32_32x32x16_bf16(kf[2],qr[1],C0,0,0,0),   P0[10],P0[11],P0[12],P0[13], pw1[0]=PKW(P0,8), pw1[1]=PKW(P0,10), pw1); \
    VRD(5); SBAR(); GAPA(C1=__builtin_amdgcn_mfma_f32_32x32x16_bf16(kf[3],qr[1],C1,0,0,0),   P0[14],P0[15],P1[0],P1[1],   pw1[2]=PKW(P0,12),pw1[3]=PKW(P0,14), pw1); \
    VRD(2); SBAR(); GAPA(C0=__builtin_amdgcn_mfma_f32_32x32x16_bf16(kf[4],qr[2],C0,0,0,0),   P1[2],P1[3],P1[4],P1[5],     pw2[0]=PKW(P1,0), pw2[1]=PKW(P1,2), pw2); \
    VRD(6); SBAR(); GAPA(C1=__builtin_amdgcn_mfma_f32_32x32x16_bf16(kf[5],qr[2],C1,0,0,0),   P1[6],P1[7],P1[8],P1[9],     pw2[2]=PKW(P1,4), pw2[3]=PKW(P1,6), pw2); \
    VRD(3); SBAR(); GAPA(C0=__builtin_amdgcn_mfma_f32_32x32x16_bf16(kf[6],qr[3],C0,0,0,0),   P1[10],P1[11],P1[12],P1[13], pw3[0]=PKW(P1,8), pw3[1]=PKW(P1,10), pw3); \
    VRD(7); SBAR(); GAPA(C1=__builtin_amdgcn_mfma_f32_32x32x16_bf16(kf[7],qr[3],C1,0,0,0),   P1[14],P1[15],0.f,0.f,       pw3[2]=PKW(P1,12),pw3[3]=PKW(P1,14), pw3); \
    l_reg+=sacc; \
    if(GK){DMA_K((t)+3,sl_cur);} if(GV){DMA_V((t)+1,sl_next);} \
    CMASK(C0,C1,t); \
    { float a=MX3(C0[0],C0[1],C1[0]),b=MX3(C0[2],C0[3],C1[1]); a=MX3(a,C1[2],C1[3]); \
      _Pragma("unroll") for(int r=4;r<16;r+=4){a=MX3(a,C0[r],C0[r+1]);b=MX3(b,C0[r+2],C0[r+3]);a=MX3(a,C1[r],C1[r+1]);b=MX3(b,C1[r+2],C1[r+3]);} \
      float rm=__builtin_fmaxf(a,b); { auto rr=__builtin_amdgcn_permlane32_swap(__float_as_uint(rm),__float_as_uint(rm),false,false); rm=__builtin_fmaxf(__uint_as_float(rr[0]),__uint_as_float(rr[1])); } \
      resc=false; \
      if(__builtin_expect(__any(rm>(float)THRL),0)){ const float dl=__builtin_fmaxf(rm,0.f); mhat+=dl; \
        _Pragma("unroll") for(int r=0;r<16;++r){C0[r]-=dl;C1[r]-=dl;} \
        _Pragma("unroll") for(int r=0;r<16;++r)negm[r]=-mhat; if constexpr(!SWA){asm volatile("":"+v"(negm));} \
        const float f=__builtin_amdgcn_exp2f(-dl); l_reg*=f; if(hi==0)wsf[r32]=f; resc=true; } } \
    SBAR(); \
    GAPB(o[0]=__builtin_amdgcn_mfma_f32_32x32x16_bf16(PAF(0),VFR(0),o[0],0,0,0), C0,0); \
    GAPB(o[1]=__builtin_amdgcn_mfma_f32_32x32x16_bf16(PAF(0),VFR(4),o[1],0,0,0), C0,4); \
    KRD(GL,0); GAPB(o[0]=__builtin_amdgcn_mfma_f32_32x32x16_bf16(PAF(1),VFR(1),o[0],0,0,0), C0,8); \
    KRD(GL,1); GAPB(o[1]=__builtin_amdgcn_mfma_f32_32x32x16_bf16(PAF(1),VFR(5),o[1],0,0,0), C0,12); \
    KRD(GL,2); GAPB(o[0]=__builtin_amdgcn_mfma_f32_32x32x16_bf16(PAF(2),VFR(2),o[0],0,0,0), C1,0); \
    KRD(GL,3); GAPB(o[1]=__builtin_amdgcn_mfma_f32_32x32x16_bf16(PAF(2),VFR(6),o[1],0,0,0), C1,4); \
    GAPB(o[0]=__builtin_amdgcn_mfma_f32_32x32x16_bf16(PAF(3),VFR(3),o[0],0,0,0), C1,8); \
    GAPB(o[1]=__builtin_amdgcn_mfma_f32_32x32x16_bf16(PAF(3),VFR(7),o[1],0,0,0), C1,12); \
    }while(0)
  int t=1;
  #undef CMASK
  #define CMASK(P0,P1,t) do{ if constexpr(SWA){ swa_mask(P0,P1,((t)==NT-1?0:NM+T0s+swa_off(t))+relq,(t)==NT-1?-128:-129,(t)==NT-1?128:129,(t)==NT-1,(t)!=NT-1&&((T0s+swa_off(t))<0||(T0s+swa_off(t))>=S_),bt,bt4s,mhat,T0s>=128); } }while(0)
  for(;t+5<NT;t+=2){
    STEP(pB0,pB1,pA0,pA1,t,true,true,true);     WAIT_BAR(2); RESC(); ROT();
    STEP(pA0,pA1,pB0,pB1,t+1,true,true,true);   WAIT_BAR(2); RESC(); ROT();
  }
  #undef CMASK
  #define CMASK(P0,P1,t) do{ if constexpr(SWA){ swa_mask(P0,P1,((t)==NT-1?0:NM+T0s+swa_off(t))+relq,(t)==NT-1?-128:-129,(t)==NT-1?128:129,(t)==NT-1,(t)!=NT-1&&((T0s+swa_off(t))<0||(T0s+swa_off(t))>=S_),bt,bt4s,mhat,T0s>=128); } else { if((t)==NT-1)meta_mask(P0,P1); } }while(0)
  #define ENDW(tt) do{ if((tt)+3<NT){WAIT_BAR(2);} else if((tt)+2<NT){WAIT_BAR(1);} else {WAIT_BAR(0);} }while(0)
  for(;t+2<NT;t+=2){
    STEP(pB0,pB1,pA0,pA1,t,(t+3<NT),(t+1<NT),(t+1<NT));       ENDW(t);   RESC(); ROT();
    STEP(pA0,pA1,pB0,pB1,t+1,(t+4<NT),(t+2<NT),(t+2<NT));     ENDW(t+1); RESC(); ROT();
  }
  STEP(pB0,pB1,pA0,pA1,NT-2,false,true,true); WAIT_BAR(0); RESC(); ROT();
  STEP(pA0,pA1,pB0,pB1,NT-1,false,false,false); RESC();
  { float sacc=pA0[0]+pA0[1]; _Pragma("unroll") for(int r=2;r<16;++r)sacc+=pA0[r]; _Pragma("unroll") for(int r=0;r<16;++r)sacc+=pA1[r]; l_reg+=sacc;
    pw0=(u32x4){PKW(pA0,0),PKW(pA0,2),PKW(pA0,4),PKW(pA0,6)};pw1=(u32x4){PKW(pA0,8),PKW(pA0,10),PKW(pA0,12),PKW(pA0,14)};pw2=(u32x4){PKW(pA1,0),PKW(pA1,2),PKW(pA1,4),PKW(pA1,6)};pw3=(u32x4){PKW(pA1,8),PKW(pA1,10),PKW(pA1,12),PKW(pA1,14)};
    SBAR(); pv(o,vb0+sl_cur,PAF(0),PAF(1),PAF(2),PAF(3)); }
  #undef PKW
  #undef PAF
  #undef VFR
  #undef PIN
  #undef MX3
  #undef GAPA
  #undef GAPB
  #undef EX
  #undef VRD
  #undef KRD
  #undef STEP
  #undef ENDW
  {auto rr=__builtin_amdgcn_permlane32_swap(__float_as_uint(l_reg),__float_as_uint(l_reg),false,false);l_reg=__uint_as_float(rr[0])+__uint_as_float(rr[1]);}
  if constexpr(SWA){ l_reg+=__builtin_amdgcn_exp2f(btab[4*264+2*g+hh]-mhat); }
  int lane_e=threadIdx.x&63; asm volatile("":"+v"(lane_e)); const int r32e=lane_e&31,hie=lane_e>>5;
  if(hie==0)wsf[32+r32e]=l_reg;asm volatile("s_waitcnt lgkmcnt(0)":::"memory");
  float rli[16];
  #pragma unroll
  for(int r=0;r<16;++r)rli[r]=__builtin_amdgcn_rcpf(wsf[32+crow(r,hie)]);
  bf16*Ow=Oc+(long)qrow0*1024+hh*D;
  { bf16*stg=(bf16*)(shm+LDS_OST)+wid*2048;
    #pragma unroll
    for(int r=0;r<16;++r){const int orow=crow(r,hie);
      #pragma unroll
      for(int d0=0;d0<2;++d0)stg[orow*64+d0*32+r32e]=(bf16)(cvtpk_s(o[d0][r]*rli[r],0.f)&0xffffu);}
    asm volatile("s_waitcnt lgkmcnt(0)":::"memory");
    #pragma unroll
    for(int i=0;i<4;++i){const int row=i*8+(lane_e>>3),ch=lane_e&7; const u32x4 v=*(const u32x4*)(stg+row*64+ch*8); if(!meta||(blk==0&&row<NM))ATTN_STORE16(Ow+(long)row*1024+ch*8,v);} }
  asm volatile("s_waitcnt lgkmcnt(0)\n\ts_barrier":::"memory");
  #undef DMA_K
  #undef DMA_V
  #undef TROW
  #undef NEGC
  #undef CMASK
  #undef START
  #undef RESC
  #undef ROT
}
constexpr int ATTN_LDS_BYTES=LDS_BYTES;
#undef SBAR
#undef WAIT_BAR
}

#define GAS __attribute__((address_space(1)))
#define LAS __attribute__((address_space(3)))
typedef unsigned short bf16;
typedef unsigned v4u __attribute__((ext_vector_type(4)));
typedef float f32x4 __attribute__((ext_vector_type(4)));
typedef short bf16x8 __attribute__((ext_vector_type(8)));
typedef GAS unsigned gu32;
typedef GAS unsigned long long gu64;
#define RLX_AGENT __ATOMIC_RELAXED, __HIP_MEMORY_SCOPE_AGENT
#define LDS_WAIT() asm volatile("s_waitcnt lgkmcnt(0)" ::: "memory")
#define VM_WAIT() asm volatile("s_waitcnt vmcnt(0)" ::: "memory")
__device__ __forceinline__ unsigned long long rt() { return __builtin_amdgcn_s_memrealtime(); }
__device__ __forceinline__ unsigned pk2(float lo, float hi) { return (unsigned)f2bf(lo) | ((unsigned)f2bf(hi) << 16); }

#define XB_TMO      128
#define XB_XCNT(j)  (256  + 64 * (j))
#define XB_XSUB(j)  (1280 + 64 * (j))
#define XB_XGEN(j)  (2304 + 64 * (j))
#define XB_TOP      3328
#define XB_TOPGEN   3392
#define XCD_BAR_WORDS 3456
#define XB_SPIN_CAP (1u << 22)

__device__ __forceinline__ unsigned xb_ld(unsigned* p)              { return __hip_atomic_load(p, __ATOMIC_RELAXED, __HIP_MEMORY_SCOPE_AGENT); }
__device__ __forceinline__ unsigned xb_add(unsigned* p, unsigned v) { return __hip_atomic_fetch_add(p, v, __ATOMIC_RELAXED, __HIP_MEMORY_SCOPE_AGENT); }
__device__ __forceinline__ unsigned xb_xcc_id() { return (unsigned)__builtin_amdgcn_s_getreg((3 << 11) | 20) & 0xFu; }
#define XB_SPIN(cond, bar) do { unsigned _sp = 0; while (cond) { __builtin_amdgcn_s_sleep(1); \
    if ((++_sp & 255u) == 0u) { if (xb_ld(&(bar)[XB_TMO])) break; if (_sp > XB_SPIN_CAP) { atomicAdd(&(bar)[XB_TMO], 1u); break; } } } } while (0)

struct XcdBarrier {
    unsigned* bar; unsigned x;
    volatile LAS unsigned* st;
};

__device__ __forceinline__ XcdBarrier xcd_barrier_post(unsigned* bar, volatile LAS unsigned* st) {
    XcdBarrier b; b.bar = bar; b.x = xb_xcc_id(); b.st = st;
    if (threadIdx.x == 0) (void)xb_add(&bar[XB_XCNT(b.x)], 1u);
    return b;
}
__device__ __forceinline__ void xcd_barrier_complete(unsigned* bar, unsigned x, unsigned& nloc, unsigned& nx) {
    const unsigned G = gridDim.x * gridDim.y * gridDim.z;
    unsigned sum, cnt, mine, sp = 0u;
    for (;;) {
        sum = 0u; cnt = 0u; mine = 0u;
#pragma unroll
        for (unsigned j = 0; j < 16; ++j) { const unsigned c = xb_ld(&bar[XB_XCNT(j)]); sum += c; cnt += (c > 0u) ? 1u : 0u; mine = (j == x) ? c : mine; }
        if (sum == G) break;
        __builtin_amdgcn_s_sleep(1);
        if ((++sp & 255u) == 0u) { if (xb_ld(&bar[XB_TMO])) break; if (sp > XB_SPIN_CAP) { atomicAdd(&bar[XB_TMO], 1u); break; } }
    }
    nloc = mine > 0u ? mine : 1u; nx = cnt > 0u ? cnt : 1u;
}

__device__ __forceinline__ void xcd_barrier(const XcdBarrier& b) {
    asm volatile("s_waitcnt vmcnt(0)" ::: "memory");
    __syncthreads();
    if (threadIdx.x == 0) {
        unsigned* bar = b.bar;
        __builtin_amdgcn_s_waitcnt(0);
        unsigned nloc = b.st[0], nx = b.st[1];
        if (nloc == 0u) { xcd_barrier_complete(bar, b.x, nloc, nx); b.st[0] = nloc; b.st[1] = nx; }
        const unsigned old = xb_add(&bar[XB_XSUB(b.x)], 1u);
        const unsigned gen = old / nloc;
        if (old + 1u == (gen + 1u) * nloc) {
            __builtin_amdgcn_fence(__ATOMIC_RELEASE, "agent");
            asm volatile("s_waitcnt vmcnt(0)" ::: "memory");
            const unsigned og = xb_add(&bar[XB_TOP], 1u);
            const unsigned tg = og / nx;
            if (og + 1u == (tg + 1u) * nx) xb_add(&bar[XB_TOPGEN], 1u);
            else XB_SPIN(xb_ld(&bar[XB_TOPGEN]) == tg, bar);
            __builtin_amdgcn_fence(__ATOMIC_ACQUIRE, "agent");
            xb_add(&bar[XB_XGEN(b.x)], 1u);
            asm volatile("s_waitcnt vmcnt(0)" ::: "memory");
        } else {
            XB_SPIN(xb_ld(&bar[XB_XGEN(b.x)]) == gen, bar);
            __builtin_amdgcn_fence(__ATOMIC_ACQUIRE, "agent");
            asm volatile("s_waitcnt vmcnt(0)" ::: "memory");
        }
    }
    __syncthreads();
}

__device__ __forceinline__ void xcd_barrier_lean(const XcdBarrier& b) {
    asm volatile("s_waitcnt vmcnt(0)" ::: "memory");
    __syncthreads();
    if (threadIdx.x == 0) {
        unsigned* bar = b.bar; unsigned bx = b.x; asm volatile("" : "+s"(bar), "+s"(bx));
        __builtin_amdgcn_s_waitcnt(0);
        unsigned nloc = b.st[0], nx = b.st[1];
        const unsigned old = xb_add(&bar[XB_XSUB(bx)], 1u);
        const unsigned gen = old / nloc;
        if (old + 1u == (gen + 1u) * nloc) {
            __builtin_amdgcn_fence(__ATOMIC_RELEASE, "agent");
            asm volatile("s_waitcnt vmcnt(0)" ::: "memory");
            const unsigned og = xb_add(&bar[XB_TOP], 1u);
            const unsigned tg = og / nx;
            if (og + 1u == (tg + 1u) * nx) xb_add(&bar[XB_TOPGEN], 1u);
            else XB_SPIN(xb_ld(&bar[XB_TOPGEN]) == tg, bar);
            __builtin_amdgcn_fence(__ATOMIC_ACQUIRE, "agent");
            xb_add(&bar[XB_XGEN(bx)], 1u);
            asm volatile("s_waitcnt vmcnt(0)" ::: "memory");
        } else {
            XB_SPIN(xb_ld(&bar[XB_XGEN(bx)]) == gen, bar);
            __builtin_amdgcn_fence(__ATOMIC_ACQUIRE, "agent");
            asm volatile("s_waitcnt vmcnt(0)" ::: "memory");
        }
    }
    __syncthreads();
}

namespace mix {
typedef short bf16x8 __attribute__((ext_vector_type(8)));
typedef short s16x4 __attribute__((ext_vector_type(4)));
typedef float f32x4 __attribute__((ext_vector_type(4)));
typedef unsigned u32x4 __attribute__((ext_vector_type(4)));
typedef unsigned u32x2 __attribute__((ext_vector_type(2)));
typedef __attribute__((address_space(3))) const char* lcp;
typedef __attribute__((address_space(3))) char* lp;
#define MFMA16(a, b, c) __builtin_amdgcn_mfma_f32_16x16x32_bf16((a), (b), (c), 0, 0, 0)
__device__ __forceinline__ bf16x8 frag_row(lcp tile, int P, int row0, int k0, int fr, int quad) { return *(const __attribute__((address_space(3))) bf16x8*)(tile + (row0 + fr) * P + (k0 + 8 * quad) * 2); }
__device__ __forceinline__ bf16x8 frag_tr(lcp tile, int P, int k0, int col0, int fr, int quad) {
    typedef short v4i16_t __attribute__((ext_vector_type(4)));
    lcp a = tile + (k0 + 8 * quad + (fr >> 2)) * P + (col0 + 4 * (fr & 3)) * 2;
    const s16x4 lo = __builtin_bit_cast(s16x4, __builtin_amdgcn_ds_read_tr16_b64_v4i16((__attribute__((address_space(3))) v4i16_t*)a));
    const s16x4 hi = __builtin_bit_cast(s16x4, __builtin_amdgcn_ds_read_tr16_b64_v4i16((__attribute__((address_space(3))) v4i16_t*)(a + 4 * P)));
    return (bf16x8){lo[0], lo[1], lo[2], lo[3], hi[0], hi[1], hi[2], hi[3]};
}
__device__ __forceinline__ unsigned pkbf(float lo, float hi) { typedef float f2 __attribute__((ext_vector_type(2))); typedef __bf16 b2 __attribute__((ext_vector_type(2))); f2 v = {lo, hi}; return __builtin_bit_cast(unsigned, __builtin_convertvector(v, b2)); }
__device__ __forceinline__ float softplus_fast(float x) { return x > 20.f ? x : 0.6931471805599453f * __builtin_amdgcn_logf(1.0f + __builtin_amdgcn_exp2f(x * 1.4426950408889634f)); }
__device__ __forceinline__ float logsigmoid_fast(float x) { return x < -20.f ? x : -0.6931471805599453f * __builtin_amdgcn_logf(1.0f + __builtin_amdgcn_exp2f(-x * 1.4426950408889634f)); }
__device__ __forceinline__ float bflo(unsigned u) { return __uint_as_float(u << 16); }
__device__ __forceinline__ float bfhi(unsigned u) { return __uint_as_float(u & 0xffff0000u); }

constexpr int SSD_CT = 0, SSD_BT = 34816, SSD_XD = 69632, SSD_XW = 88064, SSD_SB = 106496, SSD_ACS = 123904, SSD_DTL = 124416, SSD_LDS = 124928;
__device__ __forceinline__ int ssd_tok(int c, int l, int dir) { return dir == 0 ? 128 * c - 112 + l : 128 * (32 - c) + 15 - l; }
__device__ __forceinline__ void ssd_stream(int b, int h, int dir, const bf16* xbca, const float* dtga, float dt_bias, float a_neg, bf16* yout, int ypitch, lp lds) {
    int tid = threadIdx.x; asm volatile("" : "+v"(tid));
    const int lane = tid & 63, fr = lane & 15, quad = lane >> 4; const int w = __builtin_amdgcn_readfirstlane(tid >> 6);
    const int g = h >> 1;
    constexpr int P128 = 272, P64 = 144;
    f32x4 S[4];
#pragma unroll
    for (int pb = 0; pb < 4; ++pb) S[pb] = (f32x4){0.f, 0.f, 0.f, 0.f};
    __attribute__((address_space(3))) float* acs = (__attribute__((address_space(3))) float*)(lds + SSD_ACS);
    __attribute__((address_space(3))) float* dtl = (__attribute__((address_space(3))) float*)(lds + SSD_DTL);
    u32x4 pc[4], pbv[4], px[2]; float pd0 = 0.f, pd1 = 0.f;
#define SSD_PREFETCH(cc) do { \
        _Pragma("unroll") for (int i = 0; i < 4; ++i) { const int id = tid + 512 * i, row = id >> 4, ch = id & 15; const int t = ssd_tok((cc), row, dir); pc[i] = (u32x4){0u, 0u, 0u, 0u}; pbv[i] = (u32x4){0u, 0u, 0u, 0u}; \
            if (t >= 0) { const bf16* src = xbca + (size_t)row_of(b, t) * XW + g * 128 + ch * 8; pbv[i] = *(const u32x4*)(src + 256); pc[i] = *(const u32x4*)(src + 512); } } \
        _Pragma("unroll") for (int i = 0; i < 2; ++i) { const int id = tid + 512 * i, row = id >> 3, ch = id & 7; const int t = ssd_tok((cc), row, dir); px[i] = (u32x4){0u, 0u, 0u, 0u}; \
            if (t >= 0) px[i] = *(const u32x4*)(xbca + (size_t)row_of(b, t) * XW + h * 64 + ch * 8); } \
        if (w == 0) { const int t0 = ssd_tok((cc), 2 * lane, dir), t1 = ssd_tok((cc), 2 * lane + 1, dir); \
            pd0 = t0 >= 0 ? dtga[(size_t)row_of(b, t0 < 0 ? 0 : t0) * DGW + dir * 4 + h] : 0.f; pd1 = t1 >= 0 ? dtga[(size_t)row_of(b, t1 < 0 ? 0 : t1) * DGW + dir * 4 + h] : 0.f; } } while (0)
    SSD_PREFETCH(0);
    for (int c = 0; c < 33; ++c) {
        if (w == 0) {
            const int t0 = ssd_tok(c, 2 * lane, dir), t1 = ssd_tok(c, 2 * lane + 1, dir);
            const float d0 = t0 >= 0 ? softplus_fast(pd0 + dt_bias) : 0.f, d1 = t1 >= 0 ? softplus_fast(pd1 + dt_bias) : 0.f;
            const float v0 = d0 * a_neg, v1 = v0 + d1 * a_neg;
            float inc = v1;
#pragma unroll
            for (int o = 1; o < 64; o <<= 1) { const float u = __shfl_up(inc, o); if (lane >= o) inc += u; }
            const float pre = inc - v1;
            acs[2 * lane] = pre + v0; acs[2 * lane + 1] = pre + v1; dtl[2 * lane] = d0; dtl[2 * lane + 1] = d1;
        }
#pragma unroll
        for (int i = 0; i < 4; ++i) { const int id = tid + 512 * i, row = id >> 4, ch = id & 15;
            *(__attribute__((address_space(3))) u32x4*)(lds + SSD_CT + row * P128 + ch * 16) = pc[i]; *(__attribute__((address_space(3))) u32x4*)(lds + SSD_BT + row * P128 + ch * 16) = pbv[i]; }
#pragma unroll
        for (int pb = 0; pb < 4; ++pb) { u32x2 v; v.x = pkbf(S[pb][0], S[pb][1]); v.y = pkbf(S[pb][2], S[pb][3]);
            *(__attribute__((address_space(3))) u32x2*)(lds + SSD_SB + (16 * pb + fr) * P128 + (16 * w + 4 * quad) * 2) = v; }
        __syncthreads();
        const float alast = acs[127];
#pragma unroll
        for (int i = 0; i < 2; ++i) { const int id = tid + 512 * i, row = id >> 3, ch = id & 7; const u32x4 vx = px[i];
            const float d = dtl[row], dw = d * __expf(alast - acs[row]);
            u32x4 o1, o2;
            o1.x = pkbf(bflo(vx.x) * d, bfhi(vx.x) * d); o1.y = pkbf(bflo(vx.y) * d, bfhi(vx.y) * d); o1.z = pkbf(bflo(vx.z) * d, bfhi(vx.z) * d); o1.w = pkbf(bflo(vx.w) * d, bfhi(vx.w) * d);
            o2.x = pkbf(bflo(vx.x) * dw, bfhi(vx.x) * dw); o2.y = pkbf(bflo(vx.y) * dw, bfhi(vx.y) * dw); o2.z = pkbf(bflo(vx.z) * dw, bfhi(vx.z) * dw); o2.w = pkbf(bflo(vx.w) * dw, bfhi(vx.w) * dw);
            *(__attribute__((address_space(3))) u32x4*)(lds + SSD_XD + row * P64 + ch * 16) = o1; *(__attribute__((address_space(3))) u32x4*)(lds + SSD_XW + row * P64 + ch * 16) = o2; }
        if (c + 1 < 33) SSD_PREFETCH(c + 1);
        __syncthreads();
        f32x4 G[8];
#pragma unroll
        for (int sb = 0; sb < 8; ++sb) { G[sb] = (f32x4){0.f, 0.f, 0.f, 0.f};
            if (sb <= w) {
#pragma unroll
                for (int ks = 0; ks < 4; ++ks) G[sb] = MFMA16(frag_row(lds + SSD_BT, P128, 16 * sb, 32 * ks, fr, quad), frag_row(lds + SSD_CT, P128, 16 * w, 32 * ks, fr, quad), G[sb]); } }
        { const float dec = __expf(alast);
#pragma unroll
            for (int pb = 0; pb < 4; ++pb) S[pb] = S[pb] * dec;
#pragma unroll
            for (int ks = 0; ks < 4; ++ks) { const bf16x8 fb = frag_tr(lds + SSD_BT, P128, 32 * ks, 16 * w, fr, quad);
#pragma unroll
                for (int pb = 0; pb < 4; ++pb) S[pb] = MFMA16(fb, frag_tr(lds + SSD_XW, P64, 32 * ks, 16 * pb, fr, quad), S[pb]); } }
        __syncthreads();
        { const int l = 16 * w + fr; const float al = acs[l]; int dq = fr - 4 * quad; asm volatile("" : "+v"(dq));
#pragma unroll
            for (int sb = 0; sb < 8; ++sb) { u32x2 v = {0u, 0u};
                if (sb <= w) { const int s0 = 16 * sb + 4 * quad; const f32x4 as = *(const __attribute__((address_space(3))) f32x4*)(acs + s0);
                    const bool dg = sb == w;
                    const float e0 = (!dg || 0 <= dq) ? G[sb][0] * __expf(al - as[0]) : 0.f, e1 = (!dg || 1 <= dq) ? G[sb][1] * __expf(al - as[1]) : 0.f;
                    const float e2 = (!dg || 2 <= dq) ? G[sb][2] * __expf(al - as[2]) : 0.f, e3 = (!dg || 3 <= dq) ? G[sb][3] * __expf(al - as[3]) : 0.f;
                    v.x = pkbf(e0, e1); v.y = pkbf(e2, e3); }
                *(__attribute__((address_space(3))) u32x2*)(lds + SSD_BT + l * P128 + (16 * sb + 4 * quad) * 2) = v; } }
        __syncthreads();
        f32x4 Y[4], YO[4];
#pragma unroll
        for (int pb = 0; pb < 4; ++pb) { Y[pb] = (f32x4){0.f, 0.f, 0.f, 0.f}; YO[pb] = (f32x4){0.f, 0.f, 0.f, 0.f}; }
#pragma unroll
        for (int ks = 0; ks < 4; ++ks) {
            if (32 * ks <= 16 * w + 15) { const bf16x8 fs = frag_row(lds + SSD_BT, P128, 16 * w, 32 * ks, fr, quad);
#pragma unroll
                for (int pb = 0; pb < 4; ++pb) Y[pb] = MFMA16(frag_tr(lds + SSD_XD, P64, 32 * ks, 16 * pb, fr, quad), fs, Y[pb]); }
            const bf16x8 fc = frag_row(lds + SSD_CT, P128, 16 * w, 32 * ks, fr, quad);
#pragma unroll
            for (int pb = 0; pb < 4; ++pb) YO[pb] = MFMA16(frag_row(lds + SSD_SB, P128, 16 * pb, 32 * ks, fr, quad), fc, YO[pb]);
        }
        { const int l = 16 * w + fr; const float el = __expf(acs[l]); const int t = ssd_tok(c, l, dir);
            if (t >= 0) { bf16* op = yout + (size_t)row_of(b, t) * ypitch + h * 64 + 4 * quad;
#pragma unroll
                for (int pb = 0; pb < 4; ++pb) { const f32x4 y = Y[pb] + YO[pb] * el; u32x2 v; v.x = pkbf(y[0], y[1]); v.y = pkbf(y[2], y[3]); *(u32x2*)(op + 16 * pb) = v; } } }
        __syncthreads();
    }
}

constexpr int GLA_QT = 0, GLA_KT = 5120, GLA_KD = 10240, GLA_V = 15360, GLA_ATT = 24576, GLA_SB = 33792, GLA_WTOT = 38912, GLA_W2 = 39936, GLA_GB = 41984, GLA_LDS = 42112;
__device__ __forceinline__ int gla_tok(int c, int l, int dir) { return dir == 0 ? 64 * c - 48 + l : 64 * (64 - c) + 15 - l; }
__device__ __forceinline__ void gla_stream(int b, int h, int dir, const bf16* proj, const float* dtga, const float* gate_w2, const float* gate_b, bf16* oout, int opitch, lp lds) {
    int tid = threadIdx.x; asm volatile("" : "+v"(tid));
    const int lane = tid & 63, fr = lane & 15, quad = lane >> 4; const int w = __builtin_amdgcn_readfirstlane(tid >> 6);
    constexpr int P32 = 80, P64 = 144;
    typedef __attribute__((address_space(3))) float lfloat; typedef __attribute__((address_space(3))) f32x4 lf4;
    lfloat* wtot = (lfloat*)(lds + GLA_WTOT); lfloat* w2s = (lfloat*)(lds + GLA_W2); lfloat* gbs = (lfloat*)(lds + GLA_GB);
    for (int i = tid; i < 16 * 32; i += 512) w2s[i] = gate_w2[(dir * 16 + (i >> 5)) * 128 + h * 32 + (i & 31)];
    if (tid < 32) gbs[tid] = gate_b[dir * 128 + h * 32 + tid];
    __syncthreads();
    const int kb = w & 1, vbs = w >> 1;
    f32x4 S = {0.f, 0.f, 0.f, 0.f};
    const int rl = tid >> 3, kq = tid & 7;
    f32x4 pa0, pa1, pa2, pa3; unsigned long long pqq, pkk; u32x4 pvv; bool pok;
#define GLA_PREFETCH(cc) do { const int t_ = gla_tok((cc), rl, dir); pok = t_ >= 0; const size_t row_ = (size_t)row_of(b, pok ? t_ : 0); \
        pa0 = (f32x4){0.f, 0.f, 0.f, 0.f}; pa1 = pa0; pa2 = pa0; pa3 = pa0; pqq = 0ull; pkk = 0ull; pvv = (u32x4){0u, 0u, 0u, 0u}; \
        if (pok) { const float* ap = dtga + row_ * DGW + 8 + dir * 16; pa0 = *(const f32x4*)ap; pa1 = *(const f32x4*)(ap + 4); pa2 = *(const f32x4*)(ap + 8); pa3 = *(const f32x4*)(ap + 12); \
            pqq = *(const unsigned long long*)(proj + row_ * PW + PGQ + h * 32 + 4 * kq); pkk = *(const unsigned long long*)(proj + row_ * PW + PGK + h * 32 + 4 * kq); \
            pvv = *(const u32x4*)(proj + row_ * PW + PGV + h * 64 + 8 * kq); } } while (0)
    GLA_PREFETCH(0);
    for (int c = 0; c < 65; ++c) {
        const bool ok = pok;
        float gv[4] = {0.f, 0.f, 0.f, 0.f}; float qv[4] = {0.f, 0.f, 0.f, 0.f}, kv[4] = {0.f, 0.f, 0.f, 0.f}; const u32x4 vv = pvv;
        if (ok) {
            const f32x4 a0 = pa0, a1 = pa1, a2 = pa2, a3 = pa3;
            f32x4 z = *(const lf4*)(gbs + 4 * kq);
#pragma unroll
            for (int r = 0; r < 16; ++r) { const float ar = r < 4 ? a0[r & 3] : (r < 8 ? a1[r & 3] : (r < 12 ? a2[r & 3] : a3[r & 3])); const f32x4 ww = *(const lf4*)(w2s + r * 32 + 4 * kq); z = z + ww * ar; }
#pragma unroll
            for (int j = 0; j < 4; ++j) gv[j] = logsigmoid_fast(z[j]) * (1.0f / 16.0f);
            const unsigned long long qq = pqq, kk = pkk;
#pragma unroll
            for (int j = 0; j < 4; ++j) { qv[j] = __uint_as_float((unsigned)((qq >> (16 * j)) & 0xffffu) << 16) * 0.17677669529663687f; kv[j] = __uint_as_float((unsigned)((kk >> (16 * j)) & 0xffffu) << 16); }
        }
        if (c + 1 < 65) GLA_PREFETCH(c + 1);
        float bc[4];
#pragma unroll
        for (int j = 0; j < 4; ++j) { float x = gv[j];
#pragma unroll
            for (int o = 8; o < 64; o <<= 1) { const float u = __shfl_up(x, o); if (lane >= o) x += u; }
            bc[j] = x; }
        if (lane >= 56) { *(lf4*)(wtot + w * 32 + 4 * kq) = (f32x4){bc[0], bc[1], bc[2], bc[3]}; }
        *(__attribute__((address_space(3))) u32x4*)(lds + GLA_V + rl * P64 + kq * 16) = vv;
        { u32x2 sv; sv.x = pkbf(S[0], S[1]); sv.y = pkbf(S[2], S[3]); *(__attribute__((address_space(3))) u32x2*)(lds + GLA_SB + (16 * vbs + fr) * P32 + (16 * kb + 4 * quad) * 2) = sv; }
        __syncthreads();
        f32x4 pre = {0.f, 0.f, 0.f, 0.f}, blast = {0.f, 0.f, 0.f, 0.f};
#pragma unroll
        for (int ww = 0; ww < 8; ++ww) { const f32x4 tt = *(const lf4*)(wtot + ww * 32 + 4 * kq); blast = blast + tt; if (ww < w) pre = pre + tt; }
        { u32x2 oq, ok2, od; float e[4], en[4], ed[4];
#pragma unroll
            for (int j = 0; j < 4; ++j) { const float bb = bc[j] + pre[j]; e[j] = qv[j] * __expf(bb); en[j] = kv[j] * __expf(-bb); ed[j] = kv[j] * __expf(blast[j] - bb); }
            oq.x = pkbf(e[0], e[1]); oq.y = pkbf(e[2], e[3]); ok2.x = pkbf(en[0], en[1]); ok2.y = pkbf(en[2], en[3]); od.x = pkbf(ed[0], ed[1]); od.y = pkbf(ed[2], ed[3]);
            *(__attribute__((address_space(3))) u32x2*)(lds + GLA_QT + rl * P32 + kq * 8) = oq; *(__attribute__((address_space(3))) u32x2*)(lds + GLA_KT + rl * P32 + kq * 8) = ok2; *(__attribute__((address_space(3))) u32x2*)(lds + GLA_KD + rl * P32 + kq * 8) = od; }
        __syncthreads();
        { const int lb = w & 3;
#pragma unroll
            for (int i = 0; i < 2; ++i) { const int sb = 2 * (w >> 2) + i; f32x4 A = {0.f, 0.f, 0.f, 0.f};
                if (sb <= lb) A = MFMA16(frag_row(lds + GLA_KT, P32, 16 * sb, 0, fr, quad), frag_row(lds + GLA_QT, P32, 16 * lb, 0, fr, quad), A);
                const int l = 16 * lb + fr, s0 = 16 * sb + 4 * quad; u32x2 v;
                v.x = pkbf(s0 + 0 <= l ? A[0] : 0.f, s0 + 1 <= l ? A[1] : 0.f); v.y = pkbf(s0 + 2 <= l ? A[2] : 0.f, s0 + 3 <= l ? A[3] : 0.f);
                *(__attribute__((address_space(3))) u32x2*)(lds + GLA_ATT + l * P64 + s0 * 2) = v; } }
        { const f32x4 bl = *(const lf4*)(wtot + 0 * 32 + 16 * kb + 4 * quad) + *(const lf4*)(wtot + 1 * 32 + 16 * kb + 4 * quad)
                         + *(const lf4*)(wtot + 2 * 32 + 16 * kb + 4 * quad) + *(const lf4*)(wtot + 3 * 32 + 16 * kb + 4 * quad)
                         + *(const lf4*)(wtot + 4 * 32 + 16 * kb + 4 * quad) + *(const lf4*)(wtot + 5 * 32 + 16 * kb + 4 * quad)
                         + *(const lf4*)(wtot + 6 * 32 + 16 * kb + 4 * quad) + *(const lf4*)(wtot + 7 * 32 + 16 * kb + 4 * quad);
            S[0] *= __expf(bl[0]); S[1] *= __expf(bl[1]); S[2] *= __expf(bl[2]); S[3] *= __expf(bl[3]);
#pragma unroll
            for (int ks = 0; ks < 2; ++ks) S = MFMA16(frag_tr(lds + GLA_KD, P32, 32 * ks, 16 * kb, fr, quad), frag_tr(lds + GLA_V, P64, 32 * ks, 16 * vbs, fr, quad), S); }
        __syncthreads();
        { const int lb = w & 3; const int l = 16 * lb + fr; const int to = gla_tok(c, l, dir);
            const bf16x8 fq = frag_row(lds + GLA_QT, P32, 16 * lb, 0, fr, quad);
#pragma unroll
            for (int i = 0; i < 2; ++i) { const int vb = 2 * (w >> 2) + i; f32x4 O = {0.f, 0.f, 0.f, 0.f};
#pragma unroll
                for (int ks = 0; ks < 2; ++ks) if (32 * ks <= 16 * lb + 15) O = MFMA16(frag_tr(lds + GLA_V, P64, 32 * ks, 16 * vb, fr, quad), frag_row(lds + GLA_ATT, P64, 16 * lb, 32 * ks, fr, quad), O);
                O = MFMA16(frag_row(lds + GLA_SB, P32, 16 * vb, 0, fr, quad), fq, O);
                if (to >= 0) { u32x2 v; v.x = pkbf(O[0], O[1]); v.y = pkbf(O[2], O[3]); *(u32x2*)(oout + (size_t)row_of(b, to) * opitch + h * 64 + 16 * vb + 4 * quad) = v; } } }
        __syncthreads();
    }
}
#undef SSD_PREFETCH
#undef GLA_PREFETCH
}

constexpr int NWAVES = 8;
constexpr size_t MiB = 1u << 20;
constexpr size_t WS_CTL = 0, CTL_ZERO_BYTES = 1 * MiB;
constexpr size_t WS_DTGA = 1 * MiB;
constexpr size_t WS_ROUTE = 10 * MiB;
constexpr size_t WS_HMETA = 12 * MiB;
constexpr size_t WS_WIN = 13 * MiB;
constexpr size_t WS_WOUT = WS_WIN + 2ull * 3072 * 1024 * 2;
constexpr size_t WS_WGU = WS_WOUT + 2ull * 1024 * 1024 * 2;
constexpr size_t WS_WD = WS_WGU + 5632ull * 1024 * 2;
constexpr size_t WS_WMOE_GU = 46 * MiB;
constexpr size_t WS_WMOE_D = WS_WMOE_GU + 8ull * 7168 * 1024 * 2;
constexpr size_t WS_BIG = 214 * MiB;
constexpr size_t WS_TMP = 392 * MiB;
constexpr size_t WS_ACT = 457 * MiB;
constexpr size_t WS_END = 522 * MiB;
static_assert(WS_WD + 1024ull * 2816 * 2 <= WS_WMOE_GU && WS_WMOE_D + 8ull * 1024 * 3584 * 2 <= WS_BIG && WS_BIG + (size_t)MP * PW * 2 <= WS_TMP && WS_TMP + (size_t)MP * 1024 * 2 <= WS_ACT && WS_ACT + (size_t)MP * 1024 * 2 <= WS_END, "ws map");
static_assert(WS_DTGA + (size_t)MP * DGW * 4 <= WS_ROUTE, "ws map 2");
constexpr int CAP_TILES = 69;
constexpr size_t MOE_ACT_BYTES = (size_t)CAP_TILES * 256 * 3584 * 2;
static_assert(WS_BIG + 2 * MOE_ACT_BYTES <= WS_ACT, "moe pass buffers");
constexpr int MAX_SROWS = 2 * (NREG + 8 * 256);
constexpr size_t RT_E = 0;
constexpr size_t RT_G = RT_E + (size_t)NREG * 4;
constexpr size_t RT_STOK = RT_G + (size_t)NREG * 8;
constexpr size_t RT_SGATE = RT_STOK + (size_t)MAX_SROWS * 4;
constexpr size_t RT_TEXP = RT_SGATE + (size_t)MAX_SROWS * 4;
constexpr size_t RT_PASS = RT_TEXP + 4096;
constexpr size_t RT_SSA = RT_PASS + 64;
constexpr size_t RT_RANK = RT_SSA + (size_t)MAX_SROWS * 4;
constexpr size_t RT_BLKCNT = RT_RANK + (size_t)NREG * 4;
constexpr size_t RT_STOKP = RT_BLKCNT + 1024 * 64;
static_assert(RT_STOKP + (size_t)MAX_SROWS * 4 <= 2 * MiB, "route tables");
__device__ __forceinline__ int permp(int p) { return (p & ~255) | ((p & 63) << 2) | ((p >> 6) & 3); }
constexpr int CW_BAR = 4096, CW_Q = 8192;
constexpr int LDS_BYTES = 155648, LDSCTL_OFF = 143360, MISC_OFF = LDSCTL_OFF + 320;

__device__ __forceinline__ float wave_sum(float v) {
#pragma unroll
    for (int o = 1; o < 64; o <<= 1) v += __shfl_xor(v, o);
    return v;
}
__device__ __forceinline__ float wave_sum_sw(float v) {
    v += __int_as_float(__builtin_amdgcn_ds_swizzle(__float_as_int(v), (1 << 10) | 0x1f)); v += __int_as_float(__builtin_amdgcn_ds_swizzle(__float_as_int(v), (2 << 10) | 0x1f));
    v += __int_as_float(__builtin_amdgcn_ds_swizzle(__float_as_int(v), (4 << 10) | 0x1f)); v += __int_as_float(__builtin_amdgcn_ds_swizzle(__float_as_int(v), (8 << 10) | 0x1f));
    v += __int_as_float(__builtin_amdgcn_ds_swizzle(__float_as_int(v), (16 << 10) | 0x1f));
    return __int_as_float(__builtin_amdgcn_readlane(__float_as_int(v), 0)) + __int_as_float(__builtin_amdgcn_readlane(__float_as_int(v), 32));
}
__device__ __forceinline__ int wmap(int kind, int n) {
    if (kind == 0) return n;
    if (kind == 1) { if (n < 1024) return n; if (n < 1032) return 2816 + (n - 1024); if (n < 1800) return n - 8; if (n < 1832) return 2824 + (n - 1800); return n - 40; }
    return (n >> 7) * 256 + (n & 127) + (kind == 3 ? 128 : 0);
}
__device__ __forceinline__ float wscale(int kind, int n) { return (kind == 1 && n >= 1832 && n < 2088) ? 0.125f * 1.4426950408889634f : 1.0f; }
__device__ __forceinline__ void transpose_mat(const float* W, int K, int N, bf16* WT, int kind, LAS float* scr, int gw, int NGW, int lane, bool tiled = false) {
    const int nblk = (N + 31) / 32, nitems = (K / 64) * nblk;
    for (int item = gw; item < nitems; item += NGW) {
        const int kb = item / nblk, nb = item % nblk, k0 = 64 * kb, n0 = 32 * nb;
        const int nn = n0 + (lane & 31); const float wsc = wscale(kind, nn);
        float wv[32];
#pragma unroll
        for (int i = 0; i < 32; ++i) { const int kk = 2 * i + (lane >> 5); wv[i] = nn < N ? __builtin_nontemporal_load(W + (size_t)(k0 + kk) * N + nn) : 0.f; }
#pragma unroll
        for (int i = 0; i < 32; ++i) { const int kk = 2 * i + (lane >> 5); scr[kk * 33 + (lane & 31)] = wv[i] * wsc; }
        LDS_WAIT(); asm volatile("" ::: "memory");
        const int c = lane & 7;
#pragma unroll
        for (int j = 0; j < 4; ++j) { const int n = (lane >> 3) + 8 * j; const LAS float* s = scr + (8 * c) * 33 + n;
            v4u o; o.x = pk2(s[0 * 33], s[1 * 33]); o.y = pk2(s[2 * 33], s[3 * 33]); o.z = pk2(s[4 * 33], s[5 * 33]); o.w = pk2(s[6 * 33], s[7 * 33]);
            if (n0 + n < N) { const int rn = wmap(kind, n0 + n);
                if (tiled) *(GAS v4u*)(WT + ((size_t)(rn >> 8) * (K >> 6) + (k0 >> 6)) * 16384 + (size_t)(rn & 255) * 64 + 8 * c) = o; else *(GAS v4u*)(WT + (size_t)rn * K + k0 + 8 * c) = o; } }
        LDS_WAIT(); asm volatile("" ::: "memory");
    }
}
__device__ __forceinline__ void colmax_mat(const float* W, int K, int N, unsigned* cmax, int kind, int gw, int NGW, int lane, int ilo = 0, int ihi = 1 << 30) {
    const int nblk = (N + 63) / 64, nitems_ = (K / 64) * nblk, nitems = nitems_ < ihi ? nitems_ : ihi;
    for (int item = ilo + gw; item < nitems; item += NGW) { const int kb = item / nblk, nb = item % nblk, n = 64 * nb + lane;
        float m = 0.f;
        if (n < N) {
#pragma unroll 16
            for (int kk = 0; kk < 64; ++kk) m = fmaxf(m, fabsf(__builtin_nontemporal_load(W + (size_t)(64 * kb + kk) * N + n))); }
        if (n < N) atomicMax(cmax + wmap(kind, n), __float_as_uint(m * wscale(kind, n))); }
}
__device__ __forceinline__ void quant_mat(const float* W, int K, int N, signed char* W8, float* sB, const unsigned* cmax, int kind, LAS float* scr, int gw, int NGW, int lane, int maxrow = 1 << 30, int ilo = 0, int ihi = 1 << 30) {
    const int nblk = (N + 31) / 32, nitems_ = (K / 64) * nblk, nitems = nitems_ < ihi ? nitems_ : ihi;
    for (int item = ilo + gw; item < nitems; item += NGW) {
        const int kb = item / nblk, nb = item % nblk, k0 = 64 * kb, n0 = 32 * nb; const int nn = n0 + (lane & 31);
        const float cm = nn < N ? __uint_as_float(cmax[wmap(kind, nn)]) : 1.f, qs = (cm > 0.f ? 127.0f / cm : 0.f) * wscale(kind, nn);
        if (kb == 0 && lane < 32 && nn < N && wmap(kind, nn) < maxrow) sB[wmap(kind, nn)] = cm * (1.0f / 127.0f);
        float wv[32];
#pragma unroll
        for (int i = 0; i < 32; ++i) { const int kk = 2 * i + (lane >> 5); wv[i] = nn < N ? __builtin_nontemporal_load(W + (size_t)(k0 + kk) * N + nn) : 0.f; }
#pragma unroll
        for (int i = 0; i < 32; ++i) { const int kk = 2 * i + (lane >> 5); scr[kk * 33 + (lane & 31)] = rintf(wv[i] * qs); }
        LDS_WAIT(); asm volatile("" ::: "memory");
        const int c = lane & 7;
#pragma unroll
        for (int j = 0; j < 4; ++j) { const int n = (lane >> 3) + 8 * j; const LAS float* s = scr + (8 * c) * 33 + n;
            unsigned lo = 0u, hi = 0u;
#pragma unroll
            for (int q = 0; q < 4; ++q) { lo |= ((unsigned)((int)s[q * 33]) & 0xffu) << (8 * q); hi |= ((unsigned)((int)s[(4 + q) * 33]) & 0xffu) << (8 * q); }
            if (n0 + n < N && wmap(kind, n0 + n) < maxrow) *(GAS unsigned long long*)(W8 + (size_t)wmap(kind, n0 + n) * K + k0 + 8 * c) = (unsigned long long)lo | ((unsigned long long)hi << 32); }
        LDS_WAIT(); asm volatile("" ::: "memory");
    }
}
__device__ __forceinline__ void absmax_all(const float* W, long n4, unsigned* amax, long gtid, long nthreads, int lane) {
    float m = 0.f;
    for (long i = gtid; i < n4; i += 8 * nthreads) { f32x4 v[8];
#pragma unroll
        for (int u = 0; u < 8; ++u) { const long ii = i + u * nthreads; v[u] = ii < n4 ? __builtin_nontemporal_load((const GAS f32x4*)W + ii) : (f32x4){0.f, 0.f, 0.f, 0.f}; }
#pragma unroll
        for (int u = 0; u < 8; ++u) m = fmaxf(fmaxf(m, fmaxf(fabsf(v[u].x), fabsf(v[u].y))), fmaxf(fabsf(v[u].z), fabsf(v[u].w))); }
    m = fmaxf(m, __int_as_float(__builtin_amdgcn_ds_swizzle(__float_as_int(m), (1 << 10) | 0x1f))); m = fmaxf(m, __int_as_float(__builtin_amdgcn_ds_swizzle(__float_as_int(m), (2 << 10) | 0x1f)));
    m = fmaxf(m, __int_as_float(__builtin_amdgcn_ds_swizzle(__float_as_int(m), (4 << 10) | 0x1f))); m = fmaxf(m, __int_as_float(__builtin_amdgcn_ds_swizzle(__float_as_int(m), (8 << 10) | 0x1f)));
    m = fmaxf(m, __int_as_float(__builtin_amdgcn_ds_swizzle(__float_as_int(m), (16 << 10) | 0x1f)));
    if ((lane & 31) == 0) atomicMax(amax, __float_as_uint(m));
}
__device__ __forceinline__ float f8_scale(unsigned amax_bits, bool inverse) { const int e = (int)(amax_bits >> 23) - 127; if (amax_bits == 0u) return 1.0f; return __uint_as_float((unsigned)(127 + (inverse ? e - 7 : 7 - e)) << 23); }
__device__ __forceinline__ void quant_f8_mat(const float* W, int K, int N, unsigned char* W8, float S, LAS float* scr, int gw, int NGW, int lane, int ilo = 0, int ihi = 1 << 30) {
    const int nblk = (N + 31) / 32, nitems_ = (K / 64) * nblk, nitems = nitems_ < ihi ? nitems_ : ihi;
    for (int item = ilo + gw; item < nitems; item += NGW) {
        const int kb = item / nblk, nb = item % nblk, k0 = 64 * kb, n0 = 32 * nb; const int nn = n0 + (lane & 31);
        float wv[32];
#pragma unroll
        for (int i = 0; i < 32; ++i) { const int kk = 2 * i + (lane >> 5); wv[i] = nn < N ? __builtin_nontemporal_load(W + (size_t)(k0 + kk) * N + nn) : 0.f; }
#pragma unroll
        for (int i = 0; i < 32; ++i) { const int kk = 2 * i + (lane >> 5); scr[kk * 33 + (lane & 31)] = wv[i] * S; }
        LDS_WAIT(); asm volatile("" ::: "memory");
        const int c = lane & 7;
#pragma unroll
        for (int j = 0; j < 4; ++j) { const int n = (lane >> 3) + 8 * j; const LAS float* s = scr + (8 * c) * 33 + n;
            unsigned lo = 0u, hi = 0u; lo = __builtin_amdgcn_cvt_pk_fp8_f32(s[0 * 33], s[1 * 33], lo, false); lo = __builtin_amdgcn_cvt_pk_fp8_f32(s[2 * 33], s[3 * 33], lo, true);
            hi = __builtin_amdgcn_cvt_pk_fp8_f32(s[4 * 33], s[5 * 33], hi, false); hi = __builtin_amdgcn_cvt_pk_fp8_f32(s[6 * 33], s[7 * 33], hi, true);
            const int rn = n0 + n;
            if (rn < N) *(GAS unsigned long long*)(W8 + ((size_t)(rn >> 8) * (K >> 7) + (k0 >> 7)) * 32768 + (size_t)(rn & 255) * 128 + (k0 & 127) + 8 * c) = (unsigned long long)lo | ((unsigned long long)hi << 32); }
        LDS_WAIT(); asm volatile("" ::: "memory");
    }
}
__device__ __forceinline__ void rms_row_to_bf16(const float* xrow, const float* w, bf16* orow, int lane) {
    const GAS f32x4* xr = (const GAS f32x4*)xrow + lane; const GAS f32x4* wr = (const GAS f32x4*)w + lane;
    f32x4 v[4]; float s = 0.f;
#pragma unroll
    for (int j = 0; j < 4; ++j) { v[j] = xr[64 * j]; s += (v[j].x * v[j].x + v[j].y * v[j].y) + (v[j].z * v[j].z + v[j].w * v[j].w); }
    const float rstd = 1.f / sqrtf(wave_sum(s) * (1.f / 1024.f) + 1e-6f);
    GAS unsigned long long* o8 = (GAS unsigned long long*)orow + lane;
#pragma unroll
    for (int j = 0; j < 4; ++j) { const f32x4 ww = wr[64 * j]; o8[64 * j] = (unsigned long long)pk2(v[j].x * rstd * ww.x, v[j].y * rstd * ww.y) | ((unsigned long long)pk2(v[j].z * rstd * ww.z, v[j].w * rstd * ww.w) << 32); }
}

#ifndef N_LAUNCH_MODE
#define N_LAUNCH_MODE 1
#endif

template <int NB> __device__ __forceinline__ void skinny_task(const bf16* A, int K, int rb, const bf16* Bt, int b0, int bstep, f32x4 (&acc)[NB], int lane) {
    const int fr = lane & 15, quad = lane >> 4;
    const bf16* ap = A + (size_t)(16 * rb + fr) * K + 8 * quad; const bf16* bp = Bt + (size_t)(b0 + fr) * K + 8 * quad;
#pragma unroll
    for (int nb = 0; nb < NB; ++nb) acc[nb] = (f32x4){0.f, 0.f, 0.f, 0.f};
#pragma unroll 8
    for (int ks = 0; ks < K / 32; ++ks) { const bf16x8 av = *(const GAS bf16x8*)(ap + 32 * ks);
#pragma unroll
        for (int nb = 0; nb < NB; ++nb) acc[nb] = __builtin_amdgcn_mfma_f32_16x16x32_bf16(av, *(const GAS bf16x8*)(bp + (size_t)nb * bstep * K + 32 * ks), acc[nb], 0, 0, 0); }
}
template <int UNR> __device__ __forceinline__ f32x4 skinny_part(const bf16* A, int lda, int rb, const bf16* Bt, int ldb, int b0, int klen, int lane) {
    const int fr = lane & 15, quad = lane >> 4;
    const bf16* ap = A + (size_t)(16 * rb + fr) * lda + 8 * quad; const bf16* bp = Bt + (size_t)(b0 + fr) * ldb + 8 * quad;
    f32x4 acc = {0.f, 0.f, 0.f, 0.f};
#pragma unroll UNR
    for (int ks = 0; ks < klen / 32; ++ks) acc = __builtin_amdgcn_mfma_f32_16x16x32_bf16(*(const GAS bf16x8*)(ap + 32 * ks), *(const GAS bf16x8*)(bp + 32 * ks), acc, 0, 0, 0);
    return acc;
}
__device__ __forceinline__ f32x4 bf4_f32(unsigned long long q) { f32x4 v; v.x = __uint_as_float((unsigned)q << 16); v.y = __uint_as_float((unsigned)q & 0xffff0000u); v.z = __uint_as_float((unsigned)(q >> 32) << 16); v.w = __uint_as_float((unsigned)(q >> 32) & 0xffff0000u); return v; }
constexpr int HP = 2048;
template <bool IN16 = false, bool NOBF = false>
__device__ __forceinline__ void rms_row2_to_bf16(const void* xa, const void* xb, const f32x4 (&wreg)[4], bf16* oa, bf16* ob, int lane, signed char* qa8 = nullptr, signed char* qb8 = nullptr, float* sa8 = nullptr, float* sb8 = nullptr) {
    f32x4 va[4], vb[4]; float sa = 0.f, sb = 0.f;
    if constexpr (IN16) { const GAS unsigned long long* pa = (const GAS unsigned long long*)xa + lane; const GAS unsigned long long* pb = (const GAS unsigned long long*)xb + lane; unsigned long long ta[4], tb[4];
#pragma unroll
        for (int j = 0; j < 4; ++j) { ta[j] = pa[64 * j]; tb[j] = pb[64 * j]; }
#pragma unroll
        for (int j = 0; j < 4; ++j) { va[j] = bf4_f32(ta[j]); vb[j] = bf4_f32(tb[j]); } }
    else { const GAS f32x4* pa = (const GAS f32x4*)xa + lane; const GAS f32x4* pb = (const GAS f32x4*)xb + lane;
#pragma unroll
        for (int j = 0; j < 4; ++j) { va[j] = pa[64 * j]; vb[j] = pb[64 * j]; } }
#pragma unroll
    for (int j = 0; j < 4; ++j) { sa += (va[j].x * va[j].x + va[j].y * va[j].y) + (va[j].z * va[j].z + va[j].w * va[j].w); sb += (vb[j].x * vb[j].x + vb[j].y * vb[j].y) + (vb[j].z * vb[j].z + vb[j].w * vb[j].w); }
    const float ra = 1.f / sqrtf(wave_sum(sa) * (1.f / 1024.f) + 1e-6f), rb = 1.f / sqrtf(wave_sum(sb) * (1.f / 1024.f) + 1e-6f);
    GAS unsigned long long* qa = (GAS unsigned long long*)oa + lane; GAS unsigned long long* qb = (GAS unsigned long long*)ob + lane;
    if constexpr (!NOBF)
#pragma unroll
    for (int j = 0; j < 4; ++j) { const f32x4 ww = wreg[j];
        qa[64 * j] = (unsigned long long)pk2(va[j].x * ra * ww.x, va[j].y * ra * ww.y) | ((unsigned long long)pk2(va[j].z * ra * ww.z, va[j].w * ra * ww.w) << 32);
        qb[64 * j] = (unsigned long long)pk2(vb[j].x * rb * ww.x, vb[j].y * rb * ww.y) | ((unsigned long long)pk2(vb[j].z * rb * ww.z, vb[j].w * rb * ww.w) << 32); }
    if (qa8) {
        float ma = 0.f, mb = 0.f;
#pragma unroll
        for (int j = 0; j < 4; ++j) { const f32x4 ww = wreg[j]; va[j] = va[j] * ra * ww; vb[j] = vb[j] * rb * ww;
            ma = fmaxf(fmaxf(ma, fmaxf(fabsf(va[j].x), fabsf(va[j].y))), fmaxf(fabsf(va[j].z), fabsf(va[j].w))); mb = fmaxf(fmaxf(mb, fmaxf(fabsf(vb[j].x), fabsf(vb[j].y))), fmaxf(fabsf(vb[j].z), fabsf(vb[j].w))); }
#pragma unroll
        for (int o = 1; o < 64; o <<= 1) { ma = fmaxf(ma, __shfl_xor(ma, o)); mb = fmaxf(mb, __shfl_xor(mb, o)); }
        const float qsa = ma > 0.f ? 127.0f / ma : 0.f, qsb = mb > 0.f ? 127.0f / mb : 0.f; if (lane == 0) { *sa8 = ma * (1.0f / 127.0f); *sb8 = mb * (1.0f / 127.0f); }
#pragma unroll
        for (int j = 0; j < 4; ++j) {
            *((GAS unsigned*)qa8 + lane + 64 * j) = ((unsigned)((int)rintf(va[j].x * qsa)) & 0xffu) | (((unsigned)((int)rintf(va[j].y * qsa)) & 0xffu) << 8) | (((unsigned)((int)rintf(va[j].z * qsa)) & 0xffu) << 16) | (((unsigned)((int)rintf(va[j].w * qsa)) & 0xffu) << 24);
            *((GAS unsigned*)qb8 + lane + 64 * j) = ((unsigned)((int)rintf(vb[j].x * qsb)) & 0xffu) | (((unsigned)((int)rintf(vb[j].y * qsb)) & 0xffu) << 8) | (((unsigned)((int)rintf(vb[j].z * qsb)) & 0xffu) << 16) | (((unsigned)((int)rintf(vb[j].w * qsb)) & 0xffu) << 24); } }
}
struct Args { const float* in[27]; float* out; unsigned char* ws; int ph_lo, ph_hi; };
enum { IN_X = 0, IN_META, IN_RELB, IN_NMIX, IN_NFFN, IN_WIN, IN_CONVW, IN_CONVB, IN_DTB, IN_ALOG, IN_SSDD, IN_SSDN, IN_GW2, IN_GB, IN_GLAN, IN_SINK, IN_QN, IN_KN, IN_WOUT,
       IN_FG, IN_FU, IN_FD, IN_ROUTER, IN_MG, IN_MU, IN_MD, IN_FINAL };
enum { PH_PRO = 0, PH_L0 = 1, PH_L1 = 17, PH_SORT = PH_L1 + 10, PH_PASS0 = PH_SORT + 1, PH_FINAL = PH_PASS0 + 5, PH_END = PH_FINAL + 1 };

__global__ void __launch_bounds__(NWAVES * 64, 2) fwd_kernel(Args args) {
    extern __shared__ __attribute__((aligned(16))) unsigned char lds_raw[];
    LAS unsigned char* lds = (LAS unsigned char*)lds_raw;
    volatile LAS unsigned* MISC = (volatile LAS unsigned*)(lds + MISC_OFF);
    const int G = gridDim.x, bid = blockIdx.x, NGW = G * NWAVES; const long nthreads = (long)G * NWAVES * 64;
#define KAS __attribute__((address_space(4)))
#define INP(k) (*(const float* const KAS*)(ka_ + 8 * (k)))
#define IDS() const KAS char* ka_ = (const KAS char*)__builtin_amdgcn_kernarg_segment_ptr(); asm volatile("" : "+s"(ka_)); unsigned char* const ws = *(unsigned char* const KAS*)(ka_ + 224); float* const hreg = *(float* const KAS*)(ka_ + 216); (void)ws; (void)hreg; \
    int tid = threadIdx.x; asm volatile("" : "+v"(tid)); const int lane = tid & 63, wave = __builtin_amdgcn_readfirstlane(tid >> 6), gw = bid * NWAVES + wave; const long gtid = (long)bid * (NWAVES * 64) + tid; (void)lane; (void)gw; (void)gtid
    gu32* ctl = (gu32*)(args.ws + WS_CTL);
    { IDS(); for (int u = tid; u < (LDS_BYTES - LDSCTL_OFF) / 4; u += NWAVES * 64) ((LAS unsigned*)(lds + LDSCTL_OFF))[u] = 0u; }
    __syncthreads();
    XcdBarrier bar = xcd_barrier_post((unsigned*)(ctl + CW_BAR), MISC + 8);
#if N_LAUNCH_MODE == 1
#define IN(k) true
#define SEAM(k) xcd_barrier_lean(bar)
#define OPAQUE_RANGE() do { } while (0)
#else
    int lo = args.ph_lo, hi = args.ph_hi;
#define IN(k) (lo <= (k) && (k) < hi)
#define SEAM(k) do { if (IN(k) && IN((k) + 1)) xcd_barrier(bar); } while (0)
#define OPAQUE_RANGE() asm volatile("" : "+s"(lo), "+s"(hi))
#endif

#define dtga ((float*)(ws + WS_DTGA))
#define CMAX_GU ((unsigned*)(ws + 131072))
#define WGU8 ((signed char*)(ws + WS_DTGA))
#define SB_GU ((float*)(ws + WS_DTGA + 6 * MiB))
#define SA_U ((float*)(ws + WS_DTGA + 6 * MiB + 32768))
#define U8 ((signed char*)(ws + (l == 0 ? WS_TMP : WS_ACT)))
#define CMAX_IN ((unsigned*)(ws + 393216))
#define WIN8 ((signed char*)(ws + WS_WMOE_GU + 72 * MiB))
#define SB_IN ((float*)(ws + WS_WMOE_GU + 80 * MiB))
#define SA_IN ((float*)(ws + WS_HMETA + 524288))
#define U8IN ((signed char*)(ws + WS_TMP))
#define CMAX_MGU ((unsigned*)(ws + 163840))
#define WMGU8 ((signed char*)(ws + WS_WMOE_GU))
#define SB_MGU ((float*)(ws + WS_WMOE_GU + 64 * MiB))
#define YLO ((bf16*)(ws + WS_WIN))
#define YHI ((bf16*)(ws + WS_ACT + 33 * MiB))
#define Y1LO ((bf16*)(ws + WS_BIG + MOE_ACT_BYTES / 2))
#define Y1HI ((bf16*)(ws + WS_BIG + MOE_ACT_BYTES + MOE_ACT_BYTES / 2))
#define WMD8 ((unsigned char*)(ws + WS_WMOE_D))
#define AMAX_MD ((unsigned*)(ws + 131072 - 64))
#define hmeta ((float*)(ws + WS_HMETA))
#define hpart ((float*)(ws + WS_ROUTE))
#define Win ((bf16*)(ws + WS_WIN))
#define Wout ((bf16*)(ws + WS_WOUT))
#define Wgu ((bf16*)(ws + WS_WGU))
#define Wd ((bf16*)(ws + WS_WD))
#define Wmgu ((bf16*)(ws + WS_WMOE_GU))
#define Wmd ((bf16*)(ws + WS_WMOE_D))
#define big ((bf16*)(ws + WS_BIG))
#define act1k ((bf16*)(ws + WS_ACT))
#define tmp ((bf16*)(ws + WS_TMP))
#define rt_e ((int*)(ws + WS_ROUTE + RT_E))
#define rt_g ((float*)(ws + WS_ROUTE + RT_G))
#define stok ((int*)(ws + WS_ROUTE + RT_STOK))
#define stokp ((int*)(ws + WS_ROUTE + RT_STOKP))
#define sgate ((float*)(ws + WS_ROUTE + RT_SGATE))
#define texp ((int*)(ws + WS_ROUTE + RT_TEXP))
#define passt ((int*)(ws + WS_ROUTE + RT_PASS))
#define rt_rank ((int*)(ws + WS_ROUTE + RT_RANK))
#define ssa ((float*)(ws + WS_ROUTE + RT_SSA))
#define blkcnt ((int*)(ws + WS_ROUTE + RT_BLKCNT))

#ifndef PROBE_THIN_REP
#define PROBE_THIN_REP 1
#endif
#ifndef PROBE_PRO_REP
#define PROBE_PRO_REP 1
#endif
    for (int rep_ = 0; rep_ < PROBE_PRO_REP; ++rep_)
    if (IN(PH_PRO)) { IDS();
        LAS float* scr = (LAS float*)(lds + wave * 16384);
        for (int l = 0; l < 2; ++l) {
            transpose_mat(INP(IN_WOUT) + (size_t)l * 1024 * 1024, 1024, 1024, Wout + (size_t)l * 1024 * 1024, 0, scr, gw, NGW, lane);
            colmax_mat(INP(IN_WIN) + (size_t)l * 1024 * 2856, 1024, 2856, CMAX_IN + l * 3072, 1, gw, NGW, lane);
        }
        transpose_mat(INP(IN_FD), 2816, 1024, Wd, 0, scr, gw, NGW, lane);
        colmax_mat(INP(IN_FG), 1024, 2816, CMAX_GU, 2, gw, NGW, lane); colmax_mat(INP(IN_FU), 1024, 2816, CMAX_GU, 3, gw, NGW, lane);
        __syncthreads();
    }
    if (IN(PH_PRO) && IN(PH_PRO + 1)) xcd_barrier(bar);

    { constexpr int l = 0;
    {
        OPAQUE_RANGE();
        const int pb = PH_L0 + 16 * l;
#define hin_reg (l == 0 ? INP(IN_X) : (const float*)hreg)
#define hin_meta (l == 0 ? INP(IN_META) : (const float*)hmeta)
        const int meta_mod = l == 0 ? 16 : 128;
#define MKMP() MixParams mp; mp.conv_w = INP(IN_CONVW) + l * 5 * 768; mp.conv_b = INP(IN_CONVB) + l * 768; mp.dt_bias = INP(IN_DTB) + l * 8; mp.a_log = INP(IN_ALOG) + l * 8; \
        mp.ssd_d = INP(IN_SSDD) + l * 4; mp.ssd_norm_w = INP(IN_SSDN) + l * 256; mp.gate_w2 = INP(IN_GW2) + l * 2 * 16 * 128; mp.gate_b = INP(IN_GB) + l * 256; \
        mp.gla_norm_w = INP(IN_GLAN) + l * 64; mp.sink = INP(IN_SINK) + l * 4; mp.qn_w = INP(IN_QN) + l * 64; mp.kn_w = INP(IN_KN) + l * 64; mp.rel_bias = INP(IN_RELB); \
        MixBuf mb{big, dtga, tmp, act1k}; (void)mb
        for (int rep_ = 0; rep_ < PROBE_THIN_REP; ++rep_)
        if (IN(pb + 0)) { IDS();
            const float* w = INP(IN_NMIX) + l * 1024; f32x4 wreg[4];
#pragma unroll
            for (int j = 0; j < 4; ++j) wreg[j] = ((const GAS f32x4*)w + lane)[64 * j];
            if (l == 0) {
            for (int r = gw; r < NTOK; r += 2 * NGW) { const int r2 = r + NGW < NTOK ? r + NGW : r;
                const float* s1 = r < NREG ? hin_reg + (size_t)r * 1024 : hin_meta + (size_t)((r - NREG) % meta_mod) * 1024; const float* s2 = r2 < NREG ? hin_reg + (size_t)r2 * 1024 : hin_meta + (size_t)((r2 - NREG) % meta_mod) * 1024;
                rms_row2_to_bf16<false, true>(s1, s2, wreg, act1k + (size_t)r * 1024, act1k + (size_t)r2 * 1024, lane, U8IN + (size_t)r * 1024, U8IN + (size_t)r2 * 1024, SA_IN + r, SA_IN + r2); }
            } else {
            for (int r = gw; r < NREG; r += 2 * NGW) { const int r2 = r + NGW < NREG ? r + NGW : r;
                rms_row2_to_bf16<true, true>((const bf16*)hreg + (size_t)r * HP, (const bf16*)hreg + (size_t)r2 * HP, wreg, act1k + (size_t)r * 1024, act1k + (size_t)r2 * 1024, lane, U8IN + (size_t)r * 1024, U8IN + (size_t)r2 * 1024, SA_IN + r, SA_IN + r2); }
            for (int r = NREG + gw; r < NTOK; r += NGW) { const float* s1 = hin_meta + (size_t)((r - NREG) % meta_mod) * 1024;
                { GAS f32x4* hr = (GAS f32x4*)(hmeta + (size_t)(r - NREG) * 1024) + lane;
#pragma unroll
                    for (int j = 0; j < 4; ++j) { f32x4 v = hr[64 * j];
#pragma unroll
                        for (int kp = 0; kp < 4; ++kp) v = v + ((const GAS f32x4*)(hpart + ((size_t)kp * 128 + (r - NREG)) * 1024) + lane)[64 * j];
                        hr[64 * j] = v; }
                    asm volatile("s_waitcnt vmcnt(0)" ::: "memory"); }
                rms_row2_to_bf16<false, true>(s1, s1, wreg, act1k + (size_t)r * 1024, act1k + (size_t)r * 1024, lane, U8IN + (size_t)r * 1024, U8IN + (size_t)r * 1024, SA_IN + r, SA_IN + r); }
            }
            if (l == 0) { __syncthreads(); LAS float* scr = (LAS float*)(lds + wave * 16384);
                for (int l2 = 0; l2 < 2; ++l2) quant_mat(INP(IN_WIN) + (size_t)l2 * 1024 * 2856, 1024, 2856, WIN8 + (size_t)l2 * 3072 * 1024, SB_IN + l2 * 3072, CMAX_IN + l2 * 3072, 1, scr, gw, NGW, lane, 2864);
                }
        }
        SEAM(pb + 0);
#ifndef PROBE_INPROJ_REP
#define PROBE_INPROJ_REP 1
#endif
        for (int rep_ = 0; rep_ < PROBE_INPROJ_REP; ++rep_)
        if (IN(pb + 1)) { IDS();
            pg8::Gemm g{(const bf16*)U8IN, (const bf16*)(WIN8 + (size_t)l * 3072 * 1024), MP, 2816, 512}; pg8::StaticOrder S; S.init(MP, 2816, G, bid);
            pg8::EpiInProj8 E{big, SA_IN, SB_IN + l * 3072};
            pg8::gemm_phase<pg8::EpiInProj8, pg8::StaticOrder, true, true, false, false, true>(lds, g, S, E);
            const int nunits = (MP / 256) * 11, n6 = nunits % G;
            if (n6 > 0 && bid >= n6) {
                __syncthreads();
                const signed char* wdt = WIN8 + ((size_t)l * 3072 + 2816) * 1024;
                for (int i = tid; i < 48 * 64; i += NWAVES * 64) { const int row = i >> 6, ch = i & 63; *(LAS v4u*)(lds + row * 1040 + ch * 16) = *(const GAS v4u*)(wdt + (size_t)row * 1024 + ch * 16); }
                __syncthreads();
                const int fr = lane & 15, quad = lane >> 4;
                const float sb0 = SB_IN[l * 3072 + 2816 + fr], sb1 = SB_IN[l * 3072 + 2832 + fr], sb2 = fr < 8 ? SB_IN[l * 3072 + 2848 + fr] : 0.f;
                for (int blk = (bid - n6) * NWAVES + wave; blk < MP / 16; blk += (G - n6) * NWAVES) {
                    pg8::i32x4 a0 = {0, 0, 0, 0}, a1 = a0, a2 = a0;
                    const signed char* ap = U8IN + (size_t)(16 * blk + fr) * 1024 + 16 * quad;
#pragma unroll 8
                    for (int ks = 0; ks < 16; ++ks) { const pg8::i32x4 av = *(const GAS pg8::i32x4*)(ap + 64 * ks);
                        const LAS unsigned char* bp = lds + fr * 1040 + 64 * ks + 16 * quad;
                        a0 = __builtin_amdgcn_mfma_i32_16x16x64_i8(av, *(const LAS pg8::i32x4*)(bp), a0, 0, 0, 0);
                        a1 = __builtin_amdgcn_mfma_i32_16x16x64_i8(av, *(const LAS pg8::i32x4*)(bp + 16 * 1040), a1, 0, 0, 0);
                        a2 = __builtin_amdgcn_mfma_i32_16x16x64_i8(av, *(const LAS pg8::i32x4*)(bp + 32 * 1040), a2, 0, 0, 0); }
#pragma unroll
                    for (int j = 0; j < 4; ++j) { const int rj = 16 * blk + 4 * quad + j; const float sa_ = SA_IN[rj]; float* op = dtga + (size_t)rj * DGW;
                        op[fr] = (float)a0[j] * sa_ * sb0; op[16 + fr] = (float)a1[j] * sa_ * sb1; if (fr < 8) op[32 + fr] = (float)a2[j] * sa_ * sb2; }
                }
                __syncthreads();
            }
        }
        SEAM(pb + 1);
        if (IN(pb + 2)) { IDS(); MKMP();
            for (int item = gw; item < B_ * 129 * 6; item += NGW) {
                const int cg = item % 6, rr = (item / 6) % 129, b = item / (6 * 129), c = cg * 128 + 2 * lane, t0 = rr * 32;
                float w0[5], w1[5];
#pragma unroll
                for (int j = 0; j < 5; ++j) { w0[j] = mp.conv_w[j * XW + c]; w1[j] = mp.conv_w[j * XW + c + 1]; }
                const float b0 = mp.conv_b[c], b1 = mp.conv_b[c + 1];
                unsigned xin[36];
#pragma unroll
                for (int i = 0; i < 36; ++i) { const int t = t0 - 2 + i; xin[i] = (t >= 0 && t < L_) ? *(const GAS unsigned*)(big + (size_t)row_of(b, t) * PW + PX + c) : 0u; }
#pragma unroll
                for (int i = 0; i < 32; ++i) { const int t = t0 + i;
                    if (t < L_) { float a0 = b0, a1 = b1;
#pragma unroll
                        for (int j = 0; j < 5; ++j) { a0 += w0[j] * __uint_as_float(xin[i + j] << 16); a1 += w1[j] * __uint_as_float(xin[i + j] & 0xffff0000u); }
                        a0 = a0 / (1.0f + __expf(-a0)); a1 = a1 / (1.0f + __expf(-a1));
                        *(GAS unsigned*)(tmp + (size_t)row_of(b, t) * XW + c) = pk2(a0, a1); } }
            }
            const int half = lane >> 5, pi = lane & 31;
            const float inv = __builtin_amdgcn_exp2f(-(float)(pi & 15) * 0.8304820237218406f);
            const float qw0 = mp.qn_w[2 * pi], qw1 = mp.qn_w[2 * pi + 1], kw0 = mp.kn_w[2 * pi], kw1 = mp.kn_w[2 * pi + 1];
            for (int r0 = gw; r0 < NTOK; r0 += 4 * NGW) {
                unsigned xr[4][3];
#pragma unroll
                for (int q = 0; q < 4; ++q) { const int r = r0 + q * NGW;
#pragma unroll
                    for (int k = 0; k < 3; ++k) xr[q][k] = r < NTOK ? *((const GAS unsigned*)(big + (size_t)r * PW + PAQ + (half + 2 * k) * 64) + pi) : 0u; }
#pragma unroll
                for (int q = 0; q < 4; ++q) { const int r = r0 + q * NGW;
                    if (r < NTOK) {
                const int t = r < NREG ? NM + (r % S_) : (r - NREG) % NM;
                const float pos = t < NM ? (float)(t - NM) : (pi < 16 ? (float)((t - NM) / 64) : (float)((t - NM) % 64));
                const float ang = pos * inv, cs = __cosf(ang), sn = __sinf(ang);
#pragma unroll
                for (int k = 0; k < 3; ++k) { const int slot = half + 2 * k;
                    GAS unsigned* px = (GAS unsigned*)(big + (size_t)r * PW + PAQ + slot * 64) + pi; const unsigned xv = xr[q][k];
                    const float x0 = __uint_as_float(xv << 16), x1 = __uint_as_float(xv & 0xffff0000u);
                    float ss = x0 * x0 + x1 * x1;
#pragma unroll
                    for (int o = 1; o < 32; o <<= 1) ss += __shfl_xor(ss, o);
                    const float rstd = 1.0f / sqrtf(ss * (1.0f / 64.0f) + 1e-6f);
                    const float sc = slot < 4 ? attn_body::C2 : 1.0f;
                    const float y0 = x0 * rstd * (slot < 4 ? qw0 : kw0), y1 = x1 * rstd * (slot < 4 ? qw1 : kw1);
                    *px = pk2((y0 * cs - y1 * sn) * sc, (y0 * sn + y1 * cs) * sc); }
                    } }
            }
        }
        SEAM(pb + 2);
        if (IN(pb + 3)) { IDS(); MKMP();
#ifndef PROBE_ATT_REP
#define PROBE_ATT_REP 1
#endif
#ifndef PROBE_SWA_REP
#define PROBE_SWA_REP 1
#endif
#ifndef PROBE_SSD_REP
#define PROBE_SSD_REP 1
#endif
#ifndef PROBE_GLA_REP
#define PROBE_GLA_REP 1
#endif
#ifndef PROBE_MIX_REP
#define PROBE_MIX_REP 1
#endif
            for (int rep_ = 0; rep_ < PROBE_MIX_REP; ++rep_) {
            gu32* qc = (gu32*)(ws + WS_CTL) + CW_Q + l * 2048 + rep_ * 4096;
#define Q_POP(k) ({ __syncthreads(); if (tid == 0) MISC[16] = __hip_atomic_fetch_add(qc + 64 * (k), 1u, __ATOMIC_RELAXED, __HIP_MEMORY_SCOPE_AGENT); __syncthreads(); (int)MISC[16]; })
            if ((bid >> 3) & 1) { LAS float* scr = (LAS float*)(lds + wave * 16384);
                for (;;) { const int u = Q_POP(18); if (u >= (l == 0 ? 336 : 672)) break;
                    if (l == 0) {
                        if (u < 224) { const int m = u / 14, part = u % 14, e = m >> 1;
                            colmax_mat(INP((m & 1) ? IN_MU : IN_MG) + (size_t)e * 1024 * 3584, 1024, 3584, CMAX_MGU + e * 7168, 2 + (m & 1), wave, NWAVES, lane, part * 64, part * 64 + 64); }
                        else absmax_all(INP(IN_MD) + (size_t)(u - 224) * 65536 * 4, 65536, AMAX_MD, tid, NWAVES * 64, lane);
                    } else {
                        if (u < 448) { const int m = u / 28, part = u % 28, e = m >> 1;
                            quant_mat(INP((m & 1) ? IN_MU : IN_MG) + (size_t)e * 1024 * 3584, 1024, 3584, WMGU8 + (size_t)e * 7168 * 1024, SB_MGU + e * 7168, CMAX_MGU + e * 7168, 2 + (m & 1), scr, wave, NWAVES, lane, 1 << 30, part * 64, part * 64 + 64); }
                        else { const int v = u - 448, e = v / 28, part = v % 28;
                            quant_f8_mat(INP(IN_MD) + (size_t)e * 3584 * 1024, 3584, 1024, WMD8 + (size_t)e * 1024 * 3584, f8_scale(*AMAX_MD, false), scr, wave, NWAVES, lane, part * 64, part * 64 + 64); }
                    } } }
            for (;;) { const int u_ = Q_POP(0); if (u_ >= 64 * PROBE_SSD_REP) break; const int u = u_ & 63; const int b = u >> 3, h = (u >> 1) & 3, dir = u & 1;
                mix::ssd_stream(b, h, dir, tmp, dtga, mp.dt_bias[dir * 4 + h], -expf(mp.a_log[dir * 4 + h]), dir == 0 ? act1k : big + PX, dir == 0 ? 1024 : PW, (mix::lp)lds); }
            for (;;) { const int u_ = Q_POP(1); if (u_ >= 64 * PROBE_GLA_REP) break; const int u = u_ & 63; const int b = u >> 3, h = (u >> 1) & 3, dir = u & 1;
                mix::gla_stream(b, h, dir, big, dtga, mp.gate_w2, mp.gate_b, dir == 0 ? act1k + 256 : big + PB, dir == 0 ? 1024 : PW, (mix::lp)lds); }
            const int x0 = (int)(xb_xcc_id() & 7u), nmeta = l == 0 ? 2 : 0, nper = 64 + nmeta;
            for (int k = 0; k < 8; ++k) { const int q = (x0 + k) & 7;
                for (;;) { const int u_ = Q_POP(2 + q); if (u_ >= nper * PROBE_ATT_REP) break; const int u = u_ % nper;
                    const int r = u - nmeta, bg = 2 * q + (u < nmeta ? u : (r >> 5)), qb = u < nmeta ? -1 : (r & 31), b = bg >> 1, g = bg & 1;
                    attn_body::attn_unit<8, false>(b, qb, big + PAQ + g * 128, big + PAK + g * 64, big + PAV + g * 64, act1k + 768 + g * 128, (char*)lds_raw, nullptr, g); } }
            LAS float* btab = (LAS float*)(lds + 86016);
            __syncthreads();
            for (int i = tid; i < 4 * 259; i += NWAVES * 64) { const int h = i / 259, k = i % 259, rc = k - 129; btab[h * 264 + k] = (k == 0 || k == 258) ? -INFINITY : mp.rel_bias[t5_bucket(rc) * 4 + h] * 1.4426950408889634f; }
            if (tid < 4) btab[4 * 264 + tid] = mp.sink[tid] * 1.4426950408889634f;
            for (int i = tid; i < 16 * 544; i += NWAVES * 64) { const int hs = i / 544, k = i % 544, h = hs >> 2, rc = k + (hs & 3) - 260;
                btab[1088 + i] = (rc < -128 || rc > 128) ? -INFINITY : mp.rel_bias[t5_bucket(rc) * 4 + h] * 1.4426950408889634f; }
            for (int k = 0; k < 8; ++k) { const int q = (x0 + k) & 7;
                for (;;) { const int u_ = Q_POP(10 + q); if (u_ >= nper * PROBE_SWA_REP) break; const int u = u_ % nper;
                    const int r = u - nmeta, bg = 2 * q + (u < nmeta ? u : (r >> 5)), qb = u < nmeta ? -1 : (r & 31), b = bg >> 1, g = bg & 1;
                    attn_body::attn_unit<8, true>(b, qb, big + PSQ + g * 128, big + PSK + g * 64, big + PSV + g * 64, act1k + 512 + g * 128, (char*)lds_raw, btab, g); } }
            }
#undef Q_POP
        }
        SEAM(pb + 3);
        if (IN(pb + 7)) { IDS(); MKMP();
            const f32x4 snw = *(const GAS f32x4*)(mp.ssd_norm_w + 4 * lane); const float dskv = mp.ssd_d[lane >> 4]; const f32x4 gnw = *(const GAS f32x4*)(mp.gla_norm_w + ((4 * lane) & 63));
#define BFX(q, j) __uint_as_float((unsigned)(((q) >> (16 * (j))) & 0xffffu) << 16)
            for (int r = gw; r < NTOK; r += 2 * NGW) { const int r2 = r + NGW < NTOK ? r + NGW : r; const int c0 = 4 * lane;
                unsigned long long yf[2], yb[2], xx[2], zz[2], of[2], ob[2], rr[2];
#pragma unroll
                for (int k = 0; k < 2; ++k) { const size_t rk = (size_t)(k == 0 ? r : r2);
                    yf[k] = *(const GAS unsigned long long*)(act1k + rk * 1024 + c0); yb[k] = *(const GAS unsigned long long*)(big + rk * PW + PX + c0);
                    xx[k] = *(const GAS unsigned long long*)(tmp + rk * XW + c0); zz[k] = *(const GAS unsigned long long*)(big + rk * PW + PZ + c0);
                    of[k] = *(const GAS unsigned long long*)(act1k + rk * 1024 + 256 + c0); ob[k] = *(const GAS unsigned long long*)(big + rk * PW + PB + c0); rr[k] = *(const GAS unsigned long long*)(big + rk * PW + PGR + c0); }
#pragma unroll
                for (int k = 0; k < 2; ++k) { const size_t rk = (size_t)(k == 0 ? r : r2);
                    float y[4]; float ss = 0.f;
#pragma unroll
                    for (int j = 0; j < 4; ++j) { const float zv = BFX(zz[k], j); y[j] = (BFX(yf[k], j) + BFX(yb[k], j) + dskv * BFX(xx[k], j)) * (zv / (1.0f + __expf(-zv))); ss += y[j] * y[j]; }
                    const float rstd = 1.0f / sqrtf(wave_sum(ss) * (1.0f / 256.0f) + 1e-6f);
                    float o[4]; float s2 = 0.f;
#pragma unroll
                    for (int j = 0; j < 4; ++j) { o[j] = BFX(of[k], j) + BFX(ob[k], j); s2 += o[j] * o[j]; }
#pragma unroll
                    for (int sh = 1; sh < 16; sh <<= 1) s2 += __shfl_xor(s2, sh);
                    const float rs2 = 1.0f / sqrtf(s2 * (1.0f / 64.0f) + 1e-6f);
                    float o4[4];
#pragma unroll
                    for (int j = 0; j < 4; ++j) { const float rv = BFX(rr[k], j); o4[j] = o[j] * rs2 * gnw[j] * (rv / (1.0f + __expf(-rv))); }
                    if (k == 0 || r2 != r) {
                        *(GAS unsigned long long*)(act1k + rk * 1024 + c0) = (unsigned long long)pk2(y[0] * rstd * snw.x, y[1] * rstd * snw.y) | ((unsigned long long)pk2(y[2] * rstd * snw.z, y[3] * rstd * snw.w) << 32);
                        *(GAS unsigned long long*)(act1k + rk * 1024 + 256 + c0) = (unsigned long long)pk2(o4[0], o4[1]) | ((unsigned long long)pk2(o4[2], o4[3]) << 32); } }
            }
#undef BFX
        }
        SEAM(pb + 7);
        if (IN(pb + 8)) { IDS();
            pg8::Gemm g{act1k, Wout + (size_t)l * 1024 * 1024, NREG, 1024, 1024}; pg8::StaticOrder S; S.init(NREG, 1024, G, bid);
            pg8::EpiResid<(l != 0)> E{l == 0 ? (const void*)INP(IN_X) : (const void*)hreg, (bf16*)hreg};
            pg8::gemm_phase<pg8::EpiResid<(l != 0)>, pg8::StaticOrder, true, true>(lds, g, S, E);
            if (l == 0) {
                const int fr = lane & 15, quad = lane >> 4;
                for (int task = gw; task < 8 * 64; task += NGW) { const int rb = task >> 6, cb = task & 63;
                    const f32x4 acc = skinny_part<16>(act1k + (size_t)NREG * 1024, 1024, rb, Wout, 1024, cb * 16, 1024, lane);
#pragma unroll
                    for (int j = 0; j < 4; ++j) { const int mr = 16 * rb + 4 * quad + j, c = cb * 16 + fr; hmeta[(size_t)mr * 1024 + c] = INP(IN_META)[(size_t)(mr % 16) * 1024 + c] + acc[j]; } }
            }
        }
        SEAM(pb + 8);
        if (l == 0) {
            for (int rep_ = 0; rep_ < PROBE_THIN_REP; ++rep_)
            if (IN(pb + 9)) { IDS();
                const float* w = INP(IN_NFFN); f32x4 wreg[4];
#pragma unroll
                for (int j = 0; j < 4; ++j) wreg[j] = ((const GAS f32x4*)w + lane)[64 * j];
                for (int r = gw; r < NREG; r += 2 * NGW) { const int r2 = r + NGW < NREG ? r + NGW : r;
                    rms_row2_to_bf16<true, true>((const bf16*)hreg + (size_t)r * HP, (const bf16*)hreg + (size_t)r2 * HP, wreg, act1k + (size_t)r * 1024, act1k + (size_t)r2 * 1024, lane, U8 + (size_t)r * 1024, U8 + (size_t)r2 * 1024, SA_U + r, SA_U + r2); }
                for (int r = NREG + gw; r < NTOK; r += NGW) { const float* s1 = hmeta + (size_t)(r - NREG) * 1024;
                    rms_row2_to_bf16(s1, s1, wreg, act1k + (size_t)r * 1024, act1k + (size_t)r * 1024, lane, U8 + (size_t)r * 1024, U8 + (size_t)r * 1024, SA_U + r, SA_U + r); }
                __syncthreads();
                { LAS float* scr = (LAS float*)(lds + wave * 16384);
                    quant_mat(INP(IN_FG), 1024, 2816, WGU8, SB_GU, CMAX_GU, 2, scr, gw, NGW, lane); quant_mat(INP(IN_FU), 1024, 2816, WGU8, SB_GU, CMAX_GU, 3, scr, gw, NGW, lane); }
            }
            SEAM(pb + 9);
#ifndef PROBE_FFNUP_REP
#define PROBE_FFNUP_REP 1
#endif
            for (int rep_ = 0; rep_ < PROBE_FFNUP_REP; ++rep_)
            if (IN(pb + 10)) { IDS();
                pg8::Gemm g{(const bf16*)U8, (const bf16*)WGU8, NREG, 5632, 512}; pg8::StaticOrder S; S.init(NREG, 5632, G, bid);
                pg8::EpiSwiGLU8 E{big, PW, 22, SA_U, SB_GU, 0, false};
                pg8::gemm_phase<pg8::EpiSwiGLU8, pg8::StaticOrder, true, true, false, false, true>(lds, g, S, E);
                { const int fr = lane & 15, quad = lane >> 4;
                    for (int task = gw; task < 8 * 176; task += NGW) { const int rb = task / 176, fg = task % 176, f0 = 16 * fg, brow = (f0 >> 7) * 256 + (f0 & 127);
                        pg8::i32x4 ag = {0, 0, 0, 0}, au = ag;
                        const signed char* ap = U8 + (size_t)(NREG + 16 * rb + fr) * 1024 + 16 * quad; const signed char* bq = WGU8 + (size_t)(brow + fr) * 1024 + 16 * quad;
#pragma unroll 8
                        for (int ks = 0; ks < 16; ++ks) { const pg8::i32x4 av = *(const GAS pg8::i32x4*)(ap + 64 * ks);
                            ag = __builtin_amdgcn_mfma_i32_16x16x64_i8(av, *(const GAS pg8::i32x4*)(bq + 64 * ks), ag, 0, 0, 0);
                            au = __builtin_amdgcn_mfma_i32_16x16x64_i8(av, *(const GAS pg8::i32x4*)(bq + (size_t)128 * 1024 + 64 * ks), au, 0, 0, 0); }
                        const float sbg = SB_GU[brow + fr], sbu = SB_GU[brow + 128 + fr];
#pragma unroll
                        for (int j = 0; j < 4; ++j) { const float sa_ = SA_U[NREG + 16 * rb + 4 * quad + j], gg = (float)ag[j] * sa_ * sbg, uu = (float)au[j] * sa_ * sbu;
                            big[(size_t)(NREG + 16 * rb + 4 * quad + j) * PW + f0 + fr] = f2bf(gg / (1.0f + __expf(-gg)) * uu); } } }
            }
            SEAM(pb + 10);
#ifndef PROBE_FFND_REP
#define PROBE_FFND_REP 1
#endif
            if (IN(pb + 11)) { IDS();
                pg8::Gemm g{big, Wd, NREG, 1024, 2816}; pg8::StaticOrder S; S.init(NREG, 1024, G, bid);
                for (int rep_ = 0; rep_ < PROBE_FFND_REP; ++rep_) {
                pg8::EpiResid<true> E{hreg, (bf16*)hreg, rep_ + 1 < PROBE_FFND_REP ? 0.0f : 1.0f};
                pg8::gemm_phase<pg8::EpiResid<true>, pg8::StaticOrder, true, true>(lds, g, S, E); }
                { const int fr = lane & 15, quad = lane >> 4;
                    for (int task = gw; task < 4 * 8 * 64; task += NGW) { const int kp = task >> 9, rb = (task >> 6) & 7, cb = task & 63;
                        const f32x4 acc = skinny_part<11>(big + (size_t)NREG * PW + kp * 704, PW, rb, Wd + kp * 704, 2816, cb * 16, 704, lane);
#pragma unroll
                        for (int j = 0; j < 4; ++j) hpart[((size_t)kp * 128 + 16 * rb + 4 * quad + j) * 1024 + cb * 16 + fr] = acc[j]; } }
            }
            SEAM(pb + 11);
        } else {
            for (int rep_ = 0; rep_ < PROBE_THIN_REP; ++rep_)
            if (IN(pb + 9)) { IDS();
                const float* w = INP(IN_NFFN) + 1024; const float* rw = INP(IN_ROUTER);
                LAS int* lcnt = (LAS int*)lds;
                f32x4 nwr[4];
#pragma unroll
                for (int j = 0; j < 4; ++j) nwr[j] = ((const GAS f32x4*)w + lane)[64 * j];
                f32x4 rwr[4][4][2];
#pragma unroll
                for (int j = 0; j < 4; ++j)
#pragma unroll
                    for (int c = 0; c < 4; ++c) { const GAS f32x4* rp = (const GAS f32x4*)(rw + (size_t)(4 * lane + 256 * j + c) * 8); rwr[j][c][0] = rp[0]; rwr[j][c][1] = rp[1]; }
                if (tid < 16) lcnt[tid] = 0;
                __syncthreads();
                for (int r0 = gw; r0 < NREG; r0 += 2 * NGW) {
                    f32x4 v[2][4];
#pragma unroll
                    for (int q = 0; q < 2; ++q) { const int r = r0 + q * NGW < NREG ? r0 + q * NGW : r0; const GAS unsigned long long* xr = (const GAS unsigned long long*)((const bf16*)hreg + (size_t)r * HP) + lane;
#pragma unroll
                        for (int j = 0; j < 4; ++j) v[q][j] = bf4_f32(xr[64 * j]); }
#pragma unroll
                    for (int q = 0; q < 2; ++q) { const int r = r0 + q * NGW;
                        if (r < NREG) {
                            float s = 0.f;
#pragma unroll
                            for (int j = 0; j < 4; ++j) s += (v[q][j].x * v[q][j].x + v[q][j].y * v[q][j].y) + (v[q][j].z * v[q][j].z + v[q][j].w * v[q][j].w);
                            const float rstd = 1.f / sqrtf(wave_sum(s) * (1.f / 1024.f) + 1e-6f);
                            float lg[8];
#pragma unroll
                            for (int e = 0; e < 8; ++e) lg[e] = 0.f;
                            float umx = 0.f;
#pragma unroll
                            for (int j = 0; j < 4; ++j) { const f32x4 ww = nwr[j]; const f32x4 uu = v[q][j] * rstd * ww; umx = fmaxf(fmaxf(umx, fmaxf(fabsf(uu.x), fabsf(uu.y))), fmaxf(fabsf(uu.z), fabsf(uu.w))); }
#pragma unroll
                            for (int o = 1; o < 64; o <<= 1) umx = fmaxf(umx, __shfl_xor(umx, o));
                            const float uqs = umx > 0.f ? 127.0f / umx : 0.f; if (lane == 0) SA_U[r] = umx * (1.0f / 127.0f);
#pragma unroll
                            for (int j = 0; j < 4; ++j) { const f32x4 ww = nwr[j]; const f32x4 uu = v[q][j] * rstd * ww;
                                *((GAS unsigned*)(U8 + (size_t)r * 1024) + lane + 64 * j) = ((unsigned)((int)rintf(uu.x * uqs)) & 0xffu) | (((unsigned)((int)rintf(uu.y * uqs)) & 0xffu) << 8) | (((unsigned)((int)rintf(uu.z * uqs)) & 0xffu) << 16) | (((unsigned)((int)rintf(uu.w * uqs)) & 0xffu) << 24);
#pragma unroll
                                for (int c = 0; c < 4; ++c) { const f32x4 r0_ = rwr[j][c][0], r1_ = rwr[j][c][1]; const float uc = uu[c];
                                    lg[0] += uc * r0_.x; lg[1] += uc * r0_.y; lg[2] += uc * r0_.z; lg[3] += uc * r0_.w; lg[4] += uc * r1_.x; lg[5] += uc * r1_.y; lg[6] += uc * r1_.z; lg[7] += uc * r1_.w; } }
                            const bool h5 = lane & 32, h4 = lane & 16, h3 = lane & 8; float a4[4], b2[2], c1;
#pragma unroll
                            for (int k = 0; k < 4; ++k) a4[k] = (h5 ? lg[4 + k] : lg[k]) + __shfl_xor(h5 ? lg[k] : lg[4 + k], 32);
#pragma unroll
                            for (int k = 0; k < 2; ++k) b2[k] = (h4 ? a4[2 + k] : a4[k]) + __shfl_xor(h4 ? a4[k] : a4[2 + k], 16);
                            c1 = (h3 ? b2[1] : b2[0]) + __shfl_xor(h3 ? b2[0] : b2[1], 8);
                            c1 += __shfl_xor(c1, 4); c1 += __shfl_xor(c1, 2); c1 += __shfl_xor(c1, 1);
#pragma unroll
                            for (int e = 0; e < 8; ++e) lg[e] = __shfl(c1, ((e & 4) ? 32 : 0) + ((e & 2) ? 16 : 0) + ((e & 1) ? 8 : 0));
                            int i0 = 0; float v0 = lg[0];
#pragma unroll
                            for (int e = 1; e < 8; ++e) if (lg[e] > v0) { v0 = lg[e]; i0 = e; }
                            int i1 = -1; float v1 = -3.0e38f;
#pragma unroll
                            for (int e = 0; e < 8; ++e) if (e != i0 && lg[e] > v1) { v1 = lg[e]; i1 = e; }
                            if (lane == 0) { const float g1 = 1.0f / (1.0f + __expf(v0 - v1)); const int k0 = __hip_atomic_fetch_add(lcnt + i0, 1, __ATOMIC_RELAXED, __HIP_MEMORY_SCOPE_WORKGROUP), k1 = __hip_atomic_fetch_add(lcnt + 8 + i1, 1, __ATOMIC_RELAXED, __HIP_MEMORY_SCOPE_WORKGROUP);
                                rt_e[r] = i0 | (i1 << 8); rt_rank[r] = k0 | (k1 << 16); rt_g[2 * r] = 1.0f - g1; rt_g[2 * r + 1] = g1; }
                        } }
                }
                __syncthreads();
                if (tid < 16) blkcnt[bid * 16 + tid] = lcnt[tid];
            }
            SEAM(pb + 9);
#ifndef PROBE_SORT_REP
#define PROBE_SORT_REP 1
#endif
            for (int rep_ = 0; rep_ < PROBE_SORT_REP; ++rep_)
            if (IN(PH_SORT)) { IDS();
                LAS int* tot = (LAS int*)lds; LAS int* pre = tot + 16; LAS int* roff = tot + 32; LAS int* ntl = tot + 48;
                if (tid < 64) tot[tid] = 0;
                __syncthreads();
                { const int sgm = tid & 15, part = tid >> 4; int a = 0, bfore = 0;
                    for (int k = 0; k < 8; ++k) { const int wgi = part * 8 + k; if (wgi < G) { const int cv = blkcnt[wgi * 16 + sgm]; a += cv; if (wgi < bid) bfore += cv; } }
                    __hip_atomic_fetch_add(tot + sgm, a, __ATOMIC_RELAXED, __HIP_MEMORY_SCOPE_WORKGROUP); __hip_atomic_fetch_add(pre + sgm, bfore, __ATOMIC_RELAXED, __HIP_MEMORY_SCOPE_WORKGROUP); }
                __syncthreads();
                if (tid == 0) {
                    int tile = 0, T0 = 0;
                    for (int sg = 0; sg < 16; ++sg) { const int nt = (tot[sg] + 255) >> 8; roff[sg] = tile * 256; ntl[sg] = nt; if (bid == 0) for (int k = 0; k < nt; ++k) texp[tile + k] = sg & 7; tile += nt; if (sg == 7) T0 = tile; }
                    if (bid == 0) { const int T1 = tile - T0;
                        int p1 = T0 >= 64 && T0 - 64 <= CAP_TILES ? 64 : (T0 + 1) / 2, p2 = T1 >= 64 && T1 - 64 <= CAP_TILES ? T1 - 64 : (T1 + 1) / 2;
                        passt[0] = 0; passt[1] = p1; passt[2] = T0; passt[3] = T0 + p2; passt[4] = tile; }
                }
                __syncthreads();
                if (bid < 16) { const int b0 = roff[bid] + tot[bid], b1 = roff[bid] + ntl[bid] * 256; for (int i = b0 + tid; i < b1; i += NWAVES * 64) { stok[i] = -1; stokp[permp(i)] = -1; sgate[i] = 0.f; ssa[i] = 0.f; } }
                for (int k = lane; gw + k * NGW < NREG; k += 64) { const int r = gw + k * NGW;
                    { const int e = rt_e[r], rk = rt_rank[r]; const int e0 = e & 255, e1 = 8 + (e >> 8);
                        const int p0 = roff[e0] + pre[e0] + (rk & 0xffff), p1 = roff[e1] + pre[e1] + (rk >> 16);
                        const float sar = SA_U[r];
                        stok[p0] = r; stokp[permp(p0)] = r; sgate[p0] = rt_g[2 * r]; ssa[p0] = sar; stok[p1] = r; stokp[permp(p1)] = r; sgate[p1] = rt_g[2 * r + 1]; ssa[p1] = sar; } }
#ifndef PROBE_IDENT
#define PROBE_IDENT 0
#endif
                if (PROBE_IDENT) for (long i = gtid; i < MAX_SROWS; i += (long)G * NWAVES * 64) ((int*)(ws + WS_DTGA))[i] = (int)(i & 32767);
                __syncthreads();
            }
            SEAM(PH_SORT);
#ifndef PROBE_DK_HALF
#define PROBE_DK_HALF 0
#endif
#ifndef PROBE_MOE_REP
#define PROBE_MOE_REP 1
#endif
#pragma unroll 1
            for (int p_ = 0; p_ < 5 * PROBE_MOE_REP; ++p_) { const int p = p_ % 5; const float gscale_ = p_ < 5 * (PROBE_MOE_REP - 1) ? 0.0f : 1.0f;
                OPAQUE_RANGE();
                if (IN(PH_PASS0 + p)) { IDS();
                    int nd = 0;
                    LAS int* lexd = (LAS int*)(lds + 139264); LAS int* lexg = lexd + 128;
                    if (p > 0) { const int t0 = passt[p - 1], n = passt[p] - t0; if (tid < n) lexd[tid] = texp[t0 + tid]; }
                    if (p < 4) { const int t0 = passt[p], n = passt[p + 1] - t0; if (tid < n) lexg[tid] = texp[t0 + tid]; }
                    __syncthreads();
                    if (p > 0) {
                        const int t0 = passt[p - 1], t1 = passt[p]; nd = (t1 - t0) * 4;
                        pg8::Gemm g{(const bf16*)(ws + WS_BIG + (size_t)((p - 1) & 1) * MOE_ACT_BYTES), (const bf16*)WMD8, CAP_TILES * 256, 8 * 1024, (PROBE_DK_HALF && gscale_ == 0.0f) ? 896 : 1792}; pg8::MoeOrder S{t0, t1 - t0, 4, G, bid, 0, lexd, stok, t0 * 256};
                        pg8::EpiMoeDown E{p >= 3 ? Y1LO : YLO, p >= 3 ? (long)(Y1HI - Y1LO) : (long)(YHI - YLO), stok, sgate, t0 * 256, gscale_ * f8_scale(*AMAX_MD, true)};
                        pg8::gemm_phase<pg8::EpiMoeDown, pg8::MoeOrder, true, true, false, true, false, true>(lds, g, S, E);
                    }
                    if (p < 4) {
                        const int t0 = passt[p], t1 = passt[p + 1];
                        pg8::Gemm g{(const bf16*)U8, (const bf16*)WMGU8, NREG, 8 * 7168, 512}; pg8::MoeOrder S{t0, t1 - t0, 28, G, bid, nd > G ? nd - G : 0, lexg, stok, t0 * 256, stokp};
                        pg8::EpiSwiGLU8 E{(bf16*)(ws + WS_BIG + (size_t)(p & 1) * MOE_ACT_BYTES), 3584, 28, ssa, SB_MGU, t0 * 256, true};
                        pg8::gemm_phase<pg8::EpiSwiGLU8, pg8::MoeOrder, true, true, true, false, true>(lds, g, S, E);
                    }
                }
                SEAM(PH_PASS0 + p);
            }
#ifndef PROBE_BAR_REP
#define PROBE_BAR_REP 0
#endif
            for (int rep_ = 0; rep_ < PROBE_BAR_REP; ++rep_) xcd_barrier_lean(bar);
            if (IN(PH_FINAL)) { IDS();
                const float* w = INP(IN_FINAL); f32x4 fwr[4];
#pragma unroll
                for (int j = 0; j < 4; ++j) fwr[j] = ((const GAS f32x4*)w + lane)[64 * j];
                for (int r = gw; r < NREG; r += 2 * NGW) { const int r2 = r + NGW < NREG ? r + NGW : r;
                    GAS f32x4* xa = (GAS f32x4*)(hreg + (size_t)r * 1024) + lane; GAS f32x4* xb = (GAS f32x4*)(hreg + (size_t)r2 * 1024) + lane;
                    f32x4 va[4], vb[4]; float sa = 0.f, sb = 0.f;
                    { const GAS unsigned long long* ha = (const GAS unsigned long long*)((const bf16*)hreg + (size_t)r * HP) + lane; const GAS unsigned long long* hb_ = (const GAS unsigned long long*)((const bf16*)hreg + (size_t)r2 * HP) + lane;
#pragma unroll
                    for (int j = 0; j < 4; ++j) { va[j] = bf4_f32(ha[64 * j]); vb[j] = bf4_f32(hb_[64 * j]); } }
#pragma unroll
                    for (int sl = 0; sl < 2; ++sl)
#pragma unroll
                    for (int j = 0; j < 4; ++j) { const bf16* yb_ = sl == 0 ? (j < 2 ? YLO : YHI) : (j < 2 ? Y1LO : Y1HI); const int cy = 4 * lane + 256 * (j & 1);
                        const unsigned long long qa = *(const GAS unsigned long long*)(yb_ + (size_t)r * 512 + cy), qb = *(const GAS unsigned long long*)(yb_ + (size_t)r2 * 512 + cy);
                        va[j].x += __uint_as_float((unsigned)qa << 16); va[j].y += __uint_as_float((unsigned)qa & 0xffff0000u); va[j].z += __uint_as_float((unsigned)(qa >> 32) << 16); va[j].w += __uint_as_float((unsigned)(qa >> 32) & 0xffff0000u);
                        vb[j].x += __uint_as_float((unsigned)qb << 16); vb[j].y += __uint_as_float((unsigned)qb & 0xffff0000u); vb[j].z += __uint_as_float((unsigned)(qb >> 32) << 16); vb[j].w += __uint_as_float((unsigned)(qb >> 32) & 0xffff0000u); }
#pragma unroll
                    for (int j = 0; j < 4; ++j) { sa += (va[j].x * va[j].x + va[j].y * va[j].y) + (va[j].z * va[j].z + va[j].w * va[j].w); sb += (vb[j].x * vb[j].x + vb[j].y * vb[j].y) + (vb[j].z * vb[j].z + vb[j].w * vb[j].w); }
                    const float ra = 1.f / sqrtf(wave_sum_sw(sa) * (1.f / 1024.f) + 1e-6f), rb = 1.f / sqrtf(wave_sum_sw(sb) * (1.f / 1024.f) + 1e-6f);
#pragma unroll
                    for (int j = 0; j < 4; ++j) { const f32x4 ww = fwr[j]; xa[64 * j] = va[j] * ra * ww; if (r2 != r) xb[64 * j] = vb[j] * rb * ww; }
                }
            }
        }
    }
    }
    { constexpr int l = 1;
    {
        OPAQUE_RANGE();
        const int pb = PH_L0 + 16 * l;
#define hin_reg (l == 0 ? INP(IN_X) : (const float*)hreg)
#define hin_meta (l == 0 ? INP(IN_META) : (const float*)hmeta)
        const int meta_mod = l == 0 ? 16 : 128;
#define MKMP() MixParams mp; mp.conv_w = INP(IN_CONVW) + l * 5 * 768; mp.conv_b = INP(IN_CONVB) + l * 768; mp.dt_bias = INP(IN_DTB) + l * 8; mp.a_log = INP(IN_ALOG) + l * 8; \
        mp.ssd_d = INP(IN_SSDD) + l * 4; mp.ssd_norm_w = INP(IN_SSDN) + l * 256; mp.gate_w2 = INP(IN_GW2) + l * 2 * 16 * 128; mp.gate_b = INP(IN_GB) + l * 256; \
        mp.gla_norm_w = INP(IN_GLAN) + l * 64; mp.sink = INP(IN_SINK) + l * 4; mp.qn_w = INP(IN_QN) + l * 64; mp.kn_w = INP(IN_KN) + l * 64; mp.rel_bias = INP(IN_RELB); \
        MixBuf mb{big, dtga, tmp, act1k}; (void)mb
        for (int rep_ = 0; rep_ < PROBE_THIN_REP; ++rep_)
        if (IN(pb + 0)) { IDS();
            const float* w = INP(IN_NMIX) + l * 1024; f32x4 wreg[4];
#pragma unroll
            for (int j = 0; j < 4; ++j) wreg[j] = ((const GAS f32x4*)w + lane)[64 * j];
            if (l == 0) {
            for (int r = gw; r < NTOK; r += 2 * NGW) { const int r2 = r + NGW < NTOK ? r + NGW : r;
                const float* s1 = r < NREG ? hin_reg + (size_t)r * 1024 : hin_meta + (size_t)((r - NREG) % meta_mod) * 1024; const float* s2 = r2 < NREG ? hin_reg + (size_t)r2 * 1024 : hin_meta + (size_t)((r2 - NREG) % meta_mod) * 1024;
                rms_row2_to_bf16<false, true>(s1, s2, wreg, act1k + (size_t)r * 1024, act1k + (size_t)r2 * 1024, lane, U8IN + (size_t)r * 1024, U8IN + (size_t)r2 * 1024, SA_IN + r, SA_IN + r2); }
            } else {
            for (int r = gw; r < NREG; r += 2 * NGW) { const int r2 = r + NGW < NREG ? r + NGW : r;
                rms_row2_to_bf16<true, true>((const bf16*)hreg + (size_t)r * HP, (const bf16*)hreg + (size_t)r2 * HP, wreg, act1k + (size_t)r * 1024, act1k + (size_t)r2 * 1024, lane, U8IN + (size_t)r * 1024, U8IN + (size_t)r2 * 1024, SA_IN + r, SA_IN + r2); }
            for (int r = NREG + gw; r < NTOK; r += NGW) { const float* s1 = hin_meta + (size_t)((r - NREG) % meta_mod) * 1024;
                { GAS f32x4* hr = (GAS f32x4*)(hmeta + (size_t)(r - NREG) * 1024) + lane;
#pragma unroll
                    for (int j = 0; j < 4; ++j) { f32x4 v = hr[64 * j];
#pragma unroll
                        for (int kp = 0; kp < 4; ++kp) v = v + ((const GAS f32x4*)(hpart + ((size_t)kp * 128 + (r - NREG)) * 1024) + lane)[64 * j];
                        hr[64 * j] = v; }
                    asm volatile("s_waitcnt vmcnt(0)" ::: "memory"); }
                rms_row2_to_bf16<false, true>(s1, s1, wreg, act1k + (size_t)r * 1024, act1k + (size_t)r * 1024, lane, U8IN + (size_t)r * 1024, U8IN + (size_t)r * 1024, SA_IN + r, SA_IN + r); }
            }
            if (l == 0) { __syncthreads(); LAS float* scr = (LAS float*)(lds + wave * 16384);
                for (int l2 = 0; l2 < 2; ++l2) quant_mat(INP(IN_WIN) + (size_t)l2 * 1024 * 2856, 1024, 2856, WIN8 + (size_t)l2 * 3072 * 1024, SB_IN + l2 * 3072, CMAX_IN + l2 * 3072, 1, scr, gw, NGW, lane, 2864);
                }
        }
        SEAM(pb + 0);
#ifndef PROBE_INPROJ_REP
#define PROBE_INPROJ_REP 1
#endif
        for (int rep_ = 0; rep_ < PROBE_INPROJ_REP; ++rep_)
        if (IN(pb + 1)) { IDS();
            pg8::Gemm g{(const bf16*)U8IN, (const bf16*)(WIN8 + (size_t)l * 3072 * 1024), MP, 2816, 512}; pg8::StaticOrder S; S.init(MP, 2816, G, bid);
            pg8::EpiInProj8 E{big, SA_IN, SB_IN + l * 3072};
            pg8::gemm_phase<pg8::EpiInProj8, pg8::StaticOrder, true, true, false, false, true>(lds, g, S, E);
            const int nunits = (MP / 256) * 11, n6 = nunits % G;
            if (n6 > 0 && bid >= n6) {
                __syncthreads();
                const signed char* wdt = WIN8 + ((size_t)l * 3072 + 2816) * 1024;
                for (int i = tid; i < 48 * 64; i += NWAVES * 64) { const int row = i >> 6, ch = i & 63; *(LAS v4u*)(lds + row * 1040 + ch * 16) = *(const GAS v4u*)(wdt + (size_t)row * 1024 + ch * 16); }
                __syncthreads();
                const int fr = lane & 15, quad = lane >> 4;
                const float sb0 = SB_IN[l * 3072 + 2816 + fr], sb1 = SB_IN[l * 3072 + 2832 + fr], sb2 = fr < 8 ? SB_IN[l * 3072 + 2848 + fr] : 0.f;
                for (int blk = (bid - n6) * NWAVES + wave; blk < MP / 16; blk += (G - n6) * NWAVES) {
                    pg8::i32x4 a0 = {0, 0, 0, 0}, a1 = a0, a2 = a0;
                    const signed char* ap = U8IN + (size_t)(16 * blk + fr) * 1024 + 16 * quad;
#pragma unroll 8
                    for (int ks = 0; ks < 16; ++ks) { const pg8::i32x4 av = *(const GAS pg8::i32x4*)(ap + 64 * ks);
                        const LAS unsigned char* bp = lds + fr * 1040 + 64 * ks + 16 * quad;
                        a0 = __builtin_amdgcn_mfma_i32_16x16x64_i8(av, *(const LAS pg8::i32x4*)(bp), a0, 0, 0, 0);
                        a1 = __builtin_amdgcn_mfma_i32_16x16x64_i8(av, *(const LAS pg8::i32x4*)(bp + 16 * 1040), a1, 0, 0, 0);
                        a2 = __builtin_amdgcn_mfma_i32_16x16x64_i8(av, *(const LAS pg8::i32x4*)(bp + 32 * 1040), a2, 0, 0, 0); }
#pragma unroll
                    for (int j = 0; j < 4; ++j) { const int rj = 16 * blk + 4 * quad + j; const float sa_ = SA_IN[rj]; float* op = dtga + (size_t)rj * DGW;
                        op[fr] = (float)a0[j] * sa_ * sb0; op[16 + fr] = (float)a1[j] * sa_ * sb1; if (fr < 8) op[32 + fr] = (float)a2[j] * sa_ * sb2; }
                }
                __syncthreads();
            }
        }
        SEAM(pb + 1);
        if (IN(pb + 2)) { IDS(); MKMP();
            for (int item = gw; item < B_ * 129 * 6; item += NGW) {
                const int cg = item % 6, rr = (item / 6) % 129, b = item / (6 * 129), c = cg * 128 + 2 * lane, t0 = rr * 32;
                float w0[5], w1[5];
#pragma unroll
                for (int j = 0; j < 5; ++j) { w0[j] = mp.conv_w[j * XW + c]; w1[j] = mp.conv_w[j * XW + c + 1]; }
                const float b0 = mp.conv_b[c], b1 = mp.conv_b[c + 1];
                unsigned xin[36];
#pragma unroll
                for (int i = 0; i < 36; ++i) { const int t = t0 - 2 + i; xin[i] = (t >= 0 && t < L_) ? *(const GAS unsigned*)(big + (size_t)row_of(b, t) * PW + PX + c) : 0u; }
#pragma unroll
                for (int i = 0; i < 32; ++i) { const int t = t0 + i;
                    if (t < L_) { float a0 = b0, a1 = b1;
#pragma unroll
                        for (int j = 0; j < 5; ++j) { a0 += w0[j] * __uint_as_float(xin[i + j] << 16); a1 += w1[j] * __uint_as_float(xin[i + j] & 0xffff0000u); }
                        a0 = a0 / (1.0f + __expf(-a0)); a1 = a1 / (1.0f + __expf(-a1));
                        *(GAS unsigned*)(tmp + (size_t)row_of(b, t) * XW + c) = pk2(a0, a1); } }
            }
            const int half = lane >> 5, pi = lane & 31;
            const float inv = __builtin_amdgcn_exp2f(-(float)(pi & 15) * 0.8304820237218406f);
            const float qw0 = mp.qn_w[2 * pi], qw1 = mp.qn_w[2 * pi + 1], kw0 = mp.kn_w[2 * pi], kw1 = mp.kn_w[2 * pi + 1];
            for (int r0 = gw; r0 < NTOK; r0 += 4 * NGW) {
                unsigned xr[4][3];
#pragma unroll
                for (int q = 0; q < 4; ++q) { const int r = r0 + q * NGW;
#pragma unroll
                    for (int k = 0; k < 3; ++k) xr[q][k] = r < NTOK ? *((const GAS unsigned*)(big + (size_t)r * PW + PAQ + (half + 2 * k) * 64) + pi) : 0u; }
#pragma unroll
                for (int q = 0; q < 4; ++q) { const int r = r0 + q * NGW;
                    if (r < NTOK) {
                const int t = r < NREG ? NM + (r % S_) : (r - NREG) % NM;
                const float pos = t < NM ? (float)(t - NM) : (pi < 16 ? (float)((t - NM) / 64) : (float)((t - NM) % 64));
                const float ang = pos * inv, cs = __cosf(ang), sn = __sinf(ang);
#pragma unroll
                for (int k = 0; k < 3; ++k) { const int slot = half + 2 * k;
                    GAS unsigned* px = (GAS unsigned*)(big + (size_t)r * PW + PAQ + slot * 64) + pi; const unsigned xv = xr[q][k];
                    const float x0 = __uint_as_float(xv << 16), x1 = __uint_as_float(xv & 0xffff0000u);
                    float ss = x0 * x0 + x1 * x1;
#pragma unroll
                    for (int o = 1; o < 32; o <<= 1) ss += __shfl_xor(ss, o);
                    const float rstd = 1.0f / sqrtf(ss * (1.0f / 64.0f) + 1e-6f);
                    const float sc = slot < 4 ? attn_body::C2 : 1.0f;
                    const float y0 = x0 * rstd * (slot < 4 ? qw0 : kw0), y1 = x1 * rstd * (slot < 4 ? qw1 : kw1);
                    *px = pk2((y0 * cs - y1 * sn) * sc, (y0 * sn + y1 * cs) * sc); }
                    } }
            }
        }
        SEAM(pb + 2);
        if (IN(pb + 3)) { IDS(); MKMP();
#ifndef PROBE_ATT_REP
#define PROBE_ATT_REP 1
#endif
#ifndef PROBE_SWA_REP
#define PROBE_SWA_REP 1
#endif
#ifndef PROBE_SSD_REP
#define PROBE_SSD_REP 1
#endif
#ifndef PROBE_GLA_REP
#define PROBE_GLA_REP 1
#endif
#ifndef PROBE_MIX_REP
#define PROBE_MIX_REP 1
#endif
            for (int rep_ = 0; rep_ < PROBE_MIX_REP; ++rep_) {
            gu32* qc = (gu32*)(ws + WS_CTL) + CW_Q + l * 2048 + rep_ * 4096;
#define Q_POP(k) ({ __syncthreads(); if (tid == 0) MISC[16] = __hip_atomic_fetch_add(qc + 64 * (k), 1u, __ATOMIC_RELAXED, __HIP_MEMORY_SCOPE_AGENT); __syncthreads(); (int)MISC[16]; })
            if ((bid >> 3) & 1) { LAS float* scr = (LAS float*)(lds + wave * 16384);
                for (;;) { const int u = Q_POP(18); if (u >= (l == 0 ? 336 : 672)) break;
                    if (l == 0) {
                        if (u < 224) { const int m = u / 14, part = u % 14, e = m >> 1;
                            colmax_mat(INP((m & 1) ? IN_MU : IN_MG) + (size_t)e * 1024 * 3584, 1024, 3584, CMAX_MGU + e * 7168, 2 + (m & 1), wave, NWAVES, lane, part * 64, part * 64 + 64); }
                        else absmax_all(INP(IN_MD) + (size_t)(u - 224) * 65536 * 4, 65536, AMAX_MD, tid, NWAVES * 64, lane);
                    } else {
                        if (u < 448) { const int m = u / 28, part = u % 28, e = m >> 1;
                            quant_mat(INP((m & 1) ? IN_MU : IN_MG) + (size_t)e * 1024 * 3584, 1024, 3584, WMGU8 + (size_t)e * 7168 * 1024, SB_MGU + e * 7168, CMAX_MGU + e * 7168, 2 + (m & 1), scr, wave, NWAVES, lane, 1 << 30, part * 64, part * 64 + 64); }
                        else { const int v = u - 448, e = v / 28, part = v % 28;
                            quant_f8_mat(INP(IN_MD) + (size_t)e * 3584 * 1024, 3584, 1024, WMD8 + (size_t)e * 1024 * 3584, f8_scale(*AMAX_MD, false), scr, wave, NWAVES, lane, part * 64, part * 64 + 64); }
                    } } }
            for (;;) { const int u_ = Q_POP(0); if (u_ >= 64 * PROBE_SSD_REP) break; const int u = u_ & 63; const int b = u >> 3, h = (u >> 1) & 3, dir = u & 1;
                mix::ssd_stream(b, h, dir, tmp, dtga, mp.dt_bias[dir * 4 + h], -expf(mp.a_log[dir * 4 + h]), dir == 0 ? act1k : big + PX, dir == 0 ? 1024 : PW, (mix::lp)lds); }
            for (;;) { const int u_ = Q_POP(1); if (u_ >= 64 * PROBE_GLA_REP) break; const int u = u_ & 63; const int b = u >> 3, h = (u >> 1) & 3, dir = u & 1;
                mix::gla_stream(b, h, dir, big, dtga, mp.gate_w2, mp.gate_b, dir == 0 ? act1k + 256 : big + PB, dir == 0 ? 1024 : PW, (mix::lp)lds); }
            const int x0 = (int)(xb_xcc_id() & 7u), nmeta = l == 0 ? 2 : 0, nper = 64 + nmeta;
            for (int k = 0; k < 8; ++k) { const int q = (x0 + k) & 7;
                for (;;) { const int u_ = Q_POP(2 + q); if (u_ >= nper * PROBE_ATT_REP) break; const int u = u_ % nper;
                    const int r = u - nmeta, bg = 2 * q + (u < nmeta ? u : (r >> 5)), qb = u < nmeta ? -1 : (r & 31), b = bg >> 1, g = bg & 1;
                    attn_body::attn_unit<8, false>(b, qb, big + PAQ + g * 128, big + PAK + g * 64, big + PAV + g * 64, act1k + 768 + g * 128, (char*)lds_raw, nullptr, g); } }
            LAS float* btab = (LAS float*)(lds + 86016);
            __syncthreads();
            for (int i = tid; i < 4 * 259; i += NWAVES * 64) { const int h = i / 259, k = i % 259, rc = k - 129; btab[h * 264 + k] = (k == 0 || k == 258) ? -INFINITY : mp.rel_bias[t5_bucket(rc) * 4 + h] * 1.4426950408889634f; }
            if (tid < 4) btab[4 * 264 + tid] = mp.sink[tid] * 1.4426950408889634f;
            for (int i = tid; i < 16 * 544; i += NWAVES * 64) { const int hs = i / 544, k = i % 544, h = hs >> 2, rc = k + (hs & 3) - 260;
                btab[1088 + i] = (rc < -128 || rc > 128) ? -INFINITY : mp.rel_bias[t5_bucket(rc) * 4 + h] * 1.4426950408889634f; }
            for (int k = 0; k < 8; ++k) { const int q = (x0 + k) & 7;
                for (;;) { const int u_ = Q_POP(10 + q); if (u_ >= nper * PROBE_SWA_REP) break; const int u = u_ % nper;
                    const int r = u - nmeta, bg = 2 * q + (u < nmeta ? u : (r >> 5)), qb = u < nmeta ? -1 : (r & 31), b = bg >> 1, g = bg & 1;
                    attn_body::attn_unit<8, true>(b, qb, big + PSQ + g * 128, big + PSK + g * 64, big + PSV + g * 64, act1k + 512 + g * 128, (char*)lds_raw, btab, g); } }
            }
#undef Q_POP
        }
        SEAM(pb + 3);
        if (IN(pb + 7)) { IDS(); MKMP();
            const f32x4 snw = *(const GAS f32x4*)(mp.ssd_norm_w + 4 * lane); const float dskv = mp.ssd_d[lane >> 4]; const f32x4 gnw = *(const GAS f32x4*)(mp.gla_norm_w + ((4 * lane) & 63));
#define BFX(q, j) __uint_as_float((unsigned)(((q) >> (16 * (j))) & 0xffffu) << 16)
            for (int r = gw; r < NTOK; r += 2 * NGW) { const int r2 = r + NGW < NTOK ? r + NGW : r; const int c0 = 4 * lane;
                unsigned long long yf[2], yb[2], xx[2], zz[2], of[2], ob[2], rr[2];
#pragma unroll
                for (int k = 0; k < 2; ++k) { const size_t rk = (size_t)(k == 0 ? r : r2);
                    yf[k] = *(const GAS unsigned long long*)(act1k + rk * 1024 + c0); yb[k] = *(const GAS unsigned long long*)(big + rk * PW + PX + c0);
                    xx[k] = *(const GAS unsigned long long*)(tmp + rk * XW + c0); zz[k] = *(const GAS unsigned long long*)(big + rk * PW + PZ + c0);
                    of[k] = *(const GAS unsigned long long*)(act1k + rk * 1024 + 256 + c0); ob[k] = *(const GAS unsigned long long*)(big + rk * PW + PB + c0); rr[k] = *(const GAS unsigned long long*)(big + rk * PW + PGR + c0); }
#pragma unroll
                for (int k = 0; k < 2; ++k) { const size_t rk = (size_t)(k == 0 ? r : r2);
                    float y[4]; float ss = 0.f;
#pragma unroll
                    for (int j = 0; j < 4; ++j) { const float zv = BFX(zz[k], j); y[j] = (BFX(yf[k], j) + BFX(yb[k], j) + dskv * BFX(xx[k], j)) * (zv / (1.0f + __expf(-zv))); ss += y[j] * y[j]; }
                    const float rstd = 1.0f / sqrtf(wave_sum(ss) * (1.0f / 256.0f) + 1e-6f);
                    float o[4]; float s2 = 0.f;
#pragma unroll
                    for (int j = 0; j < 4; ++j) { o[j] = BFX(of[k], j) + BFX(ob[k], j); s2 += o[j] * o[j]; }
#pragma unroll
                    for (int sh = 1; sh < 16; sh <<= 1) s2 += __shfl_xor(s2, sh);
                    const float rs2 = 1.0f / sqrtf(s2 * (1.0f / 64.0f) + 1e-6f);
                    float o4[4];
#pragma unroll
                    for (int j = 0; j < 4; ++j) { const float rv = BFX(rr[k], j); o4[j] = o[j] * rs2 * gnw[j] * (rv / (1.0f + __expf(-rv))); }
                    if (k == 0 || r2 != r) {
                        *(GAS unsigned long long*)(act1k + rk * 1024 + c0) = (unsigned long long)pk2(y[0] * rstd * snw.x, y[1] * rstd * snw.y) | ((unsigned long long)pk2(y[2] * rstd * snw.z, y[3] * rstd * snw.w) << 32);
                        *(GAS unsigned long long*)(act1k + rk * 1024 + 256 + c0) = (unsigned long long)pk2(o4[0], o4[1]) | ((unsigned long long)pk2(o4[2], o4[3]) << 32); } }
            }
#undef BFX
        }
        SEAM(pb + 7);
        if (IN(pb + 8)) { IDS();
            pg8::Gemm g{act1k, Wout + (size_t)l * 1024 * 1024, NREG, 1024, 1024}; pg8::StaticOrder S; S.init(NREG, 1024, G, bid);
            pg8::EpiResid<(l != 0)> E{l == 0 ? (const void*)INP(IN_X) : (const void*)hreg, (bf16*)hreg};
            pg8::gemm_phase<pg8::EpiResid<(l != 0)>, pg8::StaticOrder, true, true>(lds, g, S, E);
            if (l == 0) {
                const int fr = lane & 15, quad = lane >> 4;
                for (int task = gw; task < 8 * 64; task += NGW) { const int rb = task >> 6, cb = task & 63;
                    const f32x4 acc = skinny_part<16>(act1k + (size_t)NREG * 1024, 1024, rb, Wout, 1024, cb * 16, 1024, lane);
#pragma unroll
                    for (int j = 0; j < 4; ++j) { const int mr = 16 * rb + 4 * quad + j, c = cb * 16 + fr; hmeta[(size_t)mr * 1024 + c] = INP(IN_META)[(size_t)(mr % 16) * 1024 + c] + acc[j]; } }
            }
        }
        SEAM(pb + 8);
        if (l == 0) {
            for (int rep_ = 0; rep_ < PROBE_THIN_REP; ++rep_)
            if (IN(pb + 9)) { IDS();
                const float* w = INP(IN_NFFN); f32x4 wreg[4];
#pragma unroll
                for (int j = 0; j < 4; ++j) wreg[j] = ((const GAS f32x4*)w + lane)[64 * j];
                for (int r = gw; r < NREG; r += 2 * NGW) { const int r2 = r + NGW < NREG ? r + NGW : r;
                    rms_row2_to_bf16<true, true>((const bf16*)hreg + (size_t)r * HP, (const bf16*)hreg + (size_t)r2 * HP, wreg, act1k + (size_t)r * 1024, act1k + (size_t)r2 * 1024, lane, U8 + (size_t)r * 1024, U8 + (size_t)r2 * 1024, SA_U + r, SA_U + r2); }
                for (int r = NREG + gw; r < NTOK; r += NGW) { const float* s1 = hmeta + (size_t)(r - NREG) * 1024;
                    rms_row2_to_bf16(s1, s1, wreg, act1k + (size_t)r * 1024, act1k + (size_t)r * 1024, lane, U8 + (size_t)r * 1024, U8 + (size_t)r * 1024, SA_U + r, SA_U + r); }
                __syncthreads();
                { LAS float* scr = (LAS float*)(lds + wave * 16384);
                    quant_mat(INP(IN_FG), 1024, 2816, WGU8, SB_GU, CMAX_GU, 2, scr, gw, NGW, lane); quant_mat(INP(IN_FU), 1024, 2816, WGU8, SB_GU, CMAX_GU, 3, scr, gw, NGW, lane); }
            }
            SEAM(pb + 9);
#ifndef PROBE_FFNUP_REP
#define PROBE_FFNUP_REP 1
#endif
            for (int rep_ = 0; rep_ < PROBE_FFNUP_REP; ++rep_)
            if (IN(pb + 10)) { IDS();
                pg8::Gemm g{(const bf16*)U8, (const bf16*)WGU8, NREG, 5632, 512}; pg8::StaticOrder S; S.init(NREG, 5632, G, bid);
                pg8::EpiSwiGLU8 E{big, PW, 22, SA_U, SB_GU, 0, false};
                pg8::gemm_phase<pg8::EpiSwiGLU8, pg8::StaticOrder, true, true, false, false, true>(lds, g, S, E);
                { const int fr = lane & 15, quad = lane >> 4;
                    for (int task = gw; task < 8 * 176; task += NGW) { const int rb = task / 176, fg = task % 176, f0 = 16 * fg, brow = (f0 >> 7) * 256 + (f0 & 127);
                        pg8::i32x4 ag = {0, 0, 0, 0}, au = ag;
                        const signed char* ap = U8 + (size_t)(NREG + 16 * rb + fr) * 1024 + 16 * quad; const signed char* bq = WGU8 + (size_t)(brow + fr) * 1024 + 16 * quad;
#pragma unroll 8
                        for (int ks = 0; ks < 16; ++ks) { const pg8::i32x4 av = *(const GAS pg8::i32x4*)(ap + 64 * ks);
                            ag = __builtin_amdgcn_mfma_i32_16x16x64_i8(av, *(const GAS pg8::i32x4*)(bq + 64 * ks), ag, 0, 0, 0);
                            au = __builtin_amdgcn_mfma_i32_16x16x64_i8(av, *(const GAS pg8::i32x4*)(bq + (size_t)128 * 1024 + 64 * ks), au, 0, 0, 0); }
                        const float sbg = SB_GU[brow + fr], sbu = SB_GU[brow + 128 + fr];
#pragma unroll
                        for (int j = 0; j < 4; ++j) { const float sa_ = SA_U[NREG + 16 * rb + 4 * quad + j], gg = (float)ag[j] * sa_ * sbg, uu = (float)au[j] * sa_ * sbu;
                            big[(size_t)(NREG + 16 * rb + 4 * quad + j) * PW + f0 + fr] = f2bf(gg / (1.0f + __expf(-gg)) * uu); } } }
            }
            SEAM(pb + 10);
#ifndef PROBE_FFND_REP
#define PROBE_FFND_REP 1
#endif
            if (IN(pb + 11)) { IDS();
                pg8::Gemm g{big, Wd, NREG, 1024, 2816}; pg8::StaticOrder S; S.init(NREG, 1024, G, bid);
                for (int rep_ = 0; rep_ < PROBE_FFND_REP; ++rep_) {
                pg8::EpiResid<true> E{hreg, (bf16*)hreg, rep_ + 1 < PROBE_FFND_REP ? 0.0f : 1.0f};
                pg8::gemm_phase<pg8::EpiResid<true>, pg8::StaticOrder, true, true>(lds, g, S, E); }
                { const int fr = lane & 15, quad = lane >> 4;
                    for (int task = gw; task < 4 * 8 * 64; task += NGW) { const int kp = task >> 9, rb = (task >> 6) & 7, cb = task & 63;
                        const f32x4 acc = skinny_part<11>(big + (size_t)NREG * PW + kp * 704, PW, rb, Wd + kp * 704, 2816, cb * 16, 704, lane);
#pragma unroll
                        for (int j = 0; j < 4; ++j) hpart[((size_t)kp * 128 + 16 * rb + 4 * quad + j) * 1024 + cb * 16 + fr] = acc[j]; } }
            }
            SEAM(pb + 11);
        } else {
            for (int rep_ = 0; rep_ < PROBE_THIN_REP; ++rep_)
            if (IN(pb + 9)) { IDS();
                const float* w = INP(IN_NFFN) + 1024; const float* rw = INP(IN_ROUTER);
                LAS int* lcnt = (LAS int*)lds;
                f32x4 nwr[4];
#pragma unroll
                for (int j = 0; j < 4; ++j) nwr[j] = ((const GAS f32x4*)w + lane)[64 * j];
                f32x4 rwr[4][4][2];
#pragma unroll
                for (int j = 0; j < 4; ++j)
#pragma unroll
                    for (int c = 0; c < 4; ++c) { const GAS f32x4* rp = (const GAS f32x4*)(rw + (size_t)(4 * lane + 256 * j + c) * 8); rwr[j][c][0] = rp[0]; rwr[j][c][1] = rp[1]; }
                if (tid < 16) lcnt[tid] = 0;
                __syncthreads();
                for (int r0 = gw; r0 < NREG; r0 += 2 * NGW) {
                    f32x4 v[2][4];
#pragma unroll
                    for (int q = 0; q < 2; ++q) { const int r = r0 + q * NGW < NREG ? r0 + q * NGW : r0; const GAS unsigned long long* xr = (const GAS unsigned long long*)((const bf16*)hreg + (size_t)r * HP) + lane;
#pragma unroll
                        for (int j = 0; j < 4; ++j) v[q][j] = bf4_f32(xr[64 * j]); }
#pragma unroll
                    for (int q = 0; q < 2; ++q) { const int r = r0 + q * NGW;
                        if (r < NREG) {
                            float s = 0.f;
#pragma unroll
                            for (int j = 0; j < 4; ++j) s += (v[q][j].x * v[q][j].x + v[q][j].y * v[q][j].y) + (v[q][j].z * v[q][j].z + v[q][j].w * v[q][j].w);
                            const float rstd = 1.f / sqrtf(wave_sum(s) * (1.f / 1024.f) + 1e-6f);
                            float lg[8];
#pragma unroll
                            for (int e = 0; e < 8; ++e) lg[e] = 0.f;
                            float umx = 0.f;
#pragma unroll
                            for (int j = 0; j < 4; ++j) { const f32x4 ww = nwr[j]; const f32x4 uu = v[q][j] * rstd * ww; umx = fmaxf(fmaxf(umx, fmaxf(fabsf(uu.x), fabsf(uu.y))), fmaxf(fabsf(uu.z), fabsf(uu.w))); }
#pragma unroll
                            for (int o = 1; o < 64; o <<= 1) umx = fmaxf(umx, __shfl_xor(umx, o));
                            const float uqs = umx > 0.f ? 127.0f / umx : 0.f; if (lane == 0) SA_U[r] = umx * (1.0f / 127.0f);
#pragma unroll
                            for (int j = 0; j < 4; ++j) { const f32x4 ww = nwr[j]; const f32x4 uu = v[q][j] * rstd * ww;
                                *((GAS unsigned*)(U8 + (size_t)r * 1024) + lane + 64 * j) = ((unsigned)((int)rintf(uu.x * uqs)) & 0xffu) | (((unsigned)((int)rintf(uu.y * uqs)) & 0xffu) << 8) | (((unsigned)((int)rintf(uu.z * uqs)) & 0xffu) << 16) | (((unsigned)((int)rintf(uu.w * uqs)) & 0xffu) << 24);
#pragma unroll
                                for (int c = 0; c < 4; ++c) { const f32x4 r0_ = rwr[j][c][0], r1_ = rwr[j][c][1]; const float uc = uu[c];
                                    lg[0] += uc * r0_.x; lg[1] += uc * r0_.y; lg[2] += uc * r0_.z; lg[3] += uc * r0_.w; lg[4] += uc * r1_.x; lg[5] += uc * r1_.y; lg[6] += uc * r1_.z; lg[7] += uc * r1_.w; } }
                            const bool h5 = lane & 32, h4 = lane & 16, h3 = lane & 8; float a4[4], b2[2], c1;
#pragma unroll
                            for (int k = 0; k < 4; ++k) a4[k] = (h5 ? lg[4 + k] : lg[k]) + __shfl_xor(h5 ? lg[k] : lg[4 + k], 32);
#pragma unroll
                            for (int k = 0; k < 2; ++k) b2[k] = (h4 ? a4[2 + k] : a4[k]) + __shfl_xor(h4 ? a4[k] : a4[2 + k], 16);
                            c1 = (h3 ? b2[1] : b2[0]) + __shfl_xor(h3 ? b2[0] : b2[1], 8);
                            c1 += __shfl_xor(c1, 4); c1 += __shfl_xor(c1, 2); c1 += __shfl_xor(c1, 1);
#pragma unroll
                            for (int e = 0; e < 8; ++e) lg[e] = __shfl(c1, ((e & 4) ? 32 : 0) + ((e & 2) ? 16 : 0) + ((e & 1) ? 8 : 0));
                            int i0 = 0; float v0 = lg[0];
#pragma unroll
                            for (int e = 1; e < 8; ++e) if (lg[e] > v0) { v0 = lg[e]; i0 = e; }
                            int i1 = -1; float v1 = -3.0e38f;
#pragma unroll
                            for (int e = 0; e < 8; ++e) if (e != i0 && lg[e] > v1) { v1 = lg[e]; i1 = e; }
                            if (lane == 0) { const float g1 = 1.0f / (1.0f + __expf(v0 - v1)); const int k0 = __hip_atomic_fetch_add(lcnt + i0, 1, __ATOMIC_RELAXED, __HIP_MEMORY_SCOPE_WORKGROUP), k1 = __hip_atomic_fetch_add(lcnt + 8 + i1, 1, __ATOMIC_RELAXED, __HIP_MEMORY_SCOPE_WORKGROUP);
                                rt_e[r] = i0 | (i1 << 8); rt_rank[r] = k0 | (k1 << 16); rt_g[2 * r] = 1.0f - g1; rt_g[2 * r + 1] = g1; }
                        } }
                }
                __syncthreads();
                if (tid < 16) blkcnt[bid * 16 + tid] = lcnt[tid];
            }
            SEAM(pb + 9);
#ifndef PROBE_SORT_REP
#define PROBE_SORT_REP 1
#endif
            for (int rep_ = 0; rep_ < PROBE_SORT_REP; ++rep_)
            if (IN(PH_SORT)) { IDS();
                LAS int* tot = (LAS int*)lds; LAS int* pre = tot + 16; LAS int* roff = tot + 32; LAS int* ntl = tot + 48;
                if (tid < 64) tot[tid] = 0;
                __syncthreads();
                { const int sgm = tid & 15, part = tid >> 4; int a = 0, bfore = 0;
                    for (int k = 0; k < 8; ++k) { const int wgi = part * 8 + k; if (wgi < G) { const int cv = blkcnt[wgi * 16 + sgm]; a += cv; if (wgi < bid) bfore += cv; } }
                    __hip_atomic_fetch_add(tot + sgm, a, __ATOMIC_RELAXED, __HIP_MEMORY_SCOPE_WORKGROUP); __hip_atomic_fetch_add(pre + sgm, bfore, __ATOMIC_RELAXED, __HIP_MEMORY_SCOPE_WORKGROUP); }
                __syncthreads();
                if (tid == 0) {
                    int tile = 0, T0 = 0;
                    for (int sg = 0; sg < 16; ++sg) { const int nt = (tot[sg] + 255) >> 8; roff[sg] = tile * 256; ntl[sg] = nt; if (bid == 0) for (int k = 0; k < nt; ++k) texp[tile + k] = sg & 7; tile += nt; if (sg == 7) T0 = tile; }
                    if (bid == 0) { const int T1 = tile - T0;
                        int p1 = T0 >= 64 && T0 - 64 <= CAP_TILES ? 64 : (T0 + 1) / 2, p2 = T1 >= 64 && T1 - 64 <= CAP_TILES ? T1 - 64 : (T1 + 1) / 2;
                        passt[0] = 0; passt[1] = p1; passt[2] = T0; passt[3] = T0 + p2; passt[4] = tile; }
                }
                __syncthreads();
                if (bid < 16) { const int b0 = roff[bid] + tot[bid], b1 = roff[bid] + ntl[bid] * 256; for (int i = b0 + tid; i < b1; i += NWAVES * 64) { stok[i] = -1; stokp[permp(i)] = -1; sgate[i] = 0.f; ssa[i] = 0.f; } }
                for (int k = lane; gw + k * NGW < NREG; k += 64) { const int r = gw + k * NGW;
                    { const int e = rt_e[r], rk = rt_rank[r]; const int e0 = e & 255, e1 = 8 + (e >> 8);
                        const int p0 = roff[e0] + pre[e0] + (rk & 0xffff), p1 = roff[e1] + pre[e1] + (rk >> 16);
                        const float sar = SA_U[r];
                        stok[p0] = r; stokp[permp(p0)] = r; sgate[p0] = rt_g[2 * r]; ssa[p0] = sar; stok[p1] = r; stokp[permp(p1)] = r; sgate[p1] = rt_g[2 * r + 1]; ssa[p1] = sar; } }
#ifndef PROBE_IDENT
#define PROBE_IDENT 0
#endif
                if (PROBE_IDENT) for (long i = gtid; i < MAX_SROWS; i += (long)G * NWAVES * 64) ((int*)(ws + WS_DTGA))[i] = (int)(i & 32767);
                __syncthreads();
            }
            SEAM(PH_SORT);
#ifndef PROBE_DK_HALF
#define PROBE_DK_HALF 0
#endif
#ifndef PROBE_MOE_REP
#define PROBE_MOE_REP 1
#endif
#pragma unroll 1
            for (int p_ = 0; p_ < 5 * PROBE_MOE_REP; ++p_) { const int p = p_ % 5; const float gscale_ = p_ < 5 * (PROBE_MOE_REP - 1) ? 0.0f : 1.0f;
                OPAQUE_RANGE();
                if (IN(PH_PASS0 + p)) { IDS();
                    int nd = 0;
                    LAS int* lexd = (LAS int*)(lds + 139264); LAS int* lexg = lexd + 128;
                    if (p > 0) { const int t0 = passt[p - 1], n = passt[p] - t0; if (tid < n) lexd[tid] = texp[t0 + tid]; }
                    if (p < 4) { const int t0 = passt[p], n = passt[p + 1] - t0; if (tid < n) lexg[tid] = texp[t0 + tid]; }
                    __syncthreads();
                    if (p > 0) {
                        const int t0 = passt[p - 1], t1 = passt[p]; nd = (t1 - t0) * 4;
                        pg8::Gemm g{(const bf16*)(ws + WS_BIG + (size_t)((p - 1) & 1) * MOE_ACT_BYTES), (const bf16*)WMD8, CAP_TILES * 256, 8 * 1024, (PROBE_DK_HALF && gscale_ == 0.0f) ? 896 : 1792}; pg8::MoeOrder S{t0, t1 - t0, 4, G, bid, 0, lexd, stok, t0 * 256};
                        pg8::EpiMoeDown E{p >= 3 ? Y1LO : YLO, p >= 3 ? (long)(Y1HI - Y1LO) : (long)(YHI - YLO), stok, sgate, t0 * 256, gscale_ * f8_scale(*AMAX_MD, true)};
                        pg8::gemm_phase<pg8::EpiMoeDown, pg8::MoeOrder, true, true, false, true, false, true>(lds, g, S, E);
                    }
                    if (p < 4) {
                        const int t0 = passt[p], t1 = passt[p + 1];
                        pg8::Gemm g{(const bf16*)U8, (const bf16*)WMGU8, NREG, 8 * 7168, 512}; pg8::MoeOrder S{t0, t1 - t0, 28, G, bid, nd > G ? nd - G : 0, lexg, stok, t0 * 256, stokp};
                        pg8::EpiSwiGLU8 E{(bf16*)(ws + WS_BIG + (size_t)(p & 1) * MOE_ACT_BYTES), 3584, 28, ssa, SB_MGU, t0 * 256, true};
                        pg8::gemm_phase<pg8::EpiSwiGLU8, pg8::MoeOrder, true, true, true, false, true>(lds, g, S, E);
                    }
                }
                SEAM(PH_PASS0 + p);
            }
#ifndef PROBE_BAR_REP
#define PROBE_BAR_REP 0
#endif
            for (int rep_ = 0; rep_ < PROBE_BAR_REP; ++rep_) xcd_barrier_lean(bar);
            if (IN(PH_FINAL)) { IDS();
                const float* w = INP(IN_FINAL); f32x4 fwr[4];
#pragma unroll
                for (int j = 0; j < 4; ++j) fwr[j] = ((const GAS f32x4*)w + lane)[64 * j];
                for (int r = gw; r < NREG; r += 2 * NGW) { const int r2 = r + NGW < NREG ? r + NGW : r;
                    GAS f32x4* xa = (GAS f32x4*)(hreg + (size_t)r * 1024) + lane; GAS f32x4* xb = (GAS f32x4*)(hreg + (size_t)r2 * 1024) + lane;
                    f32x4 va[4], vb[4]; float sa = 0.f, sb = 0.f;
                    { const GAS unsigned long long* ha = (const GAS unsigned long long*)((const bf16*)hreg + (size_t)r * HP) + lane; const GAS unsigned long long* hb_ = (const GAS unsigned long long*)((const bf16*)hreg + (size_t)r2 * HP) + lane;
#pragma unroll
                    for (int j = 0; j < 4; ++j) { va[j] = bf4_f32(ha[64 * j]); vb[j] = bf4_f32(hb_[64 * j]); } }
#pragma unroll
                    for (int sl = 0; sl < 2; ++sl)
#pragma unroll
                    for (int j = 0; j < 4; ++j) { const bf16* yb_ = sl == 0 ? (j < 2 ? YLO : YHI) : (j < 2 ? Y1LO : Y1HI); const int cy = 4 * lane + 256 * (j & 1);
                        const unsigned long long qa = *(const GAS unsigned long long*)(yb_ + (size_t)r * 512 + cy), qb = *(const GAS unsigned long long*)(yb_ + (size_t)r2 * 512 + cy);
                        va[j].x += __uint_as_float((unsigned)qa << 16); va[j].y += __uint_as_float((unsigned)qa & 0xffff0000u); va[j].z += __uint_as_float((unsigned)(qa >> 32) << 16); va[j].w += __uint_as_float((unsigned)(qa >> 32) & 0xffff0000u);
                        vb[j].x += __uint_as_float((unsigned)qb << 16); vb[j].y += __uint_as_float((unsigned)qb & 0xffff0000u); vb[j].z += __uint_as_float((unsigned)(qb >> 32) << 16); vb[j].w += __uint_as_float((unsigned)(qb >> 32) & 0xffff0000u); }
#pragma unroll
                    for (int j = 0; j < 4; ++j) { sa += (va[j].x * va[j].x + va[j].y * va[j].y) + (va[j].z * va[j].z + va[j].w * va[j].w); sb += (vb[j].x * vb[j].x + vb[j].y * vb[j].y) + (vb[j].z * vb[j].z + vb[j].w * vb[j].w); }
                    const float ra = 1.f / sqrtf(wave_sum_sw(sa) * (1.f / 1024.f) + 1e-6f), rb = 1.f / sqrtf(wave_sum_sw(sb) * (1.f / 1024.f) + 1e-6f);
#pragma unroll
                    for (int j = 0; j < 4; ++j) { const f32x4 ww = fwr[j]; xa[64 * j] = va[j] * ra * ww; if (r2 != r) xb[64 * j] = vb[j] * rb * ww; }
                }
            }
        }
    }
    }

#undef IN
#undef SEAM
}

extern "C" void kernel_launch(void* const* d_in, const int* in_sizes, int n_in, void* d_out, int out_size, void* d_ws, size_t ws_size, hipStream_t stream) {
    static int grid = 0;
    if (grid == 0) {
        if (n_in != 27 || ws_size < WS_END || out_size != NREG * 1024) { fprintf(stderr, "kernel_launch: unexpected problem (n_in %d, ws %zu, out %d)\n", n_in, ws_size, out_size); grid = -1; return; }
        int dev = 0, cus = 0;
        if (hipGetDevice(&dev) != hipSuccess || hipDeviceGetAttribute(&cus, hipDeviceAttributeMultiprocessorCount, dev) != hipSuccess) { grid = -1; return; }
        if (hipFuncSetAttribute((const void*)fwd_kernel, hipFuncAttributeMaxDynamicSharedMemorySize, LDS_BYTES) != hipSuccess) { fprintf(stderr, "kernel_launch: hipFuncSetAttribute failed\n"); grid = -1; return; }
        int per_cu = 0;
        if (hipOccupancyMaxActiveBlocksPerMultiprocessor(&per_cu, (const void*)fwd_kernel, NWAVES * 64, LDS_BYTES) != hipSuccess || per_cu < 1) fprintf(stderr, "kernel_launch: occupancy query reports %d workgroups per CU\n", per_cu);
        (void)hipGetLastError();
        grid = cus;
    }
    if (grid < 0) return;
    (void)hipMemsetAsync((char*)d_ws + WS_CTL, 0, CTL_ZERO_BYTES, stream);
    Args a{};
    for (int i = 0; i < 27; ++i) a.in[i] = (const float*)d_in[i];
    a.out = (float*)d_out; a.ws = (unsigned char*)d_ws;
#if N_LAUNCH_MODE == 1
    a.ph_lo = 0; a.ph_hi = PH_END;
    hipLaunchKernelGGL(fwd_kernel, dim3(grid), dim3(NWAVES * 64), LDS_BYTES, stream, a);
#else
    for (int ph = 0; ph < PH_END; ++ph) {
        const bool used = ph == 0 || (ph >= PH_L0 && ph < PH_L0 + 12) || (ph >= PH_L1 && ph < PH_L1 + 10) || ph >= PH_SORT;
        if (!used) continue;
        a.ph_lo = ph; a.ph_hi = ph + 1;
        hipLaunchKernelGGL(fwd_kernel, dim3(grid), dim3(NWAVES * 64), LDS_BYTES, stream, a);
    }
#endif
}
```
